# Optimizing an MI355X kernel written in HIP

```python
import jax, jax.numpy as jnp
from jax import lax
import numpy as np

D_MODEL = 2048
BATCH = 8
SEQ = 2048
DEPTH = 4
DEC_BATCH = 32
DEC_SEQ = 32
PAST_LEN = 4096

CHUNK = 64
D_POOL = 1024
POOL_WINDOWS = (2, 4, 8, 16)
N_POOL_GROUPS = 4
POOL_GROUP = D_POOL // N_POOL_GROUPS
POOL_HIST = max(POOL_WINDOWS) - 1
D_SSD = 2048
SSD_HEAD_DIM = 64
SSD_HEADS = D_SSD // SSD_HEAD_DIM
SSD_GROUPS = 2
HEADS_PER_GROUP = SSD_HEADS // SSD_GROUPS
D_STATE = 128
SSD_CONV = 4
CONV_DIM = D_SSD + 2 * SSD_GROUPS * D_STATE
D_MIX = D_POOL + D_SSD
D_IN_PROJ = D_POOL + D_SSD + CONV_DIM + SSD_HEADS
D_FF = 5632
FFN_CONV = 3
EPS = 1e-6

kernel_name = "pool_ssd_hybrid_streaming_step"


def rmsnorm(x, g):
    xf = x.astype(jnp.float32)
    y = xf * lax.rsqrt(jnp.mean(xf * xf, axis=-1, keepdims=True) + EPS)
    return (y * g.astype(jnp.float32)).astype(x.dtype)


def causal_dwconv(x, hist, w, b):
    k = w.shape[0]
    s = x.shape[1]
    ext = jnp.concatenate([hist.astype(x.dtype), x], axis=1)
    out = ext[:, 0:s] * w[0]
    for i in range(1, k):
        out = out + ext[:, i:i + s] * w[i]
    return out + b, ext[:, -(k - 1):]


def pool_mixer(u, hist, pos, w_pool, pool_scale):
    s = u.shape[1]
    ext = jnp.concatenate([hist.astype(u.dtype), u], axis=1)
    cs = jnp.cumsum(ext.astype(jnp.float32), axis=1)
    cs = jnp.pad(cs, ((0, 0), (1, 0), (0, 0)))
    end = cs[:, POOL_HIST + 1:]
    means = []
    for gi, w in enumerate(POOL_WINDOWS):
        sl = slice(gi * POOL_GROUP, (gi + 1) * POOL_GROUP)
        start = cs[:, POOL_HIST + 1 - w:POOL_HIST + 1 - w + s, sl]
        cnt = jnp.minimum(pos + 1, w).astype(jnp.float32)[None, :, None]
        means.append((end[..., sl] - start) / cnt)
    mean = jnp.concatenate(means, axis=-1)
    d = (mean - u.astype(jnp.float32)).astype(u.dtype)
    d = d.reshape(u.shape[0], s, N_POOL_GROUPS, POOL_GROUP)
    y = jnp.einsum('bsgc,gcd->bsgd', d, w_pool).reshape(u.shape)
    return y * pool_scale, ext[:, -POOL_HIST:]


def ssd_scan(xh, dt, A, Bm, Cm, D, h0):
    b, s = xh.shape[0], xh.shape[1]
    q = min(CHUNK, s)
    c = s // q
    G, J, P, N = SSD_GROUPS, HEADS_PER_GROUP, SSD_HEAD_DIM, D_STATE
    xc = (xh * dt[..., None]).reshape(b, c, q, G, J, P)
    Bc = Bm.reshape(b, c, q, G, N)
    Cc = Cm.reshape(b, c, q, G, N)
    a = jnp.moveaxis((dt * A).reshape(b, c, q, G, J), 2, -1)
    acum = jnp.cumsum(a, axis=-1)
    diff = acum[..., :, None] - acum[..., None, :]
    causal = jnp.tril(jnp.ones((q, q), dtype=bool))
    lmat = jnp.exp(jnp.where(causal, diff, -jnp.inf))
    cb = jnp.einsum('bclgn,bcsgn->bcgls', Cc, Bc)
    y_diag = jnp.einsum('bcgls,bcgjls,bcsgjp->bclgjp', cb, lmat, xc)
    decay_states = jnp.exp(acum[..., -1:] - acum)
    states = jnp.einsum('bclgn,bcgjl,bclgjp->bcgjpn', Bc, decay_states, xc)
    chunk_decay = jnp.exp(acum[..., -1])

    def step(h, inp):
        dec, st = inp
        return dec[..., None, None] * h + st, h

    h_last, h_prev = lax.scan(step, h0, (jnp.moveaxis(chunk_decay, 1, 0), jnp.moveaxis(states, 1, 0)))
    h_prev = jnp.moveaxis(h_prev, 0, 1)
    y_off = jnp.einsum('bclgn,bcgjpn,bcgjl->bclgjp', Cc, h_prev, jnp.exp(acum))
    y = (y_diag + y_off).reshape(b, s, G, J, P) + D[..., None] * xh
    return y, h_last


def ssd_mixer(z, xbc, dt_raw, conv_hist, h0, conv_w, conv_b, dt_bias, a_log, d_skip, norm_g):
    b, s = z.shape[0], z.shape[1]
    G, J, P, N = SSD_GROUPS, HEADS_PER_GROUP, SSD_HEAD_DIM, D_STATE
    xbc, new_conv = causal_dwconv(xbc, conv_hist, conv_w, conv_b)
    xbc = jax.nn.silu(xbc).astype(jnp.float32)
    xs = xbc[..., :D_SSD].reshape(b, s, G, J, P)
    Bm = xbc[..., D_SSD:D_SSD + G * N].reshape(b, s, G, N)
    Cm = xbc[..., D_SSD + G * N:].reshape(b, s, G, N)
    dt = jax.nn.softplus(dt_raw.astype(jnp.float32) + dt_bias.astype(jnp.float32)).reshape(b, s, G, J)
    A = -jnp.exp(a_log.astype(jnp.float32)).reshape(G, J)
    h0f = h0.astype(jnp.float32).reshape(b, G, J, P, N)
    y, h_last = ssd_scan(xs, dt, A, Bm, Cm, d_skip.astype(jnp.float32).reshape(G, J), h0f)
    y = y * jax.nn.silu(z.astype(jnp.float32)).reshape(b, s, G, J, P)
    yg = y.reshape(b, s, G, J * P)
    yg = yg * lax.rsqrt(jnp.mean(yg * yg, axis=-1, keepdims=True) + EPS)
    yg = yg * norm_g.astype(jnp.float32).reshape(G, J * P)
    y_out = yg.reshape(b, s, D_SSD).astype(z.dtype)
    return y_out, new_conv, h_last.reshape(b, SSD_HEADS, P, N).astype(h0.dtype)


def run_layer(x, pos, hist_pool, hist_sconv, h0, hist_fconv, p):
    xn = rmsnorm(x, p['norm_mix_pre'])
    proj = xn @ p['w_in']
    o1 = D_POOL
    o2 = o1 + D_SSD
    o3 = o2 + CONV_DIM
    u, z, xbc, dt_raw = proj[..., :o1], proj[..., o1:o2], proj[..., o2:o3], proj[..., o3:]
    y_pool, new_pool = pool_mixer(u, hist_pool, pos, p['w_pool'], p['pool_scale'])
    y_ssd, new_sconv, new_h = ssd_mixer(z, xbc, dt_raw, hist_sconv, h0, p['ssd_conv_w'], p['ssd_conv_b'],
                                        p['ssd_dt_bias'], p['ssd_a_log'], p['ssd_d'], p['ssd_norm'])
    mix = jnp.concatenate([y_pool, y_ssd], axis=-1) @ p['w_out']
    x = x + rmsnorm(mix, p['norm_mix_post'])
    hn = rmsnorm(x, p['norm_ffn_pre'])
    up = hn @ p['w_up']
    up, new_fconv = causal_dwconv(up, hist_fconv, p['ffn_conv_w'], p['ffn_conv_b'])
    gate, val = up[..., :D_FF], up[..., D_FF:]
    f = (jax.nn.silu(gate) * val) @ p['w_down']
    x = x + rmsnorm(f, p['norm_ffn_post'])
    return x, new_pool, new_sconv, new_h, new_fconv


def setup_inputs(seed: int = 0) -> dict:
    key = jax.random.key(seed)
    ks = jax.random.split(key, 32)
    f32 = jnp.float32
    nrm = lambda k, shape, sc: jax.random.normal(k, shape, f32) * sc
    gain = lambda k, shape: 1.0 + 0.1 * jax.random.normal(k, shape, f32)
    dt0 = jnp.exp(jax.random.uniform(ks[10], (DEPTH, SSD_HEADS), f32, np.log(1e-3), np.log(1e-1)))
    return {
        "x_prompt": nrm(ks[0], (BATCH, SEQ, D_MODEL), 1.0),
        "x_sample": nrm(ks[1], (DEC_BATCH, DEC_SEQ, D_MODEL), 1.0),
        "cache_pool": nrm(ks[2], (DEPTH, DEC_BATCH, POOL_HIST, D_POOL), 1.0),
        "state_ssd_conv": nrm(ks[3], (DEPTH, DEC_BATCH, SSD_CONV - 1, CONV_DIM), 1.0),
        "state_ssd": nrm(ks[4], (DEPTH, DEC_BATCH, SSD_HEADS, SSD_HEAD_DIM, D_STATE), 0.1),
        "state_ffn_conv": nrm(ks[5], (DEPTH, DEC_BATCH, FFN_CONV - 1, 2 * D_FF), 1.0),
        "norm_mix_pre": gain(ks[6], (DEPTH, D_MODEL)),
        "w_in": nrm(ks[7], (DEPTH, D_MODEL, D_IN_PROJ), D_MODEL ** -0.5),
        "w_pool": nrm(ks[8], (DEPTH, N_POOL_GROUPS, POOL_GROUP, POOL_GROUP), POOL_GROUP ** -0.5),
        "pool_scale": gain(ks[9], (DEPTH, D_POOL)),
        "ssd_conv_w": nrm(ks[11], (DEPTH, SSD_CONV, CONV_DIM), SSD_CONV ** -0.5),
        "ssd_conv_b": nrm(ks[12], (DEPTH, CONV_DIM), 0.02),
        "ssd_dt_bias": dt0 + jnp.log(-jnp.expm1(-dt0)),
        "ssd_a_log": jnp.log(jax.random.uniform(ks[13], (DEPTH, SSD_HEADS), f32, 1.0, 16.0)),
        "ssd_d": gain(ks[14], (DEPTH, SSD_HEADS)),
        "ssd_norm": gain(ks[15], (DEPTH, D_SSD)),
        "w_out": nrm(ks[16], (DEPTH, D_MIX, D_MODEL), D_MIX ** -0.5),
        "norm_mix_post": gain(ks[17], (DEPTH, D_MODEL)),
        "norm_ffn_pre": gain(ks[18], (DEPTH, D_MODEL)),
        "w_up": nrm(ks[19], (DEPTH, D_MODEL, 2 * D_FF), D_MODEL ** -0.5),
        "ffn_conv_w": nrm(ks[20], (DEPTH, FFN_CONV, 2 * D_FF), FFN_CONV ** -0.5),
        "ffn_conv_b": nrm(ks[21], (DEPTH, 2 * D_FF), 0.02),
        "w_down": nrm(ks[22], (DEPTH, D_FF, D_MODEL), D_FF ** -0.5),
        "norm_ffn_post": gain(ks[23], (DEPTH, D_MODEL)),
    }


def reference(x_prompt, x_sample, cache_pool, state_ssd_conv, state_ssd, state_ffn_conv,
              norm_mix_pre, w_in, w_pool, pool_scale, ssd_conv_w, ssd_conv_b, ssd_dt_bias,
              ssd_a_log, ssd_d, ssd_norm, w_out, norm_mix_post, norm_ffn_pre, w_up,
              ffn_conv_w, ffn_conv_b, w_down, norm_ffn_post):
    bp, sp = x_prompt.shape[0], x_prompt.shape[1]
    sd = x_sample.shape[1]
    dtp = x_prompt.dtype
    pos_p = jnp.arange(sp, dtype=jnp.int32)
    pos_s = PAST_LEN + jnp.arange(sd, dtype=jnp.int32)
    zp_pool = jnp.zeros((bp, POOL_HIST, D_POOL), dtp)
    zp_sconv = jnp.zeros((bp, SSD_CONV - 1, CONV_DIM), dtp)
    zp_h = jnp.zeros((bp, SSD_HEADS, SSD_HEAD_DIM, D_STATE), state_ssd.dtype)
    zp_fconv = jnp.zeros((bp, FFN_CONV - 1, 2 * D_FF), dtp)

    xp, xs = x_prompt, x_sample
    pool_p, pool_s, sconv_p, sconv_s, h_p, h_s, fconv_p, fconv_s = [], [], [], [], [], [], [], []
    for l in range(DEPTH):
        p = dict(norm_mix_pre=norm_mix_pre[l], w_in=w_in[l], w_pool=w_pool[l], pool_scale=pool_scale[l],
                 ssd_conv_w=ssd_conv_w[l], ssd_conv_b=ssd_conv_b[l], ssd_dt_bias=ssd_dt_bias[l],
                 ssd_a_log=ssd_a_log[l], ssd_d=ssd_d[l], ssd_norm=ssd_norm[l], w_out=w_out[l],
                 norm_mix_post=norm_mix_post[l], norm_ffn_pre=norm_ffn_pre[l], w_up=w_up[l],
                 ffn_conv_w=ffn_conv_w[l], ffn_conv_b=ffn_conv_b[l], w_down=w_down[l],
                 norm_ffn_post=norm_ffn_post[l])
        xp, a1, a2, a3, a4 = run_layer(xp, pos_p, zp_pool, zp_sconv, zp_h, zp_fconv, p)
        xs, b1, b2, b3, b4 = run_layer(xs, pos_s, cache_pool[l], state_ssd_conv[l], state_ssd[l],
                                       state_ffn_conv[l], p)
        pool_p.append(a1); sconv_p.append(a2); h_p.append(a3); fconv_p.append(a4)
        pool_s.append(b1); sconv_s.append(b2); h_s.append(b3); fconv_s.append(b4)

    return (xp, xs,
            jnp.stack(pool_p), jnp.stack(pool_s),
            jnp.stack(sconv_p), jnp.stack(sconv_s),
            jnp.stack(h_p), jnp.stack(h_s),
            jnp.stack(fconv_p), jnp.stack(fconv_s))
```

```cpp
#include <hip/hip_runtime.h>
#include <cstdio>
#include <cstdint>

#ifndef MK_MULTI
#define MK_MULTI 1
#endif

namespace pg8 {
#define PG8_LAS __attribute__((address_space(3)))
typedef unsigned short bf16_t;
typedef short bf16x8 __attribute__((ext_vector_type(8)));
typedef float f32x4 __attribute__((ext_vector_type(4)));
typedef unsigned u32x4 __attribute__((ext_vector_type(4)));
constexpr int BM = 256, BK = 64, HALF = 128, HTB = HALF * BK * 2, STAGE_BYTES = 8 * HTB, NXCD = 8, WGM = 8;

__host__ __device__ __forceinline__ int lds_byte(int r, int c) { const int st = (r >> 4) * 2 + (c >> 5), rr = r & 15, cc = c & 31, ob = rr * 64 + cc * 2; return st * 1024 + (ob ^ (((ob >> 9) & 1) << 5)); }
__host__ __device__ __forceinline__ void stage_rc(int b, int& R, int& C) { const int st = b / 1024, sb = b % 1024, swz = sb ^ (((sb >> 9) & 1) << 5); R = (st >> 1) * 16 + swz / 64; C = (st & 1) * 32 + (swz % 64) / 2; }
__host__ __device__ __forceinline__ int perm32(int rho) { const int n = rho >> 4, i = rho & 15; return 8 * (i >> 2) + 4 * n + (i & 3); }

struct Unit { int pm, pn; };
struct Gemm { const bf16_t* A; const bf16_t* Bt; int M, N, K, lda, ldb; };

struct StaticOrder {
    int nM, nN, nwg, G, c;
    __host__ __device__ void init(int M, int N, int G_, int c_) { nM = M / BM; nN = N / BM; nwg = nM * nN; G = G_; c = c_; }
    __host__ __device__ bool next(int i, Unit& u) const {
        const long L = (long)i * G + c; if (L >= nwg) return false;
        int wgid = (int)L; { const int q = nwg / NXCD, r = nwg % NXCD, xcd = wgid % NXCD, off = wgid / NXCD; wgid = (xcd < r ? xcd * (q + 1) : r * (q + 1) + (xcd - r) * q) + off; }
        const int nig = WGM * nN, gid = wgid / nig, fm = gid * WGM, gsz = (nM - fm) < WGM ? (nM - fm) : WGM;
        u.pm = fm + ((wgid % nig) % gsz); u.pn = (wgid % nig) / gsz; return true;
    }
    __device__ __forceinline__ void a_ready(const Unit&) const {}
    __device__ __forceinline__ void done(const Unit&) const {}
};

__device__ __forceinline__ unsigned cvt_pk_bf16(float lo, float hi) { unsigned r; asm volatile("v_cvt_pk_bf16_f32 %0, %1, %2" : "=v"(r) : "v"(lo), "v"(hi)); return r; }

struct EpiBf16S {
    static constexpr bool PERM = true, AFTER_DRAIN = false;
    bf16_t* O; int ldc; const float* rs; float* dt; int dt_pn;
    __device__ __forceinline__ void operator()(const f32x4 (&acc)[2][2][4][2], const Unit& u, int wr, int wc, int fr, int fq) const {
        const int row0 = u.pm * BM + wr * 64 + fr;
        if (u.pn == dt_pn) {
            if (wc == 0) {
#pragma unroll
                for (int ai = 0; ai < 2; ++ai)
#pragma unroll
                    for (int m = 0; m < 4; ++m) { const int row = row0 + ai * HALF + m * 16; const float s = rs ? rs[row] : 1.f;
#pragma unroll
                        for (int n = 0; n < 2; ++n) *(f32x4*)(dt + (size_t)row * 32 + 8 * fq + 4 * n) = acc[ai][0][m][n] * s; }
            }
            return;
        }
        const int col0 = u.pn * BM + wc * 32 + 8 * fq;
#pragma unroll
        for (int ai = 0; ai < 2; ++ai)
#pragma unroll
            for (int m = 0; m < 4; ++m) { const int row = row0 + ai * HALF + m * 16; const float s = rs ? rs[row] : 1.f; bf16_t* rowp = O + (size_t)row * ldc + col0;
#pragma unroll
                for (int bj = 0; bj < 2; ++bj) { const f32x4 v0 = acc[ai][bj][m][0] * s, v1 = acc[ai][bj][m][1] * s;
                    u32x4 w; w.x = cvt_pk_bf16(v0[0], v0[1]); w.y = cvt_pk_bf16(v0[2], v0[3]); w.z = cvt_pk_bf16(v1[0], v1[1]); w.w = cvt_pk_bf16(v1[2], v1[3]);
                    *(u32x4*)(rowp + bj * HALF) = w; } }
    }
};
struct EpiF32Ssq {
    static constexpr bool PERM = false, AFTER_DRAIN = false;
    float* C; int ldc; float* ssq;
    __device__ __forceinline__ void operator()(const f32x4 (&acc)[2][2][4][2], const Unit& u, int wr, int wc, int fr, int fq) const {
        const int row0 = u.pm * BM + wr * 64 + fr, col0 = u.pn * BM + wc * 32 + 4 * fq;
#pragma unroll
        for (int ai = 0; ai < 2; ++ai)
#pragma unroll
            for (int m = 0; m < 4; ++m) { const int row = row0 + ai * HALF + m * 16; float* rowp = C + (size_t)row * ldc + col0; float q = 0.f;
#pragma unroll
                for (int bj = 0; bj < 2; ++bj)
#pragma unroll
                    for (int n = 0; n < 2; ++n) { const f32x4 v = acc[ai][bj][m][n]; *(f32x4*)(rowp + bj * HALF + n * 16) = v; q += (v[0] * v[0] + v[1] * v[1]) + (v[2] * v[2] + v[3] * v[3]); }
                q += __shfl_xor(q, 16); q += __shfl_xor(q, 32);
                if (fq == 0) ssq[(size_t)row * 32 + u.pn * 4 + wc] = q; }
    }
};

template <class Epi, class Sched, bool ALIGN_EPI = false, bool SP2 = false>
__device__ __forceinline__ void gemm_phase(PG8_LAS unsigned char* lds, const Gemm g, const Sched& S, const Epi& E) {
    int tid_ = threadIdx.x; asm volatile("" : "+v"(tid_));
    const int tid = tid_, wid = __builtin_amdgcn_readfirstlane(tid >> 6), lane = tid & 63, wr = wid >> 2, wc = wid & 3, fr = lane & 15, fq = lane >> 4;
    const int K = g.K, nt = K / BK;
    unsigned voffA[2], voffB[2];
#pragma unroll
    for (int i = 0; i < 2; ++i) { int R, C; stage_rc(tid * 16 + i * 8192, R, C); const int Rb = Epi::PERM ? ((R & ~31) + perm32(R & 31)) : R;
        voffA[i] = (unsigned)(R * g.lda + C) * 2u; voffB[i] = (unsigned)(Rb * g.ldb + C) * 2u; }
    const size_t kstep = (size_t)(BK * 2);
    const size_t hstepA = (size_t)HALF * g.lda * 2, hstepB = (size_t)HALF * g.ldb * 2;
    const size_t tstepA = 2 * hstepA, tstepB = 2 * hstepB;
    const unsigned ldsw = (unsigned)wid * 1024u;
    const int aoff = lds_byte(wr * 64 + fr, fq * 8), boff = lds_byte(wc * 32 + fr, fq * 8);
#define PG8_SA(b, h) (((b) * 2 + (h)) * HTB)
#define PG8_SB(b, h) ((4 + (b) * 2 + (h)) * HTB)
#define PG8_STAGE(bufoff, gbase, voff) do { _Pragma("unroll") for (int _i = 0; _i < 2; ++_i) \
        __builtin_amdgcn_global_load_lds((const unsigned*)((const char*)(gbase) + (voff)[_i]), (PG8_LAS unsigned*)(lds + (bufoff) + ldsw + _i * 8192), 16, 0, 0); } while (0)
#define PG8_LDA(dst, b, h) do { _Pragma("unroll") for (int m = 0; m < 4; ++m) _Pragma("unroll") for (int k = 0; k < 2; ++k) dst[m][k] = *(const PG8_LAS bf16x8*)(lds + PG8_SA(b, h) + aoff + m * 2048 + k * 1024); } while (0)
#define PG8_LDB(dst, b, h) do { _Pragma("unroll") for (int n = 0; n < 2; ++n) _Pragma("unroll") for (int k = 0; k < 2; ++k) dst[n][k] = *(const PG8_LAS bf16x8*)(lds + PG8_SB(b, h) + boff + n * 2048 + k * 1024); } while (0)
#define PG8_MMA(ai, bj, At, Bt) do { __builtin_amdgcn_s_setprio(1); _Pragma("unroll") for (int m = 0; m < 4; ++m) _Pragma("unroll") for (int n = 0; n < 2; ++n) _Pragma("unroll") for (int k = 0; k < 2; ++k) \
        acc[ai][bj][m][n] = __builtin_amdgcn_mfma_f32_16x16x32_bf16(Bt[n][k], At[m][k], acc[ai][bj][m][n], 0, 0, 0); __builtin_amdgcn_s_setprio(0); } while (0)
#define PG8_WAIT_V(n) asm volatile("s_waitcnt vmcnt(" #n ")" ::: "memory")
#define PG8_WAIT_L(n) asm volatile("s_waitcnt lgkmcnt(" #n ")" ::: "memory")
#define PG8_BAR __builtin_amdgcn_s_barrier()
#define PG8_SCHED __builtin_amdgcn_sched_barrier(0)
    Unit cur, nxt; int ui = 0;
    if (!S.next(0, cur)) return;
    f32x4 acc[2][2][4][2];
#pragma unroll
    for (int a = 0; a < 2; ++a)
#pragma unroll
        for (int b = 0; b < 2; ++b)
#pragma unroll
            for (int m = 0; m < 4; ++m)
#pragma unroll
                for (int n = 0; n < 2; ++n) acc[a][b][m][n] = (f32x4){0.f, 0.f, 0.f, 0.f};
    bf16x8 At[4][2], B0[2][2], B1[2][2];
    const char* cA = (const char*)g.A + (size_t)cur.pm * tstepA; const char* cB = (const char*)g.Bt + (size_t)cur.pn * tstepB;
    S.a_ready(cur);
    if constexpr (SP2) {
        PG8_STAGE(PG8_SB(0, 0), cB, voffB); PG8_STAGE(PG8_SB(0, 1), cB + hstepB, voffB); PG8_STAGE(PG8_SA(0, 0), cA, voffA); PG8_STAGE(PG8_SA(0, 1), cA + hstepA, voffA);
        if (wr == 1) PG8_BAR;
        PG8_WAIT_V(2); PG8_BAR;
        PG8_STAGE(PG8_SB(1, 0), cB + kstep, voffB); PG8_STAGE(PG8_SA(1, 0), cA + kstep, voffA); PG8_STAGE(PG8_SB(1, 1), cB + hstepB + kstep, voffB);
        PG8_WAIT_V(6); PG8_BAR;
    } else {
        PG8_STAGE(PG8_SB(0, 0), cB, voffB); PG8_STAGE(PG8_SA(0, 0), cA, voffA); PG8_STAGE(PG8_SB(0, 1), cB + hstepB, voffB); PG8_STAGE(PG8_SA(0, 1), cA + hstepA, voffA);
        if (wr == 1) PG8_BAR;
        PG8_WAIT_V(4); PG8_BAR;
        PG8_STAGE(PG8_SB(1, 0), cB + kstep, voffB); PG8_STAGE(PG8_SA(1, 0), cA + kstep, voffA); PG8_STAGE(PG8_SB(1, 1), cB + hstepB + kstep, voffB);
        PG8_WAIT_V(6); PG8_BAR;
    }
    for (;;) {
        const bool has_next = S.next(ui + 1, nxt);
        const char* nA = has_next ? (const char*)g.A + (size_t)nxt.pm * tstepA : cA; const char* nB = has_next ? (const char*)g.Bt + (size_t)nxt.pn * tstepB : cB;
        for (int t = 0; t < nt; t += 2) {
            const bool last = (t == nt - 2);
            const char* a1 = cA + (size_t)(t + 1) * kstep;
            const char* a2 = last ? nA : cA + (size_t)(t + 2) * kstep; const char* b2 = last ? nB : cB + (size_t)(t + 2) * kstep;
            const char* a3 = a2 + kstep; const char* b3 = b2 + kstep;
            if (last && has_next) S.a_ready(nxt);
            if constexpr (SP2) {
            PG8_LDB(B0, 0, 0); PG8_LDB(B1, 0, 1); PG8_SCHED; PG8_LDA(At, 0, 0); PG8_STAGE(PG8_SA(1, 1), a1 + hstepA, voffA);
            PG8_WAIT_V(8); PG8_WAIT_L(0); PG8_BAR; PG8_MMA(0, 0, At, B0); PG8_MMA(0, 1, At, B1); PG8_BAR; PG8_SCHED;
            PG8_LDA(At, 0, 1); PG8_STAGE(PG8_SB(0, 0), b2, voffB); PG8_STAGE(PG8_SB(0, 1), b2 + hstepB, voffB); PG8_STAGE(PG8_SA(0, 0), a2, voffA);
            PG8_WAIT_V(8); PG8_WAIT_L(0); PG8_BAR; PG8_MMA(1, 0, At, B0); PG8_MMA(1, 1, At, B1); PG8_BAR; PG8_SCHED;
            PG8_LDB(B0, 1, 0); PG8_LDB(B1, 1, 1); PG8_SCHED; PG8_LDA(At, 1, 0); PG8_STAGE(PG8_SA(0, 1), a2 + hstepA, voffA);
            PG8_WAIT_V(8); PG8_WAIT_L(0); PG8_BAR; PG8_MMA(0, 0, At, B0); PG8_MMA(0, 1, At, B1); PG8_BAR; PG8_SCHED;
            PG8_LDA(At, 1, 1); PG8_STAGE(PG8_SB(1, 0), b3, voffB); PG8_STAGE(PG8_SB(1, 1), b3 + hstepB, voffB); PG8_STAGE(PG8_SA(1, 0), a3, voffA);
            PG8_WAIT_V(8); PG8_WAIT_L(0); PG8_BAR; PG8_MMA(1, 0, At, B0); PG8_MMA(1, 1, At, B1); PG8_BAR; PG8_SCHED;
            } else {
            PG8_LDB(B0, 0, 0); PG8_SCHED; PG8_LDA(At, 0, 0); PG8_STAGE(PG8_SA(1, 1), a1 + hstepA, voffA);
            PG8_WAIT_L(8); PG8_BAR; PG8_WAIT_L(0); PG8_MMA(0, 0, At, B0); PG8_BAR; PG8_SCHED;
            PG8_LDB(B1, 0, 1); PG8_STAGE(PG8_SB(0, 0), b2, voffB);
            PG8_BAR; PG8_WAIT_L(0); PG8_MMA(0, 1, At, B1); PG8_BAR;
            PG8_LDA(At, 0, 1); PG8_STAGE(PG8_SA(0, 0), a2, voffA);
            PG8_BAR; PG8_WAIT_L(0); PG8_MMA(1, 0, At, B0); PG8_BAR; PG8_SCHED;
            PG8_STAGE(PG8_SB(0, 1), b2 + hstepB, voffB);
            PG8_WAIT_V(6); PG8_BAR; PG8_MMA(1, 1, At, B1); PG8_BAR;
            PG8_LDB(B0, 1, 0); PG8_SCHED; PG8_LDA(At, 1, 0); PG8_STAGE(PG8_SA(0, 1), a2 + hstepA, voffA);
            PG8_WAIT_L(8); PG8_BAR; PG8_WAIT_L(0); PG8_MMA(0, 0, At, B0); PG8_BAR; PG8_SCHED;
            PG8_LDB(B1, 1, 1); PG8_STAGE(PG8_SB(1, 0), b3, voffB);
            PG8_BAR; PG8_WAIT_L(0); PG8_MMA(0, 1, At, B1); PG8_BAR;
            PG8_LDA(At, 1, 1); PG8_STAGE(PG8_SA(1, 0), a3, voffA);
            PG8_BAR; PG8_WAIT_L(0); PG8_MMA(1, 0, At, B0); PG8_BAR; PG8_SCHED;
            PG8_STAGE(PG8_SB(1, 1), b3 + hstepB, voffB);
            PG8_WAIT_V(6); PG8_BAR; PG8_MMA(1, 1, At, B1); PG8_BAR;
            }
        }
        if constexpr (ALIGN_EPI) { if (wr == 0) PG8_BAR; }
        if constexpr (!Epi::AFTER_DRAIN) { E(acc, cur, wr, wc, fr, fq); S.done(cur); }
        if (!has_next) break;
#pragma unroll
        for (int a = 0; a < 2; ++a)
#pragma unroll
            for (int b = 0; b < 2; ++b)
#pragma unroll
                for (int m = 0; m < 4; ++m)
#pragma unroll
                    for (int n = 0; n < 2; ++n) acc[a][b][m][n] = (f32x4){0.f, 0.f, 0.f, 0.f};
        cur = nxt; cA = nA; cB = nB; ++ui;
        if constexpr (ALIGN_EPI) { if (wr == 1) PG8_BAR; }
    }
    PG8_WAIT_V(0);
    if constexpr (!ALIGN_EPI) { if (wr == 0) PG8_BAR; }
    PG8_BAR;
#undef PG8_SA
#undef PG8_SB
#undef PG8_STAGE
#undef PG8_LDA
#undef PG8_LDB
#undef PG8_MMA
#undef PG8_WAIT_V
#undef PG8_WAIT_L
#undef PG8_BAR
#undef PG8_SCHED
}
}

constexpr int NWAVES = 8, NTHR = 512;
constexpr int DM = 2048, SEQ = 2048, NB_P = 8, NB_S = 32, SEQ_S = 32, DEPTH = 4;
constexpr int MP = NB_P * SEQ, MS = NB_S * SEQ_S, M = MP + MS;
constexpr int D_POOL = 1024, POOL_HIST = 15, D_SSD = 2048, HD = 64, NH = 32, HPG = 16, DS = 128, CONV_DIM = 2560, D_MIX = 3072;
constexpr int D_IN = 5664, N_PROJ = 5632, N_INP = 5888, D_FF = 5632, D_UP = 11264;
constexpr int XBC0 = 3072;
constexpr float EPS = 1e-6f;

constexpr size_t O_YP = 0, O_YS = O_YP + (size_t)MP * DM, O_POOLP = O_YS + (size_t)MS * DM, O_POOLS = O_POOLP + (size_t)DEPTH * NB_P * 15 * 1024,
    O_SCP = O_POOLS + (size_t)DEPTH * NB_S * 15 * 1024, O_SCS = O_SCP + (size_t)DEPTH * NB_P * 3 * 2560, O_SSDP = O_SCS + (size_t)DEPTH * NB_S * 3 * 2560,
    O_SSDS = O_SSDP + (size_t)DEPTH * NB_P * 32 * 64 * 128, O_FCP = O_SSDS + (size_t)DEPTH * NB_S * 32 * 64 * 128, O_FCS = O_FCP + (size_t)DEPTH * NB_P * 2 * 11264,
    O_END = O_FCS + (size_t)DEPTH * NB_S * 2 * 11264;

constexpr size_t al256(size_t x) { return (x + 255) & ~(size_t)255; }
constexpr size_t WS_CTL = 0, CTL_BYTES = 1u << 20;
constexpr size_t WS_BTIN = CTL_BYTES;
constexpr size_t WS_BTOUT = WS_BTIN + (size_t)DEPTH * N_INP * DM * 2;
constexpr size_t WS_BTUP = WS_BTOUT + (size_t)DEPTH * DM * D_MIX * 2;
constexpr size_t WS_BTDN = WS_BTUP + (size_t)DEPTH * D_UP * DM * 2;
constexpr size_t WS_WOP = WS_BTDN + (size_t)DEPTH * DM * D_FF * 2;
constexpr size_t WS_WPB = WS_WOP + (size_t)DEPTH * DM * D_POOL * 2;
constexpr size_t WS_X = WS_WPB + (size_t)DEPTH * 4 * 256 * 256 * 2;
constexpr size_t WS_XB = WS_X + (size_t)M * DM * 4;
constexpr size_t WS_R = WS_XB + (size_t)M * DM * 2;
constexpr size_t WS_DT = WS_R + al256((size_t)M * 4);
constexpr size_t WS_SSQP = WS_DT + (size_t)M * 32 * 4;
constexpr size_t WS_SSQH = WS_SSQP + (size_t)M * 32 * 4;
constexpr size_t WS_ACT = WS_SSQH + (size_t)M * 32 * 4;
constexpr size_t WS_RA = WS_ACT + (size_t)M * D_FF * 2;
constexpr size_t WS_PROJ = WS_RA;
constexpr size_t WS_MIXA = WS_PROJ + (size_t)M * N_PROJ * 2;
constexpr size_t WS_MIX = WS_MIXA + (size_t)M * D_MIX * 2;
constexpr size_t WS_UP = WS_RA;
constexpr size_t WS_END = WS_MIX + (size_t)M * DM * 4;
static_assert((size_t)M * D_UP * 2 <= WS_END - WS_RA, "UP fits region A");

constexpr int RING_BYTES = 131072, LDSCTL_OFF = RING_BYTES, LDS_BYTES = 147456;

#define LAS __attribute__((address_space(3)))
typedef unsigned short bf16;
typedef float f32x4 __attribute__((ext_vector_type(4)));
#define RLX_AGENT __ATOMIC_RELAXED, __HIP_MEMORY_SCOPE_AGENT
__device__ __forceinline__ unsigned f2bf(float f) { unsigned u = __builtin_bit_cast(unsigned, f); return (u + 0x7fffu + ((u >> 16) & 1u)) >> 16; }
__device__ __forceinline__ unsigned pk2(float lo, float hi) { return f2bf(lo) | (f2bf(hi) << 16); }
__device__ __forceinline__ float bflo(unsigned u) { return __uint_as_float(u << 16); }
__device__ __forceinline__ float bfhi(unsigned u) { return __uint_as_float(u & 0xffff0000u); }
__device__ __forceinline__ float bf2f(bf16 b) { return __uint_as_float(((unsigned)b) << 16); }
struct F8 { float v[8]; };
__device__ __forceinline__ F8 ld_bf8(const bf16* p) { const uint4 u = *(const uint4*)p; F8 r; r.v[0] = bflo(u.x); r.v[1] = bfhi(u.x); r.v[2] = bflo(u.y); r.v[3] = bfhi(u.y); r.v[4] = bflo(u.z); r.v[5] = bfhi(u.z); r.v[6] = bflo(u.w); r.v[7] = bfhi(u.w); return r; }
__device__ __forceinline__ F8 ld_f8(const float* p) { const float4 a = *(const float4*)p, b = *(const float4*)(p + 4); F8 r; r.v[0] = a.x; r.v[1] = a.y; r.v[2] = a.z; r.v[3] = a.w; r.v[4] = b.x; r.v[5] = b.y; r.v[6] = b.z; r.v[7] = b.w; return r; }
__device__ __forceinline__ F8 zero8() { F8 r;
#pragma unroll
    for (int i = 0; i < 8; ++i) r.v[i] = 0.f; return r; }
__device__ __forceinline__ void st_bf8(bf16* p, const F8& r) { uint4 u; u.x = pk2(r.v[0], r.v[1]); u.y = pk2(r.v[2], r.v[3]); u.z = pk2(r.v[4], r.v[5]); u.w = pk2(r.v[6], r.v[7]); *(uint4*)p = u; }
__device__ __forceinline__ void st_f8(float* p, const F8& r) { *(float4*)p = make_float4(r.v[0], r.v[1], r.v[2], r.v[3]); *(float4*)(p + 4) = make_float4(r.v[4], r.v[5], r.v[6], r.v[7]); }
__device__ __forceinline__ float silu_f(float x) { return x / (1.f + __expf(-x)); }
__device__ __forceinline__ float wave_sum(float v) {
#pragma unroll
    for (int o = 1; o < 64; o <<= 1) v += __shfl_xor(v, o);
    return v;
}

#define XB_TMO      128
#define XB_XCNT(j)  (256  + 64 * (j))
#define XB_XSUB(j)  (1280 + 64 * (j))
#define XB_XGEN(j)  (2304 + 64 * (j))
#define XB_TOP      3328
#define XB_TOPGEN   3392
#define XCD_BAR_WORDS 3456
#define XB_SPIN_CAP (1u << 18)
__device__ __forceinline__ unsigned xb_ld(unsigned* p)              { return __hip_atomic_load(p, __ATOMIC_RELAXED, __HIP_MEMORY_SCOPE_AGENT); }
__device__ __forceinline__ unsigned xb_add(unsigned* p, unsigned v) { return __hip_atomic_fetch_add(p, v, __ATOMIC_RELAXED, __HIP_MEMORY_SCOPE_AGENT); }
__device__ __forceinline__ unsigned xb_xcc_id() { return (unsigned)__builtin_amdgcn_s_getreg((3 << 11) | 20) & 0xFu; }
#define XB_SPIN(cond, bar) do { unsigned _sp = 0; while (cond) { __builtin_amdgcn_s_sleep(1); \
    if ((++_sp & 255u) == 0u) { if (xb_ld(&(bar)[XB_TMO])) break; if (_sp > XB_SPIN_CAP) { atomicAdd(&(bar)[XB_TMO], 1u); break; } } } } while (0)
struct XcdBarrier { unsigned* bar; unsigned x; volatile LAS unsigned* st; };
__device__ __forceinline__ XcdBarrier xcd_barrier_post(unsigned* bar, volatile LAS unsigned* st) {
    XcdBarrier b; b.bar = bar; b.x = xb_xcc_id(); b.st = st;
    if (threadIdx.x == 0) (void)xb_add(&bar[XB_XCNT(b.x)], 1u);
    return b;
}
__device__ __forceinline__ void xcd_barrier_complete(unsigned* bar, unsigned x, unsigned& nloc, unsigned& nx) {
    const unsigned G = gridDim.x * gridDim.y * gridDim.z;
    unsigned sum, cnt, mine, sp = 0u;
    for (;;) {
        sum = 0u; cnt = 0u; mine = 0u;
#pragma unroll
        for (unsigned j = 0; j < 16; ++j) { const unsigned c = xb_ld(&bar[XB_XCNT(j)]); sum += c; cnt += (c > 0u) ? 1u : 0u; mine = (j == x) ? c : mine; }
        if (sum == G) break;
        __builtin_amdgcn_s_sleep(1);
        if ((++sp & 255u) == 0u) { if (xb_ld(&bar[XB_TMO])) break; if (sp > XB_SPIN_CAP) { atomicAdd(&bar[XB_TMO], 1u); break; } }
    }
    nloc = mine > 0u ? mine : 1u; nx = cnt > 0u ? cnt : 1u;
}
__device__ __forceinline__ void xcd_barrier(const XcdBarrier& b) {
    asm volatile("s_waitcnt vmcnt(0)" ::: "memory");
    __syncthreads();
    if (threadIdx.x == 0) {
        unsigned* bar = b.bar;
        __builtin_amdgcn_s_waitcnt(0);
        unsigned nloc = b.st[0], nx = b.st[1];
        if (nloc == 0u) { xcd_barrier_complete(bar, b.x, nloc, nx); b.st[0] = nloc; b.st[1] = nx; }
        const unsigned old = xb_add(&bar[XB_XSUB(b.x)], 1u);
        const unsigned gen = old / nloc;
        if (old + 1u == (gen + 1u) * nloc) {
            __builtin_amdgcn_fence(__ATOMIC_RELEASE, "agent");
            asm volatile("s_waitcnt vmcnt(0)" ::: "memory");
            const unsigned og = xb_add(&bar[XB_TOP], 1u);
            const unsigned tg = og / nx;
            if (og + 1u == (tg + 1u) * nx) xb_add(&bar[XB_TOPGEN], 1u);
            else XB_SPIN(xb_ld(&bar[XB_TOPGEN]) == tg, bar);
            __builtin_amdgcn_fence(__ATOMIC_ACQUIRE, "agent");
            xb_add(&bar[XB_XGEN(b.x)], 1u);
            asm volatile("s_waitcnt vmcnt(0)" ::: "memory");
        } else {
            XB_SPIN(xb_ld(&bar[XB_XGEN(b.x)]) == gen, bar);
            __builtin_amdgcn_fence(__ATOMIC_ACQUIRE, "agent");
            asm volatile("s_waitcnt vmcnt(0)" ::: "memory");
        }
    }
    __syncthreads();
}

struct Args { const float* in[24]; float* out; unsigned char* ws; int ph_lo, ph_hi; };

struct Ctx {
    LAS unsigned char* lds; int tid, lane, wave, G, gw, NGW;
    const float* const* in; float* out; unsigned char* ws;
    __device__ __forceinline__ void refresh() {
        int t = threadIdx.x; asm volatile("" : "+v"(t)); tid = t; lane = t & 63; wave = __builtin_amdgcn_readfirstlane(t >> 6); gw = blockIdx.x * NWAVES + wave; NGW = G * NWAVES; }
};

__device__ __forceinline__ void conv_item(const float* W, int N, const float* gain, bf16* dst, int ldd, LAS float* scr, int kb, int nb, int lane) {
    const int k0 = 64 * kb, n0 = 32 * nb;
#pragma unroll 8
    for (int i = 0; i < 32; ++i) { const int kk = 2 * i + (lane >> 5); const float gsc = gain ? gain[k0 + kk] : 1.f; scr[kk * 33 + (lane & 31)] = W[(size_t)(k0 + kk) * N + n0 + (lane & 31)] * gsc; }
    asm volatile("s_waitcnt lgkmcnt(0)" ::: "memory");
    const int c = lane & 7;
#pragma unroll
    for (int j = 0; j < 4; ++j) { const int n = (lane >> 3) + 8 * j; const LAS float* s = scr + (8 * c) * 33 + n;
        uint4 o; o.x = pk2(s[0 * 33], s[1 * 33]); o.y = pk2(s[2 * 33], s[3 * 33]); o.z = pk2(s[4 * 33], s[5 * 33]); o.w = pk2(s[6 * 33], s[7 * 33]);
        *(uint4*)(dst + (size_t)(n0 + n) * ldd + k0 + 8 * c) = o; }
    asm volatile("s_waitcnt lgkmcnt(0)" ::: "memory");
}
__device__ __forceinline__ void phase_convert(Ctx C) {
    C.refresh();
    LAS float* scr = (LAS float*)(C.lds + C.wave * 16384);
    constexpr int I_IN = (DM / 64) * (D_IN / 32), I_OUT = (D_MIX / 64) * (DM / 32), I_UP = (DM / 64) * (D_UP / 32), I_DN = (D_FF / 64) * (DM / 32), I_L = I_IN + I_OUT + I_UP + I_DN;
    for (int it = C.gw; it < DEPTH * I_L; it += C.NGW) {
        const int l = it / I_L; int r = it % I_L;
        if (r < I_IN) { const int nbk = D_IN / 32; conv_item(C.in[7] + (size_t)l * DM * D_IN, D_IN, C.in[6] + l * DM, (bf16*)(C.ws + WS_BTIN) + (size_t)l * N_INP * DM, DM, scr, r / nbk, r % nbk, C.lane); continue; }
        r -= I_IN;
        if (r < I_OUT) { const int nbk = DM / 32, kb = r / nbk, nb = r % nbk; const float* W = C.in[16] + (size_t)l * D_MIX * DM;
            if (kb < 16) conv_item(W, DM, C.in[9] + l * D_POOL, (bf16*)(C.ws + WS_WOP) + (size_t)l * DM * D_POOL, D_POOL, scr, kb, nb, C.lane);
            else conv_item(W, DM, C.in[15] + l * D_SSD - D_POOL, (bf16*)(C.ws + WS_BTOUT) + (size_t)l * DM * D_MIX, D_MIX, scr, kb, nb, C.lane);
            continue; }
        r -= I_OUT;
        if (r < I_UP) { const int nbk = D_UP / 32; conv_item(C.in[19] + (size_t)l * DM * D_UP, D_UP, C.in[18] + l * DM, (bf16*)(C.ws + WS_BTUP) + (size_t)l * D_UP * DM, DM, scr, r / nbk, r % nbk, C.lane); continue; }
        r -= I_UP;
        { const int nbk = DM / 32; conv_item(C.in[22] + (size_t)l * D_FF * DM, DM, nullptr, (bf16*)(C.ws + WS_BTDN) + (size_t)l * DM * D_FF, D_FF, scr, r / nbk, r % nbk, C.lane); }
    }
    { const int gt = C.gw * 64 + C.lane, NGT = C.NGW * 64; constexpr int PER_L = (N_INP - D_IN) * DM / 8;
      for (int i = gt; i < DEPTH * PER_L; i += NGT) { const int l = i / PER_L, r = i % PER_L; *(uint4*)((bf16*)(C.ws + WS_BTIN) + ((size_t)l * N_INP + D_IN) * DM + (size_t)r * 8) = make_uint4(0u, 0u, 0u, 0u); }
      const float* wp = C.in[8]; bf16* wpb = (bf16*)(C.ws + WS_WPB);
      for (int i = gt; i < DEPTH * 4 * 256 * 256 / 8; i += NGT) { const F8 v = ld_f8(wp + (size_t)i * 8); st_bf8(wpb + (size_t)i * 8, v); } }
    for (int row = C.gw; row < M; row += C.NGW) {
        const float* src = row < MP ? C.in[0] + (size_t)row * DM : C.in[1] + (size_t)(row - MP) * DM;
        float* X = (float*)(C.ws + WS_X) + (size_t)row * DM; bf16* XB = (bf16*)(C.ws + WS_XB) + (size_t)row * DM; float q = 0.f;
#pragma unroll
        for (int j = 0; j < 8; ++j) { const int idx = (C.lane + 64 * j) * 4; const float4 v = *(const float4*)(src + idx); *(float4*)(X + idx) = v; q += (v.x * v.x + v.y * v.y) + (v.z * v.z + v.w * v.w);
            *(uint2*)(XB + idx) = make_uint2(pk2(v.x, v.y), pk2(v.z, v.w)); }
        q = wave_sum(q);
        if (C.lane == 0) ((float*)(C.ws + WS_R))[row] = rsqrtf(q * (1.f / DM) + EPS);
    }
}

__device__ __forceinline__ void phase_resid(Ctx C, const float* gpost, bool final_out) {
    C.refresh();
    const float* MIX = (const float*)(C.ws + WS_MIX); const float* SSQ = (const float*)(C.ws + WS_SSQP);
    for (int row = C.gw; row < M; row += C.NGW) {
        float p = C.lane < 32 ? SSQ[(size_t)row * 32 + C.lane] : 0.f; p = wave_sum(p);
        const float rs = rsqrtf(p * (1.f / DM) + EPS);
        float* X = (float*)(C.ws + WS_X) + (size_t)row * DM; bf16* XB = (bf16*)(C.ws + WS_XB) + (size_t)row * DM; const float* mx = MIX + (size_t)row * DM;
        float* Y = C.out + O_YP + (size_t)row * DM; float q = 0.f;
#pragma unroll
        for (int j = 0; j < 8; ++j) { const int idx = (C.lane + 64 * j) * 4; const float4 m4 = *(const float4*)(mx + idx), g4 = *(const float4*)(gpost + idx); float4 v = *(const float4*)(X + idx);
            v.x += m4.x * rs * g4.x; v.y += m4.y * rs * g4.y; v.z += m4.z * rs * g4.z; v.w += m4.w * rs * g4.w;
            *(float4*)(X + idx) = v; if (final_out) *(float4*)(Y + idx) = v;
            q += (v.x * v.x + v.y * v.y) + (v.z * v.z + v.w * v.w);
            *(uint2*)(XB + idx) = make_uint2(pk2(v.x, v.y), pk2(v.z, v.w)); }
        q = wave_sum(q);
        if (C.lane == 0) ((float*)(C.ws + WS_R))[row] = rsqrtf(q * (1.f / DM) + EPS);
    }
}

__device__ __forceinline__ void phase_gnorm(Ctx C) {
    C.refresh();
    const float* SSQH = (const float*)(C.ws + WS_SSQH); bf16* MIXA = (bf16*)(C.ws + WS_MIXA);
    for (int row = C.gw; row < M; row += C.NGW) {
        float p = C.lane < 32 ? SSQH[(size_t)row * 32 + C.lane] : 0.f;
#pragma unroll
        for (int o = 1; o < 16; o <<= 1) p += __shfl_xor(p, o);
        const float s0 = __shfl(p, 0), s1 = __shfl(p, 16);
        const float r0 = rsqrtf(s0 * (1.f / 1024.f) + EPS), r1 = rsqrtf(s1 * (1.f / 1024.f) + EPS);
        bf16* y = MIXA + (size_t)row * D_MIX + D_POOL;
#pragma unroll
        for (int j = 0; j < 4; ++j) { const int c = (C.lane + 64 * j) * 8; const float r = c < 1024 ? r0 : r1; F8 v = ld_bf8(y + c);
#pragma unroll
            for (int i = 0; i < 8; ++i) v.v[i] *= r;
            st_bf8(y + c, v); }
    }
}

__device__ __forceinline__ void phase_act(Ctx C, int l) {
    C.refresh();
    const bf16* UP = (const bf16*)(C.ws + WS_UP); bf16* ACT = (bf16*)(C.ws + WS_ACT);
    const float* cw = C.in[20] + (size_t)l * 3 * D_UP; const float* cb = C.in[21] + (size_t)l * D_UP; const float* hist = C.in[5] + (size_t)l * NB_S * 2 * D_UP;
    constexpr int NCG = D_FF / 8, NSTRIP = M / 32;
    const int gt = C.gw * 64 + C.lane, NGT = C.NGW * 64;
    for (int it = gt; it < NSTRIP * NCG; it += NGT) {
        const int strip = it / NCG, c = (it % NCG) * 8, row0 = strip * 32; const bool prm = row0 < MP;
        const int b = prm ? row0 / SEQ : (row0 - MP) / SEQ_S, t0 = prm ? row0 % SEQ : 0;
        F8 p2g, p1g, p2v, p1v;
        if (t0 == 0) { if (prm) { p2g = zero8(); p1g = zero8(); p2v = zero8(); p1v = zero8(); }
            else { const float* h = hist + (size_t)b * 2 * D_UP; p2g = ld_f8(h + c); p2v = ld_f8(h + D_FF + c); p1g = ld_f8(h + D_UP + c); p1v = ld_f8(h + D_UP + D_FF + c); } }
        else { p2g = ld_bf8(UP + (size_t)(row0 - 2) * D_UP + c); p2v = ld_bf8(UP + (size_t)(row0 - 2) * D_UP + D_FF + c); p1g = ld_bf8(UP + (size_t)(row0 - 1) * D_UP + c); p1v = ld_bf8(UP + (size_t)(row0 - 1) * D_UP + D_FF + c); }
        const F8 w0g = ld_f8(cw + c), w1g = ld_f8(cw + D_UP + c), w2g = ld_f8(cw + 2 * D_UP + c), bg = ld_f8(cb + c);
        const F8 w0v = ld_f8(cw + D_FF + c), w1v = ld_f8(cw + D_UP + D_FF + c), w2v = ld_f8(cw + 2 * D_UP + D_FF + c), bv = ld_f8(cb + D_FF + c);
        for (int r = 0; r < 32; ++r) {
            const F8 cg = ld_bf8(UP + (size_t)(row0 + r) * D_UP + c), cv = ld_bf8(UP + (size_t)(row0 + r) * D_UP + D_FF + c); F8 o;
#pragma unroll
            for (int i = 0; i < 8; ++i) { const float g = bg.v[i] + w0g.v[i] * p2g.v[i] + w1g.v[i] * p1g.v[i] + w2g.v[i] * cg.v[i]; const float v = bv.v[i] + w0v.v[i] * p2v.v[i] + w1v.v[i] * p1v.v[i] + w2v.v[i] * cv.v[i]; o.v[i] = silu_f(g) * v; }
            st_bf8(ACT + (size_t)(row0 + r) * D_FF + c, o);
            p2g = p1g; p1g = cg; p2v = p1v; p1v = cv;
        }
        if (!prm || t0 + 32 == SEQ) {
            float* o = C.out + (prm ? O_FCP + ((size_t)(l * NB_P + b) * 2) * D_UP : O_FCS + ((size_t)(l * NB_S + b) * 2) * D_UP);
            st_f8(o + c, p2g); st_f8(o + D_FF + c, p2v); st_f8(o + D_UP + c, p1g); st_f8(o + D_UP + D_FF + c, p1v);
        }
    }
}

__device__ __forceinline__ void phase_pool(Ctx C, int l) {
    C.refresh();
    const bf16* PROJ = (const bf16*)(C.ws + WS_PROJ); bf16* MIXA = (bf16*)(C.ws + WS_MIXA);
    const float* hist = C.in[2] + (size_t)l * NB_S * POOL_HIST * D_POOL;
    constexpr int NCG = D_POOL / 8, NSTRIP = M / 32;
    const int gt = C.gw * 64 + C.lane, NGT = C.NGW * 64;
    for (int it = gt; it < NSTRIP * NCG; it += NGT) {
        const int strip = it / NCG, cgi = it % NCG, c = cgi * 8, row0 = strip * 32; const bool prm = row0 < MP;
        const int b = prm ? row0 / SEQ : (row0 - MP) / SEQ_S, t0 = prm ? row0 % SEQ : 0, w = 2 << (cgi >> 5);
        const int rb = row0 - t0;
        const float* hb = hist + (size_t)b * POOL_HIST * D_POOL;
        F8 s = zero8();
        for (int i = 1; i < w; ++i) { const int t = t0 - i; F8 v;
            if (t >= 0) v = ld_bf8(PROJ + (size_t)(rb + t) * N_PROJ + c); else if (!prm) v = ld_f8(hb + (size_t)(POOL_HIST + t) * D_POOL + c); else v = zero8();
#pragma unroll
            for (int k = 0; k < 8; ++k) s.v[k] += v.v[k]; }
        for (int r = 0; r < 32; ++r) {
            const int t = t0 + r; const F8 cur = ld_bf8(PROJ + (size_t)(rb + t) * N_PROJ + c);
            const float inv = 1.f / (float)(prm ? (t + 1 < w ? t + 1 : w) : w); F8 o;
#pragma unroll
            for (int k = 0; k < 8; ++k) { s.v[k] += cur.v[k]; o.v[k] = s.v[k] * inv - cur.v[k]; }
            st_bf8(MIXA + (size_t)(rb + t) * D_MIX + c, o);
            const int tl = t - w + 1; F8 v;
            if (tl >= 0) v = ld_bf8(PROJ + (size_t)(rb + tl) * N_PROJ + c); else if (!prm) v = ld_f8(hb + (size_t)(POOL_HIST + tl) * D_POOL + c); else v = zero8();
#pragma unroll
            for (int k = 0; k < 8; ++k) s.v[k] -= v.v[k];
        }
    }
    for (int it = gt; it < (NB_P + NB_S) * 15 * NCG; it += NGT) {
        const int cg = it % NCG, i = (it / NCG) % 15, sb = it / (NCG * 15); const bool prm = sb < NB_P; const int b = prm ? sb : sb - NB_P;
        const int row = prm ? b * SEQ + (SEQ - 15 + i) : MP + b * SEQ_S + (SEQ_S - 15 + i);
        float* o = C.out + (prm ? O_POOLP + ((size_t)(l * NB_P + b) * 15 + i) * D_POOL : O_POOLS + ((size_t)(l * NB_S + b) * 15 + i) * D_POOL);
        st_f8(o + cg * 8, ld_bf8(PROJ + (size_t)row * N_PROJ + cg * 8));
    }
    constexpr int NCG2 = CONV_DIM / 8;
    for (int it = gt; it < (NB_P + NB_S) * 3 * NCG2; it += NGT) {
        const int cg = it % NCG2, i = (it / NCG2) % 3, sb = it / (NCG2 * 3); const bool prm = sb < NB_P; const int b = prm ? sb : sb - NB_P;
        const int row = prm ? b * SEQ + (SEQ - 3 + i) : MP + b * SEQ_S + (SEQ_S - 3 + i);
        float* o = C.out + (prm ? O_SCP + ((size_t)(l * NB_P + b) * 3 + i) * CONV_DIM : O_SCS + ((size_t)(l * NB_S + b) * 3 + i) * CONV_DIM);
        st_f8(o + cg * 8, ld_bf8(PROJ + (size_t)row * N_PROJ + XBC0 + cg * 8));
    }
}

__device__ __forceinline__ void phase_ssd(Ctx C, int l) {
    C.refresh();
    LAS float* xs = (LAS float*)(C.lds); LAS float* Bs = (LAS float*)(C.lds + 16384); LAS float* Cs = (LAS float*)(C.lds + 49152); LAS float* ys = (LAS float*)(C.lds + 81920);
    LAS float* dts = (LAS float*)(C.lds + 98304); LAS float* dAs = dts + 64;
    const bf16* PROJ = (const bf16*)(C.ws + WS_PROJ); const float* DT = (const float*)(C.ws + WS_DT); bf16* MIXA = (bf16*)(C.ws + WS_MIXA); float* SSQH = (float*)(C.ws + WS_SSQH);
    const float* cw = C.in[10] + (size_t)l * 4 * CONV_DIM; const float* cb = C.in[11] + (size_t)l * CONV_DIM;
    const int tid = C.tid, p = tid >> 3, n0 = (tid & 7) * 16;
    for (int u = blockIdx.x; u < NB_P * NH + NB_S * NH; u += C.G) {
        const bool prm = u < NB_P * NH; const int su = prm ? u : u - NB_P * NH, b = su / NH, hh = su % NH, g = hh / HPG;
        const int rb = prm ? b * SEQ : MP + b * SEQ_S, rows = prm ? 64 : 32, nchunk = prm ? SEQ / 64 : 1;
        const float Aneg = -__expf(C.in[13][l * NH + hh]), Dsk = C.in[14][l * NH + hh], dtb = C.in[12][l * NH + hh];
        const float* chist = C.in[3] + ((size_t)(l * NB_S + b) * 3) * CONV_DIM;
        float h[16];
        if (prm) {
#pragma unroll
            for (int i = 0; i < 16; ++i) h[i] = 0.f;
        } else { const float* h0 = C.in[4] + ((((size_t)l * NB_S + b) * NH + hh) * HD + p) * DS + n0;
#pragma unroll
            for (int i = 0; i < 4; ++i) { const float4 v = *(const float4*)(h0 + 4 * i); h[4 * i] = v.x; h[4 * i + 1] = v.y; h[4 * i + 2] = v.z; h[4 * i + 3] = v.w; } }
        for (int ch = 0; ch < nchunk; ++ch) {
            const int tb = ch * 64;
            for (int e = tid; e < rows * 40; e += NTHR) {
                const int cg = e % 40, tt = e / 40, t = tb + tt;
                int cc; LAS float* dstp;
                if (cg < 8) { cc = hh * HD + cg * 8; dstp = xs + tt * 64 + cg * 8; }
                else if (cg < 24) { cc = D_SSD + g * DS + (cg - 8) * 8; dstp = Bs + tt * 128 + (cg - 8) * 8; }
                else { cc = D_SSD + 2 * DS + g * DS + (cg - 24) * 8; dstp = Cs + tt * 128 + (cg - 24) * 8; }
                F8 a = ld_f8(cb + cc);
#pragma unroll
                for (int i = 0; i < 4; ++i) { const int ti = t - 3 + i; F8 v;
                    if (ti >= 0) v = ld_bf8(PROJ + (size_t)(rb + ti) * N_PROJ + XBC0 + cc); else if (!prm) v = ld_f8(chist + (size_t)(3 + ti) * CONV_DIM + cc); else v = zero8();
                    const F8 wv = ld_f8(cw + (size_t)i * CONV_DIM + cc);
#pragma unroll
                    for (int k = 0; k < 8; ++k) a.v[k] += wv.v[k] * v.v[k]; }
#pragma unroll
                for (int k = 0; k < 8; ++k) dstp[k] = silu_f(a.v[k]);
            }
            if (tid < rows) { const float xr = DT[(size_t)(rb + tb + tid) * 32 + hh] + dtb; const float dtv = xr > 20.f ? xr : log1pf(__expf(xr)); dts[tid] = dtv; dAs[tid] = __expf(dtv * Aneg); }
            __syncthreads();
            for (int tt = 0; tt < rows; ++tt) {
                const float xv = xs[tt * 64 + p], xdt = xv * dts[tt], dA = dAs[tt]; float acc = 0.f;
#pragma unroll
                for (int i = 0; i < 4; ++i) { const f32x4 bv = *(const LAS f32x4*)(Bs + tt * 128 + n0 + 4 * i), cv = *(const LAS f32x4*)(Cs + tt * 128 + n0 + 4 * i);
                    h[4 * i] = dA * h[4 * i] + xdt * bv[0]; acc += cv[0] * h[4 * i];
                    h[4 * i + 1] = dA * h[4 * i + 1] + xdt * bv[1]; acc += cv[1] * h[4 * i + 1];
                    h[4 * i + 2] = dA * h[4 * i + 2] + xdt * bv[2]; acc += cv[2] * h[4 * i + 2];
                    h[4 * i + 3] = dA * h[4 * i + 3] + xdt * bv[3]; acc += cv[3] * h[4 * i + 3]; }
                acc += __shfl_xor(acc, 1); acc += __shfl_xor(acc, 2); acc += __shfl_xor(acc, 4);
                if ((tid & 7) == 0) ys[tt * 64 + p] = acc + Dsk * xv;
            }
            __syncthreads();
            for (int e = tid; e < rows * 64; e += NTHR) {
                const int tt = e >> 6, pp = e & 63; const size_t row = (size_t)(rb + tb + tt);
                const float zv = bf2f(PROJ[row * N_PROJ + D_POOL + hh * HD + pp]); const float yz = ys[tt * 64 + pp] * silu_f(zv);
                MIXA[row * D_MIX + D_POOL + hh * HD + pp] = (bf16)f2bf(yz);
                const float q = wave_sum(yz * yz);
                if (pp == 0) SSQH[row * 32 + hh] = q;
            }
            __syncthreads();
        }
        float* ho = C.out + (prm ? O_SSDP + ((((size_t)l * NB_P + b) * NH + hh) * HD + p) * DS + n0 : O_SSDS + ((((size_t)l * NB_S + b) * NH + hh) * HD + p) * DS + n0);
#pragma unroll
        for (int i = 0; i < 4; ++i) *(float4*)(ho + 4 * i) = make_float4(h[4 * i], h[4 * i + 1], h[4 * i + 2], h[4 * i + 3]);
    }
}

constexpr int PH_CONV = 0, PH_FOLD = 1, PH_L0 = 2, PH_PER_L = 9, N_PHASES = PH_L0 + DEPTH * PH_PER_L;
constexpr int CW_BAR = 4096;

__global__ void __launch_bounds__(NTHR, 2) fwd_kernel(Args args) {
    extern __shared__ __attribute__((aligned(16))) unsigned char lds_raw[];
    Ctx C; C.lds = (LAS unsigned char*)lds_raw; C.G = gridDim.x; C.in = args.in; C.out = args.out; C.ws = args.ws; C.refresh();
    volatile LAS unsigned* MISC = (volatile LAS unsigned*)(C.lds + LDSCTL_OFF);
    if (threadIdx.x < 64) MISC[threadIdx.x] = 0u;
    __syncthreads();
    const int lo = args.ph_lo, hi = args.ph_hi;
    unsigned* barw = (unsigned*)(args.ws + WS_CTL) + CW_BAR;
    XcdBarrier bar; bar.bar = barw; bar.x = 0; bar.st = MISC + 8;
    if (hi - lo > 1) bar = xcd_barrier_post(barw, MISC + 8);
#define IN(k) (lo <= (k) && (k) < hi)
#define SEAM(k) do { if ((k) + 1 < hi) xcd_barrier(bar); } while (0)
    LAS unsigned char* ring = C.lds;

    if (IN(PH_CONV)) { phase_convert(C); SEAM(PH_CONV); }
    if (IN(PH_FOLD)) {
        for (int w = (int)blockIdx.x; w < DEPTH * 4 * 8; w += C.G) { const int lg = w >> 3, l = lg >> 2, g = lg & 3;
            pg8::Gemm gm{(const bf16*)(C.ws + WS_WOP) + (size_t)l * DM * D_POOL + g * 256, (const bf16*)(C.ws + WS_WPB) + (size_t)lg * 65536, DM, 256, 256, D_POOL, 256};
            pg8::StaticOrder S; S.init(DM, 256, 8, w & 7);
            pg8::EpiBf16S E{(bf16*)(C.ws + WS_BTOUT) + (size_t)l * DM * D_MIX + g * 256, D_MIX, nullptr, nullptr, -1};
            pg8::gemm_phase<pg8::EpiBf16S, pg8::StaticOrder, true, true>(ring, gm, S, E);
        }
        SEAM(PH_FOLD);
    }
    for (int l = 0; l < DEPTH; ++l) {
        const int pb = PH_L0 + l * PH_PER_L;
        if (IN(pb + 0)) {
            pg8::Gemm gm{(const bf16*)(C.ws + WS_XB), (const bf16*)(C.ws + WS_BTIN) + (size_t)l * N_INP * DM, M, N_INP, DM, DM, DM};
            pg8::StaticOrder S; S.init(M, N_INP, C.G, (int)blockIdx.x);
            pg8::EpiBf16S E{(bf16*)(C.ws + WS_PROJ), N_PROJ, (const float*)(C.ws + WS_R), (float*)(C.ws + WS_DT), N_PROJ / 256};
            pg8::gemm_phase<pg8::EpiBf16S, pg8::StaticOrder, true, true>(ring, gm, S, E);
            SEAM(pb + 0);
        }
        if (IN(pb + 1)) { phase_ssd(C, l); phase_pool(C, l); SEAM(pb + 1); }
        if (IN(pb + 2)) { phase_gnorm(C); SEAM(pb + 2); }
        if (IN(pb + 3)) {
            pg8::Gemm gm{(const bf16*)(C.ws + WS_MIXA), (const bf16*)(C.ws + WS_BTOUT) + (size_t)l * DM * D_MIX, M, DM, D_MIX, D_MIX, D_MIX};
            pg8::StaticOrder S; S.init(M, DM, C.G, (int)blockIdx.x);
            pg8::EpiF32Ssq E{(float*)(C.ws + WS_MIX), DM, (float*)(C.ws + WS_SSQP)};
            pg8::gemm_phase<pg8::EpiF32Ssq, pg8::StaticOrder, true, true>(ring, gm, S, E);
            SEAM(pb + 3);
        }
        if (IN(pb + 4)) { phase_resid(C, C.in[17] + l * DM, false); SEAM(pb + 4); }
        if (IN(pb + 5)) {
            pg8::Gemm gm{(const bf16*)(C.ws + WS_XB), (const bf16*)(C.ws + WS_BTUP) + (size_t)l * D_UP * DM, M, D_UP, DM, DM, DM};
            pg8::StaticOrder S; S.init(M, D_UP, C.G, (int)blockIdx.x);
            pg8::EpiBf16S E{(bf16*)(C.ws + WS_UP), D_UP, (const float*)(C.ws + WS_R), nullptr, -1};
            pg8::gemm_phase<pg8::EpiBf16S, pg8::StaticOrder, true, true>(ring, gm, S, E);
            SEAM(pb + 5);
        }
        if (IN(pb + 6)) { phase_act(C, l); SEAM(pb + 6); }
        if (IN(pb + 7)) {
            pg8::Gemm gm{(const bf16*)(C.ws + WS_ACT), (const bf16*)(C.ws + WS_BTDN) + (size_t)l * DM * D_FF, M, DM, D_FF, D_FF, D_FF};
            pg8::StaticOrder S; S.init(M, DM, C.G, (int)blockIdx.x);
            pg8::EpiF32Ssq E{(float*)(C.ws + WS_MIX), DM, (float*)(C.ws + WS_SSQP)};
            pg8::gemm_phase<pg8::EpiF32Ssq, pg8::StaticOrder, true, true>(ring, gm, S, E);
            SEAM(pb + 7);
        }
        if (IN(pb + 8)) { phase_resid(C, C.in[23] + l * DM, l == DEPTH - 1); SEAM(pb + 8); }
    }
#undef IN
#undef SEAM
}

extern "C" void kernel_launch(void* const* d_in, const int* in_sizes, int n_in, void* d_out, int out_size, void* d_ws, size_t ws_size, hipStream_t stream) {
    static int grid = 0;
    if (grid == 0) {
        if (n_in != 24 || (size_t)out_size != O_END || ws_size < WS_END) { fprintf(stderr, "kernel_launch: shape mismatch: n_in %d out %d (want %zu) ws %zu (need %zu)\n", n_in, out_size, (size_t)O_END, ws_size, (size_t)WS_END); grid = -1; return; }
        int dev = 0, cus = 0, per_cu = 0;
        if (hipGetDevice(&dev) != hipSuccess || hipDeviceGetAttribute(&cus, hipDeviceAttributeMultiprocessorCount, dev) != hipSuccess) { grid = -1; return; }
        if (hipFuncSetAttribute((const void*)fwd_kernel, hipFuncAttributeMaxDynamicSharedMemorySize, LDS_BYTES) != hipSuccess) { fprintf(stderr, "kernel_launch: hipFuncSetAttribute failed\n"); grid = -1; return; }
        if (hipOccupancyMaxActiveBlocksPerMultiprocessor(&per_cu, (const void*)fwd_kernel, NTHR, LDS_BYTES) != hipSuccess || per_cu < 1) fprintf(stderr, "kernel_launch: occupancy query reports %d\n", per_cu);
        (void)hipGetLastError();
        grid = cus;
    }
    if (grid < 0) return;
    if (hipMemsetAsync((char*)d_ws + WS_CTL, 0, CTL_BYTES, stream) != hipSuccess) return;
    Args a{};
    for (int i = 0; i < 24; ++i) a.in[i] = (const float*)d_in[i];
    a.out = (float*)d_out; a.ws = (unsigned char*)d_ws;
#if MK_MULTI
    for (int k = 0; k < N_PHASES; ++k) { a.ph_lo = k; a.ph_hi = k + 1; hipLaunchKernelGGL(fwd_kernel, dim3(grid), dim3(NTHR), LDS_BYTES, stream, a); }
#else
    a.ph_lo = 0; a.ph_hi = N_PHASES; hipLaunchKernelGGL(fwd_kernel, dim3(grid), dim3(NTHR), LDS_BYTES, stream, a);
#endif
}
```

```cpp
#include <hip/hip_runtime.h>
#include <cstdio>
#include <cstdint>

#ifndef MK_MULTI
#define MK_MULTI 0
#endif

namespace pg8 {
#define PG8_LAS __attribute__((address_space(3)))
typedef unsigned short bf16_t;
typedef short bf16x8 __attribute__((ext_vector_type(8)));
typedef float f32x4 __attribute__((ext_vector_type(4)));
typedef unsigned u32x4 __attribute__((ext_vector_type(4)));
constexpr int BM = 256, BK = 64, HALF = 128, HTB = HALF * BK * 2, STAGE_BYTES = 8 * HTB, NXCD = 8, WGM = 8;

__host__ __device__ __forceinline__ int lds_byte(int r, int c) { const int st = (r >> 4) * 2 + (c >> 5), rr = r & 15, cc = c & 31, ob = rr * 64 + cc * 2; return st * 1024 + (ob ^ (((ob >> 9) & 1) << 5)); }
__host__ __device__ __forceinline__ void stage_rc(int b, int& R, int& C) { const int st = b / 1024, sb = b % 1024, swz = sb ^ (((sb >> 9) & 1) << 5); R = (st >> 1) * 16 + swz / 64; C = (st & 1) * 32 + (swz % 64) / 2; }
__host__ __device__ __forceinline__ int perm32(int rho) { const int n = rho >> 4, i = rho & 15; return 8 * (i >> 2) + 4 * n + (i & 3); }

struct Unit { int pm, pn; };
struct Gemm { const bf16_t* A; const bf16_t* Bt; int M, N, K, lda, ldb; };

struct StaticOrder {
    int nM, nN, nwg, G, c;
    __host__ __device__ void init(int M, int N, int G_, int c_) { nM = M / BM; nN = N / BM; nwg = nM * nN; G = G_; c = c_; }
    __host__ __device__ bool next(int i, Unit& u) const {
        const long L = (long)i * G + c; if (L >= nwg) return false;
        int wgid = (int)L; { const int q = nwg / NXCD, r = nwg % NXCD, xcd = wgid % NXCD, off = wgid / NXCD; wgid = (xcd < r ? xcd * (q + 1) : r * (q + 1) + (xcd - r) * q) + off; }
        const int nig = WGM * nN, gid = wgid / nig, fm = gid * WGM, gsz = (nM - fm) < WGM ? (nM - fm) : WGM;
        u.pm = fm + ((wgid % nig) % gsz); u.pn = (wgid % nig) / gsz; return true;
    }
    __device__ __forceinline__ void a_ready(const Unit&) const {}
    __device__ __forceinline__ void done(const Unit&) const {}
};

__device__ __forceinline__ unsigned cvt_pk_bf16(float lo, float hi) { unsigned r; asm volatile("v_cvt_pk_bf16_f32 %0, %1, %2" : "=v"(r) : "v"(lo), "v"(hi)); return r; }

struct EpiBf16S {
    static constexpr bool PERM = true, AFTER_DRAIN = false;
    bf16_t* O; int ldc; const float* rs; float* dt; int dt_pn;
    __device__ __forceinline__ void operator()(const f32x4 (&acc)[2][2][4][2], const Unit& u, int wr, int wc, int fr, int fq) const {
        const int row0 = u.pm * BM + wr * 64 + fr;
        if (u.pn == dt_pn) {
            if (wc == 0) {
#pragma unroll
                for (int ai = 0; ai < 2; ++ai)
#pragma unroll
                    for (int m = 0; m < 4; ++m) { const int row = row0 + ai * HALF + m * 16; const float s = rs ? rs[row] : 1.f;
#pragma unroll
                        for (int n = 0; n < 2; ++n) *(f32x4*)(dt + (size_t)row * 32 + 8 * fq + 4 * n) = acc[ai][0][m][n] * s; }
            }
            return;
        }
        const int col0 = u.pn * BM + wc * 32 + 8 * fq;
#pragma unroll
        for (int ai = 0; ai < 2; ++ai)
#pragma unroll
            for (int m = 0; m < 4; ++m) { const int row = row0 + ai * HALF + m * 16; const float s = rs ? rs[row] : 1.f; bf16_t* rowp = O + (size_t)row * ldc + col0;
#pragma unroll
                for (int bj = 0; bj < 2; ++bj) { const f32x4 v0 = acc[ai][bj][m][0] * s, v1 = acc[ai][bj][m][1] * s;
                    u32x4 w; w.x = cvt_pk_bf16(v0[0], v0[1]); w.y = cvt_pk_bf16(v0[2], v0[3]); w.z = cvt_pk_bf16(v1[0], v1[1]); w.w = cvt_pk_bf16(v1[2], v1[3]);
                    *(u32x4*)(rowp + bj * HALF) = w; } }
    }
};
struct EpiF32Ssq {
    static constexpr bool PERM = false, AFTER_DRAIN = false;
    float* C; int ldc; float* ssq;
    __device__ __forceinline__ void operator()(const f32x4 (&acc)[2][2][4][2], const Unit& u, int wr, int wc, int fr, int fq) const {
        const int row0 = u.pm * BM + wr * 64 + fr, col0 = u.pn * BM + wc * 32 + 4 * fq;
#pragma unroll
        for (int ai = 0; ai < 2; ++ai)
#pragma unroll
            for (int m = 0; m < 4; ++m) { const int row = row0 + ai * HALF + m * 16; float* rowp = C + (size_t)row * ldc + col0; float q = 0.f;
#pragma unroll
                for (int bj = 0; bj < 2; ++bj)
#pragma unroll
                    for (int n = 0; n < 2; ++n) { const f32x4 v = acc[ai][bj][m][n]; *(f32x4*)(rowp + bj * HALF + n * 16) = v; q += (v[0] * v[0] + v[1] * v[1]) + (v[2] * v[2] + v[3] * v[3]); }
                q += __shfl_xor(q, 16); q += __shfl_xor(q, 32);
                if (fq == 0) ssq[(size_t)row * 32 + u.pn * 4 + wc] = q; }
    }
};

template <class Epi, class Sched, bool ALIGN_EPI = false, bool SP2 = false>
__device__ __forceinline__ void gemm_phase(PG8_LAS unsigned char* lds, const Gemm g, const Sched& S, const Epi& E) {
    int tid_ = threadIdx.x; asm volatile("" : "+v"(tid_));
    const int tid = tid_, wid = __builtin_amdgcn_readfirstlane(tid >> 6), lane = tid & 63, wr = wid >> 2, wc = wid & 3, fr = lane & 15, fq = lane >> 4;
    const int K = g.K, nt = K / BK;
    unsigned voffA[2], voffB[2];
#pragma unroll
    for (int i = 0; i < 2; ++i) { int R, C; stage_rc(tid * 16 + i * 8192, R, C); const int Rb = Epi::PERM ? ((R & ~31) + perm32(R & 31)) : R;
        voffA[i] = (unsigned)(R * g.lda + C) * 2u; voffB[i] = (unsigned)(Rb * g.ldb + C) * 2u; }
    const size_t kstep = (size_t)(BK * 2);
    const size_t hstepA = (size_t)HALF * g.lda * 2, hstepB = (size_t)HALF * g.ldb * 2;
    const size_t tstepA = 2 * hstepA, tstepB = 2 * hstepB;
    const unsigned ldsw = (unsigned)wid * 1024u;
    const int aoff = lds_byte(wr * 64 + fr, fq * 8), boff = lds_byte(wc * 32 + fr, fq * 8);
#define PG8_SA(b, h) (((b) * 2 + (h)) * HTB)
#define PG8_SB(b, h) ((4 + (b) * 2 + (h)) * HTB)
#define PG8_STAGE(bufoff, gbase, voff) do { _Pragma("unroll") for (int _i = 0; _i < 2; ++_i) \
        __builtin_amdgcn_global_load_lds((const unsigned*)((const char*)(gbase) + (voff)[_i]), (PG8_LAS unsigned*)(lds + (bufoff) + ldsw + _i * 8192), 16, 0, 0); } while (0)
#define PG8_LDA(dst, b, h) do { _Pragma("unroll") for (int m = 0; m < 4; ++m) _Pragma("unroll") for (int k = 0; k < 2; ++k) dst[m][k] = *(const PG8_LAS bf16x8*)(lds + PG8_SA(b, h) + aoff + m * 2048 + k * 1024); } while (0)
#define PG8_LDB(dst, b, h) do { _Pragma("unroll") for (int n = 0; n < 2; ++n) _Pragma("unroll") for (int k = 0; k < 2; ++k) dst[n][k] = *(const PG8_LAS bf16x8*)(lds + PG8_SB(b, h) + boff + n * 2048 + k * 1024); } while (0)
#define PG8_MMA(ai, bj, At, Bt) do { __builtin_amdgcn_s_setprio(1); _Pragma("unroll") for (int m = 0; m < 4; ++m) _Pragma("unroll") for (int n = 0; n < 2; ++n) _Pragma("unroll") for (int k = 0; k < 2; ++k) \
        acc[ai][bj][m][n] = __builtin_amdgcn_mfma_f32_16x16x32_bf16(Bt[n][k], At[m][k], acc[ai][bj][m][n], 0, 0, 0); __builtin_amdgcn_s_setprio(0); } while (0)
#define PG8_WAIT_V(n) asm volatile("s_waitcnt vmcnt(" #n ")" ::: "memory")
#define PG8_WAIT_L(n) asm volatile("s_waitcnt lgkmcnt(" #n ")" ::: "memory")
#define PG8_BAR __builtin_amdgcn_s_barrier()
#define PG8_SCHED __builtin_amdgcn_sched_barrier(0)
    Unit cur, nxt; int ui = 0;
    if (!S.next(0, cur)) return;
    f32x4 acc[2][2][4][2];
#pragma unroll
    for (int a = 0; a < 2; ++a)
#pragma unroll
        for (int b = 0; b < 2; ++b)
#pragma unroll
            for (int m = 0; m < 4; ++m)
#pragma unroll
                for (int n = 0; n < 2; ++n) acc[a][b][m][n] = (f32x4){0.f, 0.f, 0.f, 0.f};
    bf16x8 At[4][2], B0[2][2], B1[2][2];
    const char* cA = (const char*)g.A + (size_t)cur.pm * tstepA; const char* cB = (const char*)g.Bt + (size_t)cur.pn * tstepB;
    S.a_ready(cur);
    if constexpr (SP2) {
        PG8_STAGE(PG8_SB(0, 0), cB, voffB); PG8_STAGE(PG8_SB(0, 1), cB + hstepB, voffB); PG8_STAGE(PG8_SA(0, 0), cA, voffA); PG8_STAGE(PG8_SA(0, 1), cA + hstepA, voffA);
        if (wr == 1) PG8_BAR;
        PG8_WAIT_V(2); PG8_BAR;
        PG8_STAGE(PG8_SB(1, 0), cB + kstep, voffB); PG8_STAGE(PG8_SA(1, 0), cA + kstep, voffA); PG8_STAGE(PG8_SB(1, 1), cB + hstepB + kstep, voffB);
        PG8_WAIT_V(6); PG8_BAR;
    } else {
        PG8_STAGE(PG8_SB(0, 0), cB, voffB); PG8_STAGE(PG8_SA(0, 0), cA, voffA); PG8_STAGE(PG8_SB(0, 1), cB + hstepB, voffB); PG8_STAGE(PG8_SA(0, 1), cA + hstepA, voffA);
        if (wr == 1) PG8_BAR;
        PG8_WAIT_V(4); PG8_BAR;
        PG8_STAGE(PG8_SB(1, 0), cB + kstep, voffB); PG8_STAGE(PG8_SA(1, 0), cA + kstep, voffA); PG8_STAGE(PG8_SB(1, 1), cB + hstepB + kstep, voffB);
        PG8_WAIT_V(6); PG8_BAR;
    }
    for (;;) {
        const bool has_next = S.next(ui + 1, nxt);
        const char* nA = has_next ? (const char*)g.A + (size_t)nxt.pm * tstepA : cA; const char* nB = has_next ? (const char*)g.Bt + (size_t)nxt.pn * tstepB : cB;
        for (int t = 0; t < nt; t += 2) {
            const bool last = (t == nt - 2);
            const char* a1 = cA + (size_t)(t + 1) * kstep;
            const char* a2 = last ? nA : cA + (size_t)(t + 2) * kstep; const char* b2 = last ? nB : cB + (size_t)(t + 2) * kstep;
            const char* a3 = a2 + kstep; const char* b3 = b2 + kstep;
            if (last && has_next) S.a_ready(nxt);
            if constexpr (SP2) {
            PG8_LDB(B0, 0, 0); PG8_LDB(B1, 0, 1); PG8_SCHED; PG8_LDA(At, 0, 0); PG8_STAGE(PG8_SA(1, 1), a1 + hstepA, voffA);
            PG8_WAIT_V(8); PG8_WAIT_L(0); PG8_BAR; PG8_MMA(0, 0, At, B0); PG8_MMA(0, 1, At, B1); PG8_BAR; PG8_SCHED;
            PG8_LDA(At, 0, 1); PG8_STAGE(PG8_SB(0, 0), b2, voffB); PG8_STAGE(PG8_SB(0, 1), b2 + hstepB, voffB); PG8_STAGE(PG8_SA(0, 0), a2, voffA);
            PG8_WAIT_V(8); PG8_WAIT_L(0); PG8_BAR; PG8_MMA(1, 0, At, B0); PG8_MMA(1, 1, At, B1); PG8_BAR; PG8_SCHED;
            PG8_LDB(B0, 1, 0); PG8_LDB(B1, 1, 1); PG8_SCHED; PG8_LDA(At, 1, 0); PG8_STAGE(PG8_SA(0, 1), a2 + hstepA, voffA);
            PG8_WAIT_V(8); PG8_WAIT_L(0); PG8_BAR; PG8_MMA(0, 0, At, B0); PG8_MMA(0, 1, At, B1); PG8_BAR; PG8_SCHED;
            PG8_LDA(At, 1, 1); PG8_STAGE(PG8_SB(1, 0), b3, voffB); PG8_STAGE(PG8_SB(1, 1), b3 + hstepB, voffB); PG8_STAGE(PG8_SA(1, 0), a3, voffA);
            PG8_WAIT_V(8); PG8_WAIT_L(0); PG8_BAR; PG8_MMA(1, 0, At, B0); PG8_MMA(1, 1, At, B1); PG8_BAR; PG8_SCHED;
            } else {
            PG8_LDB(B0, 0, 0); PG8_SCHED; PG8_LDA(At, 0, 0); PG8_STAGE(PG8_SA(1, 1), a1 + hstepA, voffA);
            PG8_WAIT_L(8); PG8_BAR; PG8_WAIT_L(0); PG8_MMA(0, 0, At, B0); PG8_BAR; PG8_SCHED;
            PG8_LDB(B1, 0, 1); PG8_STAGE(PG8_SB(0, 0), b2, voffB);
            PG8_BAR; PG8_WAIT_L(0); PG8_MMA(0, 1, At, B1); PG8_BAR;
            PG8_LDA(At, 0, 1); PG8_STAGE(PG8_SA(0, 0), a2, voffA);
            PG8_BAR; PG8_WAIT_L(0); PG8_MMA(1, 0, At, B0); PG8_BAR; PG8_SCHED;
            PG8_STAGE(PG8_SB(0, 1), b2 + hstepB, voffB);
            PG8_WAIT_V(6); PG8_BAR; PG8_MMA(1, 1, At, B1); PG8_BAR;
            PG8_LDB(B0, 1, 0); PG8_SCHED; PG8_LDA(At, 1, 0); PG8_STAGE(PG8_SA(0, 1), a2 + hstepA, voffA);
            PG8_WAIT_L(8); PG8_BAR; PG8_WAIT_L(0); PG8_MMA(0, 0, At, B0); PG8_BAR; PG8_SCHED;
            PG8_LDB(B1, 1, 1); PG8_STAGE(PG8_SB(1, 0), b3, voffB);
            PG8_BAR; PG8_WAIT_L(0); PG8_MMA(0, 1, At, B1); PG8_BAR;
            PG8_LDA(At, 1, 1); PG8_STAGE(PG8_SA(1, 0), a3, voffA);
            PG8_BAR; PG8_WAIT_L(0); PG8_MMA(1, 0, At, B0); PG8_BAR; PG8_SCHED;
            PG8_STAGE(PG8_SB(1, 1), b3 + hstepB, voffB);
            PG8_WAIT_V(6); PG8_BAR; PG8_MMA(1, 1, At, B1); PG8_BAR;
            }
        }
        if constexpr (ALIGN_EPI) { if (wr == 0) PG8_BAR; }
        if constexpr (!Epi::AFTER_DRAIN) { E(acc, cur, wr, wc, fr, fq); S.done(cur); }
        if (!has_next) break;
#pragma unroll
        for (int a = 0; a < 2; ++a)
#pragma unroll
            for (int b = 0; b < 2; ++b)
#pragma unroll
                for (int m = 0; m < 4; ++m)
#pragma unroll
                    for (int n = 0; n < 2; ++n) acc[a][b][m][n] = (f32x4){0.f, 0.f, 0.f, 0.f};
        cur = nxt; cA = nA; cB = nB; ++ui;
        if constexpr (ALIGN_EPI) { if (wr == 1) PG8_BAR; }
    }
    PG8_WAIT_V(0);
    if constexpr (!ALIGN_EPI) { if (wr == 0) PG8_BAR; }
    PG8_BAR;
#undef PG8_SA
#undef PG8_SB
#undef PG8_STAGE
#undef PG8_LDA
#undef PG8_LDB
#undef PG8_MMA
#undef PG8_WAIT_V
#undef PG8_WAIT_L
#undef PG8_BAR
#undef PG8_SCHED
}
}

constexpr int NWAVES = 8, NTHR = 512;
constexpr int DM = 2048, SEQ = 2048, NB_P = 8, NB_S = 32, SEQ_S = 32, DEPTH = 4;
constexpr int MP = NB_P * SEQ, MS = NB_S * SEQ_S, M = MP + MS;
constexpr int D_POOL = 1024, POOL_HIST = 15, D_SSD = 2048, HD = 64, NH = 32, HPG = 16, DS = 128, CONV_DIM = 2560, D_MIX = 3072;
constexpr int D_IN = 5664, N_PROJ = 5632, N_INP = 5888, D_FF = 5632, D_UP = 11264;
constexpr int XBC0 = 3072;
constexpr float EPS = 1e-6f;

constexpr size_t O_YP = 0, O_YS = O_YP + (size_t)MP * DM, O_POOLP = O_YS + (size_t)MS * DM, O_POOLS = O_POOLP + (size_t)DEPTH * NB_P * 15 * 1024,
    O_SCP = O_POOLS + (size_t)DEPTH * NB_S * 15 * 1024, O_SCS = O_SCP + (size_t)DEPTH * NB_P * 3 * 2560, O_SSDP = O_SCS + (size_t)DEPTH * NB_S * 3 * 2560,
    O_SSDS = O_SSDP + (size_t)DEPTH * NB_P * 32 * 64 * 128, O_FCP = O_SSDS + (size_t)DEPTH * NB_S * 32 * 64 * 128, O_FCS = O_FCP + (size_t)DEPTH * NB_P * 2 * 11264,
    O_END = O_FCS + (size_t)DEPTH * NB_S * 2 * 11264;

constexpr size_t al256(size_t x) { return (x + 255) & ~(size_t)255; }
constexpr size_t WS_CTL = 0, CTL_BYTES = 1u << 20;
constexpr size_t WS_BTIN = CTL_BYTES;
constexpr size_t WS_BTOUT = WS_BTIN + (size_t)DEPTH * N_INP * DM * 2;
constexpr size_t WS_BTUP = WS_BTOUT + (size_t)DEPTH * DM * D_MIX * 2;
constexpr size_t WS_BTDN = WS_BTUP + (size_t)DEPTH * D_UP * DM * 2;
constexpr size_t WS_WOP = WS_BTDN + (size_t)DEPTH * DM * D_FF * 2;
constexpr size_t WS_WPB = WS_WOP + (size_t)DEPTH * DM * D_POOL * 2;
constexpr size_t WS_X = WS_WPB + (size_t)DEPTH * 4 * 256 * 256 * 2;
constexpr size_t WS_XB = WS_X + (size_t)M * DM * 4;
constexpr size_t WS_R = WS_XB + (size_t)M * DM * 2;
constexpr size_t WS_DT = WS_R + al256((size_t)M * 4);
constexpr size_t WS_SSQP = WS_DT + (size_t)M * 32 * 4;
constexpr size_t WS_SSQH = WS_SSQP + (size_t)M * 32 * 4;
constexpr size_t WS_ACT = WS_SSQH + (size_t)M * 32 * 4;
constexpr size_t WS_RA = WS_ACT + (size_t)M * D_FF * 2;
constexpr size_t WS_PROJ = WS_RA;
constexpr size_t WS_MIXA = WS_PROJ + (size_t)M * N_PROJ * 2;
constexpr size_t WS_MIX = WS_MIXA + (size_t)M * D_MIX * 2;
constexpr size_t WS_UP = WS_RA;
constexpr size_t WS_END = WS_MIX + (size_t)M * DM * 4;
static_assert((size_t)M * D_UP * 2 <= WS_END - WS_RA, "UP fits region A");

constexpr int RING_BYTES = 131072, LDSCTL_OFF = RING_BYTES, LDS_BYTES = 147456;

#define LAS __attribute__((address_space(3)))
typedef unsigned short bf16;
typedef float f32x4 __attribute__((ext_vector_type(4)));
#define RLX_AGENT __ATOMIC_RELAXED, __HIP_MEMORY_SCOPE_AGENT
__device__ __forceinline__ unsigned f2bf(float f) { unsigned u = __builtin_bit_cast(unsigned, f); return (u + 0x7fffu + ((u >> 16) & 1u)) >> 16; }
__device__ __forceinline__ unsigned pk2(float lo, float hi) { return f2bf(lo) | (f2bf(hi) << 16); }
__device__ __forceinline__ float bflo(unsigned u) { return __uint_as_float(u << 16); }
__device__ __forceinline__ float bfhi(unsigned u) { return __uint_as_float(u & 0xffff0000u); }
__device__ __forceinline__ float bf2f(bf16 b) { return __uint_as_float(((unsigned)b) << 16); }
struct F8 { float v[8]; };
__device__ __forceinline__ F8 ld_bf8(const bf16* p) { const uint4 u = *(const uint4*)p; F8 r; r.v[0] = bflo(u.x); r.v[1] = bfhi(u.x); r.v[2] = bflo(u.y); r.v[3] = bfhi(u.y); r.v[4] = bflo(u.z); r.v[5] = bfhi(u.z); r.v[6] = bflo(u.w); r.v[7] = bfhi(u.w); return r; }
__device__ __forceinline__ F8 ld_f8(const float* p) { const float4 a = *(const float4*)p, b = *(const float4*)(p + 4); F8 r; r.v[0] = a.x; r.v[1] = a.y; r.v[2] = a.z; r.v[3] = a.w; r.v[4] = b.x; r.v[5] = b.y; r.v[6] = b.z; r.v[7] = b.w; return r; }
__device__ __forceinline__ F8 zero8() { F8 r;
#pragma unroll
    for (int i = 0; i < 8; ++i) r.v[i] = 0.f; return r; }
__device__ __forceinline__ void st_bf8(bf16* p, const F8& r) { uint4 u; u.x = pk2(r.v[0], r.v[1]); u.y = pk2(r.v[2], r.v[3]); u.z = pk2(r.v[4], r.v[5]); u.w = pk2(r.v[6], r.v[7]); *(uint4*)p = u; }
__device__ __forceinline__ void st_f8(float* p, const F8& r) { *(float4*)p = make_float4(r.v[0], r.v[1], r.v[2], r.v[3]); *(float4*)(p + 4) = make_float4(r.v[4], r.v[5], r.v[6], r.v[7]); }
__device__ __forceinline__ float silu_f(float x) { return x / (1.f + __expf(-x)); }
__device__ __forceinline__ float wave_sum(float v) {
#pragma unroll
    for (int o = 1; o < 64; o <<= 1) v += __shfl_xor(v, o);
    return v;
}

#define XB_TMO      128
#define XB_XCNT(j)  (256  + 64 * (j))
#define XB_XSUB(j)  (1280 + 64 * (j))
#define XB_XGEN(j)  (2304 + 64 * (j))
#define XB_TOP      3328
#define XB_TOPGEN   3392
#define XCD_BAR_WORDS 3456
#define XB_SPIN_CAP (1u << 18)
__device__ __forceinline__ unsigned xb_ld(unsigned* p)              { return __hip_atomic_load(p, __ATOMIC_RELAXED, __HIP_MEMORY_SCOPE_AGENT); }
__device__ __forceinline__ unsigned xb_add(unsigned* p, unsigned v) { return __hip_atomic_fetch_add(p, v, __ATOMIC_RELAXED, __HIP_MEMORY_SCOPE_AGENT); }
__device__ __forceinline__ unsigned xb_xcc_id() { return (unsigned)__builtin_amdgcn_s_getreg((3 << 11) | 20) & 0xFu; }
#define XB_SPIN(cond, bar) do { unsigned _sp = 0; while (cond) { __builtin_amdgcn_s_sleep(1); \
    if ((++_sp & 255u) == 0u) { if (xb_ld(&(bar)[XB_TMO])) break; if (_sp > XB_SPIN_CAP) { atomicAdd(&(bar)[XB_TMO], 1u); break; } } } } while (0)
struct XcdBarrier { unsigned* bar; unsigned x; volatile LAS unsigned* st; };
__device__ __forceinline__ XcdBarrier xcd_barrier_post(unsigned* bar, volatile LAS unsigned* st) {
    XcdBarrier b; b.bar = bar; b.x = xb_xcc_id(); b.st = st;
    if (threadIdx.x == 0) (void)xb_add(&bar[XB_XCNT(b.x)], 1u);
    return b;
}
__device__ __forceinline__ void xcd_barrier_complete(unsigned* bar, unsigned x, unsigned& nloc, unsigned& nx) {
    const unsigned G = gridDim.x * gridDim.y * gridDim.z;
    unsigned sum, cnt, mine, sp = 0u;
    for (;;) {
        sum = 0u; cnt = 0u; mine = 0u;
#pragma unroll
        for (unsigned j = 0; j < 16; ++j) { const unsigned c = xb_ld(&bar[XB_XCNT(j)]); sum += c; cnt += (c > 0u) ? 1u : 0u; mine = (j == x) ? c : mine; }
        if (sum == G) break;
        __builtin_amdgcn_s_sleep(1);
        if ((++sp & 255u) == 0u) { if (xb_ld(&bar[XB_TMO])) break; if (sp > XB_SPIN_CAP) { atomicAdd(&bar[XB_TMO], 1u); break; } }
    }
    nloc = mine > 0u ? mine : 1u; nx = cnt > 0u ? cnt : 1u;
}
__device__ __forceinline__ void xcd_barrier(const XcdBarrier& b) {
    asm volatile("s_waitcnt vmcnt(0)" ::: "memory");
    __syncthreads();
    if (threadIdx.x == 0) {
        unsigned* bar = b.bar;
        __builtin_amdgcn_s_waitcnt(0);
        unsigned nloc = b.st[0], nx = b.st[1];
        if (nloc == 0u) { xcd_barrier_complete(bar, b.x, nloc, nx); b.st[0] = nloc; b.st[1] = nx; }
        const unsigned old = xb_add(&bar[XB_XSUB(b.x)], 1u);
        const unsigned gen = old / nloc;
        if (old + 1u == (gen + 1u) * nloc) {
            __builtin_amdgcn_fence(__ATOMIC_RELEASE, "agent");
            asm volatile("s_waitcnt vmcnt(0)" ::: "memory");
            const unsigned og = xb_add(&bar[XB_TOP], 1u);
            const unsigned tg = og / nx;
            if (og + 1u == (tg + 1u) * nx) xb_add(&bar[XB_TOPGEN], 1u);
            else XB_SPIN(xb_ld(&bar[XB_TOPGEN]) == tg, bar);
            __builtin_amdgcn_fence(__ATOMIC_ACQUIRE, "agent");
            xb_add(&bar[XB_XGEN(b.x)], 1u);
            asm volatile("s_waitcnt vmcnt(0)" ::: "memory");
        } else {
            XB_SPIN(xb_ld(&bar[XB_XGEN(b.x)]) == gen, bar);
            __builtin_amdgcn_fence(__ATOMIC_ACQUIRE, "agent");
            asm volatile("s_waitcnt vmcnt(0)" ::: "memory");
        }
    }
    __syncthreads();
}

struct Args { const float* in[24]; float* out; unsigned char* ws; int ph_lo, ph_hi; };

struct Ctx {
    LAS unsigned char* lds; int tid, lane, wave, G, gw, NGW;
    const float* const* in; float* out; unsigned char* ws;
    __device__ __forceinline__ void refresh() {
        int t = threadIdx.x; asm volatile("" : "+v"(t)); tid = t; lane = t & 63; wave = __builtin_amdgcn_readfirstlane(t >> 6); gw = blockIdx.x * NWAVES + wave; NGW = G * NWAVES; }
};

__device__ __forceinline__ void conv_item(const float* W, int N, const float* gain, bf16* dst, int ldd, LAS float* scr, int kb, int nb, int lane) {
    const int k0 = 64 * kb, n0 = 32 * nb;
#pragma unroll 8
    for (int i = 0; i < 32; ++i) { const int kk = 2 * i + (lane >> 5); const float gsc = gain ? gain[k0 + kk] : 1.f; scr[kk * 33 + (lane & 31)] = W[(size_t)(k0 + kk) * N + n0 + (lane & 31)] * gsc; }
    asm volatile("s_waitcnt lgkmcnt(0)" ::: "memory");
    const int c = lane & 7;
#pragma unroll
    for (int j = 0; j < 4; ++j) { const int n = (lane >> 3) + 8 * j; const LAS float* s = scr + (8 * c) * 33 + n;
        uint4 o; o.x = pk2(s[0 * 33], s[1 * 33]); o.y = pk2(s[2 * 33], s[3 * 33]); o.z = pk2(s[4 * 33], s[5 * 33]); o.w = pk2(s[6 * 33], s[7 * 33]);
        *(uint4*)(dst + (size_t)(n0 + n) * ldd + k0 + 8 * c) = o; }
    asm volatile("s_waitcnt lgkmcnt(0)" ::: "memory");
}
__device__ __forceinline__ void phase_convert(Ctx C) {
    C.refresh();
    LAS float* scr = (LAS float*)(C.lds + C.wave * 16384);
    constexpr int I_IN = (DM / 64) * (D_IN / 32), I_OUT = (D_MIX / 64) * (DM / 32), I_UP = (DM / 64) * (D_UP / 32), I_DN = (D_FF / 64) * (DM / 32), I_L = I_IN + I_OUT + I_UP + I_DN;
    for (int it = C.gw; it < DEPTH * I_L; it += C.NGW) {
        const int l = it / I_L; int r = it % I_L;
        if (r < I_IN) { const int nbk = D_IN / 32; conv_item(C.in[7] + (size_t)l * DM * D_IN, D_IN, C.in[6] + l * DM, (bf16*)(C.ws + WS_BTIN) + (size_t)l * N_INP * DM, DM, scr, r / nbk, r % nbk, C.lane); continue; }
        r -= I_IN;
        if (r < I_OUT) { const int nbk = DM / 32, kb = r / nbk, nb = r % nbk; const float* W = C.in[16] + (size_t)l * D_MIX * DM;
            if (kb < 16) conv_item(W, DM, C.in[9] + l * D_POOL, (bf16*)(C.ws + WS_WOP) + (size_t)l * DM * D_POOL, D_POOL, scr, kb, nb, C.lane);
            else conv_item(W, DM, C.in[15] + l * D_SSD - D_POOL, (bf16*)(C.ws + WS_BTOUT) + (size_t)l * DM * D_MIX, D_MIX, scr, kb, nb, C.lane);
            continue; }
        r -= I_OUT;
        if (r < I_UP) { const int nbk = D_UP / 32; conv_item(C.in[19] + (size_t)l * DM * D_UP, D_UP, C.in[18] + l * DM, (bf16*)(C.ws + WS_BTUP) + (size_t)l * D_UP * DM, DM, scr, r / nbk, r % nbk, C.lane); continue; }
        r -= I_UP;
        { const int nbk = DM / 32; conv_item(C.in[22] + (size_t)l * D_FF * DM, DM, nullptr, (bf16*)(C.ws + WS_BTDN) + (size_t)l * DM * D_FF, D_FF, scr, r / nbk, r % nbk, C.lane); }
    }
    { const int gt = C.gw * 64 + C.lane, NGT = C.NGW * 64; constexpr int PER_L = (N_INP - D_IN) * DM / 8;
      for (int i = gt; i < DEPTH * PER_L; i += NGT) { const int l = i / PER_L, r = i % PER_L; *(uint4*)((bf16*)(C.ws + WS_BTIN) + ((size_t)l * N_INP + D_IN) * DM + (size_t)r * 8) = make_uint4(0u, 0u, 0u, 0u); }
      const float* wp = C.in[8]; bf16* wpb = (bf16*)(C.ws + WS_WPB);
      for (int i = gt; i < DEPTH * 4 * 256 * 256 / 8; i += NGT) { const F8 v = ld_f8(wp + (size_t)i * 8); st_bf8(wpb + (size_t)i * 8, v); } }
    for (int row = C.gw; row < M; row += C.NGW) {
        const float* src = row < MP ? C.in[0] + (size_t)row * DM : C.in[1] + (size_t)(row - MP) * DM;
        float* X = (float*)(C.ws + WS_X) + (size_t)row * DM; bf16* XB = (bf16*)(C.ws + WS_XB) + (size_t)row * DM; float q = 0.f;
#pragma unroll
        for (int j = 0; j < 8; ++j) { const int idx = (C.lane + 64 * j) * 4; const float4 v = *(const float4*)(src + idx); *(float4*)(X + idx) = v; q += (v.x * v.x + v.y * v.y) + (v.z * v.z + v.w * v.w);
            *(uint2*)(XB + idx) = make_uint2(pk2(v.x, v.y), pk2(v.z, v.w)); }
        q = wave_sum(q);
        if (C.lane == 0) ((float*)(C.ws + WS_R))[row] = rsqrtf(q * (1.f / DM) + EPS);
    }
}

__device__ __forceinline__ void phase_resid(Ctx C, const float* gpost, bool final_out) {
    C.refresh();
    const float* MIX = (const float*)(C.ws + WS_MIX); const float* SSQ = (const float*)(C.ws + WS_SSQP);
    for (int row = C.gw; row < M; row += C.NGW) {
        float p = C.lane < 32 ? SSQ[(size_t)row * 32 + C.lane] : 0.f; p = wave_sum(p);
        const float rs = rsqrtf(p * (1.f / DM) + EPS);
        float* X = (float*)(C.ws + WS_X) + (size_t)row * DM; bf16* XB = (bf16*)(C.ws + WS_XB) + (size_t)row * DM; const float* mx = MIX + (size_t)row * DM;
        float* Y = C.out + O_YP + (size_t)row * DM; float q = 0.f;
#pragma unroll
        for (int j = 0; j < 8; ++j) { const int idx = (C.lane + 64 * j) * 4; const float4 m4 = *(const float4*)(mx + idx), g4 = *(const float4*)(gpost + idx); float4 v = *(const float4*)(X + idx);
            v.x += m4.x * rs * g4.x; v.y += m4.y * rs * g4.y; v.z += m4.z * rs * g4.z; v.w += m4.w * rs * g4.w;
            *(float4*)(X + idx) = v; if (final_out) *(float4*)(Y + idx) = v;
            q += (v.x * v.x + v.y * v.y) + (v.z * v.z + v.w * v.w);
            *(uint2*)(XB + idx) = make_uint2(pk2(v.x, v.y), pk2(v.z, v.w)); }
        q = wave_sum(q);
        if (C.lane == 0) ((float*)(C.ws + WS_R))[row] = rsqrtf(q * (1.f / DM) + EPS);
    }
}

__device__ __forceinline__ void phase_gnorm(Ctx C) {
    C.refresh();
    const float* SSQH = (const float*)(C.ws + WS_SSQH); bf16* MIXA = (bf16*)(C.ws + WS_MIXA);
    for (int row = C.gw; row < M; row += C.NGW) {
        float p = C.lane < 32 ? SSQH[(size_t)row * 32 + C.lane] : 0.f;
#pragma unroll
        for (int o = 1; o < 16; o <<= 1) p += __shfl_xor(p, o);
        const float s0 = __shfl(p, 0), s1 = __shfl(p, 16);
        const float r0 = rsqrtf(s0 * (1.f / 1024.f) + EPS), r1 = rsqrtf(s1 * (1.f / 1024.f) + EPS);
        bf16* y = MIXA + (size_t)row * D_MIX + D_POOL;
#pragma unroll
        for (int j = 0; j < 4; ++j) { const int c = (C.lane + 64 * j) * 8; const float r = c < 1024 ? r0 : r1; F8 v = ld_bf8(y + c);
#pragma unroll
            for (int i = 0; i < 8; ++i) v.v[i] *= r;
            st_bf8(y + c, v); }
    }
}

__device__ __forceinline__ void phase_act(Ctx C, int l) {
    C.refresh();
    const bf16* UP = (const bf16*)(C.ws + WS_UP); bf16* ACT = (bf16*)(C.ws + WS_ACT);
    const float* cw = C.in[20] + (size_t)l * 3 * D_UP; const float* cb = C.in[21] + (size_t)l * D_UP; const float* hist = C.in[5] + (size_t)l * NB_S * 2 * D_UP;
    constexpr int NCG = D_FF / 8, NSTRIP = M / 32;
    const int gt = C.gw * 64 + C.lane, NGT = C.NGW * 64;
    for (int it = gt; it < NSTRIP * NCG; it += NGT) {
        const int strip = it / NCG, c = (it % NCG) * 8, row0 = strip * 32; const bool prm = row0 < MP;
        const int b = prm ? row0 / SEQ : (row0 - MP) / SEQ_S, t0 = prm ? row0 % SEQ : 0;
        F8 p2g, p1g, p2v, p1v;
        if (t0 == 0) { if (prm) { p2g = zero8(); p1g = zero8(); p2v = zero8(); p1v = zero8(); }
            else { const float* h = hist + (size_t)b * 2 * D_UP; p2g = ld_f8(h + c); p2v = ld_f8(h + D_FF + c); p1g = ld_f8(h + D_UP + c); p1v = ld_f8(h + D_UP + D_FF + c); } }
        else { p2g = ld_bf8(UP + (size_t)(row0 - 2) * D_UP + c); p2v = ld_bf8(UP + (size_t)(row0 - 2) * D_UP + D_FF + c); p1g = ld_bf8(UP + (size_t)(row0 - 1) * D_UP + c); p1v = ld_bf8(UP + (size_t)(row0 - 1) * D_UP + D_FF + c); }
        const F8 w0g = ld_f8(cw + c), w1g = ld_f8(cw + D_UP + c), w2g = ld_f8(cw + 2 * D_UP + c), bg = ld_f8(cb + c);
        const F8 w0v = ld_f8(cw + D_FF + c), w1v = ld_f8(cw + D_UP + D_FF + c), w2v = ld_f8(cw + 2 * D_UP + D_FF + c), bv = ld_f8(cb + D_FF + c);
        for (int r = 0; r < 32; ++r) {
            const F8 cg = ld_bf8(UP + (size_t)(row0 + r) * D_UP + c), cv = ld_bf8(UP + (size_t)(row0 + r) * D_UP + D_FF + c); F8 o;
#pragma unroll
            for (int i = 0; i < 8; ++i) { const float g = bg.v[i] + w0g.v[i] * p2g.v[i] + w1g.v[i] * p1g.v[i] + w2g.v[i] * cg.v[i]; const float v = bv.v[i] + w0v.v[i] * p2v.v[i] + w1v.v[i] * p1v.v[i] + w2v.v[i] * cv.v[i]; o.v[i] = silu_f(g) * v; }
            st_bf8(ACT + (size_t)(row0 + r) * D_FF + c, o);
            p2g = p1g; p1g = cg; p2v = p1v; p1v = cv;
        }
        if (!prm || t0 + 32 == SEQ) {
            float* o = C.out + (prm ? O_FCP + ((size_t)(l * NB_P + b) * 2) * D_UP : O_FCS + ((size_t)(l * NB_S + b) * 2) * D_UP);
            st_f8(o + c, p2g); st_f8(o + D_FF + c, p2v); st_f8(o + D_UP + c, p1g); st_f8(o + D_UP + D_FF + c, p1v);
        }
    }
}

__device__ __forceinline__ void phase_pool(Ctx C, int l) {
    C.refresh();
    const bf16* PROJ = (const bf16*)(C.ws + WS_PROJ); bf16* MIXA = (bf16*)(C.ws + WS_MIXA);
    const float* hist = C.in[2] + (size_t)l * NB_S * POOL_HIST * D_POOL;
    constexpr int NCG = D_POOL / 8, NSTRIP = M / 32;
    const int gt = C.gw * 64 + C.lane, NGT = C.NGW * 64;
    for (int it = gt; it < NSTRIP * NCG; it += NGT) {
        const int strip = it / NCG, cgi = it % NCG, c = cgi * 8, row0 = strip * 32; const bool prm = row0 < MP;
        const int b = prm ? row0 / SEQ : (row0 - MP) / SEQ_S, t0 = prm ? row0 % SEQ : 0, w = 2 << (cgi >> 5);
        const int rb = row0 - t0;
        const float* hb = hist + (size_t)b * POOL_HIST * D_POOL;
        F8 s = zero8();
        for (int i = 1; i < w; ++i) { const int t = t0 - i; F8 v;
            if (t >= 0) v = ld_bf8(PROJ + (size_t)(rb + t) * N_PROJ + c); else if (!prm) v = ld_f8(hb + (size_t)(POOL_HIST + t) * D_POOL + c); else v = zero8();
#pragma unroll
            for (int k = 0; k < 8; ++k) s.v[k] += v.v[k]; }
        for (int r = 0; r < 32; ++r) {
            const int t = t0 + r; const F8 cur = ld_bf8(PROJ + (size_t)(rb + t) * N_PROJ + c);
            const float inv = 1.f / (float)(prm ? (t + 1 < w ? t + 1 : w) : w); F8 o;
#pragma unroll
            for (int k = 0; k < 8; ++k) { s.v[k] += cur.v[k]; o.v[k] = s.v[k] * inv - cur.v[k]; }
            st_bf8(MIXA + (size_t)(rb + t) * D_MIX + c, o);
            const int tl = t - w + 1; F8 v;
            if (tl >= 0) v = ld_bf8(PROJ + (size_t)(rb + tl) * N_PROJ + c); else if (!prm) v = ld_f8(hb + (size_t)(POOL_HIST + tl) * D_POOL + c); else v = zero8();
#pragma unroll
            for (int k = 0; k < 8; ++k) s.v[k] -= v.v[k];
        }
    }
    for (int it = gt; it < (NB_P + NB_S) * 15 * NCG; it += NGT) {
        const int cg = it % NCG, i = (it / NCG) % 15, sb = it / (NCG * 15); const bool prm = sb < NB_P; const int b = prm ? sb : sb - NB_P;
        const int row = prm ? b * SEQ + (SEQ - 15 + i) : MP + b * SEQ_S + (SEQ_S - 15 + i);
        float* o = C.out + (prm ? O_POOLP + ((size_t)(l * NB_P + b) * 15 + i) * D_POOL : O_POOLS + ((size_t)(l * NB_S + b) * 15 + i) * D_POOL);
        st_f8(o + cg * 8, ld_bf8(PROJ + (size_t)row * N_PROJ + cg * 8));
    }
    constexpr int NCG2 = CONV_DIM / 8;
    for (int it = gt; it < (NB_P + NB_S) * 3 * NCG2; it += NGT) {
        const int cg = it % NCG2, i = (it / NCG2) % 3, sb = it / (NCG2 * 3); const bool prm = sb < NB_P; const int b = prm ? sb : sb - NB_P;
        const int row = prm ? b * SEQ + (SEQ - 3 + i) : MP + b * SEQ_S + (SEQ_S - 3 + i);
        float* o = C.out + (prm ? O_SCP + ((size_t)(l * NB_P + b) * 3 + i) * CONV_DIM : O_SCS + ((size_t)(l * NB_S + b) * 3 + i) * CONV_DIM);
        st_f8(o + cg * 8, ld_bf8(PROJ + (size_t)row * N_PROJ + XBC0 + cg * 8));
    }
}

__device__ __forceinline__ void phase_ssd(Ctx C, int l) {
    C.refresh();
    LAS float* xs = (LAS float*)(C.lds); LAS float* Bs = (LAS float*)(C.lds + 16384); LAS float* Cs = (LAS float*)(C.lds + 49152); LAS float* ys = (LAS float*)(C.lds + 81920);
    LAS float* dts = (LAS float*)(C.lds + 98304); LAS float* dAs = dts + 64;
    const bf16* PROJ = (const bf16*)(C.ws + WS_PROJ); const float* DT = (const float*)(C.ws + WS_DT); bf16* MIXA = (bf16*)(C.ws + WS_MIXA); float* SSQH = (float*)(C.ws + WS_SSQH);
    const float* cw = C.in[10] + (size_t)l * 4 * CONV_DIM; const float* cb = C.in[11] + (size_t)l * CONV_DIM;
    const int tid = C.tid, p = tid >> 3, n0 = (tid & 7) * 16;
    for (int u = blockIdx.x; u < NB_P * NH + NB_S * NH; u += C.G) {
        const bool prm = u < NB_P * NH; const int su = prm ? u : u - NB_P * NH, b = su / NH, hh = su % NH, g = hh / HPG;
        const int rb = prm ? b * SEQ : MP + b * SEQ_S, rows = prm ? 64 : 32, nchunk = prm ? SEQ / 64 : 1;
        const float Aneg = -__expf(C.in[13][l * NH + hh]), Dsk = C.in[14][l * NH + hh], dtb = C.in[12][l * NH + hh];
        const float* chist = C.in[3] + ((size_t)(l * NB_S + b) * 3) * CONV_DIM;
        float h[16];
        if (prm) {
#pragma unroll
            for (int i = 0; i < 16; ++i) h[i] = 0.f;
        } else { const float* h0 = C.in[4] + ((((size_t)l * NB_S + b) * NH + hh) * HD + p) * DS + n0;
#pragma unroll
            for (int i = 0; i < 4; ++i) { const float4 v = *(const float4*)(h0 + 4 * i); h[4 * i] = v.x; h[4 * i + 1] = v.y; h[4 * i + 2] = v.z; h[4 * i + 3] = v.w; } }
        for (int ch = 0; ch < nchunk; ++ch) {
            const int tb = ch * 64;
            for (int e = tid; e < rows * 40; e += NTHR) {
                const int cg = e % 40, tt = e / 40, t = tb + tt;
                int cc; LAS float* dstp;
                if (cg < 8) { cc = hh * HD + cg * 8; dstp = xs + tt * 64 + cg * 8; }
                else if (cg < 24) { cc = D_SSD + g * DS + (cg - 8) * 8; dstp = Bs + tt * 128 + (cg - 8) * 8; }
                else { cc = D_SSD + 2 * DS + g * DS + (cg - 24) * 8; dstp = Cs + tt * 128 + (cg - 24) * 8; }
                F8 a = ld_f8(cb + cc);
#pragma unroll
                for (int i = 0; i < 4; ++i) { const int ti = t - 3 + i; F8 v;
                    if (ti >= 0) v = ld_bf8(PROJ + (size_t)(rb + ti) * N_PROJ + XBC0 + cc); else if (!prm) v = ld_f8(chist + (size_t)(3 + ti) * CONV_DIM + cc); else v = zero8();
                    const F8 wv = ld_f8(cw + (size_t)i * CONV_DIM + cc);
#pragma unroll
                    for (int k = 0; k < 8; ++k) a.v[k] += wv.v[k] * v.v[k]; }
#pragma unroll
                for (int k = 0; k < 8; ++k) dstp[k] = silu_f(a.v[k]);
            }
            if (tid < rows) { const float xr = DT[(size_t)(rb + tb + tid) * 32 + hh] + dtb; const float dtv = xr > 20.f ? xr : log1pf(__expf(xr)); dts[tid] = dtv; dAs[tid] = __expf(dtv * Aneg); }
            __syncthreads();
            for (int tt = 0; tt < rows; ++tt) {
                const float xv = xs[tt * 64 + p], xdt = xv * dts[tt], dA = dAs[tt]; float acc = 0.f;
#pragma unroll
                for (int i = 0; i < 4; ++i) { const f32x4 bv = *(const LAS f32x4*)(Bs + tt * 128 + n0 + 4 * i), cv = *(const LAS f32x4*)(Cs + tt * 128 + n0 + 4 * i);
                    h[4 * i] = dA * h[4 * i] + xdt * bv[0]; acc += cv[0] * h[4 * i];
                    h[4 * i + 1] = dA * h[4 * i + 1] + xdt * bv[1]; acc += cv[1] * h[4 * i + 1];
                    h[4 * i + 2] = dA * h[4 * i + 2] + xdt * bv[2]; acc += cv[2] * h[4 * i + 2];
                    h[4 * i + 3] = dA * h[4 * i + 3] + xdt * bv[3]; acc += cv[3] * h[4 * i + 3]; }
                acc += __shfl_xor(acc, 1); acc += __shfl_xor(acc, 2); acc += __shfl_xor(acc, 4);
                if ((tid & 7) == 0) ys[tt * 64 + p] = acc + Dsk * xv;
            }
            __syncthreads();
            for (int e = tid; e < rows * 64; e += NTHR) {
                const int tt = e >> 6, pp = e & 63; const size_t row = (size_t)(rb + tb + tt);
                const float zv = bf2f(PROJ[row * N_PROJ + D_POOL + hh * HD + pp]); const float yz = ys[tt * 64 + pp] * silu_f(zv);
                MIXA[row * D_MIX + D_POOL + hh * HD + pp] = (bf16)f2bf(yz);
                const float q = wave_sum(yz * yz);
                if (pp == 0) SSQH[row * 32 + hh] = q;
            }
            __syncthreads();
        }
        float* ho = C.out + (prm ? O_SSDP + ((((size_t)l * NB_P + b) * NH + hh) * HD + p) * DS + n0 : O_SSDS + ((((size_t)l * NB_S + b) * NH + hh) * HD + p) * DS + n0);
#pragma unroll
        for (int i = 0; i < 4; ++i) *(float4*)(ho + 4 * i) = make_float4(h[4 * i], h[4 * i + 1], h[4 * i + 2], h[4 * i + 3]);
    }
}

constexpr int PH_CONV = 0, PH_FOLD = 1, PH_L0 = 2, PH_PER_L = 9, N_PHASES = PH_L0 + DEPTH * PH_PER_L;
constexpr int CW_BAR = 4096;

__global__ void __launch_bounds__(NTHR, 2) fwd_kernel(Args args) {
    extern __shared__ __attribute__((aligned(16))) unsigned char lds_raw[];
    Ctx C; C.lds = (LAS unsigned char*)lds_raw; C.G = gridDim.x; C.in = args.in; C.out = args.out; C.ws = args.ws; C.refresh();
    volatile LAS unsigned* MISC = (volatile LAS unsigned*)(C.lds + LDSCTL_OFF);
    if (threadIdx.x < 64) MISC[threadIdx.x] = 0u;
    __syncthreads();
    const int lo = args.ph_lo, hi = args.ph_hi;
    unsigned* barw = (unsigned*)(args.ws + WS_CTL) + CW_BAR;
    XcdBarrier bar; bar.bar = barw; bar.x = 0; bar.st = MISC + 8;
    if (hi - lo > 1) bar = xcd_barrier_post(barw, MISC + 8);
#define IN(k) (lo <= (k) && (k) < hi)
#define SEAM(k) do { if ((k) + 1 < hi) xcd_barrier(bar); } while (0)
    LAS unsigned char* ring = C.lds;

    if (IN(PH_CONV)) { phase_convert(C); SEAM(PH_CONV); }
    if (IN(PH_FOLD)) {
        for (int w = (int)blockIdx.x; w < DEPTH * 4 * 8; w += C.G) { const int lg = w >> 3, l = lg >> 2, g = lg & 3;
            pg8::Gemm gm{(const bf16*)(C.ws + WS_WOP) + (size_t)l * DM * D_POOL + g * 256, (const bf16*)(C.ws + WS_WPB) + (size_t)lg * 65536, DM, 256, 256, D_POOL, 256};
            pg8::StaticOrder S; S.init(DM, 256, 8, w & 7);
            pg8::EpiBf16S E{(bf16*)(C.ws + WS_BTOUT) + (size_t)l * DM * D_MIX + g * 256, D_MIX, nullptr, nullptr, -1};
            pg8::gemm_phase<pg8::EpiBf16S, pg8::StaticOrder, true, true>(ring, gm, S, E);
        }
        SEAM(PH_FOLD);
    }
    for (int l = 0; l < DEPTH; ++l) {
        const int pb = PH_L0 + l * PH_PER_L;
        if (IN(pb + 0)) {
            pg8::Gemm gm{(const bf16*)(C.ws + WS_XB), (const bf16*)(C.ws + WS_BTIN) + (size_t)l * N_INP * DM, M, N_INP, DM, DM, DM};
            pg8::StaticOrder S; S.init(M, N_INP, C.G, (int)blockIdx.x);
            pg8::EpiBf16S E{(bf16*)(C.ws + WS_PROJ), N_PROJ, (const float*)(C.ws + WS_R), (float*)(C.ws + WS_DT), N_PROJ / 256};
            pg8::gemm_phase<pg8::EpiBf16S, pg8::StaticOrder, true, true>(ring, gm, S, E);
            SEAM(pb + 0);
        }
        if (IN(pb + 1)) { phase_ssd(C, l); phase_pool(C, l); SEAM(pb + 1); }
        if (IN(pb + 2)) { phase_gnorm(C); SEAM(pb + 2); }
        if (IN(pb + 3)) {
            pg8::Gemm gm{(const bf16*)(C.ws + WS_MIXA), (const bf16*)(C.ws + WS_BTOUT) + (size_t)l * DM * D_MIX, M, DM, D_MIX, D_MIX, D_MIX};
            pg8::StaticOrder S; S.init(M, DM, C.G, (int)blockIdx.x);
            pg8::EpiF32Ssq E{(float*)(C.ws + WS_MIX), DM, (float*)(C.ws + WS_SSQP)};
            pg8::gemm_phase<pg8::EpiF32Ssq, pg8::StaticOrder, true, true>(ring, gm, S, E);
            SEAM(pb + 3);
        }
        if (IN(pb + 4)) { phase_resid(C, C.in[17] + l * DM, false); SEAM(pb + 4); }
        if (IN(pb + 5)) {
            pg8::Gemm gm{(const bf16*)(C.ws + WS_XB), (const bf16*)(C.ws + WS_BTUP) + (size_t)l * D_UP * DM, M, D_UP, DM, DM, DM};
            pg8::StaticOrder S; S.init(M, D_UP, C.G, (int)blockIdx.x);
            pg8::EpiBf16S E{(bf16*)(C.ws + WS_UP), D_UP, (const float*)(C.ws + WS_R), nullptr, -1};
            pg8::gemm_phase<pg8::EpiBf16S, pg8::StaticOrder, true, true>(ring, gm, S, E);
            SEAM(pb + 5);
        }
        if (IN(pb + 6)) { phase_act(C, l); SEAM(pb + 6); }
        if (IN(pb + 7)) {
            pg8::Gemm gm{(const bf16*)(C.ws + WS_ACT), (const bf16*)(C.ws + WS_BTDN) + (size_t)l * DM * D_FF, M, DM, D_FF, D_FF, D_FF};
            pg8::StaticOrder S; S.init(M, DM, C.G, (int)blockIdx.x);
            pg8::EpiF32Ssq E{(float*)(C.ws + WS_MIX), DM, (float*)(C.ws + WS_SSQP)};
            pg8::gemm_phase<pg8::EpiF32Ssq, pg8::StaticOrder, true, true>(ring, gm, S, E);
            SEAM(pb + 7);
        }
        if (IN(pb + 8)) { phase_resid(C, C.in[23] + l * DM, l == DEPTH - 1); SEAM(pb + 8); }
    }
#undef IN
#undef SEAM
}

extern "C" void kernel_launch(void* const* d_in, const int* in_sizes, int n_in, void* d_out, int out_size, void* d_ws, size_t ws_size, hipStream_t stream) {
    static int grid = 0;
    if (grid == 0) {
        if (n_in != 24 || (size_t)out_size != O_END || ws_size < WS_END) { fprintf(stderr, "kernel_launch: shape mismatch: n_in %d out %d (want %zu) ws %zu (need %zu)\n", n_in, out_size, (size_t)O_END, ws_size, (size_t)WS_END); grid = -1; return; }
        int dev = 0, cus = 0, per_cu = 0;
        if (hipGetDevice(&dev) != hipSuccess || hipDeviceGetAttribute(&cus, hipDeviceAttributeMultiprocessorCount, dev) != hipSuccess) { grid = -1; return; }
        if (hipFuncSetAttribute((const void*)fwd_kernel, hipFuncAttributeMaxDynamicSharedMemorySize, LDS_BYTES) != hipSuccess) { fprintf(stderr, "kernel_launch: hipFuncSetAttribute failed\n"); grid = -1; return; }
        if (hipOccupancyMaxActiveBlocksPerMultiprocessor(&per_cu, (const void*)fwd_kernel, NTHR, LDS_BYTES) != hipSuccess || per_cu < 1) fprintf(stderr, "kernel_launch: occupancy query reports %d\n", per_cu);
        (void)hipGetLastError();
        grid = cus;
    }
    if (grid < 0) return;
    if (hipMemsetAsync((char*)d_ws + WS_CTL, 0, CTL_BYTES, stream) != hipSuccess) return;
    Args a{};
    for (int i = 0; i < 24; ++i) a.in[i] = (const float*)d_in[i];
    a.out = (float*)d_out; a.ws = (unsigned char*)d_ws;
#if MK_MULTI
    for (int k = 0; k < N_PHASES; ++k) { a.ph_lo = k; a.ph_hi = k + 1; hipLaunchKernelGGL(fwd_kernel, dim3(grid), dim3(NTHR), LDS_BYTES, stream, a); }
#else
    a.ph_lo = 0; a.ph_hi = N_PHASES; hipLaunchKernelGGL(fwd_kernel, dim3(grid), dim3(NTHR), LDS_BYTES, stream, a);
#endif
}
```

```cpp
#include <hip/hip_runtime.h>
#include <cstdio>
#include <cstdint>

#ifndef PROBE_SEL
#define PROBE_SEL 0
#endif
#ifndef MK_MULTI
#define MK_MULTI 0
#endif

namespace pg8 {
#define PG8_LAS __attribute__((address_space(3)))
typedef unsigned short bf16_t;
typedef short bf16x8 __attribute__((ext_vector_type(8)));
typedef float f32x4 __attribute__((ext_vector_type(4)));
typedef unsigned u32x4 __attribute__((ext_vector_type(4)));
constexpr int BM = 256, BK = 64, HALF = 128, HTB = HALF * BK * 2, STAGE_BYTES = 8 * HTB, NXCD = 8, WGM = 8;

__host__ __device__ __forceinline__ int lds_byte(int r, int c) { const int st = (r >> 4) * 2 + (c >> 5), rr = r & 15, cc = c & 31, ob = rr * 64 + cc * 2; return st * 1024 + (ob ^ (((ob >> 9) & 1) << 5)); }
__host__ __device__ __forceinline__ void stage_rc(int b, int& R, int& C) { const int st = b / 1024, sb = b % 1024, swz = sb ^ (((sb >> 9) & 1) << 5); R = (st >> 1) * 16 + swz / 64; C = (st & 1) * 32 + (swz % 64) / 2; }
__host__ __device__ __forceinline__ int perm32(int rho) { const int n = rho >> 4, i = rho & 15; return 8 * (i >> 2) + 4 * n + (i & 3); }

struct Unit { int pm, pn; };
struct Gemm { const bf16_t* A; const bf16_t* Bt; int M, N, K, lda, ldb; };

struct StaticOrder {
    int nM, nN, nwg, G, c;
    __host__ __device__ void init(int M, int N, int G_, int c_) { nM = M / BM; nN = N / BM; nwg = nM * nN; G = G_; c = c_; }
    __host__ __device__ bool next(int i, Unit& u) const {
        const long L = (long)i * G + c; if (L >= nwg) return false;
        int wgid = (int)L; { const int q = nwg / NXCD, r = nwg % NXCD, xcd = wgid % NXCD, off = wgid / NXCD; wgid = (xcd < r ? xcd * (q + 1) : r * (q + 1) + (xcd - r) * q) + off; }
        const int nig = WGM * nN, gid = wgid / nig, fm = gid * WGM, gsz = (nM - fm) < WGM ? (nM - fm) : WGM;
        u.pm = fm + ((wgid % nig) % gsz); u.pn = (wgid % nig) / gsz; return true;
    }
    __device__ __forceinline__ void a_ready(const Unit&) const {}
    __device__ __forceinline__ void done(const Unit&) const {}
};

__device__ __forceinline__ unsigned cvt_pk_bf16(float lo, float hi) { unsigned r; asm volatile("v_cvt_pk_bf16_f32 %0, %1, %2" : "=v"(r) : "v"(lo), "v"(hi)); return r; }

struct EpiBf16S {
    static constexpr bool PERM = true, AFTER_DRAIN = false;
    bf16_t* O; int ldc; const float* rs; float* dt; int dt_pn;
    __device__ __forceinline__ void operator()(const f32x4 (&acc)[2][2][4][2], const Unit& u, int wr, int wc, int fr, int fq) const {
        const int row0 = u.pm * BM + wr * 64 + fr;
        if (u.pn == dt_pn) {
            if (wc == 0) {
#pragma unroll
                for (int ai = 0; ai < 2; ++ai)
#pragma unroll
                    for (int m = 0; m < 4; ++m) { const int row = row0 + ai * HALF + m * 16; const float s = rs ? rs[row] : 1.f;
#pragma unroll
                        for (int n = 0; n < 2; ++n) *(f32x4*)(dt + (size_t)row * 32 + 8 * fq + 4 * n) = acc[ai][0][m][n] * s; }
            }
            return;
        }
        const int col0 = u.pn * BM + wc * 32 + 8 * fq;
#pragma unroll
        for (int ai = 0; ai < 2; ++ai)
#pragma unroll
            for (int m = 0; m < 4; ++m) { const int row = row0 + ai * HALF + m * 16; const float s = rs ? rs[row] : 1.f; bf16_t* rowp = O + (size_t)row * ldc + col0;
#pragma unroll
                for (int bj = 0; bj < 2; ++bj) { const f32x4 v0 = acc[ai][bj][m][0] * s, v1 = acc[ai][bj][m][1] * s;
                    u32x4 w; w.x = cvt_pk_bf16(v0[0], v0[1]); w.y = cvt_pk_bf16(v0[2], v0[3]); w.z = cvt_pk_bf16(v1[0], v1[1]); w.w = cvt_pk_bf16(v1[2], v1[3]);
                    *(u32x4*)(rowp + bj * HALF) = w; } }
    }
};
struct EpiF32Ssq {
    static constexpr bool PERM = false, AFTER_DRAIN = false;
    float* C; int ldc; float* ssq;
    __device__ __forceinline__ void operator()(const f32x4 (&acc)[2][2][4][2], const Unit& u, int wr, int wc, int fr, int fq) const {
        const int row0 = u.pm * BM + wr * 64 + fr, col0 = u.pn * BM + wc * 32 + 4 * fq;
#pragma unroll
        for (int ai = 0; ai < 2; ++ai)
#pragma unroll
            for (int m = 0; m < 4; ++m) { const int row = row0 + ai * HALF + m * 16; float* rowp = C + (size_t)row * ldc + col0; float q = 0.f;
#pragma unroll
                for (int bj = 0; bj < 2; ++bj)
#pragma unroll
                    for (int n = 0; n < 2; ++n) { const f32x4 v = acc[ai][bj][m][n]; *(f32x4*)(rowp + bj * HALF + n * 16) = v; q += (v[0] * v[0] + v[1] * v[1]) + (v[2] * v[2] + v[3] * v[3]); }
                q += __shfl_xor(q, 16); q += __shfl_xor(q, 32);
                if (fq == 0) ssq[(size_t)row * 32 + u.pn * 4 + wc] = q; }
    }
};

template <class Epi, class Sched, bool ALIGN_EPI = false, bool SP2 = false>
__device__ __forceinline__ void gemm_phase(PG8_LAS unsigned char* lds, const Gemm g, const Sched& S, const Epi& E) {
    int tid_ = threadIdx.x; asm volatile("" : "+v"(tid_));
    const int tid = tid_, wid = __builtin_amdgcn_readfirstlane(tid >> 6), lane = tid & 63, wr = wid >> 2, wc = wid & 3, fr = lane & 15, fq = lane >> 4;
    const int K = g.K, nt = K / BK;
    unsigned voffA[2], voffB[2];
#pragma unroll
    for (int i = 0; i < 2; ++i) { int R, C; stage_rc(tid * 16 + i * 8192, R, C); const int Rb = Epi::PERM ? ((R & ~31) + perm32(R & 31)) : R;
        voffA[i] = (unsigned)(R * g.lda + C) * 2u; voffB[i] = (unsigned)(Rb * g.ldb + C) * 2u; }
    const size_t kstep = (size_t)(BK * 2);
    const size_t hstepA = (size_t)HALF * g.lda * 2, hstepB = (size_t)HALF * g.ldb * 2;
    const size_t tstepA = 2 * hstepA, tstepB = 2 * hstepB;
    const unsigned ldsw = (unsigned)wid * 1024u;
    const int aoff = lds_byte(wr * 64 + fr, fq * 8), boff = lds_byte(wc * 32 + fr, fq * 8);
#define PG8_SA(b, h) (((b) * 2 + (h)) * HTB)
#define PG8_SB(b, h) ((4 + (b) * 2 + (h)) * HTB)
#define PG8_STAGE(bufoff, gbase, voff) do { _Pragma("unroll") for (int _i = 0; _i < 2; ++_i) \
        __builtin_amdgcn_global_load_lds((const unsigned*)((const char*)(gbase) + (voff)[_i]), (PG8_LAS unsigned*)(lds + (bufoff) + ldsw + _i * 8192), 16, 0, 0); } while (0)
#define PG8_LDA(dst, b, h) do { _Pragma("unroll") for (int m = 0; m < 4; ++m) _Pragma("unroll") for (int k = 0; k < 2; ++k) dst[m][k] = *(const PG8_LAS bf16x8*)(lds + PG8_SA(b, h) + aoff + m * 2048 + k * 1024); } while (0)
#define PG8_LDB(dst, b, h) do { _Pragma("unroll") for (int n = 0; n < 2; ++n) _Pragma("unroll") for (int k = 0; k < 2; ++k) dst[n][k] = *(const PG8_LAS bf16x8*)(lds + PG8_SB(b, h) + boff + n * 2048 + k * 1024); } while (0)
#define PG8_MMA(ai, bj, At, Bt) do { __builtin_amdgcn_s_setprio(1); _Pragma("unroll") for (int m = 0; m < 4; ++m) _Pragma("unroll") for (int n = 0; n < 2; ++n) _Pragma("unroll") for (int k = 0; k < 2; ++k) \
        acc[ai][bj][m][n] = __builtin_amdgcn_mfma_f32_16x16x32_bf16(Bt[n][k], At[m][k], acc[ai][bj][m][n], 0, 0, 0); __builtin_amdgcn_s_setprio(0); } while (0)
#define PG8_WAIT_V(n) asm volatile("s_waitcnt vmcnt(" #n ")" ::: "memory")
#define PG8_WAIT_L(n) asm volatile("s_waitcnt lgkmcnt(" #n ")" ::: "memory")
#define PG8_BAR __builtin_amdgcn_s_barrier()
#define PG8_SCHED __builtin_amdgcn_sched_barrier(0)
    Unit cur, nxt; int ui = 0;
    if (!S.next(0, cur)) return;
    f32x4 acc[2][2][4][2];
#pragma unroll
    for (int a = 0; a < 2; ++a)
#pragma unroll
        for (int b = 0; b < 2; ++b)
#pragma unroll
            for (int m = 0; m < 4; ++m)
#pragma unroll
                for (int n = 0; n < 2; ++n) acc[a][b][m][n] = (f32x4){0.f, 0.f, 0.f, 0.f};
    bf16x8 At[4][2], B0[2][2], B1[2][2];
    const char* cA = (const char*)g.A + (size_t)cur.pm * tstepA; const char* cB = (const char*)g.Bt + (size_t)cur.pn * tstepB;
    S.a_ready(cur);
    if constexpr (SP2) {
        PG8_STAGE(PG8_SB(0, 0), cB, voffB); PG8_STAGE(PG8_SB(0, 1), cB + hstepB, voffB); PG8_STAGE(PG8_SA(0, 0), cA, voffA); PG8_STAGE(PG8_SA(0, 1), cA + hstepA, voffA);
        if (wr == 1) PG8_BAR;
        PG8_WAIT_V(2); PG8_BAR;
        PG8_STAGE(PG8_SB(1, 0), cB + kstep, voffB); PG8_STAGE(PG8_SA(1, 0), cA + kstep, voffA); PG8_STAGE(PG8_SB(1, 1), cB + hstepB + kstep, voffB);
        PG8_WAIT_V(6); PG8_BAR;
    } else {
        PG8_STAGE(PG8_SB(0, 0), cB, voffB); PG8_STAGE(PG8_SA(0, 0), cA, voffA); PG8_STAGE(PG8_SB(0, 1), cB + hstepB, voffB); PG8_STAGE(PG8_SA(0, 1), cA + hstepA, voffA);
        if (wr == 1) PG8_BAR;
        PG8_WAIT_V(4); PG8_BAR;
        PG8_STAGE(PG8_SB(1, 0), cB + kstep, voffB); PG8_STAGE(PG8_SA(1, 0), cA + kstep, voffA); PG8_STAGE(PG8_SB(1, 1), cB + hstepB + kstep, voffB);
        PG8_WAIT_V(6); PG8_BAR;
    }
    for (;;) {
        const bool has_next = S.next(ui + 1, nxt);
        const char* nA = has_next ? (const char*)g.A + (size_t)nxt.pm * tstepA : cA; const char* nB = has_next ? (const char*)g.Bt + (size_t)nxt.pn * tstepB : cB;
        for (int t = 0; t < nt; t += 2) {
            const bool last = (t == nt - 2);
            const char* a1 = cA + (size_t)(t + 1) * kstep;
            const char* a2 = last ? nA : cA + (size_t)(t + 2) * kstep; const char* b2 = last ? nB : cB + (size_t)(t + 2) * kstep;
            const char* a3 = a2 + kstep; const char* b3 = b2 + kstep;
            if (last && has_next) S.a_ready(nxt);
            if constexpr (SP2) {
            PG8_LDB(B0, 0, 0); PG8_LDB(B1, 0, 1); PG8_SCHED; PG8_LDA(At, 0, 0); PG8_STAGE(PG8_SA(1, 1), a1 + hstepA, voffA);
            PG8_WAIT_V(8); PG8_WAIT_L(0); PG8_BAR; PG8_MMA(0, 0, At, B0); PG8_MMA(0, 1, At, B1); PG8_BAR; PG8_SCHED;
            PG8_LDA(At, 0, 1); PG8_STAGE(PG8_SB(0, 0), b2, voffB); PG8_STAGE(PG8_SB(0, 1), b2 + hstepB, voffB); PG8_STAGE(PG8_SA(0, 0), a2, voffA);
            PG8_WAIT_V(8); PG8_WAIT_L(0); PG8_BAR; PG8_MMA(1, 0, At, B0); PG8_MMA(1, 1, At, B1); PG8_BAR; PG8_SCHED;
            PG8_LDB(B0, 1, 0); PG8_LDB(B1, 1, 1); PG8_SCHED; PG8_LDA(At, 1, 0); PG8_STAGE(PG8_SA(0, 1), a2 + hstepA, voffA);
            PG8_WAIT_V(8); PG8_WAIT_L(0); PG8_BAR; PG8_MMA(0, 0, At, B0); PG8_MMA(0, 1, At, B1); PG8_BAR; PG8_SCHED;
            PG8_LDA(At, 1, 1); PG8_STAGE(PG8_SB(1, 0), b3, voffB); PG8_STAGE(PG8_SB(1, 1), b3 + hstepB, voffB); PG8_STAGE(PG8_SA(1, 0), a3, voffA);
            PG8_WAIT_V(8); PG8_WAIT_L(0); PG8_BAR; PG8_MMA(1, 0, At, B0); PG8_MMA(1, 1, At, B1); PG8_BAR; PG8_SCHED;
            } else {
            PG8_LDB(B0, 0, 0); PG8_SCHED; PG8_LDA(At, 0, 0); PG8_STAGE(PG8_SA(1, 1), a1 + hstepA, voffA);
            PG8_WAIT_L(8); PG8_BAR; PG8_WAIT_L(0); PG8_MMA(0, 0, At, B0); PG8_BAR; PG8_SCHED;
            PG8_LDB(B1, 0, 1); PG8_STAGE(PG8_SB(0, 0), b2, voffB);
            PG8_BAR; PG8_WAIT_L(0); PG8_MMA(0, 1, At, B1); PG8_BAR;
            PG8_LDA(At, 0, 1); PG8_STAGE(PG8_SA(0, 0), a2, voffA);
            PG8_BAR; PG8_WAIT_L(0); PG8_MMA(1, 0, At, B0); PG8_BAR; PG8_SCHED;
            PG8_STAGE(PG8_SB(0, 1), b2 + hstepB, voffB);
            PG8_WAIT_V(6); PG8_BAR; PG8_MMA(1, 1, At, B1); PG8_BAR;
            PG8_LDB(B0, 1, 0); PG8_SCHED; PG8_LDA(At, 1, 0); PG8_STAGE(PG8_SA(0, 1), a2 + hstepA, voffA);
            PG8_WAIT_L(8); PG8_BAR; PG8_WAIT_L(0); PG8_MMA(0, 0, At, B0); PG8_BAR; PG8_SCHED;
            PG8_LDB(B1, 1, 1); PG8_STAGE(PG8_SB(1, 0), b3, voffB);
            PG8_BAR; PG8_WAIT_L(0); PG8_MMA(0, 1, At, B1); PG8_BAR;
            PG8_LDA(At, 1, 1); PG8_STAGE(PG8_SA(1, 0), a3, voffA);
            PG8_BAR; PG8_WAIT_L(0); PG8_MMA(1, 0, At, B0); PG8_BAR; PG8_SCHED;
            PG8_STAGE(PG8_SB(1, 1), b3 + hstepB, voffB);
            PG8_WAIT_V(6); PG8_BAR; PG8_MMA(1, 1, At, B1); PG8_BAR;
            }
        }
        if constexpr (ALIGN_EPI) { if (wr == 0) PG8_BAR; }
        if constexpr (!Epi::AFTER_DRAIN) { E(acc, cur, wr, wc, fr, fq); S.done(cur); }
        if (!has_next) break;
#pragma unroll
        for (int a = 0; a < 2; ++a)
#pragma unroll
            for (int b = 0; b < 2; ++b)
#pragma unroll
                for (int m = 0; m < 4; ++m)
#pragma unroll
                    for (int n = 0; n < 2; ++n) acc[a][b][m][n] = (f32x4){0.f, 0.f, 0.f, 0.f};
        cur = nxt; cA = nA; cB = nB; ++ui;
        if constexpr (ALIGN_EPI) { if (wr == 1) PG8_BAR; }
    }
    PG8_WAIT_V(0);
    if constexpr (!ALIGN_EPI) { if (wr == 0) PG8_BAR; }
    PG8_BAR;
#undef PG8_SA
#undef PG8_SB
#undef PG8_STAGE
#undef PG8_LDA
#undef PG8_LDB
#undef PG8_MMA
#undef PG8_WAIT_V
#undef PG8_WAIT_L
#undef PG8_BAR
#undef PG8_SCHED
}
}

constexpr int NWAVES = 8, NTHR = 512;
constexpr int DM = 2048, SEQ = 2048, NB_P = 8, NB_S = 32, SEQ_S = 32, DEPTH = 4;
constexpr int MP = NB_P * SEQ, MS = NB_S * SEQ_S, M = MP + MS;
constexpr int D_POOL = 1024, POOL_HIST = 15, D_SSD = 2048, HD = 64, NH = 32, HPG = 16, DS = 128, CONV_DIM = 2560, D_MIX = 3072;
constexpr int D_IN = 5664, N_PROJ = 5632, N_INP = 5888, D_FF = 5632, D_UP = 11264;
constexpr int XBC0 = 3072;
constexpr float EPS = 1e-6f;

constexpr size_t O_YP = 0, O_YS = O_YP + (size_t)MP * DM, O_POOLP = O_YS + (size_t)MS * DM, O_POOLS = O_POOLP + (size_t)DEPTH * NB_P * 15 * 1024,
    O_SCP = O_POOLS + (size_t)DEPTH * NB_S * 15 * 1024, O_SCS = O_SCP + (size_t)DEPTH * NB_P * 3 * 2560, O_SSDP = O_SCS + (size_t)DEPTH * NB_S * 3 * 2560,
    O_SSDS = O_SSDP + (size_t)DEPTH * NB_P * 32 * 64 * 128, O_FCP = O_SSDS + (size_t)DEPTH * NB_S * 32 * 64 * 128, O_FCS = O_FCP + (size_t)DEPTH * NB_P * 2 * 11264,
    O_END = O_FCS + (size_t)DEPTH * NB_S * 2 * 11264;

constexpr size_t al256(size_t x) { return (x + 255) & ~(size_t)255; }
constexpr size_t WS_CTL = 0, CTL_BYTES = 1u << 20;
constexpr size_t WS_BTIN = CTL_BYTES;
constexpr size_t WS_BTOUT = WS_BTIN + (size_t)DEPTH * N_INP * DM * 2;
constexpr size_t WS_BTUP = WS_BTOUT + (size_t)DEPTH * DM * D_MIX * 2;
constexpr size_t WS_BTDN = WS_BTUP + (size_t)DEPTH * D_UP * DM * 2;
constexpr size_t WS_WOP = WS_BTDN + (size_t)DEPTH * DM * D_FF * 2;
constexpr size_t WS_WPB = WS_WOP + (size_t)DEPTH * DM * D_POOL * 2;
constexpr size_t WS_X = WS_WPB + (size_t)DEPTH * 4 * 256 * 256 * 2;
constexpr size_t WS_XB = WS_X + (size_t)M * DM * 4;
constexpr size_t WS_R = WS_XB + (size_t)M * DM * 2;
constexpr size_t WS_DT = WS_R + al256((size_t)M * 4);
constexpr size_t WS_SSQP = WS_DT + (size_t)M * 32 * 4;
constexpr size_t WS_SSQH = WS_SSQP + (size_t)M * 32 * 4;
constexpr size_t WS_ACT = WS_SSQH + (size_t)M * 32 * 4;
constexpr size_t WS_RA = WS_ACT + (size_t)M * D_FF * 2;
constexpr size_t WS_PROJ = WS_RA;
constexpr size_t WS_MIXA = WS_PROJ + (size_t)M * N_PROJ * 2;
constexpr size_t WS_MIX = WS_MIXA + (size_t)M * D_MIX * 2;
constexpr size_t WS_UP = WS_RA;
constexpr size_t WS_END = WS_MIX + (size_t)M * DM * 4;
static_assert((size_t)M * D_UP * 2 <= WS_END - WS_RA, "UP fits region A");

constexpr int RING_BYTES = 131072, LDSCTL_OFF = RING_BYTES, LDS_BYTES = 147456;

#define LAS __attribute__((address_space(3)))
typedef unsigned short bf16;
typedef float f32x4 __attribute__((ext_vector_type(4)));
#define RLX_AGENT __ATOMIC_RELAXED, __HIP_MEMORY_SCOPE_AGENT
__device__ __forceinline__ unsigned f2bf(float f) { unsigned u = __builtin_bit_cast(unsigned, f); return (u + 0x7fffu + ((u >> 16) & 1u)) >> 16; }
__device__ __forceinline__ unsigned pk2(float lo, float hi) { unsigned r; asm("v_cvt_pk_bf16_f32 %0, %1, %2" : "=v"(r) : "v"(lo), "v"(hi)); return r; }
__device__ __forceinline__ float bflo(unsigned u) { return __uint_as_float(u << 16); }
__device__ __forceinline__ float bfhi(unsigned u) { return __uint_as_float(u & 0xffff0000u); }
__device__ __forceinline__ float bf2f(bf16 b) { return __uint_as_float(((unsigned)b) << 16); }
struct F8 { float v[8]; };
__device__ __forceinline__ F8 ld_bf8(const bf16* p) { const uint4 u = *(const uint4*)p; F8 r; r.v[0] = bflo(u.x); r.v[1] = bfhi(u.x); r.v[2] = bflo(u.y); r.v[3] = bfhi(u.y); r.v[4] = bflo(u.z); r.v[5] = bfhi(u.z); r.v[6] = bflo(u.w); r.v[7] = bfhi(u.w); return r; }
__device__ __forceinline__ F8 ld_f8(const float* p) { const float4 a = *(const float4*)p, b = *(const float4*)(p + 4); F8 r; r.v[0] = a.x; r.v[1] = a.y; r.v[2] = a.z; r.v[3] = a.w; r.v[4] = b.x; r.v[5] = b.y; r.v[6] = b.z; r.v[7] = b.w; return r; }
__device__ __forceinline__ F8 zero8() { F8 r;
#pragma unroll
    for (int i = 0; i < 8; ++i) r.v[i] = 0.f; return r; }
__device__ __forceinline__ void st_bf8(bf16* p, const F8& r) { uint4 u; u.x = pk2(r.v[0], r.v[1]); u.y = pk2(r.v[2], r.v[3]); u.z = pk2(r.v[4], r.v[5]); u.w = pk2(r.v[6], r.v[7]); *(uint4*)p = u; }
__device__ __forceinline__ void st_f8(float* p, const F8& r) { *(float4*)p = make_float4(r.v[0], r.v[1], r.v[2], r.v[3]); *(float4*)(p + 4) = make_float4(r.v[4], r.v[5], r.v[6], r.v[7]); }
__device__ __forceinline__ float silu_f(float x) { return x * __builtin_amdgcn_rcpf(1.f + __expf(-x)); }
__device__ __forceinline__ float wave_sum(float v) {
#pragma unroll
    for (int o = 1; o < 64; o <<= 1) v += __shfl_xor(v, o);
    return v;
}

#define XB_TMO      128
#define XB_XCNT(j)  (256  + 64 * (j))
#define XB_XSUB(j)  (1280 + 64 * (j))
#define XB_XGEN(j)  (2304 + 64 * (j))
#define XB_TOP      3328
#define XB_TOPGEN   3392
#define XCD_BAR_WORDS 3456
#define XB_SPIN_CAP (1u << 18)
__device__ __forceinline__ unsigned xb_ld(unsigned* p)              { return __hip_atomic_load(p, __ATOMIC_RELAXED, __HIP_MEMORY_SCOPE_AGENT); }
__device__ __forceinline__ unsigned xb_add(unsigned* p, unsigned v) { return __hip_atomic_fetch_add(p, v, __ATOMIC_RELAXED, __HIP_MEMORY_SCOPE_AGENT); }
__device__ __forceinline__ unsigned xb_xcc_id() { return (unsigned)__builtin_amdgcn_s_getreg((3 << 11) | 20) & 0xFu; }
#define XB_SPIN(cond, bar) do { unsigned _sp = 0; while (cond) { __builtin_amdgcn_s_sleep(1); \
    if ((++_sp & 255u) == 0u) { if (xb_ld(&(bar)[XB_TMO])) break; if (_sp > XB_SPIN_CAP) { atomicAdd(&(bar)[XB_TMO], 1u); break; } } } } while (0)
struct XcdBarrier { unsigned* bar; unsigned x; volatile LAS unsigned* st; };
__device__ __forceinline__ XcdBarrier xcd_barrier_post(unsigned* bar, volatile LAS unsigned* st) {
    XcdBarrier b; b.bar = bar; b.x = xb_xcc_id(); b.st = st;
    if (threadIdx.x == 0) (void)xb_add(&bar[XB_XCNT(b.x)], 1u);
    return b;
}
__device__ __forceinline__ void xcd_barrier_complete(unsigned* bar, unsigned x, unsigned& nloc, unsigned& nx) {
    const unsigned G = gridDim.x * gridDim.y * gridDim.z;
    unsigned sum, cnt, mine, sp = 0u;
    for (;;) {
        sum = 0u; cnt = 0u; mine = 0u;
#pragma unroll
        for (unsigned j = 0; j < 16; ++j) { const unsigned c = xb_ld(&bar[XB_XCNT(j)]); sum += c; cnt += (c > 0u) ? 1u : 0u; mine = (j == x) ? c : mine; }
        if (sum == G) break;
        __builtin_amdgcn_s_sleep(1);
        if ((++sp & 255u) == 0u) { if (xb_ld(&bar[XB_TMO])) break; if (sp > XB_SPIN_CAP) { atomicAdd(&bar[XB_TMO], 1u); break; } }
    }
    nloc = mine > 0u ? mine : 1u; nx = cnt > 0u ? cnt : 1u;
}
__device__ __forceinline__ void xcd_barrier(const XcdBarrier& b) {
    asm volatile("s_waitcnt vmcnt(0)" ::: "memory");
    __syncthreads();
    if (threadIdx.x == 0) {
        unsigned* bar = b.bar;
        __builtin_amdgcn_s_waitcnt(0);
        unsigned nloc = b.st[0], nx = b.st[1];
        if (nloc == 0u) { xcd_barrier_complete(bar, b.x, nloc, nx); b.st[0] = nloc; b.st[1] = nx; }
        const unsigned old = xb_add(&bar[XB_XSUB(b.x)], 1u);
        const unsigned gen = old / nloc;
        if (old + 1u == (gen + 1u) * nloc) {
            __builtin_amdgcn_fence(__ATOMIC_RELEASE, "agent");
            asm volatile("s_waitcnt vmcnt(0)" ::: "memory");
            const unsigned og = xb_add(&bar[XB_TOP], 1u);
            const unsigned tg = og / nx;
            if (og + 1u == (tg + 1u) * nx) xb_add(&bar[XB_TOPGEN], 1u);
            else XB_SPIN(xb_ld(&bar[XB_TOPGEN]) == tg, bar);
            __builtin_amdgcn_fence(__ATOMIC_ACQUIRE, "agent");
            xb_add(&bar[XB_XGEN(b.x)], 1u);
            asm volatile("s_waitcnt vmcnt(0)" ::: "memory");
        } else {
            XB_SPIN(xb_ld(&bar[XB_XGEN(b.x)]) == gen, bar);
            __builtin_amdgcn_fence(__ATOMIC_ACQUIRE, "agent");
            asm volatile("s_waitcnt vmcnt(0)" ::: "memory");
        }
    }
    __syncthreads();
}

struct Args { const float* in[24]; float* out; unsigned char* ws; int ph_lo, ph_hi; };

struct Ctx {
    LAS unsigned char* lds; int tid, lane, wave, G, gw, NGW;
    const float* const* in; float* out; unsigned char* ws;
    __device__ __forceinline__ void refresh() {
        int t = threadIdx.x; asm volatile("" : "+v"(t)); tid = t; lane = t & 63; wave = __builtin_amdgcn_readfirstlane(t >> 6); gw = blockIdx.x * NWAVES + wave; NGW = G * NWAVES; }
};

__device__ __forceinline__ void conv_item(const float* W, int N, const float* gain, bf16* dst, int ldd, LAS float* scr, int kb, int nb, int lane) {
    const int k0 = 64 * kb, n0 = 32 * nb;
    float wv[32];
#pragma unroll
    for (int i = 0; i < 32; ++i) { const int kk = 2 * i + (lane >> 5); wv[i] = W[(size_t)(k0 + kk) * N + n0 + (lane & 31)]; }
#pragma unroll
    for (int i = 0; i < 32; ++i) { const int kk = 2 * i + (lane >> 5); const float gsc = gain ? gain[k0 + kk] : 1.f; scr[kk * 33 + (lane & 31)] = wv[i] * gsc; }
    asm volatile("s_waitcnt lgkmcnt(0)" ::: "memory");
    const int c = lane & 7;
#pragma unroll
    for (int j = 0; j < 4; ++j) { const int n = (lane >> 3) + 8 * j; const LAS float* s = scr + (8 * c) * 33 + n;
        uint4 o; o.x = pk2(s[0 * 33], s[1 * 33]); o.y = pk2(s[2 * 33], s[3 * 33]); o.z = pk2(s[4 * 33], s[5 * 33]); o.w = pk2(s[6 * 33], s[7 * 33]);
        *(uint4*)(dst + (size_t)(n0 + n) * ldd + k0 + 8 * c) = o; }
    asm volatile("s_waitcnt lgkmcnt(0)" ::: "memory");
}
__device__ __forceinline__ void phase_convert(Ctx C) {
    C.refresh();
    LAS float* scr = (LAS float*)(C.lds + C.wave * 16384);
    constexpr int I_IN = (DM / 64) * (D_IN / 32), I_OUT = (D_MIX / 64) * (DM / 32), I_UP = (DM / 64) * (D_UP / 32), I_DN = (D_FF / 64) * (DM / 32), I_L = I_IN + I_OUT + I_UP + I_DN;
    for (int it = C.gw; it < DEPTH * I_L; it += C.NGW) {
        const int l = it / I_L; int r = it % I_L;
        if (r < I_IN) { const int nbk = D_IN / 32; conv_item(C.in[7] + (size_t)l * DM * D_IN, D_IN, C.in[6] + l * DM, (bf16*)(C.ws + WS_BTIN) + (size_t)l * N_INP * DM, DM, scr, r / nbk, r % nbk, C.lane); continue; }
        r -= I_IN;
        if (r < I_OUT) { const int nbk = DM / 32, kb = r / nbk, nb = r % nbk; const float* W = C.in[16] + (size_t)l * D_MIX * DM;
            if (kb < 16) conv_item(W, DM, C.in[9] + l * D_POOL, (bf16*)(C.ws + WS_WOP) + (size_t)l * DM * D_POOL, D_POOL, scr, kb, nb, C.lane);
            else conv_item(W, DM, C.in[15] + l * D_SSD - D_POOL, (bf16*)(C.ws + WS_BTOUT) + (size_t)l * DM * D_MIX, D_MIX, scr, kb, nb, C.lane);
            continue; }
        r -= I_OUT;
        if (r < I_UP) { const int nbk = D_UP / 32; conv_item(C.in[19] + (size_t)l * DM * D_UP, D_UP, C.in[18] + l * DM, (bf16*)(C.ws + WS_BTUP) + (size_t)l * D_UP * DM, DM, scr, r / nbk, r % nbk, C.lane); continue; }
        r -= I_UP;
        { const int nbk = DM / 32; conv_item(C.in[22] + (size_t)l * D_FF * DM, DM, nullptr, (bf16*)(C.ws + WS_BTDN) + (size_t)l * DM * D_FF, D_FF, scr, r / nbk, r % nbk, C.lane); }
    }
    { const int gt = C.gw * 64 + C.lane, NGT = C.NGW * 64; constexpr int PER_L = (N_INP - D_IN) * DM / 8;
      for (int i = gt; i < DEPTH * PER_L; i += NGT) { const int l = i / PER_L, r = i % PER_L; *(uint4*)((bf16*)(C.ws + WS_BTIN) + ((size_t)l * N_INP + D_IN) * DM + (size_t)r * 8) = make_uint4(0u, 0u, 0u, 0u); }
      const float* wp = C.in[8]; bf16* wpb = (bf16*)(C.ws + WS_WPB);
      for (int i = gt; i < DEPTH * 4 * 256 * 256 / 8; i += NGT) { const F8 v = ld_f8(wp + (size_t)i * 8); st_bf8(wpb + (size_t)i * 8, v); } }
    for (int row = C.gw; row < M; row += C.NGW) {
        const float* src = row < MP ? C.in[0] + (size_t)row * DM : C.in[1] + (size_t)(row - MP) * DM;
        float* X = (float*)(C.ws + WS_X) + (size_t)row * DM; bf16* XB = (bf16*)(C.ws + WS_XB) + (size_t)row * DM; float q = 0.f;
#pragma unroll
        for (int j = 0; j < 8; ++j) { const int idx = (C.lane + 64 * j) * 4; const float4 v = *(const float4*)(src + idx); *(float4*)(X + idx) = v; q += (v.x * v.x + v.y * v.y) + (v.z * v.z + v.w * v.w);
            *(uint2*)(XB + idx) = make_uint2(pk2(v.x, v.y), pk2(v.z, v.w)); }
        q = wave_sum(q);
        if (C.lane == 0) ((float*)(C.ws + WS_R))[row] = rsqrtf(q * (1.f / DM) + EPS);
    }
}

__device__ __forceinline__ void phase_resid(Ctx C, const float* gpost, bool final_out) {
    C.refresh();
    const float* MIX = (const float*)(C.ws + WS_MIX); const float* SSQ = (const float*)(C.ws + WS_SSQP);
    for (int row = C.gw; row < M; row += C.NGW) {
        float p = C.lane < 32 ? SSQ[(size_t)row * 32 + C.lane] : 0.f; p = wave_sum(p);
        const float rs = rsqrtf(p * (1.f / DM) + EPS);
        float* X = (float*)(C.ws + WS_X) + (size_t)row * DM; bf16* XB = (bf16*)(C.ws + WS_XB) + (size_t)row * DM; const float* mx = MIX + (size_t)row * DM;
        float* Y = C.out + O_YP + (size_t)row * DM; float q = 0.f;
#pragma unroll
        for (int j = 0; j < 8; ++j) { const int idx = (C.lane + 64 * j) * 4; const float4 m4 = *(const float4*)(mx + idx), g4 = *(const float4*)(gpost + idx); float4 v = *(const float4*)(X + idx);
            v.x += m4.x * rs * g4.x; v.y += m4.y * rs * g4.y; v.z += m4.z * rs * g4.z; v.w += m4.w * rs * g4.w;
            *(float4*)(X + idx) = v; if (final_out) *(float4*)(Y + idx) = v;
            q += (v.x * v.x + v.y * v.y) + (v.z * v.z + v.w * v.w);
            *(uint2*)(XB + idx) = make_uint2(pk2(v.x, v.y), pk2(v.z, v.w)); }
        q = wave_sum(q);
        if (C.lane == 0) ((float*)(C.ws + WS_R))[row] = rsqrtf(q * (1.f / DM) + EPS);
    }
}

__device__ __forceinline__ void phase_gnorm(Ctx C) {
    C.refresh();
    const float* SSQH = (const float*)(C.ws + WS_SSQH); bf16* MIXA = (bf16*)(C.ws + WS_MIXA);
    for (int row = C.gw; row < M; row += C.NGW) {
        float p = C.lane < 32 ? SSQH[(size_t)row * 32 + C.lane] : 0.f;
#pragma unroll
        for (int o = 1; o < 16; o <<= 1) p += __shfl_xor(p, o);
        const float s0 = __shfl(p, 0), s1 = __shfl(p, 16);
        const float r0 = rsqrtf(s0 * (1.f / 1024.f) + EPS), r1 = rsqrtf(s1 * (1.f / 1024.f) + EPS);
        bf16* y = MIXA + (size_t)row * D_MIX + D_POOL;
#pragma unroll
        for (int j = 0; j < 4; ++j) { const int c = (C.lane + 64 * j) * 8; const float r = c < 1024 ? r0 : r1; F8 v = ld_bf8(y + c);
#pragma unroll
            for (int i = 0; i < 8; ++i) v.v[i] *= r;
            st_bf8(y + c, v); }
    }
}

__device__ __forceinline__ void phase_act(Ctx C, int l) {
    C.refresh();
    const bf16* UP = (const bf16*)(C.ws + WS_UP); bf16* ACT = (bf16*)(C.ws + WS_ACT);
    const float* cw = C.in[20] + (size_t)l * 3 * D_UP; const float* cb = C.in[21] + (size_t)l * D_UP; const float* hist = C.in[5] + (size_t)l * NB_S * 2 * D_UP;
    constexpr int NCG = D_FF / 8, NSTRIP = M / 32;
    const int gt = C.gw * 64 + C.lane, NGT = C.NGW * 64;
    for (int it = gt; it < NSTRIP * NCG; it += NGT) {
        const int strip = it / NCG, c = (it % NCG) * 8, row0 = strip * 32; const bool prm = row0 < MP;
        const int b = prm ? row0 / SEQ : (row0 - MP) / SEQ_S, t0 = prm ? row0 % SEQ : 0;
        F8 p2g, p1g, p2v, p1v;
        if (t0 == 0) { if (prm) { p2g = zero8(); p1g = zero8(); p2v = zero8(); p1v = zero8(); }
            else { const float* h = hist + (size_t)b * 2 * D_UP; p2g = ld_f8(h + c); p2v = ld_f8(h + D_FF + c); p1g = ld_f8(h + D_UP + c); p1v = ld_f8(h + D_UP + D_FF + c); } }
        else { p2g = ld_bf8(UP + (size_t)(row0 - 2) * D_UP + c); p2v = ld_bf8(UP + (size_t)(row0 - 2) * D_UP + D_FF + c); p1g = ld_bf8(UP + (size_t)(row0 - 1) * D_UP + c); p1v = ld_bf8(UP + (size_t)(row0 - 1) * D_UP + D_FF + c); }
        const F8 w0g = ld_f8(cw + c), w1g = ld_f8(cw + D_UP + c), w2g = ld_f8(cw + 2 * D_UP + c), bg = ld_f8(cb + c);
        const F8 w0v = ld_f8(cw + D_FF + c), w1v = ld_f8(cw + D_UP + D_FF + c), w2v = ld_f8(cw + 2 * D_UP + D_FF + c), bv = ld_f8(cb + D_FF + c);
        for (int r = 0; r < 32; ++r) {
            const F8 cg = ld_bf8(UP + (size_t)(row0 + r) * D_UP + c), cv = ld_bf8(UP + (size_t)(row0 + r) * D_UP + D_FF + c); F8 o;
#pragma unroll
            for (int i = 0; i < 8; ++i) { const float g = bg.v[i] + w0g.v[i] * p2g.v[i] + w1g.v[i] * p1g.v[i] + w2g.v[i] * cg.v[i]; const float v = bv.v[i] + w0v.v[i] * p2v.v[i] + w1v.v[i] * p1v.v[i] + w2v.v[i] * cv.v[i]; o.v[i] = silu_f(g) * v; }
            st_bf8(ACT + (size_t)(row0 + r) * D_FF + c, o);
            p2g = p1g; p1g = cg; p2v = p1v; p1v = cv;
        }
        if (!prm || t0 + 32 == SEQ) {
            float* o = C.out + (prm ? O_FCP + ((size_t)(l * NB_P + b) * 2) * D_UP : O_FCS + ((size_t)(l * NB_S + b) * 2) * D_UP);
            st_f8(o + c, p2g); st_f8(o + D_FF + c, p2v); st_f8(o + D_UP + c, p1g); st_f8(o + D_UP + D_FF + c, p1v);
        }
    }
}

__device__ __forceinline__ void phase_pool(Ctx C, int l) {
    C.refresh();
    const bf16* PROJ = (const bf16*)(C.ws + WS_PROJ); bf16* MIXA = (bf16*)(C.ws + WS_MIXA);
    const float* hist = C.in[2] + (size_t)l * NB_S * POOL_HIST * D_POOL;
    constexpr int NCG = D_POOL / 8, NSTRIP = M / 32;
    const int gt = C.gw * 64 + C.lane, NGT = C.NGW * 64;
    for (int it = gt; it < NSTRIP * NCG; it += NGT) {
        const int strip = it / NCG, cgi = it % NCG, c = cgi * 8, row0 = strip * 32; const bool prm = row0 < MP;
        const int b = prm ? row0 / SEQ : (row0 - MP) / SEQ_S, t0 = prm ? row0 % SEQ : 0, w = 2 << (cgi >> 5);
        const int rb = row0 - t0;
        const float* hb = hist + (size_t)b * POOL_HIST * D_POOL;
        F8 s = zero8();
        for (int i = 1; i < w; ++i) { const int t = t0 - i; F8 v;
            if (t >= 0) v = ld_bf8(PROJ + (size_t)(rb + t) * N_PROJ + c); else if (!prm) v = ld_f8(hb + (size_t)(POOL_HIST + t) * D_POOL + c); else v = zero8();
#pragma unroll
            for (int k = 0; k < 8; ++k) s.v[k] += v.v[k]; }
        for (int r = 0; r < 32; ++r) {
            const int t = t0 + r; const F8 cur = ld_bf8(PROJ + (size_t)(rb + t) * N_PROJ + c);
            const float inv = 1.f / (float)(prm ? (t + 1 < w ? t + 1 : w) : w); F8 o;
#pragma unroll
            for (int k = 0; k < 8; ++k) { s.v[k] += cur.v[k]; o.v[k] = s.v[k] * inv - cur.v[k]; }
            st_bf8(MIXA + (size_t)(rb + t) * D_MIX + c, o);
            const int tl = t - w + 1; F8 v;
            if (tl >= 0) v = ld_bf8(PROJ + (size_t)(rb + tl) * N_PROJ + c); else if (!prm) v = ld_f8(hb + (size_t)(POOL_HIST + tl) * D_POOL + c); else v = zero8();
#pragma unroll
            for (int k = 0; k < 8; ++k) s.v[k] -= v.v[k];
        }
    }
    for (int it = gt; it < (NB_P + NB_S) * 15 * NCG; it += NGT) {
        const int cg = it % NCG, i = (it / NCG) % 15, sb = it / (NCG * 15); const bool prm = sb < NB_P; const int b = prm ? sb : sb - NB_P;
        const int row = prm ? b * SEQ + (SEQ - 15 + i) : MP + b * SEQ_S + (SEQ_S - 15 + i);
        float* o = C.out + (prm ? O_POOLP + ((size_t)(l * NB_P + b) * 15 + i) * D_POOL : O_POOLS + ((size_t)(l * NB_S + b) * 15 + i) * D_POOL);
        st_f8(o + cg * 8, ld_bf8(PROJ + (size_t)row * N_PROJ + cg * 8));
    }
    constexpr int NCG2 = CONV_DIM / 8;
    for (int it = gt; it < (NB_P + NB_S) * 3 * NCG2; it += NGT) {
        const int cg = it % NCG2, i = (it / NCG2) % 3, sb = it / (NCG2 * 3); const bool prm = sb < NB_P; const int b = prm ? sb : sb - NB_P;
        const int row = prm ? b * SEQ + (SEQ - 3 + i) : MP + b * SEQ_S + (SEQ_S - 3 + i);
        float* o = C.out + (prm ? O_SCP + ((size_t)(l * NB_P + b) * 3 + i) * CONV_DIM : O_SCS + ((size_t)(l * NB_S + b) * 3 + i) * CONV_DIM);
        st_f8(o + cg * 8, ld_bf8(PROJ + (size_t)row * N_PROJ + XBC0 + cg * 8));
    }
}

__device__ __forceinline__ void phase_ssd(Ctx C, int l) {
    C.refresh();
    LAS float* xs = (LAS float*)(C.lds); LAS float* Bs = (LAS float*)(C.lds + 16384); LAS float* Cs = (LAS float*)(C.lds + 49152); LAS float* ys = (LAS float*)(C.lds + 81920);
    LAS float* dts = (LAS float*)(C.lds + 98304); LAS float* dAs = dts + 64;
    const bf16* PROJ = (const bf16*)(C.ws + WS_PROJ); const float* DT = (const float*)(C.ws + WS_DT); bf16* MIXA = (bf16*)(C.ws + WS_MIXA); float* SSQH = (float*)(C.ws + WS_SSQH);
    const float* cw = C.in[10] + (size_t)l * 4 * CONV_DIM; const float* cb = C.in[11] + (size_t)l * CONV_DIM;
    const int tid = C.tid, p = tid >> 3, n0 = (tid & 7) * 16;
    for (int u = blockIdx.x; u < NB_P * NH + NB_S * NH; u += C.G) {
        const bool prm = u < NB_P * NH; const int su = prm ? u : u - NB_P * NH, b = su / NH, hh = su % NH, g = hh / HPG;
        const int rb = prm ? b * SEQ : MP + b * SEQ_S, rows = prm ? 64 : 32, nchunk = prm ? SEQ / 64 : 1;
        const float Aneg = -__expf(C.in[13][l * NH + hh]), Dsk = C.in[14][l * NH + hh], dtb = C.in[12][l * NH + hh];
        const float* chist = C.in[3] + ((size_t)(l * NB_S + b) * 3) * CONV_DIM;
        float h[16];
        if (prm) {
#pragma unroll
            for (int i = 0; i < 16; ++i) h[i] = 0.f;
        } else { const float* h0 = C.in[4] + ((((size_t)l * NB_S + b) * NH + hh) * HD + p) * DS + n0;
#pragma unroll
            for (int i = 0; i < 4; ++i) { const float4 v = *(const float4*)(h0 + 4 * i); h[4 * i] = v.x; h[4 * i + 1] = v.y; h[4 * i + 2] = v.z; h[4 * i + 3] = v.w; } }
        for (int ch = 0; ch < nchunk; ++ch) {
            const int tb = ch * 64;
            for (int e = tid; e < rows * 40; e += NTHR) {
                const int cg = e % 40, tt = e / 40, t = tb + tt;
                int cc; LAS float* dstp;
                if (cg < 8) { cc = hh * HD + cg * 8; dstp = xs + tt * 64 + cg * 8; }
                else if (cg < 24) { cc = D_SSD + g * DS + (cg - 8) * 8; dstp = Bs + tt * 128 + (cg - 8) * 8; }
                else { cc = D_SSD + 2 * DS + g * DS + (cg - 24) * 8; dstp = Cs + tt * 128 + (cg - 24) * 8; }
                F8 a = ld_f8(cb + cc);
#pragma unroll
                for (int i = 0; i < 4; ++i) { const int ti = t - 3 + i; F8 v;
                    if (ti >= 0) v = ld_bf8(PROJ + (size_t)(rb + ti) * N_PROJ + XBC0 + cc); else if (!prm) v = ld_f8(chist + (size_t)(3 + ti) * CONV_DIM + cc); else v = zero8();
                    const F8 wv = ld_f8(cw + (size_t)i * CONV_DIM + cc);
#pragma unroll
                    for (int k = 0; k < 8; ++k) a.v[k] += wv.v[k] * v.v[k]; }
#pragma unroll
                for (int k = 0; k < 8; ++k) dstp[k] = silu_f(a.v[k]);
            }
            if (tid < rows) { const float xr = DT[(size_t)(rb + tb + tid) * 32 + hh] + dtb; const float dtv = xr > 20.f ? xr : log1pf(__expf(xr)); dts[tid] = dtv; dAs[tid] = __expf(dtv * Aneg); }
            __syncthreads();
            for (int tt = 0; tt < rows; ++tt) {
                const float xv = xs[tt * 64 + p], xdt = xv * dts[tt], dA = dAs[tt]; float acc = 0.f;
#pragma unroll
                for (int i = 0; i < 4; ++i) { const f32x4 bv = *(const LAS f32x4*)(Bs + tt * 128 + n0 + 4 * i), cv = *(const LAS f32x4*)(Cs + tt * 128 + n0 + 4 * i);
                    h[4 * i] = dA * h[4 * i] + xdt * bv[0]; acc += cv[0] * h[4 * i];
                    h[4 * i + 1] = dA * h[4 * i + 1] + xdt * bv[1]; acc += cv[1] * h[4 * i + 1];
                    h[4 * i + 2] = dA * h[4 * i + 2] + xdt * bv[2]; acc += cv[2] * h[4 * i + 2];
                    h[4 * i + 3] = dA * h[4 * i + 3] + xdt * bv[3]; acc += cv[3] * h[4 * i + 3]; }
                acc += __shfl_xor(acc, 1); acc += __shfl_xor(acc, 2); acc += __shfl_xor(acc, 4);
                if ((tid & 7) == 0) ys[tt * 64 + p] = acc + Dsk * xv;
            }
            __syncthreads();
            for (int e = tid; e < rows * 64; e += NTHR) {
                const int tt = e >> 6, pp = e & 63; const size_t row = (size_t)(rb + tb + tt);
                const float zv = bf2f(PROJ[row * N_PROJ + D_POOL + hh * HD + pp]); const float yz = ys[tt * 64 + pp] * silu_f(zv);
                MIXA[row * D_MIX + D_POOL + hh * HD + pp] = (bf16)f2bf(yz);
                const float q = wave_sum(yz * yz);
                if (pp == 0) SSQH[row * 32 + hh] = q;
            }
            __syncthreads();
        }
        float* ho = C.out + (prm ? O_SSDP + ((((size_t)l * NB_P + b) * NH + hh) * HD + p) * DS + n0 : O_SSDS + ((((size_t)l * NB_S + b) * NH + hh) * HD + p) * DS + n0);
#pragma unroll
        for (int i = 0; i < 4; ++i) *(float4*)(ho + 4 * i) = make_float4(h[4 * i], h[4 * i + 1], h[4 * i + 2], h[4 * i + 3]);
    }
}

constexpr int SL_C = 0, SL_B = 17408, SL_BWT = 34816, SL_XT = 53248, SL_H = 62464, SL_M = 79872, SL_DT = 89088, SL_AC = SL_DT + 512, SL_W = SL_AC + 512, SL_DEC = SL_W + 512, SL_SSQ = SL_DEC + 16, SL_CW = SL_SSQ + 1024;
constexpr int PC = 272, PT = 144;
typedef short bf16x8_t __attribute__((ext_vector_type(8)));
__device__ __forceinline__ bf16x8_t ld_op(const LAS unsigned char* base, int row, int pitch, int kelem) { return *(const LAS bf16x8_t*)(base + row * pitch + kelem * 2); }
__device__ __forceinline__ int swz(int row, int byte) { return byte ^ (((row >> 3) & 7) << 4); }
__device__ __forceinline__ bf16x8_t ld_op_sw(const LAS unsigned char* base, int row, int pitch, int kelem) { return *(const LAS bf16x8_t*)(base + row * pitch + swz(row, kelem * 2)); }
__device__ __forceinline__ F8 unpack8(const uint4 u) { F8 r; r.v[0] = bflo(u.x); r.v[1] = bfhi(u.x); r.v[2] = bflo(u.y); r.v[3] = bfhi(u.y); r.v[4] = bflo(u.z); r.v[5] = bfhi(u.z); r.v[6] = bflo(u.w); r.v[7] = bfhi(u.w); return r; }

typedef unsigned u32x4_t __attribute__((ext_vector_type(4)));
typedef unsigned u32x2_t __attribute__((ext_vector_type(2)));
__device__ __forceinline__ F8 lds_f8(const LAS float* p) { const f32x4 a = *(const LAS f32x4*)p, b = *(const LAS f32x4*)(p + 4); F8 r; r.v[0] = a[0]; r.v[1] = a[1]; r.v[2] = a[2]; r.v[3] = a[3]; r.v[4] = b[0]; r.v[5] = b[1]; r.v[6] = b[2]; r.v[7] = b[3]; return r; }
__device__ __forceinline__ void ssd_stage(LAS unsigned char* L, int cg, int l0, int rows_valid, const LAS float* cwl, const LAS float* w_s, const uint4 (&rawq)[11]) {
    F8 cwv[4];
#pragma unroll
    for (int i = 0; i < 4; ++i) cwv[i] = lds_f8(cwl + 8 * i);
    const F8 cbv = lds_f8(cwl + 32);
#pragma unroll
    for (int h = 0; h < 2; ++h) {
        float o[4][8];
#pragma unroll
        for (int i = 0; i < 4; ++i)
#pragma unroll
            for (int k = 0; k < 8; ++k) o[i][k] = cbv.v[k];
#pragma unroll
        for (int jj = 0; jj < 7; ++jj) { const F8 rj = unpack8(rawq[4 * h + jj]);
#pragma unroll
            for (int i = 0; i < 4; ++i) { const int tap = jj - i;
                if (tap >= 0 && tap < 4) {
#pragma unroll
                    for (int k = 0; k < 8; ++k) o[i][k] += cwv[tap].v[k] * rj.v[k]; } } }
        const int lb = l0 + 4 * h;
#pragma unroll
        for (int i = 0; i < 4; ++i) { const float okf = lb + i < rows_valid ? 1.f : 0.f;
#pragma unroll
            for (int k = 0; k < 8; ++k) o[i][k] = silu_f(o[i][k]) * okf; }
        if (cg < 8) {
#pragma unroll
            for (int k = 0; k < 8; ++k) *(LAS u32x2_t*)(L + SL_XT + (8 * cg + k) * PT + swz(8 * cg + k, lb * 2)) = (u32x2_t){pk2(o[0][k], o[1][k]), pk2(o[2][k], o[3][k])};
        } else if (cg < 24) { const int n0 = 8 * (cg - 8);
#pragma unroll
            for (int i = 0; i < 4; ++i) *(LAS u32x4_t*)(L + SL_B + (lb + i) * PC + n0 * 2) = (u32x4_t){pk2(o[i][0], o[i][1]), pk2(o[i][2], o[i][3]), pk2(o[i][4], o[i][5]), pk2(o[i][6], o[i][7])};
            const f32x4 wl = *(const LAS f32x4*)(w_s + lb);
#pragma unroll
            for (int k = 0; k < 8; ++k) *(LAS u32x2_t*)(L + SL_BWT + (n0 + k) * PT + swz(n0 + k, lb * 2)) = (u32x2_t){pk2(o[0][k] * wl[0], o[1][k] * wl[1]), pk2(o[2][k] * wl[2], o[3][k] * wl[3])};
        } else { const int n0 = 8 * (cg - 24);
#pragma unroll
            for (int i = 0; i < 4; ++i) *(LAS u32x4_t*)(L + SL_C + (lb + i) * PC + n0 * 2) = (u32x4_t){pk2(o[i][0], o[i][1]), pk2(o[i][2], o[i][3]), pk2(o[i][4], o[i][5]), pk2(o[i][6], o[i][7])};
        }
        __builtin_amdgcn_sched_barrier(0);
    }
}
__device__ __forceinline__ void ssd_dt(LAS unsigned char* L, int par, float xr, bool valid, float Aneg, int lane) {
    const float dtv = valid ? (xr > 20.f ? xr : log1pf(__expf(xr))) : 0.f;
    float a = dtv * Aneg;
#pragma unroll
    for (int o = 1; o < 64; o <<= 1) { const float v = __shfl_up(a, o); if (lane >= o) a += v; }
    const float last = __shfl(a, 63);
    ((LAS float*)(L + SL_DT))[par * 64 + lane] = dtv; ((LAS float*)(L + SL_AC))[par * 64 + lane] = a; ((LAS float*)(L + SL_W))[par * 64 + lane] = dtv * __expf(last - a);
    if (lane == 0) ((LAS float*)(L + SL_DEC))[par] = __expf(last);
}
#define WG_BAR() do { asm volatile("s_waitcnt lgkmcnt(0)" ::: "memory"); __builtin_amdgcn_s_barrier(); asm volatile("" ::: "memory"); } while (0)
__device__ __forceinline__ void stage_role(int tq, int& cg, int& l0) {
    const int ws = tq >> 6, lane = tq & 63;
    if (ws == 0) { cg = lane & 7; l0 = (lane >> 3) * 8; }
    else { const int idx = ((ws - 1) & 1) * 64 + lane; cg = (ws <= 2 ? 8 : 24) + (idx & 15); l0 = (idx >> 4) * 8; }
}
#define OPQ_V(x) asm volatile("" : "+v"(x))
#define OPQ_S(x) asm volatile("" : "+s"(x))
__device__ __forceinline__ void phase_ssd2(Ctx C, int l) {
    C.refresh();
    LAS unsigned char* L = C.lds;
    const bf16* PROJ = (const bf16*)(C.ws + WS_PROJ); const float* DT = (const float*)(C.ws + WS_DT); bf16* MIXA = (bf16*)(C.ws + WS_MIXA); float* SSQH = (float*)(C.ws + WS_SSQH);
    const int tid0 = C.tid, w0 = C.wave;
    typedef float f4 __attribute__((ext_vector_type(4)));
#if PROBE_SEL > 0
    unsigned long long tprev2 = __builtin_amdgcn_s_memrealtime(); volatile LAS unsigned* MISC2 = (volatile LAS unsigned*)(C.lds + LDSCTL_OFF);
#define STAMP2(ty) do { if (blockIdx.x == 0 && threadIdx.x == 0) { const unsigned long long tn = __builtin_amdgcn_s_memrealtime(); MISC2[16 + (ty)] += (unsigned)(tn - tprev2); tprev2 = tn; } } while (0)
#else
#define STAMP2(ty) do { } while (0)
#endif
    for (int u = blockIdx.x; u < NB_P * NH + NB_S * NH; u += C.G) {
        STAMP2(19);
        const bool prm = u < NB_P * NH; const int su = prm ? u : u - NB_P * NH, b = su / NH, hh = su % NH, g = hh / HPG;
        const int rb = prm ? b * SEQ : MP + b * SEQ_S, rows = prm ? 64 : 32, nchunk = prm ? SEQ / 64 : 1;
        const float Aneg = -__expf(C.in[13][l * NH + hh]), Dsk = C.in[14][l * NH + hh], dtb = C.in[12][l * NH + hh];
        f4 hacc[4]; float xrn;
        {
            uint4 rawq[11];
            int tq = tid0, w = w0; OPQ_V(tq); OPQ_S(w);
            const int lane = tq & 63, r16 = lane & 15, q = lane >> 4; const bool stg = tq < 320; int cg, l0; stage_role(tq, cg, l0); if (!stg) { cg = 0; l0 = 0; }
            const float* chist = C.in[3] + ((size_t)(l * NB_S + b) * 3) * CONV_DIM;
            const int cc = cg < 8 ? hh * HD + cg * 8 : (cg < 24 ? D_SSD + g * DS + (cg - 8) * 8 : D_SSD + 2 * DS + g * DS + (cg - 24) * 8);
            LAS float* cwl = (LAS float*)(L + SL_CW) + cg * 40;
            if (stg && l0 == 0) { const float* cw = C.in[10] + (size_t)l * 4 * CONV_DIM + cc;
#pragma unroll
                for (int i = 0; i < 4; ++i) { const F8 v = ld_f8(cw + (size_t)i * CONV_DIM); *(LAS f32x4*)(cwl + 8 * i) = (f32x4){v.v[0], v.v[1], v.v[2], v.v[3]}; *(LAS f32x4*)(cwl + 8 * i + 4) = (f32x4){v.v[4], v.v[5], v.v[6], v.v[7]}; }
                const F8 v = ld_f8(C.in[11] + (size_t)l * CONV_DIM + cc); *(LAS f32x4*)(cwl + 32) = (f32x4){v.v[0], v.v[1], v.v[2], v.v[3]}; *(LAS f32x4*)(cwl + 36) = (f32x4){v.v[4], v.v[5], v.v[6], v.v[7]}; }
#pragma unroll
            for (int pj = 0; pj < 4; ++pj) {
                if (prm) hacc[pj] = (f4){0.f, 0.f, 0.f, 0.f};
                else { const float4 v = *(const float4*)(C.in[4] + ((((size_t)l * NB_S + b) * NH + hh) * HD + 16 * pj + r16) * DS + 16 * w + 4 * q); hacc[pj] = (f4){v.x, v.y, v.z, v.w}; }
                *(LAS u32x2_t*)(L + SL_H + (16 * pj + r16) * PC + (16 * w + 4 * q) * 2) = (u32x2_t){pk2(hacc[pj][0], hacc[pj][1]), pk2(hacc[pj][2], hacc[pj][3])};
            }
            const float xr0 = DT[((size_t)rb + (lane < rows ? lane : 0)) * 32 + hh] + dtb;
            {
                const int l0c = l0; const unsigned lo = stg ? (unsigned)(l0c * N_PROJ + cc) * 2u : 0u;
                uint4 pv[11]; F8 hv[3];
#pragma unroll
                for (int j = 0; j < 11; ++j) { const int jr = (j < 3 && l0c == 0) ? 3 : j;
                    const char* ub = (const char*)PROJ + (((size_t)rb) * N_PROJ + XBC0) * 2; pv[j] = *(const uint4*)(ub + ((long)lo + (long)(jr - 3) * (N_PROJ * 2))); }
#pragma unroll
                for (int j = 0; j < 3; ++j) hv[j] = ld_f8((const float*)((const char*)(chist + (size_t)j * CONV_DIM) + (unsigned)cc * 4u));
#pragma unroll
                for (int j = 0; j < 11; ++j) { const int t = l0c - 3 + j; uint4 v = pv[j];
                    if (j < 3) { const uint4 hq = make_uint4(pk2(hv[j].v[0], hv[j].v[1]), pk2(hv[j].v[2], hv[j].v[3]), pk2(hv[j].v[4], hv[j].v[5]), pk2(hv[j].v[6], hv[j].v[7]));
                        const bool useh = t < 0 && !prm, zero = t < 0 && prm;
                        v.x = useh ? hq.x : (zero ? 0u : v.x); v.y = useh ? hq.y : (zero ? 0u : v.y); v.z = useh ? hq.z : (zero ? 0u : v.z); v.w = useh ? hq.w : (zero ? 0u : v.w); }
                    const bool beyond = t >= rows;
                    v.x = beyond ? 0u : v.x; v.y = beyond ? 0u : v.y; v.z = beyond ? 0u : v.z; v.w = beyond ? 0u : v.w;
                    rawq[j] = v; }
            }
            if (w == 0) ssd_dt(L, 0, xr0, lane < rows, Aneg, lane);
            xrn = DT[((size_t)(rb + 64) + lane) * 32 + hh] + dtb;
            WG_BAR();
            if (stg) ssd_stage(L, cg, l0, rows, cwl, (const LAS float*)(L + SL_W), rawq);
            WG_BAR();
        }
        STAMP2(13);
        for (int c = 0; c < nchunk; ++c) {
            const int par = c & 1, tb = c * 64; const bool more = c + 1 < nchunk;
            uint2 zq[2]; uint4 rawq[11];
            {
                int tq = tid0, w = w0; OPQ_V(tq); OPQ_S(w);
                const int lane = tq & 63, r16 = lane & 15, q = lane >> 4;
                const float xrc = xrn;
                xrn = DT[((size_t)(rb + tb + 128) + lane) * 32 + hh] + dtb;
                {
                    int cg, l0c; stage_role(tq, cg, l0c);
                    const int cc = cg < 8 ? hh * HD + cg * 8 : (cg < 24 ? D_SSD + g * DS + (cg - 8) * 8 : D_SSD + 2 * DS + g * DS + (cg - 24) * 8);
                    const unsigned lo = tq < 320 ? (unsigned)(l0c * N_PROJ + cc) * 2u : 0u;
#pragma unroll
                    for (int j = 0; j < 11; ++j) { const char* ub = (const char*)PROJ + ((size_t)(rb + tb + 61 + j) * N_PROJ + XBC0) * 2; rawq[j] = *(const uint4*)(ub + lo); }
                }
                { const int pi = w >> 1, li0 = 2 * (w & 1);
#pragma unroll
                  for (int t = 0; t < 2; ++t) { const int lrow = 16 * (li0 + t) + r16; const char* ub = (const char*)PROJ + ((size_t)(rb + tb + 16 * (li0 + t)) * N_PROJ + D_POOL + hh * HD + 16 * pi) * 2;
                    zq[t] = lrow < rows ? *(const uint2*)(ub + (unsigned)(r16 * N_PROJ + 4 * q) * 2u) : make_uint2(0u, 0u); } }
                if (more && w == 0) ssd_dt(L, par ^ 1, xrc, true, Aneg, lane);
                const LAS float* ac = (const LAS float*)(L + SL_AC) + par * 64; const LAS float* dts = (const LAS float*)(L + SL_DT) + par * 64;
#pragma unroll
                for (int t = 0; t < 2; ++t) { const int T = 2 * w + t, si = T >> 2, li = T & 3; f4 acc = (f4){0.f, 0.f, 0.f, 0.f};
#pragma unroll
                    for (int ks = 0; ks < 4; ++ks) acc = __builtin_amdgcn_mfma_f32_16x16x32_bf16(ld_op(L + SL_B, 16 * si + r16, PC, 32 * ks + 8 * q), ld_op(L + SL_C, 16 * li + r16, PC, 32 * ks + 8 * q), acc, 0, 0, 0);
                    const int lr = 16 * li + r16, s0 = 16 * si + 4 * q; const float al = ac[lr]; const f4 as = *(const LAS f4*)(ac + s0), ds = *(const LAS f4*)(dts + s0); float m[4];
#pragma unroll
                    for (int r = 0; r < 4; ++r) m[r] = (s0 + r <= lr) ? acc[r] * __expf(al - as[r]) * ds[r] : 0.f;
                    *(LAS u32x2_t*)(L + SL_M + lr * PT + s0 * 2) = (u32x2_t){pk2(m[0], m[1]), pk2(m[2], m[3])}; }
            }
            WG_BAR(); STAMP2(14);
            {
                int tq = tid0, w = w0; OPQ_V(tq); OPQ_S(w);
                const int lane = tq & 63, r16 = lane & 15, q = lane >> 4, pi = w >> 1, li0 = 2 * (w & 1);
                const LAS float* ac = (const LAS float*)(L + SL_AC) + par * 64;
#pragma unroll
                for (int t = 0; t < 2; ++t) { const int li = li0 + t; f4 yd = (f4){0.f, 0.f, 0.f, 0.f}, yo = (f4){0.f, 0.f, 0.f, 0.f};
#pragma unroll
                    for (int ks = 0; ks < 2; ++ks) yd = __builtin_amdgcn_mfma_f32_16x16x32_bf16(ld_op_sw(L + SL_XT, 16 * pi + r16, PT, 32 * ks + 8 * q), ld_op(L + SL_M, 16 * li + r16, PT, 32 * ks + 8 * q), yd, 0, 0, 0);
#pragma unroll
                    for (int ks = 0; ks < 4; ++ks) yo = __builtin_amdgcn_mfma_f32_16x16x32_bf16(ld_op(L + SL_H, 16 * pi + r16, PC, 32 * ks + 8 * q), ld_op(L + SL_C, 16 * li + r16, PC, 32 * ks + 8 * q), yo, 0, 0, 0);
                    const int lr = 16 * li + r16, p0 = 16 * pi + 4 * q; const float e = __expf(ac[lr]);
                    const float zf[4] = {bflo(zq[t].x), bfhi(zq[t].x), bflo(zq[t].y), bfhi(zq[t].y)}; float yz[4], ss = 0.f;
#pragma unroll
                    for (int r = 0; r < 4; ++r) { const float xv = bf2f(*(const LAS bf16*)(L + SL_XT + (p0 + r) * PT + swz(p0 + r, lr * 2))); const float y = yd[r] + e * yo[r] + Dsk * xv; yz[r] = y * silu_f(zf[r]); ss += yz[r] * yz[r]; }
                    if (lr < rows) { char* ub = (char*)MIXA + ((size_t)(rb + tb + 16 * li) * D_MIX + D_POOL + hh * HD + 16 * pi) * 2; *(uint2*)(ub + (unsigned)(r16 * D_MIX + 4 * q) * 2u) = make_uint2(pk2(yz[0], yz[1]), pk2(yz[2], yz[3])); }
                    ss += __shfl_xor(ss, 16); ss += __shfl_xor(ss, 32);
                    if (q == 0) ((LAS float*)(L + SL_SSQ))[lr * 4 + pi] = ss; }
            }
            {
                int tq = tid0, w = w0; OPQ_V(tq); OPQ_S(w);
                const int lane = tq & 63, r16 = lane & 15, q = lane >> 4;
                const float dec = ((const LAS float*)(L + SL_DEC))[par];
#pragma unroll
                for (int pj = 0; pj < 4; ++pj) { hacc[pj] = hacc[pj] * dec;
#pragma unroll
                    for (int ks = 0; ks < 2; ++ks) hacc[pj] = __builtin_amdgcn_mfma_f32_16x16x32_bf16(ld_op_sw(L + SL_BWT, 16 * w + r16, PT, 32 * ks + 8 * q), ld_op_sw(L + SL_XT, 16 * pj + r16, PT, 32 * ks + 8 * q), hacc[pj], 0, 0, 0); }
            }
            WG_BAR(); STAMP2(15);
            {
                int tq = tid0, w = w0; OPQ_V(tq); OPQ_S(w);
                const int lane = tq & 63, r16 = lane & 15, q = lane >> 4;
#pragma unroll
                for (int pj = 0; pj < 4; ++pj) *(LAS u32x2_t*)(L + SL_H + (16 * pj + r16) * PC + (16 * w + 4 * q) * 2) = (u32x2_t){pk2(hacc[pj][0], hacc[pj][1]), pk2(hacc[pj][2], hacc[pj][3])};
                if (more && tq < 320) { int cg, l0; stage_role(tq, cg, l0); ssd_stage(L, cg, l0, 64, (const LAS float*)(L + SL_CW) + cg * 40, (const LAS float*)(L + SL_W) + (par ^ 1) * 64, rawq); }
                if (tq >= 448 && (tq - 448) < rows) { const int lr = tq - 448; const f4 s4 = *(const LAS f4*)(L + SL_SSQ + lr * 16); SSQH[(size_t)(rb + tb + lr) * 32 + hh] = (s4[0] + s4[1]) + (s4[2] + s4[3]); }
            }
            WG_BAR();
            STAMP2(16);
        }
        {
            int tq = tid0, w = w0; OPQ_V(tq); OPQ_S(w);
            const int lane = tq & 63, r16 = lane & 15, q = lane >> 4;
            float* ho = C.out + (prm ? O_SSDP + (((size_t)l * NB_P + b) * NH + hh) * HD * DS : O_SSDS + (((size_t)l * NB_S + b) * NH + hh) * HD * DS);
#pragma unroll
            for (int pj = 0; pj < 4; ++pj) *(float4*)(ho + (size_t)(16 * pj + r16) * DS + 16 * w + 4 * q) = make_float4(hacc[pj][0], hacc[pj][1], hacc[pj][2], hacc[pj][3]); }
    }
}

constexpr int PH_CONV = 0, PH_FOLD = 1, PH_L0 = 2, PH_PER_L = 9, N_PHASES = PH_L0 + DEPTH * PH_PER_L;
constexpr int CW_BAR = 4096;

__global__ void __launch_bounds__(NTHR, 2) fwd_kernel(Args args) {
    extern __shared__ __attribute__((aligned(16))) unsigned char lds_raw[];
    Ctx C; C.lds = (LAS unsigned char*)lds_raw; C.G = gridDim.x; C.in = args.in; C.out = args.out; C.ws = args.ws; C.refresh();
    volatile LAS unsigned* MISC = (volatile LAS unsigned*)(C.lds + LDSCTL_OFF);
    if (threadIdx.x < 64) MISC[threadIdx.x] = 0u;
    __syncthreads();
    const int lo = args.ph_lo, hi = args.ph_hi;
    unsigned* barw = (unsigned*)(args.ws + WS_CTL) + CW_BAR;
    XcdBarrier bar; bar.bar = barw; bar.x = 0; bar.st = MISC + 8;
    if (hi - lo > 1) bar = xcd_barrier_post(barw, MISC + 8);
#define IN(k) (lo <= (k) && (k) < hi)
#if PROBE_SEL > 0
    unsigned long long tprev = __builtin_amdgcn_s_memrealtime();
#define STAMP(ty) do { if (blockIdx.x == 0 && threadIdx.x == 0) { const unsigned long long tn = __builtin_amdgcn_s_memrealtime(); MISC[16 + (ty)] += (unsigned)(tn - tprev); tprev = tn; } } while (0)
#else
#define STAMP(ty) do { } while (0)
#endif
#define SEAM(k) do { if ((k) + 1 < hi) xcd_barrier(bar); } while (0)
    LAS unsigned char* ring = C.lds;

    if (IN(PH_CONV)) { phase_convert(C); SEAM(PH_CONV); STAMP(0); }
    if (IN(PH_FOLD)) {
        for (int w = (int)blockIdx.x; w < DEPTH * 4 * 8; w += C.G) { const int lg = w >> 3, l = lg >> 2, g = lg & 3;
            pg8::Gemm gm{(const bf16*)(C.ws + WS_WOP) + (size_t)l * DM * D_POOL + g * 256, (const bf16*)(C.ws + WS_WPB) + (size_t)lg * 65536, DM, 256, 256, D_POOL, 256};
            pg8::StaticOrder S; S.init(DM, 256, 8, w & 7);
            pg8::EpiBf16S E{(bf16*)(C.ws + WS_BTOUT) + (size_t)l * DM * D_MIX + g * 256, D_MIX, nullptr, nullptr, -1};
            pg8::gemm_phase<pg8::EpiBf16S, pg8::StaticOrder, true, true>(ring, gm, S, E);
        }
        SEAM(PH_FOLD); STAMP(1);
    }
    for (int l = 0; l < DEPTH; ++l) {
        const int pb = PH_L0 + l * PH_PER_L;
        if (IN(pb + 0)) {
            pg8::Gemm gm{(const bf16*)(C.ws + WS_XB), (const bf16*)(C.ws + WS_BTIN) + (size_t)l * N_INP * DM, M, N_INP, DM, DM, DM};
            pg8::StaticOrder S; S.init(M, N_INP, C.G, (int)blockIdx.x);
            pg8::EpiBf16S E{(bf16*)(C.ws + WS_PROJ), N_PROJ, (const float*)(C.ws + WS_R), (float*)(C.ws + WS_DT), N_PROJ / 256};
            pg8::gemm_phase<pg8::EpiBf16S, pg8::StaticOrder, true, true>(ring, gm, S, E);
            SEAM(pb + 0); STAMP(2);
        }
        if (IN(pb + 1)) { phase_ssd2(C, l); STAMP(11); phase_pool(C, l); STAMP(12); SEAM(pb + 1); STAMP(3); }
        if (IN(pb + 2)) { phase_gnorm(C); SEAM(pb + 2); STAMP(4); }
        if (IN(pb + 3)) {
            pg8::Gemm gm{(const bf16*)(C.ws + WS_MIXA), (const bf16*)(C.ws + WS_BTOUT) + (size_t)l * DM * D_MIX, M, DM, D_MIX, D_MIX, D_MIX};
            pg8::StaticOrder S; S.init(M, DM, C.G, (int)blockIdx.x);
            pg8::EpiF32Ssq E{(float*)(C.ws + WS_MIX), DM, (float*)(C.ws + WS_SSQP)};
            pg8::gemm_phase<pg8::EpiF32Ssq, pg8::StaticOrder, true, true>(ring, gm, S, E);
            SEAM(pb + 3); STAMP(5);
        }
        if (IN(pb + 4)) { phase_resid(C, C.in[17] + l * DM, false); SEAM(pb + 4); STAMP(6); }
        if (IN(pb + 5)) {
            pg8::Gemm gm{(const bf16*)(C.ws + WS_XB), (const bf16*)(C.ws + WS_BTUP) + (size_t)l * D_UP * DM, M, D_UP, DM, DM, DM};
            pg8::StaticOrder S; S.init(M, D_UP, C.G, (int)blockIdx.x);
            pg8::EpiBf16S E{(bf16*)(C.ws + WS_UP), D_UP, (const float*)(C.ws + WS_R), nullptr, -1};
            pg8::gemm_phase<pg8::EpiBf16S, pg8::StaticOrder, true, true>(ring, gm, S, E);
            SEAM(pb + 5); STAMP(7);
        }
        if (IN(pb + 6)) { phase_act(C, l); SEAM(pb + 6); STAMP(8); }
        if (IN(pb + 7)) {
            pg8::Gemm gm{(const bf16*)(C.ws + WS_ACT), (const bf16*)(C.ws + WS_BTDN) + (size_t)l * DM * D_FF, M, DM, D_FF, D_FF, D_FF};
            pg8::StaticOrder S; S.init(M, DM, C.G, (int)blockIdx.x);
            pg8::EpiF32Ssq E{(float*)(C.ws + WS_MIX), DM, (float*)(C.ws + WS_SSQP)};
            pg8::gemm_phase<pg8::EpiF32Ssq, pg8::StaticOrder, true, true>(ring, gm, S, E);
            SEAM(pb + 7); STAMP(9);
        }
        if (IN(pb + 8)) { phase_resid(C, C.in[23] + l * DM, l == DEPTH - 1); SEAM(pb + 8); STAMP(10); }
    }
#if PROBE_SEL > 0
    if (blockIdx.x == 0 && threadIdx.x == 0) { asm volatile("s_waitcnt vmcnt(0)" ::: "memory"); unsigned tot = 0; for (int ty = 0; ty < 20; ++ty) if ((PROBE_SEL >> ty) & 1) tot += MISC[16 + ty]; C.out[0] = (float)tot * 0.0001f; }
#endif
#undef IN
#undef SEAM
}

extern "C" void kernel_launch(void* const* d_in, const int* in_sizes, int n_in, void* d_out, int out_size, void* d_ws, size_t ws_size, hipStream_t stream) {
    static int grid = 0;
    if (grid == 0) {
        if (n_in != 24 || (size_t)out_size != O_END || ws_size < WS_END) { fprintf(stderr, "kernel_launch: shape mismatch: n_in %d out %d (want %zu) ws %zu (need %zu)\n", n_in, out_size, (size_t)O_END, ws_size, (size_t)WS_END); grid = -1; return; }
        int dev = 0, cus = 0, per_cu = 0;
        if (hipGetDevice(&dev) != hipSuccess || hipDeviceGetAttribute(&cus, hipDeviceAttributeMultiprocessorCount, dev) != hipSuccess) { grid = -1; return; }
        if (hipFuncSetAttribute((const void*)fwd_kernel, hipFuncAttributeMaxDynamicSharedMemorySize, LDS_BYTES) != hipSuccess) { fprintf(stderr, "kernel_launch: hipFuncSetAttribute failed\n"); grid = -1; return; }
        if (hipOccupancyMaxActiveBlocksPerMultiprocessor(&per_cu, (const void*)fwd_kernel, NTHR, LDS_BYTES) != hipSuccess || per_cu < 1) fprintf(stderr, "kernel_launch: occupancy query reports %d\n", per_cu);
        (void)hipGetLastError();
        grid = cus;
    }
    if (grid < 0) return;
    if (hipMemsetAsync((char*)d_ws + WS_CTL, 0, CTL_BYTES, stream) != hipSuccess) return;
    Args a{};
    for (int i = 0; i < 24; ++i) a.in[i] = (const float*)d_in[i];
    a.out = (float*)d_out; a.ws = (unsigned char*)d_ws;
#if MK_MULTI
    for (int k = 0; k < N_PHASES; ++k) { a.ph_lo = k; a.ph_hi = k + 1; hipLaunchKernelGGL(fwd_kernel, dim3(grid), dim3(NTHR), LDS_BYTES, stream, a); }
#else
    a.ph_lo = 0; a.ph_hi = N_PHASES; hipLaunchKernelGGL(fwd_kernel, dim3(grid), dim3(NTHR), LDS_BYTES, stream, a);
#endif
}
```

```cpp
#include <hip/hip_runtime.h>
#include <cstdio>
#include <cstdint>

#ifndef PROBE_SEL
#define PROBE_SEL 0
#endif
#ifndef MK_MULTI
#define MK_MULTI 0
#endif

namespace pg8 {
#define PG8_LAS __attribute__((address_space(3)))
typedef unsigned short bf16_t;
typedef short bf16x8 __attribute__((ext_vector_type(8)));
typedef float f32x4 __attribute__((ext_vector_type(4)));
typedef unsigned u32x4 __attribute__((ext_vector_type(4)));
constexpr int BM = 256, BK = 64, HALF = 128, HTB = HALF * BK * 2, STAGE_BYTES = 8 * HTB, NXCD = 8, WGM = 8;

__host__ __device__ __forceinline__ int lds_byte(int r, int c) { const int st = (r >> 4) * 2 + (c >> 5), rr = r & 15, cc = c & 31, ob = rr * 64 + cc * 2; return st * 1024 + (ob ^ (((ob >> 9) & 1) << 5)); }
__host__ __device__ __forceinline__ void stage_rc(int b, int& R, int& C) { const int st = b / 1024, sb = b % 1024, swz = sb ^ (((sb >> 9) & 1) << 5); R = (st >> 1) * 16 + swz / 64; C = (st & 1) * 32 + (swz % 64) / 2; }
__host__ __device__ __forceinline__ int perm32(int rho) { const int n = rho >> 4, i = rho & 15; return 8 * (i >> 2) + 4 * n + (i & 3); }

struct Unit { int pm, pn, ks; };
struct Gemm { const bf16_t* A; const bf16_t* Bt; int M, N, K, lda, ldb, kslice; };

struct StaticOrder {
    int nM, nN, nwg, G, c;
    __host__ __device__ void init(int M, int N, int G_, int c_) { nM = M / BM; nN = N / BM; nwg = nM * nN; G = G_; c = c_; }
    __host__ __device__ bool next(int i, Unit& u) const {
        const long L = (long)i * G + c; if (L >= nwg) return false;
        int wgid = (int)L; { const int q = nwg / NXCD, r = nwg % NXCD, xcd = wgid % NXCD, off = wgid / NXCD; wgid = (xcd < r ? xcd * (q + 1) : r * (q + 1) + (xcd - r) * q) + off; }
        const int nig = WGM * nN, gid = wgid / nig, fm = gid * WGM, gsz = (nM - fm) < WGM ? (nM - fm) : WGM;
        u.pm = fm + ((wgid % nig) % gsz); u.pn = (wgid % nig) / gsz; u.ks = 0; return true;
    }
    __device__ __forceinline__ void a_ready(const Unit&) const {}
    __device__ __forceinline__ void done(const Unit&) const {}
};
struct SplitKOrder {
    int nM, nN, KS, nwg, G, c;
    __host__ __device__ void init(int M, int N, int KS_, int G_, int c_) { nM = M / BM; nN = N / BM; KS = KS_; nwg = nM * nN * KS; G = G_; c = c_; }
    __host__ __device__ bool next(int i, Unit& u) const { const long L = (long)i * G + c; if (L >= nwg) return false; const int l = (int)L; u.pn = l % nN; u.ks = (l / nN) % KS; u.pm = l / (nN * KS); return true; }
    __device__ __forceinline__ void a_ready(const Unit&) const {}
    __device__ __forceinline__ void done(const Unit&) const {}
};

__device__ __forceinline__ unsigned cvt_pk_bf16(float lo, float hi) { unsigned r; asm volatile("v_cvt_pk_bf16_f32 %0, %1, %2" : "=v"(r) : "v"(lo), "v"(hi)); return r; }

struct EpiBf16S {
    static constexpr bool PERM = true, AFTER_DRAIN = false;
    bf16_t* O; int ldc; const float* rs; float* dt; int dt_pn;
    __device__ __forceinline__ void operator()(const f32x4 (&acc)[2][2][4][2], const Unit& u, int wr, int wc, int fr, int fq) const {
        const int row0 = u.pm * BM + wr * 64 + fr;
        if (u.pn == dt_pn) {
            if (wc == 0) {
#pragma unroll
                for (int ai = 0; ai < 2; ++ai)
#pragma unroll
                    for (int m = 0; m < 4; ++m) { const int row = row0 + ai * HALF + m * 16; const float s = rs ? rs[row] : 1.f;
#pragma unroll
                        for (int n = 0; n < 2; ++n) *(f32x4*)(dt + (size_t)row * 32 + 8 * fq + 4 * n) = acc[ai][0][m][n] * s; }
            }
            return;
        }
        const int col0 = u.pn * BM + wc * 32 + 8 * fq;
#pragma unroll
        for (int ai = 0; ai < 2; ++ai)
#pragma unroll
            for (int m = 0; m < 4; ++m) { const int row = row0 + ai * HALF + m * 16; const float s = rs ? rs[row] : 1.f; bf16_t* rowp = O + (size_t)row * ldc + col0;
#pragma unroll
                for (int bj = 0; bj < 2; ++bj) { const f32x4 v0 = acc[ai][bj][m][0] * s, v1 = acc[ai][bj][m][1] * s;
                    u32x4 w; w.x = cvt_pk_bf16(v0[0], v0[1]); w.y = cvt_pk_bf16(v0[2], v0[3]); w.z = cvt_pk_bf16(v1[0], v1[1]); w.w = cvt_pk_bf16(v1[2], v1[3]);
                    *(u32x4*)(rowp + bj * HALF) = w; } }
    }
};
struct EpiF32Ssq {
    static constexpr bool PERM = false, AFTER_DRAIN = false;
    float* C; int ldc; float* ssq;
    __device__ __forceinline__ void operator()(const f32x4 (&acc)[2][2][4][2], const Unit& u, int wr, int wc, int fr, int fq) const {
        const int row0 = u.pm * BM + wr * 64 + fr, col0 = u.pn * BM + wc * 32 + 4 * fq;
#pragma unroll
        for (int ai = 0; ai < 2; ++ai)
#pragma unroll
            for (int m = 0; m < 4; ++m) { const int row = row0 + ai * HALF + m * 16; float* rowp = C + (size_t)row * ldc + col0; float q = 0.f;
#pragma unroll
                for (int bj = 0; bj < 2; ++bj)
#pragma unroll
                    for (int n = 0; n < 2; ++n) { const f32x4 v = acc[ai][bj][m][n]; *(f32x4*)(rowp + bj * HALF + n * 16) = v; q += (v[0] * v[0] + v[1] * v[1]) + (v[2] * v[2] + v[3] * v[3]); }
                q += __shfl_xor(q, 16); q += __shfl_xor(q, 32);
                if (fq == 0) ssq[(size_t)row * 32 + u.pn * 4 + wc] = q; }
    }
};

struct EpiBf16Ssq {
    static constexpr bool PERM = true, AFTER_DRAIN = false;
    bf16_t* O; int ldc; float* ssq;
    __device__ __forceinline__ void operator()(const f32x4 (&acc)[2][2][4][2], const Unit& u, int wr, int wc, int fr, int fq) const {
        const int row0 = u.pm * BM + wr * 64 + fr, col0 = u.pn * BM + wc * 32 + 8 * fq;
#pragma unroll
        for (int ai = 0; ai < 2; ++ai)
#pragma unroll
            for (int m = 0; m < 4; ++m) { const int row = row0 + ai * HALF + m * 16; bf16_t* rowp = O + (size_t)row * ldc + col0; float q = 0.f;
#pragma unroll
                for (int bj = 0; bj < 2; ++bj) { const f32x4 v0 = acc[ai][bj][m][0], v1 = acc[ai][bj][m][1];
                    q += ((v0[0] * v0[0] + v0[1] * v0[1]) + (v0[2] * v0[2] + v0[3] * v0[3])) + ((v1[0] * v1[0] + v1[1] * v1[1]) + (v1[2] * v1[2] + v1[3] * v1[3]));
                    u32x4 w; w.x = cvt_pk_bf16(v0[0], v0[1]); w.y = cvt_pk_bf16(v0[2], v0[3]); w.z = cvt_pk_bf16(v1[0], v1[1]); w.w = cvt_pk_bf16(v1[2], v1[3]);
                    *(u32x4*)(rowp + bj * HALF) = w; }
                q += __shfl_xor(q, 16); q += __shfl_xor(q, 32);
                if (fq == 0) ssq[(size_t)row * 32 + u.pn * 4 + wc] = q; }
    }
};
struct EpiF32Slab {
    static constexpr bool PERM = false, AFTER_DRAIN = false;
    float* C; int ldc, Mrows;
    __device__ __forceinline__ void operator()(const f32x4 (&acc)[2][2][4][2], const Unit& u, int wr, int wc, int fr, int fq) const {
        const int row0 = u.pm * BM + wr * 64 + fr, col0 = u.pn * BM + wc * 32 + 4 * fq; float* base = C + (size_t)u.ks * Mrows * ldc;
#pragma unroll
        for (int ai = 0; ai < 2; ++ai)
#pragma unroll
            for (int m = 0; m < 4; ++m) { float* rowp = base + (size_t)(row0 + ai * HALF + m * 16) * ldc + col0;
#pragma unroll
                for (int bj = 0; bj < 2; ++bj)
#pragma unroll
                    for (int n = 0; n < 2; ++n) *(f32x4*)(rowp + bj * HALF + n * 16) = acc[ai][bj][m][n]; }
    }
};
template <class Epi, class Sched, bool ALIGN_EPI = false, bool SP2 = false>
__device__ __forceinline__ void gemm_phase(PG8_LAS unsigned char* lds, const Gemm g, const Sched& S, const Epi& E) {
    int tid_ = threadIdx.x; asm volatile("" : "+v"(tid_));
    const int tid = tid_, wid = __builtin_amdgcn_readfirstlane(tid >> 6), lane = tid & 63, wr = wid >> 2, wc = wid & 3, fr = lane & 15, fq = lane >> 4;
    const int K = g.K, nt = K / BK;
    unsigned voffA[2], voffB[2];
#pragma unroll
    for (int i = 0; i < 2; ++i) { int R, C; stage_rc(tid * 16 + i * 8192, R, C); const int Rb = Epi::PERM ? ((R & ~31) + perm32(R & 31)) : R;
        voffA[i] = (unsigned)(R * g.lda + C) * 2u; voffB[i] = (unsigned)(Rb * g.ldb + C) * 2u; }
    const size_t kstep = (size_t)(BK * 2);
    const size_t hstepA = (size_t)HALF * g.lda * 2, hstepB = (size_t)HALF * g.ldb * 2;
    const size_t tstepA = 2 * hstepA, tstepB = 2 * hstepB;
    const unsigned ldsw = (unsigned)wid * 1024u;
    const int aoff = lds_byte(wr * 64 + fr, fq * 8), boff = lds_byte(wc * 32 + fr, fq * 8);
#define PG8_SA(b, h) (((b) * 2 + (h)) * HTB)
#define PG8_SB(b, h) ((4 + (b) * 2 + (h)) * HTB)
#define PG8_STAGE(bufoff, gbase, voff) do { _Pragma("unroll") for (int _i = 0; _i < 2; ++_i) \
        __builtin_amdgcn_global_load_lds((const unsigned*)((const char*)(gbase) + (voff)[_i]), (PG8_LAS unsigned*)(lds + (bufoff) + ldsw + _i * 8192), 16, 0, 0); } while (0)
#define PG8_LDA(dst, b, h) do { _Pragma("unroll") for (int m = 0; m < 4; ++m) _Pragma("unroll") for (int k = 0; k < 2; ++k) dst[m][k] = *(const PG8_LAS bf16x8*)(lds + PG8_SA(b, h) + aoff + m * 2048 + k * 1024); } while (0)
#define PG8_LDB(dst, b, h) do { _Pragma("unroll") for (int n = 0; n < 2; ++n) _Pragma("unroll") for (int k = 0; k < 2; ++k) dst[n][k] = *(const PG8_LAS bf16x8*)(lds + PG8_SB(b, h) + boff + n * 2048 + k * 1024); } while (0)
#define PG8_MMA(ai, bj, At, Bt) do { __builtin_amdgcn_s_setprio(1); _Pragma("unroll") for (int m = 0; m < 4; ++m) _Pragma("unroll") for (int n = 0; n < 2; ++n) _Pragma("unroll") for (int k = 0; k < 2; ++k) \
        acc[ai][bj][m][n] = __builtin_amdgcn_mfma_f32_16x16x32_bf16(Bt[n][k], At[m][k], acc[ai][bj][m][n], 0, 0, 0); __builtin_amdgcn_s_setprio(0); } while (0)
#define PG8_WAIT_V(n) asm volatile("s_waitcnt vmcnt(" #n ")" ::: "memory")
#define PG8_WAIT_L(n) asm volatile("s_waitcnt lgkmcnt(" #n ")" ::: "memory")
#define PG8_BAR __builtin_amdgcn_s_barrier()
#define PG8_SCHED __builtin_amdgcn_sched_barrier(0)
    Unit cur, nxt; int ui = 0;
    if (!S.next(0, cur)) return;
    f32x4 acc[2][2][4][2];
#pragma unroll
    for (int a = 0; a < 2; ++a)
#pragma unroll
        for (int b = 0; b < 2; ++b)
#pragma unroll
            for (int m = 0; m < 4; ++m)
#pragma unroll
                for (int n = 0; n < 2; ++n) acc[a][b][m][n] = (f32x4){0.f, 0.f, 0.f, 0.f};
    bf16x8 At[4][2], B0[2][2], B1[2][2];
    const size_t ksb = (size_t)g.kslice * 2;
    const char* cA = (const char*)g.A + (size_t)cur.pm * tstepA + cur.ks * ksb; const char* cB = (const char*)g.Bt + (size_t)cur.pn * tstepB + cur.ks * ksb;
    S.a_ready(cur);
    if constexpr (SP2) {
        PG8_STAGE(PG8_SB(0, 0), cB, voffB); PG8_STAGE(PG8_SB(0, 1), cB + hstepB, voffB); PG8_STAGE(PG8_SA(0, 0), cA, voffA); PG8_STAGE(PG8_SA(0, 1), cA + hstepA, voffA);
        if (wr == 1) PG8_BAR;
        PG8_WAIT_V(2); PG8_BAR;
        PG8_STAGE(PG8_SB(1, 0), cB + kstep, voffB); PG8_STAGE(PG8_SA(1, 0), cA + kstep, voffA); PG8_STAGE(PG8_SB(1, 1), cB + hstepB + kstep, voffB);
        PG8_WAIT_V(6); PG8_BAR;
    } else {
        PG8_STAGE(PG8_SB(0, 0), cB, voffB); PG8_STAGE(PG8_SA(0, 0), cA, voffA); PG8_STAGE(PG8_SB(0, 1), cB + hstepB, voffB); PG8_STAGE(PG8_SA(0, 1), cA + hstepA, voffA);
        if (wr == 1) PG8_BAR;
        PG8_WAIT_V(4); PG8_BAR;
        PG8_STAGE(PG8_SB(1, 0), cB + kstep, voffB); PG8_STAGE(PG8_SA(1, 0), cA + kstep, voffA); PG8_STAGE(PG8_SB(1, 1), cB + hstepB + kstep, voffB);
        PG8_WAIT_V(6); PG8_BAR;
    }
    for (;;) {
        const bool has_next = S.next(ui + 1, nxt);
        const char* nA = has_next ? (const char*)g.A + (size_t)nxt.pm * tstepA + nxt.ks * ksb : cA; const char* nB = has_next ? (const char*)g.Bt + (size_t)nxt.pn * tstepB + nxt.ks * ksb : cB;
        for (int t = 0; t < nt; t += 2) {
            const bool last = (t == nt - 2);
            const char* a1 = cA + (size_t)(t + 1) * kstep;
            const char* a2 = last ? nA : cA + (size_t)(t + 2) * kstep; const char* b2 = last ? nB : cB + (size_t)(t + 2) * kstep;
            const char* a3 = a2 + kstep; const char* b3 = b2 + kstep;
            if (last && has_next) S.a_ready(nxt);
            if constexpr (SP2) {
            PG8_LDB(B0, 0, 0); PG8_LDB(B1, 0, 1); PG8_SCHED; PG8_LDA(At, 0, 0); PG8_STAGE(PG8_SA(1, 1), a1 + hstepA, voffA);
            PG8_WAIT_V(8); PG8_WAIT_L(0); PG8_BAR; PG8_MMA(0, 0, At, B0); PG8_MMA(0, 1, At, B1); PG8_BAR; PG8_SCHED;
            PG8_LDA(At, 0, 1); PG8_STAGE(PG8_SB(0, 0), b2, voffB); PG8_STAGE(PG8_SB(0, 1), b2 + hstepB, voffB); PG8_STAGE(PG8_SA(0, 0), a2, voffA);
            PG8_WAIT_V(8); PG8_WAIT_L(0); PG8_BAR; PG8_MMA(1, 0, At, B0); PG8_MMA(1, 1, At, B1); PG8_BAR; PG8_SCHED;
            PG8_LDB(B0, 1, 0); PG8_LDB(B1, 1, 1); PG8_SCHED; PG8_LDA(At, 1, 0); PG8_STAGE(PG8_SA(0, 1), a2 + hstepA, voffA);
            PG8_WAIT_V(8); PG8_WAIT_L(0); PG8_BAR; PG8_MMA(0, 0, At, B0); PG8_MMA(0, 1, At, B1); PG8_BAR; PG8_SCHED;
            PG8_LDA(At, 1, 1); PG8_STAGE(PG8_SB(1, 0), b3, voffB); PG8_STAGE(PG8_SB(1, 1), b3 + hstepB, voffB); PG8_STAGE(PG8_SA(1, 0), a3, voffA);
            PG8_WAIT_V(8); PG8_WAIT_L(0); PG8_BAR; PG8_MMA(1, 0, At, B0); PG8_MMA(1, 1, At, B1); PG8_BAR; PG8_SCHED;
            } else {
            PG8_LDB(B0, 0, 0); PG8_SCHED; PG8_LDA(At, 0, 0); PG8_STAGE(PG8_SA(1, 1), a1 + hstepA, voffA);
            PG8_WAIT_L(8); PG8_BAR; PG8_WAIT_L(0); PG8_MMA(0, 0, At, B0); PG8_BAR; PG8_SCHED;
            PG8_LDB(B1, 0, 1); PG8_STAGE(PG8_SB(0, 0), b2, voffB);
            PG8_BAR; PG8_WAIT_L(0); PG8_MMA(0, 1, At, B1); PG8_BAR;
            PG8_LDA(At, 0, 1); PG8_STAGE(PG8_SA(0, 0), a2, voffA);
            PG8_BAR; PG8_WAIT_L(0); PG8_MMA(1, 0, At, B0); PG8_BAR; PG8_SCHED;
            PG8_STAGE(PG8_SB(0, 1), b2 + hstepB, voffB);
            PG8_WAIT_V(6); PG8_BAR; PG8_MMA(1, 1, At, B1); PG8_BAR;
            PG8_LDB(B0, 1, 0); PG8_SCHED; PG8_LDA(At, 1, 0); PG8_STAGE(PG8_SA(0, 1), a2 + hstepA, voffA);
            PG8_WAIT_L(8); PG8_BAR; PG8_WAIT_L(0); PG8_MMA(0, 0, At, B0); PG8_BAR; PG8_SCHED;
            PG8_LDB(B1, 1, 1); PG8_STAGE(PG8_SB(1, 0), b3, voffB);
            PG8_BAR; PG8_WAIT_L(0); PG8_MMA(0, 1, At, B1); PG8_BAR;
            PG8_LDA(At, 1, 1); PG8_STAGE(PG8_SA(1, 0), a3, voffA);
            PG8_BAR; PG8_WAIT_L(0); PG8_MMA(1, 0, At, B0); PG8_BAR; PG8_SCHED;
            PG8_STAGE(PG8_SB(1, 1), b3 + hstepB, voffB);
            PG8_WAIT_V(6); PG8_BAR; PG8_MMA(1, 1, At, B1); PG8_BAR;
            }
        }
        if constexpr (ALIGN_EPI) { if (wr == 0) PG8_BAR; }
        if constexpr (!Epi::AFTER_DRAIN) { E(acc, cur, wr, wc, fr, fq); S.done(cur); }
        if (!has_next) break;
#pragma unroll
        for (int a = 0; a < 2; ++a)
#pragma unroll
            for (int b = 0; b < 2; ++b)
#pragma unroll
                for (int m = 0; m < 4; ++m)
#pragma unroll
                    for (int n = 0; n < 2; ++n) acc[a][b][m][n] = (f32x4){0.f, 0.f, 0.f, 0.f};
        cur = nxt; cA = nA; cB = nB; ++ui;
        if constexpr (ALIGN_EPI) { if (wr == 1) PG8_BAR; }
    }
    PG8_WAIT_V(0);
    if constexpr (!ALIGN_EPI) { if (wr == 0) PG8_BAR; }
    PG8_BAR;
#undef PG8_SA
#undef PG8_SB
#undef PG8_STAGE
#undef PG8_LDA
#undef PG8_LDB
#undef PG8_MMA
#undef PG8_WAIT_V
#undef PG8_WAIT_L
#undef PG8_BAR
#undef PG8_SCHED
}
}

constexpr int NWAVES = 8, NTHR = 512;
constexpr int DM = 2048, SEQ = 2048, NB_P = 8, NB_S = 32, SEQ_S = 32, DEPTH = 4;
constexpr int MP = NB_P * SEQ, MS = NB_S * SEQ_S, M = MP + MS;
constexpr int D_POOL = 1024, POOL_HIST = 15, D_SSD = 2048, HD = 64, NH = 32, HPG = 16, DS = 128, CONV_DIM = 2560, D_MIX = 3072;
constexpr int D_IN = 5664, N_PROJ = 5632, N_INP = 5888, D_FF = 5632, D_UP = 11264;
constexpr int XBC0 = 3072;
constexpr float EPS = 1e-6f;

constexpr size_t O_YP = 0, O_YS = O_YP + (size_t)MP * DM, O_POOLP = O_YS + (size_t)MS * DM, O_POOLS = O_POOLP + (size_t)DEPTH * NB_P * 15 * 1024,
    O_SCP = O_POOLS + (size_t)DEPTH * NB_S * 15 * 1024, O_SCS = O_SCP + (size_t)DEPTH * NB_P * 3 * 2560, O_SSDP = O_SCS + (size_t)DEPTH * NB_S * 3 * 2560,
    O_SSDS = O_SSDP + (size_t)DEPTH * NB_P * 32 * 64 * 128, O_FCP = O_SSDS + (size_t)DEPTH * NB_S * 32 * 64 * 128, O_FCS = O_FCP + (size_t)DEPTH * NB_P * 2 * 11264,
    O_END = O_FCS + (size_t)DEPTH * NB_S * 2 * 11264;

constexpr size_t al256(size_t x) { return (x + 255) & ~(size_t)255; }
constexpr size_t WS_CTL = 0, CTL_BYTES = 1u << 20;
constexpr size_t WS_BTIN = CTL_BYTES;
constexpr size_t WS_BTOUT = WS_BTIN + (size_t)DEPTH * N_INP * DM * 2;
constexpr size_t WS_BTUP = WS_BTOUT + (size_t)DEPTH * DM * D_MIX * 2;
constexpr size_t WS_BTDN = WS_BTUP + (size_t)DEPTH * D_UP * DM * 2;
constexpr size_t WS_WOP = WS_BTDN + (size_t)DEPTH * DM * D_FF * 2;
constexpr size_t WS_WPB = WS_WOP + (size_t)DEPTH * DM * D_POOL * 2;
constexpr size_t WS_X = WS_WPB + (size_t)DEPTH * 4 * 256 * 256 * 2;
constexpr size_t WS_XB = WS_X + (size_t)M * DM * 4;
constexpr size_t WS_R = WS_XB + (size_t)M * DM * 2;
constexpr size_t WS_DT = WS_R + al256((size_t)M * 4);
constexpr size_t WS_SSQP = WS_DT + (size_t)M * 32 * 4;
constexpr size_t WS_SSQH = WS_SSQP + (size_t)M * 32 * 4;
constexpr size_t WS_ACT = WS_SSQH + (size_t)M * 32 * 4;
constexpr size_t WS_RA = WS_ACT + (size_t)M * D_FF * 2;
constexpr size_t WS_PROJ = WS_RA;
constexpr size_t WS_MIXA = WS_PROJ + (size_t)M * N_PROJ * 2;
constexpr size_t WS_MIX = WS_MIXA + (size_t)M * D_MIX * 2;
constexpr size_t WS_UP = WS_RA;
constexpr int KS_OUT = 8, KS_DN = 4;
constexpr size_t WS_SLAB = WS_MIX + (size_t)M * DM * 4;
constexpr size_t WS_END = WS_SLAB + (size_t)KS_OUT * MS * DM * 4;
static_assert((size_t)M * D_UP * 2 <= WS_END - WS_RA, "UP fits region A");

constexpr int RING_BYTES = 131072, LDSCTL_OFF = RING_BYTES, LDS_BYTES = 147456;

#define LAS __attribute__((address_space(3)))
typedef unsigned short bf16;
typedef float f32x4 __attribute__((ext_vector_type(4)));
#define RLX_AGENT __ATOMIC_RELAXED, __HIP_MEMORY_SCOPE_AGENT
__device__ __forceinline__ unsigned f2bf(float f) { unsigned u = __builtin_bit_cast(unsigned, f); return (u + 0x7fffu + ((u >> 16) & 1u)) >> 16; }
__device__ __forceinline__ unsigned pk2(float lo, float hi) { unsigned r; asm("v_cvt_pk_bf16_f32 %0, %1, %2" : "=v"(r) : "v"(lo), "v"(hi)); return r; }
__device__ __forceinline__ float bflo(unsigned u) { return __uint_as_float(u << 16); }
__device__ __forceinline__ float bfhi(unsigned u) { return __uint_as_float(u & 0xffff0000u); }
__device__ __forceinline__ float bf2f(bf16 b) { return __uint_as_float(((unsigned)b) << 16); }
struct F8 { float v[8]; };
__device__ __forceinline__ F8 ld_bf8(const bf16* p) { const uint4 u = *(const uint4*)p; F8 r; r.v[0] = bflo(u.x); r.v[1] = bfhi(u.x); r.v[2] = bflo(u.y); r.v[3] = bfhi(u.y); r.v[4] = bflo(u.z); r.v[5] = bfhi(u.z); r.v[6] = bflo(u.w); r.v[7] = bfhi(u.w); return r; }
__device__ __forceinline__ F8 unpack8(const uint4 u) { F8 r; r.v[0] = bflo(u.x); r.v[1] = bfhi(u.x); r.v[2] = bflo(u.y); r.v[3] = bfhi(u.y); r.v[4] = bflo(u.z); r.v[5] = bfhi(u.z); r.v[6] = bflo(u.w); r.v[7] = bfhi(u.w); return r; }
__device__ __forceinline__ F8 ld_f8(const float* p) { const float4 a = *(const float4*)p, b = *(const float4*)(p + 4); F8 r; r.v[0] = a.x; r.v[1] = a.y; r.v[2] = a.z; r.v[3] = a.w; r.v[4] = b.x; r.v[5] = b.y; r.v[6] = b.z; r.v[7] = b.w; return r; }
__device__ __forceinline__ F8 zero8() { F8 r;
#pragma unroll
    for (int i = 0; i < 8; ++i) r.v[i] = 0.f; return r; }
__device__ __forceinline__ void st_bf8(bf16* p, const F8& r) { uint4 u; u.x = pk2(r.v[0], r.v[1]); u.y = pk2(r.v[2], r.v[3]); u.z = pk2(r.v[4], r.v[5]); u.w = pk2(r.v[6], r.v[7]); *(uint4*)p = u; }
__device__ __forceinline__ void st_f8(float* p, const F8& r) { *(float4*)p = make_float4(r.v[0], r.v[1], r.v[2], r.v[3]); *(float4*)(p + 4) = make_float4(r.v[4], r.v[5], r.v[6], r.v[7]); }
__device__ __forceinline__ float silu_f(float x) { return x * __builtin_amdgcn_rcpf(1.f + __expf(-x)); }
__device__ __forceinline__ float wave_sum(float v) {
#pragma unroll
    for (int o = 1; o < 64; o <<= 1) v += __shfl_xor(v, o);
    return v;
}

#define XB_TMO      128
#define XB_XCNT(j)  (256  + 64 * (j))
#define XB_XSUB(j)  (1280 + 64 * (j))
#define XB_XGEN(j)  (2304 + 64 * (j))
#define XB_TOP      3328
#define XB_TOPGEN   3392
#define XCD_BAR_WORDS 3456
#define XB_SPIN_CAP (1u << 18)
__device__ __forceinline__ unsigned xb_ld(unsigned* p)              { return __hip_atomic_load(p, __ATOMIC_RELAXED, __HIP_MEMORY_SCOPE_AGENT); }
__device__ __forceinline__ unsigned xb_add(unsigned* p, unsigned v) { return __hip_atomic_fetch_add(p, v, __ATOMIC_RELAXED, __HIP_MEMORY_SCOPE_AGENT); }
__device__ __forceinline__ unsigned xb_xcc_id() { return (unsigned)__builtin_amdgcn_s_getreg((3 << 11) | 20) & 0xFu; }
#define XB_SPIN(cond, bar) do { unsigned _sp = 0; while (cond) { __builtin_amdgcn_s_sleep(1); \
    if ((++_sp & 255u) == 0u) { if (xb_ld(&(bar)[XB_TMO])) break; if (_sp > XB_SPIN_CAP) { atomicAdd(&(bar)[XB_TMO], 1u); break; } } } } while (0)
struct XcdBarrier { unsigned* bar; unsigned x; volatile LAS unsigned* st; };
__device__ __forceinline__ XcdBarrier xcd_barrier_post(unsigned* bar, volatile LAS unsigned* st) {
    XcdBarrier b; b.bar = bar; b.x = xb_xcc_id(); b.st = st;
    if (threadIdx.x == 0) (void)xb_add(&bar[XB_XCNT(b.x)], 1u);
    return b;
}
__device__ __forceinline__ void xcd_barrier_complete(unsigned* bar, unsigned x, unsigned& nloc, unsigned& nx) {
    const unsigned G = gridDim.x * gridDim.y * gridDim.z;
    unsigned sum, cnt, mine, sp = 0u;
    for (;;) {
        sum = 0u; cnt = 0u; mine = 0u;
#pragma unroll
        for (unsigned j = 0; j < 16; ++j) { const unsigned c = xb_ld(&bar[XB_XCNT(j)]); sum += c; cnt += (c > 0u) ? 1u : 0u; mine = (j == x) ? c : mine; }
        if (sum == G) break;
        __builtin_amdgcn_s_sleep(1);
        if ((++sp & 255u) == 0u) { if (xb_ld(&bar[XB_TMO])) break; if (sp > XB_SPIN_CAP) { atomicAdd(&bar[XB_TMO], 1u); break; } }
    }
    nloc = mine > 0u ? mine : 1u; nx = cnt > 0u ? cnt : 1u;
}
__device__ __forceinline__ void xcd_barrier(const XcdBarrier& b) {
    asm volatile("s_waitcnt vmcnt(0)" ::: "memory");
    __syncthreads();
    if (threadIdx.x == 0) {
        unsigned* bar = b.bar;
        __builtin_amdgcn_s_waitcnt(0);
        unsigned nloc = b.st[0], nx = b.st[1];
        if (nloc == 0u) { xcd_barrier_complete(bar, b.x, nloc, nx); b.st[0] = nloc; b.st[1] = nx; }
        const unsigned old = xb_add(&bar[XB_XSUB(b.x)], 1u);
        const unsigned gen = old / nloc;
        if (old + 1u == (gen + 1u) * nloc) {
            __builtin_amdgcn_fence(__ATOMIC_RELEASE, "agent");
            asm volatile("s_waitcnt vmcnt(0)" ::: "memory");
            const unsigned og = xb_add(&bar[XB_TOP], 1u);
            const unsigned tg = og / nx;
            if (og + 1u == (tg + 1u) * nx) xb_add(&bar[XB_TOPGEN], 1u);
            else XB_SPIN(xb_ld(&bar[XB_TOPGEN]) == tg, bar);
            __builtin_amdgcn_fence(__ATOMIC_ACQUIRE, "agent");
            xb_add(&bar[XB_XGEN(b.x)], 1u);
            asm volatile("s_waitcnt vmcnt(0)" ::: "memory");
        } else {
            XB_SPIN(xb_ld(&bar[XB_XGEN(b.x)]) == gen, bar);
            __builtin_amdgcn_fence(__ATOMIC_ACQUIRE, "agent");
            asm volatile("s_waitcnt vmcnt(0)" ::: "memory");
        }
    }
    __syncthreads();
}

struct Args { const float* in[24]; float* out; unsigned char* ws; int ph_lo, ph_hi; };

struct Ctx {
    LAS unsigned char* lds; int tid, lane, wave, G, gw, NGW;
    const float* const* in; float* out; unsigned char* ws;
    __device__ __forceinline__ void refresh() {
        int t = threadIdx.x; asm volatile("" : "+v"(t)); tid = t; lane = t & 63; wave = __builtin_amdgcn_readfirstlane(t >> 6); gw = blockIdx.x * NWAVES + wave; NGW = G * NWAVES; }
};

__device__ __forceinline__ void conv_item(const float* W, int N, const float* gain, bf16* dst, int ldd, LAS float* scr, int kb, int nb, int lane) {
    const int k0 = 64 * kb, n0 = 32 * nb;
    float wv[32];
#pragma unroll
    for (int i = 0; i < 32; ++i) { const int kk = 2 * i + (lane >> 5); wv[i] = W[(size_t)(k0 + kk) * N + n0 + (lane & 31)]; }
#pragma unroll
    for (int i = 0; i < 32; ++i) { const int kk = 2 * i + (lane >> 5); const float gsc = gain ? gain[k0 + kk] : 1.f; scr[kk * 33 + (lane & 31)] = wv[i] * gsc; }
    asm volatile("s_waitcnt lgkmcnt(0)" ::: "memory");
    const int c = lane & 7;
#pragma unroll
    for (int j = 0; j < 4; ++j) { const int n = (lane >> 3) + 8 * j; const LAS float* s = scr + (8 * c) * 33 + n;
        uint4 o; o.x = pk2(s[0 * 33], s[1 * 33]); o.y = pk2(s[2 * 33], s[3 * 33]); o.z = pk2(s[4 * 33], s[5 * 33]); o.w = pk2(s[6 * 33], s[7 * 33]);
        *(uint4*)(dst + (size_t)(n0 + n) * ldd + k0 + 8 * c) = o; }
    asm volatile("s_waitcnt lgkmcnt(0)" ::: "memory");
}
__device__ __forceinline__ void phase_convert(Ctx C) {
    C.refresh();
    LAS float* scr = (LAS float*)(C.lds + C.wave * 16384);
    constexpr int I_IN = (DM / 64) * (D_IN / 32), I_OUT = (D_MIX / 64) * (DM / 32), I_UP = (DM / 64) * (D_UP / 32), I_DN = (D_FF / 64) * (DM / 32), I_L = I_IN + I_OUT + I_UP + I_DN;
    for (int it = C.gw; it < DEPTH * I_L; it += C.NGW) {
        const int l = it / I_L; int r = it % I_L;
        if (r < I_IN) { const int nbk = D_IN / 32; conv_item(C.in[7] + (size_t)l * DM * D_IN, D_IN, C.in[6] + l * DM, (bf16*)(C.ws + WS_BTIN) + (size_t)l * N_INP * DM, DM, scr, r / nbk, r % nbk, C.lane); continue; }
        r -= I_IN;
        if (r < I_OUT) { const int nbk = DM / 32, kb = r / nbk, nb = r % nbk; const float* W = C.in[16] + (size_t)l * D_MIX * DM;
            if (kb < 16) conv_item(W, DM, C.in[9] + l * D_POOL, (bf16*)(C.ws + WS_WOP) + (size_t)l * DM * D_POOL, D_POOL, scr, kb, nb, C.lane);
            else conv_item(W, DM, C.in[15] + l * D_SSD - D_POOL, (bf16*)(C.ws + WS_BTOUT) + (size_t)l * DM * D_MIX, D_MIX, scr, kb, nb, C.lane);
            continue; }
        r -= I_OUT;
        if (r < I_UP) { const int nbk = D_UP / 32; conv_item(C.in[19] + (size_t)l * DM * D_UP, D_UP, C.in[18] + l * DM, (bf16*)(C.ws + WS_BTUP) + (size_t)l * D_UP * DM, DM, scr, r / nbk, r % nbk, C.lane); continue; }
        r -= I_UP;
        { const int nbk = DM / 32; conv_item(C.in[22] + (size_t)l * D_FF * DM, DM, nullptr, (bf16*)(C.ws + WS_BTDN) + (size_t)l * DM * D_FF, D_FF, scr, r / nbk, r % nbk, C.lane); }
    }
    { const int gt = C.gw * 64 + C.lane, NGT = C.NGW * 64; constexpr int PER_L = (N_INP - D_IN) * DM / 8;
      for (int i = gt; i < DEPTH * PER_L; i += NGT) { const int l = i / PER_L, r = i % PER_L; *(uint4*)((bf16*)(C.ws + WS_BTIN) + ((size_t)l * N_INP + D_IN) * DM + (size_t)r * 8) = make_uint4(0u, 0u, 0u, 0u); }
      const float* wp = C.in[8]; bf16* wpb = (bf16*)(C.ws + WS_WPB);
      for (int i = gt; i < DEPTH * 4 * 256 * 256 / 8; i += NGT) { const F8 v = ld_f8(wp + (size_t)i * 8); st_bf8(wpb + (size_t)i * 8, v); } }
    for (int row = C.gw; row < M; row += C.NGW) {
        const float* src = row < MP ? C.in[0] + (size_t)row * DM : C.in[1] + (size_t)(row - MP) * DM;
        bf16* XB = (bf16*)(C.ws + WS_XB) + (size_t)row * DM; float q = 0.f;
#pragma unroll
        for (int j = 0; j < 8; ++j) { const int idx = (C.lane + 64 * j) * 4; const float4 v = *(const float4*)(src + idx); q += (v.x * v.x + v.y * v.y) + (v.z * v.z + v.w * v.w);
            *(uint2*)(XB + idx) = make_uint2(pk2(v.x, v.y), pk2(v.z, v.w)); }
        q = wave_sum(q);
        if (C.lane == 0) ((float*)(C.ws + WS_R))[row] = rsqrtf(q * (1.f / DM) + EPS);
    }
}

__device__ __forceinline__ void phase_resid(Ctx C, const float* gpost, bool final_out, int nslab) {
    C.refresh();
    const bf16* MIXB = (const bf16*)(C.ws + WS_MIX); const float* SSQ = (const float*)(C.ws + WS_SSQP); const float* SLAB = (const float*)(C.ws + WS_SLAB);
    for (int row = C.gw; row < M; row += C.NGW) {
        F8 mv[4]; float p; uint4 xq[4];
        bf16* XB = (bf16*)(C.ws + WS_XB) + (size_t)row * DM;
#pragma unroll
        for (int j = 0; j < 4; ++j) xq[j] = *(const uint4*)(XB + (C.lane + 64 * j) * 8);
        if (row < MP) {
            p = C.lane < 32 ? SSQ[(size_t)row * 32 + C.lane] : 0.f;
#pragma unroll
            for (int j = 0; j < 4; ++j) mv[j] = ld_bf8(MIXB + (size_t)row * DM + (C.lane + 64 * j) * 8);
        } else {
            p = 0.f;
#pragma unroll
            for (int j = 0; j < 4; ++j) { F8 a = zero8();
                for (int s = 0; s < nslab; ++s) { const F8 t = ld_f8(SLAB + ((size_t)s * MS + (row - MP)) * DM + (C.lane + 64 * j) * 8);
#pragma unroll
                    for (int k = 0; k < 8; ++k) a.v[k] += t.v[k]; }
                mv[j] = a;
#pragma unroll
                for (int k = 0; k < 8; ++k) p += a.v[k] * a.v[k]; }
        }
        p = wave_sum(p);
        const float rs = rsqrtf(p * (1.f / DM) + EPS);
        float* Y = C.out + O_YP + (size_t)row * DM; float q = 0.f;
#pragma unroll
        for (int j = 0; j < 4; ++j) { const int idx = (C.lane + 64 * j) * 8; const F8 g8 = ld_f8(gpost + idx); F8 v = unpack8(xq[j]);
#pragma unroll
            for (int k = 0; k < 8; ++k) { v.v[k] += mv[j].v[k] * rs * g8.v[k]; q += v.v[k] * v.v[k]; }
            if (final_out) st_f8(Y + idx, v);
            st_bf8(XB + idx, v); }
        q = wave_sum(q);
        if (C.lane == 0) ((float*)(C.ws + WS_R))[row] = rsqrtf(q * (1.f / DM) + EPS);
    }
}

__device__ __forceinline__ void phase_gnorm(Ctx C) {
    C.refresh();
    const float* SSQH = (const float*)(C.ws + WS_SSQH); bf16* MIXA = (bf16*)(C.ws + WS_MIXA);
    for (int rowb = C.gw * 4; rowb < M; rowb += C.NGW * 4) {
        uint4 qv[4][4]; float pr[4];
#pragma unroll
        for (int rr = 0; rr < 4; ++rr) { const int row = rowb + rr; pr[rr] = C.lane < 32 ? SSQH[(size_t)row * 32 + C.lane] : 0.f;
#pragma unroll
            for (int j = 0; j < 4; ++j) qv[rr][j] = *(const uint4*)(MIXA + (size_t)row * D_MIX + D_POOL + (C.lane + 64 * j) * 8); }
#pragma unroll
        for (int rr = 0; rr < 4; ++rr) { const int row = rowb + rr; float p = pr[rr];
#pragma unroll
            for (int o = 1; o < 16; o <<= 1) p += __shfl_xor(p, o);
            const float s0 = __shfl(p, 0), s1 = __shfl(p, 16);
            const float r0 = rsqrtf(s0 * (1.f / 1024.f) + EPS), r1 = rsqrtf(s1 * (1.f / 1024.f) + EPS);
            bf16* y = MIXA + (size_t)row * D_MIX + D_POOL;
#pragma unroll
            for (int j = 0; j < 4; ++j) { const int c = (C.lane + 64 * j) * 8; const float r = c < 1024 ? r0 : r1; F8 v = unpack8(qv[rr][j]);
#pragma unroll
                for (int i = 0; i < 8; ++i) v.v[i] *= r;
                st_bf8(y + c, v); } }
    }
}

__device__ __forceinline__ void phase_act(Ctx C, int l) {
    C.refresh();
    const bf16* UP = (const bf16*)(C.ws + WS_UP); bf16* ACT = (bf16*)(C.ws + WS_ACT);
    const float* cw = C.in[20] + (size_t)l * 3 * D_UP; const float* cb = C.in[21] + (size_t)l * D_UP; const float* hist = C.in[5] + (size_t)l * NB_S * 2 * D_UP;
    constexpr int NCG = D_FF / 8, NSTRIP = M / 32;
    const int gt = C.gw * 64 + C.lane, NGT = C.NGW * 64;
    for (int it = gt; it < NSTRIP * NCG; it += NGT) {
        const int strip = it / NCG, c = (it % NCG) * 8, row0 = strip * 32; const bool prm = row0 < MP;
        const int b = prm ? row0 / SEQ : (row0 - MP) / SEQ_S, t0 = prm ? row0 % SEQ : 0;
        F8 p2g, p1g, p2v, p1v;
        if (t0 == 0) { if (prm) { p2g = zero8(); p1g = zero8(); p2v = zero8(); p1v = zero8(); }
            else { const float* h = hist + (size_t)b * 2 * D_UP; p2g = ld_f8(h + c); p2v = ld_f8(h + D_FF + c); p1g = ld_f8(h + D_UP + c); p1v = ld_f8(h + D_UP + D_FF + c); } }
        else { p2g = ld_bf8(UP + (size_t)(row0 - 2) * D_UP + c); p2v = ld_bf8(UP + (size_t)(row0 - 2) * D_UP + D_FF + c); p1g = ld_bf8(UP + (size_t)(row0 - 1) * D_UP + c); p1v = ld_bf8(UP + (size_t)(row0 - 1) * D_UP + D_FF + c); }
        const F8 w0g = ld_f8(cw + c), w1g = ld_f8(cw + D_UP + c), w2g = ld_f8(cw + 2 * D_UP + c), bg = ld_f8(cb + c);
        const F8 w0v = ld_f8(cw + D_FF + c), w1v = ld_f8(cw + D_UP + D_FF + c), w2v = ld_f8(cw + 2 * D_UP + D_FF + c), bv = ld_f8(cb + D_FF + c);
        for (int r0 = 0; r0 < 32; r0 += 8) {
            uint4 qg[8], qv[8];
#pragma unroll
            for (int r = 0; r < 8; ++r) { qg[r] = *(const uint4*)(UP + (size_t)(row0 + r0 + r) * D_UP + c); qv[r] = *(const uint4*)(UP + (size_t)(row0 + r0 + r) * D_UP + D_FF + c); }
#pragma unroll
            for (int r = 0; r < 8; ++r) { const F8 cg = unpack8(qg[r]), cv = unpack8(qv[r]); F8 o;
#pragma unroll
                for (int i = 0; i < 8; ++i) { const float g = bg.v[i] + w0g.v[i] * p2g.v[i] + w1g.v[i] * p1g.v[i] + w2g.v[i] * cg.v[i]; const float v = bv.v[i] + w0v.v[i] * p2v.v[i] + w1v.v[i] * p1v.v[i] + w2v.v[i] * cv.v[i]; o.v[i] = silu_f(g) * v; }
                st_bf8(ACT + (size_t)(row0 + r0 + r) * D_FF + c, o);
                p2g = p1g; p1g = cg; p2v = p1v; p1v = cv; }
        }
        if (!prm || t0 + 32 == SEQ) {
            float* o = C.out + (prm ? O_FCP + ((size_t)(l * NB_P + b) * 2) * D_UP : O_FCS + ((size_t)(l * NB_S + b) * 2) * D_UP);
            st_f8(o + c, p2g); st_f8(o + D_FF + c, p2v); st_f8(o + D_UP + c, p1g); st_f8(o + D_UP + D_FF + c, p1v);
        }
    }
}

__device__ __forceinline__ void phase_pool(Ctx C, int l) {
    C.refresh();
    const bf16* PROJ = (const bf16*)(C.ws + WS_PROJ); bf16* MIXA = (bf16*)(C.ws + WS_MIXA);
    const float* hist = C.in[2] + (size_t)l * NB_S * POOL_HIST * D_POOL;
    constexpr int NCG = D_POOL / 8, NSTRIP = M / 32;
    const int gt = C.gw * 64 + C.lane, NGT = C.NGW * 64;
    for (int it = gt; it < NSTRIP * NCG; it += NGT) {
        const int strip = it / NCG, cgi = it % NCG, c = cgi * 8, row0 = strip * 32; const bool prm = row0 < MP;
        const int b = prm ? row0 / SEQ : (row0 - MP) / SEQ_S, t0 = prm ? row0 % SEQ : 0, w = 2 << (cgi >> 5);
        const int rb = row0 - t0;
        const float* hb = hist + (size_t)b * POOL_HIST * D_POOL;
        F8 s = zero8();
        for (int i = 1; i < w; ++i) { const int t = t0 - i; F8 v;
            if (t >= 0) v = ld_bf8(PROJ + (size_t)(rb + t) * N_PROJ + c); else if (!prm) v = ld_f8(hb + (size_t)(POOL_HIST + t) * D_POOL + c); else v = zero8();
#pragma unroll
            for (int k = 0; k < 8; ++k) s.v[k] += v.v[k]; }
        for (int r0 = 0; r0 < 32; r0 += 8) {
            uint4 qc[8], ql[8];
#pragma unroll
            for (int r = 0; r < 8; ++r) { const int t = t0 + r0 + r, tl = t - w + 1; qc[r] = *(const uint4*)(PROJ + (size_t)(rb + t) * N_PROJ + c); ql[r] = *(const uint4*)(PROJ + (size_t)(rb + (tl > 0 ? tl : 0)) * N_PROJ + c); }
#pragma unroll
            for (int r = 0; r < 8; ++r) { const int t = t0 + r0 + r, tl = t - w + 1; const F8 cur = unpack8(qc[r]);
                const float inv = 1.f / (float)(prm ? (t + 1 < w ? t + 1 : w) : w); F8 o;
#pragma unroll
                for (int k = 0; k < 8; ++k) { s.v[k] += cur.v[k]; o.v[k] = s.v[k] * inv - cur.v[k]; }
                st_bf8(MIXA + (size_t)(rb + t) * D_MIX + c, o);
                F8 v = unpack8(ql[r]);
                if (tl < 0) { if (!prm) v = ld_f8(hb + (size_t)(POOL_HIST + tl) * D_POOL + c); else v = zero8(); }
#pragma unroll
                for (int k = 0; k < 8; ++k) s.v[k] -= v.v[k]; }
        }
    }
    for (int it = gt; it < (NB_P + NB_S) * 15 * NCG; it += NGT) {
        const int cg = it % NCG, i = (it / NCG) % 15, sb = it / (NCG * 15); const bool prm = sb < NB_P; const int b = prm ? sb : sb - NB_P;
        const int row = prm ? b * SEQ + (SEQ - 15 + i) : MP + b * SEQ_S + (SEQ_S - 15 + i);
        float* o = C.out + (prm ? O_POOLP + ((size_t)(l * NB_P + b) * 15 + i) * D_POOL : O_POOLS + ((size_t)(l * NB_S + b) * 15 + i) * D_POOL);
        st_f8(o + cg * 8, ld_bf8(PROJ + (size_t)row * N_PROJ + cg * 8));
    }
    constexpr int NCG2 = CONV_DIM / 8;
    for (int it = gt; it < (NB_P + NB_S) * 3 * NCG2; it += NGT) {
        const int cg = it % NCG2, i = (it / NCG2) % 3, sb = it / (NCG2 * 3); const bool prm = sb < NB_P; const int b = prm ? sb : sb - NB_P;
        const int row = prm ? b * SEQ + (SEQ - 3 + i) : MP + b * SEQ_S + (SEQ_S - 3 + i);
        float* o = C.out + (prm ? O_SCP + ((size_t)(l * NB_P + b) * 3 + i) * CONV_DIM : O_SCS + ((size_t)(l * NB_S + b) * 3 + i) * CONV_DIM);
        st_f8(o + cg * 8, ld_bf8(PROJ + (size_t)row * N_PROJ + XBC0 + cg * 8));
    }
}

__device__ __forceinline__ void phase_ssd(Ctx C, int l) {
    C.refresh();
    LAS float* xs = (LAS float*)(C.lds); LAS float* Bs = (LAS float*)(C.lds + 16384); LAS float* Cs = (LAS float*)(C.lds + 49152); LAS float* ys = (LAS float*)(C.lds + 81920);
    LAS float* dts = (LAS float*)(C.lds + 98304); LAS float* dAs = dts + 64;
    const bf16* PROJ = (const bf16*)(C.ws + WS_PROJ); const float* DT = (const float*)(C.ws + WS_DT); bf16* MIXA = (bf16*)(C.ws + WS_MIXA); float* SSQH = (float*)(C.ws + WS_SSQH);
    const float* cw = C.in[10] + (size_t)l * 4 * CONV_DIM; const float* cb = C.in[11] + (size_t)l * CONV_DIM;
    const int tid = C.tid, p = tid >> 3, n0 = (tid & 7) * 16;
    for (int u = blockIdx.x; u < NB_P * NH + NB_S * NH; u += C.G) {
        const bool prm = u < NB_P * NH; const int su = prm ? u : u - NB_P * NH, b = su / NH, hh = su % NH, g = hh / HPG;
        const int rb = prm ? b * SEQ : MP + b * SEQ_S, rows = prm ? 64 : 32, nchunk = prm ? SEQ / 64 : 1;
        const float Aneg = -__expf(C.in[13][l * NH + hh]), Dsk = C.in[14][l * NH + hh], dtb = C.in[12][l * NH + hh];
        const float* chist = C.in[3] + ((size_t)(l * NB_S + b) * 3) * CONV_DIM;
        float h[16];
        if (prm) {
#pragma unroll
            for (int i = 0; i < 16; ++i) h[i] = 0.f;
        } else { const float* h0 = C.in[4] + ((((size_t)l * NB_S + b) * NH + hh) * HD + p) * DS + n0;
#pragma unroll
            for (int i = 0; i < 4; ++i) { const float4 v = *(const float4*)(h0 + 4 * i); h[4 * i] = v.x; h[4 * i + 1] = v.y; h[4 * i + 2] = v.z; h[4 * i + 3] = v.w; } }
        for (int ch = 0; ch < nchunk; ++ch) {
            const int tb = ch * 64;
            for (int e = tid; e < rows * 40; e += NTHR) {
                const int cg = e % 40, tt = e / 40, t = tb + tt;
                int cc; LAS float* dstp;
                if (cg < 8) { cc = hh * HD + cg * 8; dstp = xs + tt * 64 + cg * 8; }
                else if (cg < 24) { cc = D_SSD + g * DS + (cg - 8) * 8; dstp = Bs + tt * 128 + (cg - 8) * 8; }
                else { cc = D_SSD + 2 * DS + g * DS + (cg - 24) * 8; dstp = Cs + tt * 128 + (cg - 24) * 8; }
                F8 a = ld_f8(cb + cc);
#pragma unroll
                for (int i = 0; i < 4; ++i) { const int ti = t - 3 + i; F8 v;
                    if (ti >= 0) v = ld_bf8(PROJ + (size_t)(rb + ti) * N_PROJ + XBC0 + cc); else if (!prm) v = ld_f8(chist + (size_t)(3 + ti) * CONV_DIM + cc); else v = zero8();
                    const F8 wv = ld_f8(cw + (size_t)i * CONV_DIM + cc);
#pragma unroll
                    for (int k = 0; k < 8; ++k) a.v[k] += wv.v[k] * v.v[k]; }
#pragma unroll
                for (int k = 0; k < 8; ++k) dstp[k] = silu_f(a.v[k]);
            }
            if (tid < rows) { const float xr = DT[(size_t)(rb + tb + tid) * 32 + hh] + dtb; const float dtv = xr > 20.f ? xr : log1pf(__expf(xr)); dts[tid] = dtv; dAs[tid] = __expf(dtv * Aneg); }
            __syncthreads();
            for (int tt = 0; tt < rows; ++tt) {
                const float xv = xs[tt * 64 + p], xdt = xv * dts[tt], dA = dAs[tt]; float acc = 0.f;
#pragma unroll
                for (int i = 0; i < 4; ++i) { const f32x4 bv = *(const LAS f32x4*)(Bs + tt * 128 + n0 + 4 * i), cv = *(const LAS f32x4*)(Cs + tt * 128 + n0 + 4 * i);
                    h[4 * i] = dA * h[4 * i] + xdt * bv[0]; acc += cv[0] * h[4 * i];
                    h[4 * i + 1] = dA * h[4 * i + 1] + xdt * bv[1]; acc += cv[1] * h[4 * i + 1];
                    h[4 * i + 2] = dA * h[4 * i + 2] + xdt * bv[2]; acc += cv[2] * h[4 * i + 2];
                    h[4 * i + 3] = dA * h[4 * i + 3] + xdt * bv[3]; acc += cv[3] * h[4 * i + 3]; }
                acc += __shfl_xor(acc, 1); acc += __shfl_xor(acc, 2); acc += __shfl_xor(acc, 4);
                if ((tid & 7) == 0) ys[tt * 64 + p] = acc + Dsk * xv;
            }
            __syncthreads();
            for (int e = tid; e < rows * 64; e += NTHR) {
                const int tt = e >> 6, pp = e & 63; const size_t row = (size_t)(rb + tb + tt);
                const float zv = bf2f(PROJ[row * N_PROJ + D_POOL + hh * HD + pp]); const float yz = ys[tt * 64 + pp] * silu_f(zv);
                MIXA[row * D_MIX + D_POOL + hh * HD + pp] = (bf16)f2bf(yz);
                const float q = wave_sum(yz * yz);
                if (pp == 0) SSQH[row * 32 + hh] = q;
            }
            __syncthreads();
        }
        float* ho = C.out + (prm ? O_SSDP + ((((size_t)l * NB_P + b) * NH + hh) * HD + p) * DS + n0 : O_SSDS + ((((size_t)l * NB_S + b) * NH + hh) * HD + p) * DS + n0);
#pragma unroll
        for (int i = 0; i < 4; ++i) *(float4*)(ho + 4 * i) = make_float4(h[4 * i], h[4 * i + 1], h[4 * i + 2], h[4 * i + 3]);
    }
}

constexpr int SL_C = 0, SL_B = 17408, SL_BWT = 34816, SL_XT = 53248, SL_H = 62464, SL_M = 79872, SL_DT = 89088, SL_AC = SL_DT + 512, SL_W = SL_AC + 512, SL_DEC = SL_W + 512, SL_SSQ = SL_DEC + 16, SL_CW = SL_SSQ + 1024;
constexpr int PC = 272, PT = 144;
typedef short bf16x8_t __attribute__((ext_vector_type(8)));
__device__ __forceinline__ bf16x8_t ld_op(const LAS unsigned char* base, int row, int pitch, int kelem) { return *(const LAS bf16x8_t*)(base + row * pitch + kelem * 2); }
__device__ __forceinline__ int swz(int row, int byte) { return byte ^ (((row >> 3) & 7) << 4); }
__device__ __forceinline__ bf16x8_t ld_op_sw(const LAS unsigned char* base, int row, int pitch, int kelem) { return *(const LAS bf16x8_t*)(base + row * pitch + swz(row, kelem * 2)); }

typedef unsigned u32x4_t __attribute__((ext_vector_type(4)));
typedef unsigned u32x2_t __attribute__((ext_vector_type(2)));
__device__ __forceinline__ F8 lds_f8(const LAS float* p) { const f32x4 a = *(const LAS f32x4*)p, b = *(const LAS f32x4*)(p + 4); F8 r; r.v[0] = a[0]; r.v[1] = a[1]; r.v[2] = a[2]; r.v[3] = a[3]; r.v[4] = b[0]; r.v[5] = b[1]; r.v[6] = b[2]; r.v[7] = b[3]; return r; }
__device__ __forceinline__ void ssd_stage(LAS unsigned char* L, int cg, int l0, int rows_valid, const LAS float* cwl, const LAS float* w_s, const uint4 (&rawq)[11]) {
    F8 cwv[4];
#pragma unroll
    for (int i = 0; i < 4; ++i) cwv[i] = lds_f8(cwl + 8 * i);
    const F8 cbv = lds_f8(cwl + 32);
#pragma unroll
    for (int h = 0; h < 2; ++h) {
        float o[4][8];
#pragma unroll
        for (int i = 0; i < 4; ++i)
#pragma unroll
            for (int k = 0; k < 8; ++k) o[i][k] = cbv.v[k];
#pragma unroll
        for (int jj = 0; jj < 7; ++jj) { const F8 rj = unpack8(rawq[4 * h + jj]);
#pragma unroll
            for (int i = 0; i < 4; ++i) { const int tap = jj - i;
                if (tap >= 0 && tap < 4) {
#pragma unroll
                    for (int k = 0; k < 8; ++k) o[i][k] += cwv[tap].v[k] * rj.v[k]; } } }
        const int lb = l0 + 4 * h;
#pragma unroll
        for (int i = 0; i < 4; ++i) { const float okf = lb + i < rows_valid ? 1.f : 0.f;
#pragma unroll
            for (int k = 0; k < 8; ++k) o[i][k] = silu_f(o[i][k]) * okf; }
        if (cg < 8) {
#pragma unroll
            for (int k = 0; k < 8; ++k) *(LAS u32x2_t*)(L + SL_XT + (8 * cg + k) * PT + swz(8 * cg + k, lb * 2)) = (u32x2_t){pk2(o[0][k], o[1][k]), pk2(o[2][k], o[3][k])};
        } else if (cg < 24) { const int n0 = 8 * (cg - 8);
#pragma unroll
            for (int i = 0; i < 4; ++i) *(LAS u32x4_t*)(L + SL_B + (lb + i) * PC + n0 * 2) = (u32x4_t){pk2(o[i][0], o[i][1]), pk2(o[i][2], o[i][3]), pk2(o[i][4], o[i][5]), pk2(o[i][6], o[i][7])};
            const f32x4 wl = *(const LAS f32x4*)(w_s + lb);
#pragma unroll
            for (int k = 0; k < 8; ++k) *(LAS u32x2_t*)(L + SL_BWT + (n0 + k) * PT + swz(n0 + k, lb * 2)) = (u32x2_t){pk2(o[0][k] * wl[0], o[1][k] * wl[1]), pk2(o[2][k] * wl[2], o[3][k] * wl[3])};
        } else { const int n0 = 8 * (cg - 24);
#pragma unroll
            for (int i = 0; i < 4; ++i) *(LAS u32x4_t*)(L + SL_C + (lb + i) * PC + n0 * 2) = (u32x4_t){pk2(o[i][0], o[i][1]), pk2(o[i][2], o[i][3]), pk2(o[i][4], o[i][5]), pk2(o[i][6], o[i][7])};
        }
        __builtin_amdgcn_sched_barrier(0);
    }
}
__device__ __forceinline__ void ssd_dt(LAS unsigned char* L, int par, float xr, bool valid, float Aneg, int lane) {
    const float dtv = valid ? (xr > 20.f ? xr : log1pf(__expf(xr))) : 0.f;
    float a = dtv * Aneg;
#pragma unroll
    for (int o = 1; o < 64; o <<= 1) { const float v = __shfl_up(a, o); if (lane >= o) a += v; }
    const float last = __shfl(a, 63);
    ((LAS float*)(L + SL_DT))[par * 64 + lane] = dtv; ((LAS float*)(L + SL_AC))[par * 64 + lane] = a; ((LAS float*)(L + SL_W))[par * 64 + lane] = dtv * __expf(last - a);
    if (lane == 0) ((LAS float*)(L + SL_DEC))[par] = __expf(last);
}
#define WG_BAR() do { asm volatile("s_waitcnt lgkmcnt(0)" ::: "memory"); __builtin_amdgcn_s_barrier(); asm volatile("" ::: "memory"); } while (0)
__device__ __forceinline__ void stage_role(int tq, int& cg, int& l0) {
    const int ws = tq >> 6, lane = tq & 63;
    if (ws == 0) { cg = lane & 7; l0 = (lane >> 3) * 8; }
    else { const int idx = ((ws - 1) & 1) * 64 + lane; cg = (ws <= 2 ? 8 : 24) + (idx & 15); l0 = (idx >> 4) * 8; }
}
#define OPQ_V(x) asm volatile("" : "+v"(x))
#define OPQ_S(x) asm volatile("" : "+s"(x))
__device__ __forceinline__ void phase_ssd2(Ctx C, int l) {
    C.refresh();
    LAS unsigned char* L = C.lds;
    const bf16* PROJ = (const bf16*)(C.ws + WS_PROJ); const float* DT = (const float*)(C.ws + WS_DT); bf16* MIXA = (bf16*)(C.ws + WS_MIXA); float* SSQH = (float*)(C.ws + WS_SSQH);
    const int tid0 = C.tid, w0 = C.wave;
    typedef float f4 __attribute__((ext_vector_type(4)));
#if PROBE_SEL > 0
    unsigned long long tprev2 = __builtin_amdgcn_s_memrealtime(); volatile LAS unsigned* MISC2 = (volatile LAS unsigned*)(C.lds + LDSCTL_OFF);
#define STAMP2(ty) do { if (blockIdx.x == 0 && threadIdx.x == 0) { const unsigned long long tn = __builtin_amdgcn_s_memrealtime(); MISC2[16 + (ty)] += (unsigned)(tn - tprev2); tprev2 = tn; } } while (0)
#else
#define STAMP2(ty) do { } while (0)
#endif
    for (int u = blockIdx.x; u < NB_P * NH + NB_S * NH; u += C.G) {
        STAMP2(19);
        const bool prm = u < NB_P * NH; const int su = prm ? u : u - NB_P * NH, b = su / NH, hh = su % NH, g = hh / HPG;
        const int rb = prm ? b * SEQ : MP + b * SEQ_S, rows = prm ? 64 : 32, nchunk = prm ? SEQ / 64 : 1;
        const float Aneg = -__expf(C.in[13][l * NH + hh]), Dsk = C.in[14][l * NH + hh], dtb = C.in[12][l * NH + hh];
        f4 hacc[4]; float xrn;
        {
            uint4 rawq[11];
            int tq = tid0, w = w0; OPQ_V(tq); OPQ_S(w);
            const int lane = tq & 63, r16 = lane & 15, q = lane >> 4; const bool stg = tq < 320; int cg, l0; stage_role(tq, cg, l0); if (!stg) { cg = 0; l0 = 0; }
            const float* chist = C.in[3] + ((size_t)(l * NB_S + b) * 3) * CONV_DIM;
            const int cc = cg < 8 ? hh * HD + cg * 8 : (cg < 24 ? D_SSD + g * DS + (cg - 8) * 8 : D_SSD + 2 * DS + g * DS + (cg - 24) * 8);
            LAS float* cwl = (LAS float*)(L + SL_CW) + cg * 40;
            if (stg && l0 == 0) { const float* cw = C.in[10] + (size_t)l * 4 * CONV_DIM + cc;
#pragma unroll
                for (int i = 0; i < 4; ++i) { const F8 v = ld_f8(cw + (size_t)i * CONV_DIM); *(LAS f32x4*)(cwl + 8 * i) = (f32x4){v.v[0], v.v[1], v.v[2], v.v[3]}; *(LAS f32x4*)(cwl + 8 * i + 4) = (f32x4){v.v[4], v.v[5], v.v[6], v.v[7]}; }
                const F8 v = ld_f8(C.in[11] + (size_t)l * CONV_DIM + cc); *(LAS f32x4*)(cwl + 32) = (f32x4){v.v[0], v.v[1], v.v[2], v.v[3]}; *(LAS f32x4*)(cwl + 36) = (f32x4){v.v[4], v.v[5], v.v[6], v.v[7]}; }
#pragma unroll
            for (int pj = 0; pj < 4; ++pj) {
                if (prm) hacc[pj] = (f4){0.f, 0.f, 0.f, 0.f};
                else { const float4 v = *(const float4*)(C.in[4] + ((((size_t)l * NB_S + b) * NH + hh) * HD + 16 * pj + r16) * DS + 16 * w + 4 * q); hacc[pj] = (f4){v.x, v.y, v.z, v.w}; }
                *(LAS u32x2_t*)(L + SL_H + (16 * pj + r16) * PC + (16 * w + 4 * q) * 2) = (u32x2_t){pk2(hacc[pj][0], hacc[pj][1]), pk2(hacc[pj][2], hacc[pj][3])};
            }
            const float xr0 = DT[((size_t)rb + (lane < rows ? lane : 0)) * 32 + hh] + dtb;
            {
                const int l0c = l0; const unsigned lo = stg ? (unsigned)(l0c * N_PROJ + cc) * 2u : 0u;
                uint4 pv[11]; F8 hv[3];
#pragma unroll
                for (int j = 0; j < 11; ++j) { const int jr = (j < 3 && l0c == 0) ? 3 : j;
                    const char* ub = (const char*)PROJ + (((size_t)rb) * N_PROJ + XBC0) * 2; pv[j] = *(const uint4*)(ub + ((long)lo + (long)(jr - 3) * (N_PROJ * 2))); }
#pragma unroll
                for (int j = 0; j < 3; ++j) hv[j] = ld_f8((const float*)((const char*)(chist + (size_t)j * CONV_DIM) + (unsigned)cc * 4u));
#pragma unroll
                for (int j = 0; j < 11; ++j) { const int t = l0c - 3 + j; uint4 v = pv[j];
                    if (j < 3) { const uint4 hq = make_uint4(pk2(hv[j].v[0], hv[j].v[1]), pk2(hv[j].v[2], hv[j].v[3]), pk2(hv[j].v[4], hv[j].v[5]), pk2(hv[j].v[6], hv[j].v[7]));
                        const bool useh = t < 0 && !prm, zero = t < 0 && prm;
                        v.x = useh ? hq.x : (zero ? 0u : v.x); v.y = useh ? hq.y : (zero ? 0u : v.y); v.z = useh ? hq.z : (zero ? 0u : v.z); v.w = useh ? hq.w : (zero ? 0u : v.w); }
                    const bool beyond = t >= rows;
                    v.x = beyond ? 0u : v.x; v.y = beyond ? 0u : v.y; v.z = beyond ? 0u : v.z; v.w = beyond ? 0u : v.w;
                    rawq[j] = v; }
            }
            if (w == 0) ssd_dt(L, 0, xr0, lane < rows, Aneg, lane);
            xrn = DT[((size_t)(rb + 64) + lane) * 32 + hh] + dtb;
            WG_BAR();
            if (stg) ssd_stage(L, cg, l0, rows, cwl, (const LAS float*)(L + SL_W), rawq);
            WG_BAR();
        }
        STAMP2(13);
        for (int c = 0; c < nchunk; ++c) {
            const int par = c & 1, tb = c * 64; const bool more = c + 1 < nchunk;
            uint2 zq[2]; uint4 rawq[11];
            {
                int tq = tid0, w = w0; OPQ_V(tq); OPQ_S(w);
                const int lane = tq & 63, r16 = lane & 15, q = lane >> 4;
                const float xrc = xrn;
                xrn = DT[((size_t)(rb + tb + 128) + lane) * 32 + hh] + dtb;
                {
                    int cg, l0c; stage_role(tq, cg, l0c);
                    const int cc = cg < 8 ? hh * HD + cg * 8 : (cg < 24 ? D_SSD + g * DS + (cg - 8) * 8 : D_SSD + 2 * DS + g * DS + (cg - 24) * 8);
                    const unsigned lo = tq < 320 ? (unsigned)(l0c * N_PROJ + cc) * 2u : 0u;
#pragma unroll
                    for (int j = 0; j < 11; ++j) { const char* ub = (const char*)PROJ + ((size_t)(rb + tb + 61 + j) * N_PROJ + XBC0) * 2; rawq[j] = *(const uint4*)(ub + lo); }
                }
                { const int pi = w >> 1, li0 = 2 * (w & 1);
#pragma unroll
                  for (int t = 0; t < 2; ++t) { const int lrow = 16 * (li0 + t) + r16; const char* ub = (const char*)PROJ + ((size_t)(rb + tb + 16 * (li0 + t)) * N_PROJ + D_POOL + hh * HD + 16 * pi) * 2;
                    zq[t] = lrow < rows ? *(const uint2*)(ub + (unsigned)(r16 * N_PROJ + 4 * q) * 2u) : make_uint2(0u, 0u); } }
                if (more && w == 0) ssd_dt(L, par ^ 1, xrc, true, Aneg, lane);
                const LAS float* ac = (const LAS float*)(L + SL_AC) + par * 64; const LAS float* dts = (const LAS float*)(L + SL_DT) + par * 64;
#pragma unroll
                for (int t = 0; t < 2; ++t) { const int T = 2 * w + t, si = T >> 2, li = T & 3; f4 acc = (f4){0.f, 0.f, 0.f, 0.f};
#pragma unroll
                    for (int ks = 0; ks < 4; ++ks) acc = __builtin_amdgcn_mfma_f32_16x16x32_bf16(ld_op(L + SL_B, 16 * si + r16, PC, 32 * ks + 8 * q), ld_op(L + SL_C, 16 * li + r16, PC, 32 * ks + 8 * q), acc, 0, 0, 0);
                    const int lr = 16 * li + r16, s0 = 16 * si + 4 * q; const float al = ac[lr]; const f4 as = *(const LAS f4*)(ac + s0), ds = *(const LAS f4*)(dts + s0); float m[4];
#pragma unroll
                    for (int r = 0; r < 4; ++r) m[r] = (s0 + r <= lr) ? acc[r] * __expf(al - as[r]) * ds[r] : 0.f;
                    *(LAS u32x2_t*)(L + SL_M + lr * PT + s0 * 2) = (u32x2_t){pk2(m[0], m[1]), pk2(m[2], m[3])}; }
            }
            WG_BAR(); STAMP2(14);
            {
                int tq = tid0, w = w0; OPQ_V(tq); OPQ_S(w);
                const int lane = tq & 63, r16 = lane & 15, q = lane >> 4, pi = w >> 1, li0 = 2 * (w & 1);
                const LAS float* ac = (const LAS float*)(L + SL_AC) + par * 64;
#pragma unroll
                for (int t = 0; t < 2; ++t) { const int li = li0 + t; f4 yd = (f4){0.f, 0.f, 0.f, 0.f}, yo = (f4){0.f, 0.f, 0.f, 0.f};
#pragma unroll
                    for (int ks = 0; ks < 2; ++ks) yd = __builtin_amdgcn_mfma_f32_16x16x32_bf16(ld_op_sw(L + SL_XT, 16 * pi + r16, PT, 32 * ks + 8 * q), ld_op(L + SL_M, 16 * li + r16, PT, 32 * ks + 8 * q), yd, 0, 0, 0);
#pragma unroll
                    for (int ks = 0; ks < 4; ++ks) yo = __builtin_amdgcn_mfma_f32_16x16x32_bf16(ld_op(L + SL_H, 16 * pi + r16, PC, 32 * ks + 8 * q), ld_op(L + SL_C, 16 * li + r16, PC, 32 * ks + 8 * q), yo, 0, 0, 0);
                    const int lr = 16 * li + r16, p0 = 16 * pi + 4 * q; const float e = __expf(ac[lr]);
                    const float zf[4] = {bflo(zq[t].x), bfhi(zq[t].x), bflo(zq[t].y), bfhi(zq[t].y)}; float yz[4], ss = 0.f;
#pragma unroll
                    for (int r = 0; r < 4; ++r) { const float xv = bf2f(*(const LAS bf16*)(L + SL_XT + (p0 + r) * PT + swz(p0 + r, lr * 2))); const float y = yd[r] + e * yo[r] + Dsk * xv; yz[r] = y * silu_f(zf[r]); ss += yz[r] * yz[r]; }
                    if (lr < rows) { char* ub = (char*)MIXA + ((size_t)(rb + tb + 16 * li) * D_MIX + D_POOL + hh * HD + 16 * pi) * 2; *(uint2*)(ub + (unsigned)(r16 * D_MIX + 4 * q) * 2u) = make_uint2(pk2(yz[0], yz[1]), pk2(yz[2], yz[3])); }
                    ss += __shfl_xor(ss, 16); ss += __shfl_xor(ss, 32);
                    if (q == 0) ((LAS float*)(L + SL_SSQ))[lr * 4 + pi] = ss; }
            }
            {
                int tq = tid0, w = w0; OPQ_V(tq); OPQ_S(w);
                const int lane = tq & 63, r16 = lane & 15, q = lane >> 4;
                const float dec = ((const LAS float*)(L + SL_DEC))[par];
#pragma unroll
                for (int pj = 0; pj < 4; ++pj) { hacc[pj] = hacc[pj] * dec;
#pragma unroll
                    for (int ks = 0; ks < 2; ++ks) hacc[pj] = __builtin_amdgcn_mfma_f32_16x16x32_bf16(ld_op_sw(L + SL_BWT, 16 * w + r16, PT, 32 * ks + 8 * q), ld_op_sw(L + SL_XT, 16 * pj + r16, PT, 32 * ks + 8 * q), hacc[pj], 0, 0, 0); }
            }
            WG_BAR(); STAMP2(15);
            {
                int tq = tid0, w = w0; OPQ_V(tq); OPQ_S(w);
                const int lane = tq & 63, r16 = lane & 15, q = lane >> 4;
#pragma unroll
                for (int pj = 0; pj < 4; ++pj) *(LAS u32x2_t*)(L + SL_H + (16 * pj + r16) * PC + (16 * w + 4 * q) * 2) = (u32x2_t){pk2(hacc[pj][0], hacc[pj][1]), pk2(hacc[pj][2], hacc[pj][3])};
                if (more && tq < 320) { int cg, l0; stage_role(tq, cg, l0); ssd_stage(L, cg, l0, 64, (const LAS float*)(L + SL_CW) + cg * 40, (const LAS float*)(L + SL_W) + (par ^ 1) * 64, rawq); }
                if (tq >= 448 && (tq - 448) < rows) { const int lr = tq - 448; const f4 s4 = *(const LAS f4*)(L + SL_SSQ + lr * 16); SSQH[(size_t)(rb + tb + lr) * 32 + hh] = (s4[0] + s4[1]) + (s4[2] + s4[3]); }
            }
            WG_BAR();
            STAMP2(16);
        }
        {
            int tq = tid0, w = w0; OPQ_V(tq); OPQ_S(w);
            const int lane = tq & 63, r16 = lane & 15, q = lane >> 4;
            float* ho = C.out + (prm ? O_SSDP + (((size_t)l * NB_P + b) * NH + hh) * HD * DS : O_SSDS + (((size_t)l * NB_S + b) * NH + hh) * HD * DS);
#pragma unroll
            for (int pj = 0; pj < 4; ++pj) *(float4*)(ho + (size_t)(16 * pj + r16) * DS + 16 * w + 4 * q) = make_float4(hacc[pj][0], hacc[pj][1], hacc[pj][2], hacc[pj][3]); }
    }
}

constexpr int PH_CONV = 0, PH_FOLD = 1, PH_L0 = 2, PH_PER_L = 9, N_PHASES = PH_L0 + DEPTH * PH_PER_L;
constexpr int CW_BAR = 4096;

__global__ void __launch_bounds__(NTHR, 2) fwd_kernel(Args args) {
    extern __shared__ __attribute__((aligned(16))) unsigned char lds_raw[];
    Ctx C; C.lds = (LAS unsigned char*)lds_raw; C.G = gridDim.x; C.in = args.in; C.out = args.out; C.ws = args.ws; C.refresh();
    volatile LAS unsigned* MISC = (volatile LAS unsigned*)(C.lds + LDSCTL_OFF);
    if (threadIdx.x < 64) MISC[threadIdx.x] = 0u;
    __syncthreads();
    const int lo = args.ph_lo, hi = args.ph_hi;
    unsigned* barw = (unsigned*)(args.ws + WS_CTL) + CW_BAR;
    XcdBarrier bar; bar.bar = barw; bar.x = 0; bar.st = MISC + 8;
    if (hi - lo > 1) bar = xcd_barrier_post(barw, MISC + 8);
#define IN(k) (lo <= (k) && (k) < hi)
#if PROBE_SEL > 0
    unsigned long long tprev = __builtin_amdgcn_s_memrealtime();
#define STAMP(ty) do { if (blockIdx.x == 0 && threadIdx.x == 0) { const unsigned long long tn = __builtin_amdgcn_s_memrealtime(); MISC[16 + (ty)] += (unsigned)(tn - tprev); tprev = tn; } } while (0)
#else
#define STAMP(ty) do { } while (0)
#endif
#define SEAM(k) do { if ((k) + 1 < hi) xcd_barrier(bar); } while (0)
    LAS unsigned char* ring = C.lds;
    const int vcu = (C.G % 8 == 0) ? ((int)blockIdx.x % 8) * (C.G / 8) + (int)blockIdx.x / 8 : (int)blockIdx.x;

    if (IN(PH_CONV)) { phase_convert(C); SEAM(PH_CONV); STAMP(0); }
    if (IN(PH_FOLD)) {
        for (int w = (int)blockIdx.x; w < DEPTH * 4 * 8; w += C.G) { const int lg = w >> 3, l = lg >> 2, g = lg & 3;
            pg8::Gemm gm{(const bf16*)(C.ws + WS_WOP) + (size_t)l * DM * D_POOL + g * 256, (const bf16*)(C.ws + WS_WPB) + (size_t)lg * 65536, DM, 256, 256, D_POOL, 256, 0};
            pg8::StaticOrder S; S.init(DM, 256, 8, w & 7);
            pg8::EpiBf16S E{(bf16*)(C.ws + WS_BTOUT) + (size_t)l * DM * D_MIX + g * 256, D_MIX, nullptr, nullptr, -1};
            pg8::gemm_phase<pg8::EpiBf16S, pg8::StaticOrder, true, true>(ring, gm, S, E);
        }
        SEAM(PH_FOLD); STAMP(1);
    }
    for (int l = 0; l < DEPTH; ++l) {
        const int pb = PH_L0 + l * PH_PER_L;
        if (IN(pb + 0)) {
            pg8::Gemm gm{(const bf16*)(C.ws + WS_XB), (const bf16*)(C.ws + WS_BTIN) + (size_t)l * N_INP * DM, M, N_INP, DM, DM, DM, 0};
            pg8::StaticOrder S; S.init(M, N_INP, C.G, (int)blockIdx.x);
            pg8::EpiBf16S E{(bf16*)(C.ws + WS_PROJ), N_PROJ, (const float*)(C.ws + WS_R), (float*)(C.ws + WS_DT), N_PROJ / 256};
            pg8::gemm_phase<pg8::EpiBf16S, pg8::StaticOrder, true, true>(ring, gm, S, E);
            SEAM(pb + 0); STAMP(2);
        }
        if (IN(pb + 1)) { phase_ssd2(C, l); STAMP(11); phase_pool(C, l); STAMP(12); SEAM(pb + 1); STAMP(3); }
        if (IN(pb + 2)) { phase_gnorm(C); SEAM(pb + 2); STAMP(4); }
        if (IN(pb + 3)) {
            {
                pg8::Gemm gm{(const bf16*)(C.ws + WS_MIXA), (const bf16*)(C.ws + WS_BTOUT) + (size_t)l * DM * D_MIX, MP, DM, D_MIX, D_MIX, D_MIX, 0};
                pg8::StaticOrder S; S.init(MP, DM, C.G, (int)blockIdx.x);
                pg8::EpiBf16Ssq E{(bf16*)(C.ws + WS_MIX), DM, (float*)(C.ws + WS_SSQP)};
                pg8::gemm_phase<pg8::EpiBf16Ssq, pg8::StaticOrder, true, true>(ring, gm, S, E); }
            {
                pg8::Gemm gm{(const bf16*)(C.ws + WS_MIXA) + (size_t)MP * D_MIX, (const bf16*)(C.ws + WS_BTOUT) + (size_t)l * DM * D_MIX, MS, DM, D_MIX / KS_OUT, D_MIX, D_MIX, D_MIX / KS_OUT};
                pg8::SplitKOrder S; S.init(MS, DM, KS_OUT, C.G, vcu);
                pg8::EpiF32Slab E{(float*)(C.ws + WS_SLAB), DM, MS};
                pg8::gemm_phase<pg8::EpiF32Slab, pg8::SplitKOrder, true, true>(ring, gm, S, E); }
            SEAM(pb + 3); STAMP(5);
        }
        if (IN(pb + 4)) { phase_resid(C, C.in[17] + l * DM, false, KS_OUT); SEAM(pb + 4); STAMP(6); }
        if (IN(pb + 5)) {
            pg8::Gemm gm{(const bf16*)(C.ws + WS_XB), (const bf16*)(C.ws + WS_BTUP) + (size_t)l * D_UP * DM, M, D_UP, DM, DM, DM, 0};
            pg8::StaticOrder S; S.init(M, D_UP, C.G, (int)blockIdx.x);
            pg8::EpiBf16S E{(bf16*)(C.ws + WS_UP), D_UP, (const float*)(C.ws + WS_R), nullptr, -1};
            pg8::gemm_phase<pg8::EpiBf16S, pg8::StaticOrder, true, true>(ring, gm, S, E);
            SEAM(pb + 5); STAMP(7);
        }
        if (IN(pb + 6)) { phase_act(C, l); SEAM(pb + 6); STAMP(8); }
        if (IN(pb + 7)) {
            {
                pg8::Gemm gm{(const bf16*)(C.ws + WS_ACT), (const bf16*)(C.ws + WS_BTDN) + (size_t)l * DM * D_FF, MP, DM, D_FF, D_FF, D_FF, 0};
                pg8::StaticOrder S; S.init(MP, DM, C.G, (int)blockIdx.x);
                pg8::EpiBf16Ssq E{(bf16*)(C.ws + WS_MIX), DM, (float*)(C.ws + WS_SSQP)};
                pg8::gemm_phase<pg8::EpiBf16Ssq, pg8::StaticOrder, true, true>(ring, gm, S, E); }
            {
                pg8::Gemm gm{(const bf16*)(C.ws + WS_ACT) + (size_t)MP * D_FF, (const bf16*)(C.ws + WS_BTDN) + (size_t)l * DM * D_FF, MS, DM, D_FF / KS_DN, D_FF, D_FF, D_FF / KS_DN};
                pg8::SplitKOrder S; S.init(MS, DM, KS_DN, C.G, vcu);
                pg8::EpiF32Slab E{(float*)(C.ws + WS_SLAB), DM, MS};
                pg8::gemm_phase<pg8::EpiF32Slab, pg8::SplitKOrder, true, true>(ring, gm, S, E); }
            SEAM(pb + 7); STAMP(9);
        }
        if (IN(pb + 8)) { phase_resid(C, C.in[23] + l * DM, l == DEPTH - 1, KS_DN); SEAM(pb + 8); STAMP(10); }
    }
#if PROBE_SEL > 0
    if (blockIdx.x == 0 && threadIdx.x == 0) { asm volatile("s_waitcnt vmcnt(0)" ::: "memory"); unsigned tot = 0; for (int ty = 0; ty < 20; ++ty) if ((PROBE_SEL >> ty) & 1) tot += MISC[16 + ty]; C.out[0] = (float)tot * 0.0001f; }
#endif
#undef IN
#undef SEAM
}

extern "C" void kernel_launch(void* const* d_in, const int* in_sizes, int n_in, void* d_out, int out_size, void* d_ws, size_t ws_size, hipStream_t stream) {
    static int grid = 0;
    if (grid == 0) {
        if (n_in != 24 || (size_t)out_size != O_END || ws_size < WS_END) { fprintf(stderr, "kernel_launch: shape mismatch: n_in %d out %d (want %zu) ws %zu (need %zu)\n", n_in, out_size, (size_t)O_END, ws_size, (size_t)WS_END); grid = -1; return; }
        int dev = 0, cus = 0, per_cu = 0;
        if (hipGetDevice(&dev) != hipSuccess || hipDeviceGetAttribute(&cus, hipDeviceAttributeMultiprocessorCount, dev) != hipSuccess) { grid = -1; return; }
        if (hipFuncSetAttribute((const void*)fwd_kernel, hipFuncAttributeMaxDynamicSharedMemorySize, LDS_BYTES) != hipSuccess) { fprintf(stderr, "kernel_launch: hipFuncSetAttribute failed\n"); grid = -1; return; }
        if (hipOccupancyMaxActiveBlocksPerMultiprocessor(&per_cu, (const void*)fwd_kernel, NTHR, LDS_BYTES) != hipSuccess || per_cu < 1) fprintf(stderr, "kernel_launch: occupancy query reports %d\n", per_cu);
        (void)hipGetLastError();
        grid = cus;
    }
    if (grid < 0) return;
    if (hipMemsetAsync((char*)d_ws + WS_CTL, 0, CTL_BYTES, stream) != hipSuccess) return;
    Args a{};
    for (int i = 0; i < 24; ++i) a.in[i] = (const float*)d_in[i];
    a.out = (float*)d_out; a.ws = (unsigned char*)d_ws;
#if MK_MULTI
    for (int k = 0; k < N_PHASES; ++k) { a.ph_lo = k; a.ph_hi = k + 1; hipLaunchKernelGGL(fwd_kernel, dim3(grid), dim3(NTHR), LDS_BYTES, stream, a); }
#else
    a.ph_lo = 0; a.ph_hi = N_PHASES; hipLaunchKernelGGL(fwd_kernel, dim3(grid), dim3(NTHR), LDS_BYTES, stream, a);
#endif
}
```

```cpp
#include <hip/hip_runtime.h>
#include <cstdio>
#include <cstdint>

#ifndef PROBE_SEL
#define PROBE_SEL 0
#endif
#ifndef MK_MULTI
#define MK_MULTI 0
#endif

__device__ __forceinline__ int lane_id() { int l; asm volatile("v_mbcnt_lo_u32_b32 %0, -1, 0\n\tv_mbcnt_hi_u32_b32 %0, -1, %0" : "=v"(l)); return l; }
namespace pg8 {
#define PG8_LAS __attribute__((address_space(3)))
typedef unsigned short bf16_t;
typedef short bf16x8 __attribute__((ext_vector_type(8)));
typedef float f32x4 __attribute__((ext_vector_type(4)));
typedef unsigned u32x4 __attribute__((ext_vector_type(4)));
constexpr int BM = 256, BK = 64, HALF = 128, HTB = HALF * BK * 2, STAGE_BYTES = 8 * HTB, NXCD = 8, WGM = 8;

__host__ __device__ __forceinline__ int lds_byte(int r, int c) { const int st = (r >> 4) * 2 + (c >> 5), rr = r & 15, cc = c & 31, ob = rr * 64 + cc * 2; return st * 1024 + (ob ^ (((ob >> 9) & 1) << 5)); }
__host__ __device__ __forceinline__ void stage_rc(int b, int& R, int& C) { const int st = b / 1024, sb = b % 1024, swz = sb ^ (((sb >> 9) & 1) << 5); R = (st >> 1) * 16 + swz / 64; C = (st & 1) * 32 + (swz % 64) / 2; }
__host__ __device__ __forceinline__ int perm32(int rho) { const int n = rho >> 4, i = rho & 15; return 8 * (i >> 2) + 4 * n + (i & 3); }

struct Unit { int pm, pn, ks; };
struct Gemm { const bf16_t* A; const bf16_t* Bt; int M, N, K, lda, ldb, kslice; };

struct StaticOrder {
    int nM, nN, nwg, G, c;
    __host__ __device__ void init(int M, int N, int G_, int c_) { nM = M / BM; nN = N / BM; nwg = nM * nN; G = G_; c = c_; }
    __host__ __device__ bool next(int i, Unit& u) const {
        const long L = (long)i * G + c; if (L >= nwg) return false;
        int wgid = (int)L; { const int q = nwg / NXCD, r = nwg % NXCD, xcd = wgid % NXCD, off = wgid / NXCD; wgid = (xcd < r ? xcd * (q + 1) : r * (q + 1) + (xcd - r) * q) + off; }
        const int nig = WGM * nN, gid = wgid / nig, fm = gid * WGM, gsz = (nM - fm) < WGM ? (nM - fm) : WGM;
        u.pm = fm + ((wgid % nig) % gsz); u.pn = (wgid % nig) / gsz; u.ks = 0; return true;
    }
    __device__ __forceinline__ void a_ready(const Unit&) const {}
    __device__ __forceinline__ void done(const Unit&) const {}
};
struct SplitKOrder {
    int nM, nN, KS, nwg, G, c;
    __host__ __device__ void init(int M, int N, int KS_, int G_, int c_) { nM = M / BM; nN = N / BM; KS = KS_; nwg = nM * nN * KS; G = G_; c = c_; }
    __host__ __device__ bool next(int i, Unit& u) const { const long L = (long)i * G + c; if (L >= nwg) return false; const int l = (int)L; u.pn = l % nN; u.ks = (l / nN) % KS; u.pm = l / (nN * KS); return true; }
    __device__ __forceinline__ void a_ready(const Unit&) const {}
    __device__ __forceinline__ void done(const Unit&) const {}
};

__device__ __forceinline__ unsigned cvt_pk_bf16(float lo, float hi) { unsigned r; asm volatile("v_cvt_pk_bf16_f32 %0, %1, %2" : "=v"(r) : "v"(lo), "v"(hi)); return r; }

struct EpiBf16S {
    static constexpr bool PERM = true, AFTER_DRAIN = false;
    bf16_t* O; int ldc; const float* rs; float* dt; int dt_pn;
    __device__ __forceinline__ void operator()(const f32x4 (&acc)[2][2][4][2], const Unit& u, int wr, int wc, int fr, int fq) const {
        const int row0 = u.pm * BM + wr * 64 + fr;
        if (u.pn == dt_pn) {
            if (wc == 0) {
#pragma unroll
                for (int ai = 0; ai < 2; ++ai)
#pragma unroll
                    for (int m = 0; m < 4; ++m) { const int row = row0 + ai * HALF + m * 16; const float s = rs ? rs[row] : 1.f;
#pragma unroll
                        for (int n = 0; n < 2; ++n) *(f32x4*)(dt + (size_t)row * 32 + 8 * fq + 4 * n) = acc[ai][0][m][n] * s; }
            }
            return;
        }
        const int col0 = u.pn * BM + wc * 32 + 8 * fq;
#pragma unroll
        for (int ai = 0; ai < 2; ++ai)
#pragma unroll
            for (int m = 0; m < 4; ++m) { const int row = row0 + ai * HALF + m * 16; const float s = rs ? rs[row] : 1.f; bf16_t* rowp = O + (size_t)row * ldc + col0;
#pragma unroll
                for (int bj = 0; bj < 2; ++bj) { const f32x4 v0 = acc[ai][bj][m][0] * s, v1 = acc[ai][bj][m][1] * s;
                    u32x4 w; w.x = cvt_pk_bf16(v0[0], v0[1]); w.y = cvt_pk_bf16(v0[2], v0[3]); w.z = cvt_pk_bf16(v1[0], v1[1]); w.w = cvt_pk_bf16(v1[2], v1[3]);
                    *(u32x4*)(rowp + bj * HALF) = w; } }
    }
};
struct EpiF32Ssq {
    static constexpr bool PERM = false, AFTER_DRAIN = false;
    float* C; int ldc; float* ssq;
    __device__ __forceinline__ void operator()(const f32x4 (&acc)[2][2][4][2], const Unit& u, int wr, int wc, int fr, int fq) const {
        const int row0 = u.pm * BM + wr * 64 + fr, col0 = u.pn * BM + wc * 32 + 4 * fq;
#pragma unroll
        for (int ai = 0; ai < 2; ++ai)
#pragma unroll
            for (int m = 0; m < 4; ++m) { const int row = row0 + ai * HALF + m * 16; float* rowp = C + (size_t)row * ldc + col0; float q = 0.f;
#pragma unroll
                for (int bj = 0; bj < 2; ++bj)
#pragma unroll
                    for (int n = 0; n < 2; ++n) { const f32x4 v = acc[ai][bj][m][n]; *(f32x4*)(rowp + bj * HALF + n * 16) = v; q += (v[0] * v[0] + v[1] * v[1]) + (v[2] * v[2] + v[3] * v[3]); }
                q += __shfl_xor(q, 16); q += __shfl_xor(q, 32);
                if (fq == 0) ssq[(size_t)row * 32 + u.pn * 4 + wc] = q; }
    }
};

struct EpiBf16Ssq {
    static constexpr bool PERM = true, AFTER_DRAIN = false;
    bf16_t* O; int ldc; float* ssq;
    __device__ __forceinline__ void operator()(const f32x4 (&acc)[2][2][4][2], const Unit& u, int wr, int wc, int fr, int fq) const {
        const int row0 = u.pm * BM + wr * 64 + fr, col0 = u.pn * BM + wc * 32 + 8 * fq;
#pragma unroll
        for (int ai = 0; ai < 2; ++ai)
#pragma unroll
            for (int m = 0; m < 4; ++m) { const int row = row0 + ai * HALF + m * 16; bf16_t* rowp = O + (size_t)row * ldc + col0; float q = 0.f;
#pragma unroll
                for (int bj = 0; bj < 2; ++bj) { const f32x4 v0 = acc[ai][bj][m][0], v1 = acc[ai][bj][m][1];
                    q += ((v0[0] * v0[0] + v0[1] * v0[1]) + (v0[2] * v0[2] + v0[3] * v0[3])) + ((v1[0] * v1[0] + v1[1] * v1[1]) + (v1[2] * v1[2] + v1[3] * v1[3]));
                    u32x4 w; w.x = cvt_pk_bf16(v0[0], v0[1]); w.y = cvt_pk_bf16(v0[2], v0[3]); w.z = cvt_pk_bf16(v1[0], v1[1]); w.w = cvt_pk_bf16(v1[2], v1[3]);
                    *(u32x4*)(rowp + bj * HALF) = w; }
                q += __shfl_xor(q, 16); q += __shfl_xor(q, 32);
                if (fq == 0) ssq[(size_t)row * 32 + u.pn * 4 + wc] = q; }
    }
};
template <int CTRL> __device__ __forceinline__ float dppf(float old, float src) { return __builtin_bit_cast(float, __builtin_amdgcn_update_dpp(__builtin_bit_cast(int, old), __builtin_bit_cast(int, src), CTRL, 0xF, 0xF, false)); }
struct EpiUpAct {
    static constexpr bool PERM = true, AFTER_DRAIN = false;
    bf16_t* ACT; bf16_t* UP; bf16_t* SIDE; const float* rs; const float* cw; const float* cb; int dff;
    PG8_LAS float* wlds;
    __device__ __forceinline__ void operator()(const f32x4 (&acc)[2][2][4][2], const Unit& u, int wr, int wc, int fr, int fq) const {
        const int row0 = u.pm * BM + wr * 64 + fr, cbase = u.pn * HALF + wc * 32 + 8 * fq, dup = 2 * dff;
        if (u.pm >= 64) {
#pragma unroll
            for (int ai = 0; ai < 2; ++ai)
#pragma unroll
                for (int m = 0; m < 4; ++m) { const int row = row0 + ai * HALF + m * 16; const float s = rs[row];
#pragma unroll
                    for (int bj = 0; bj < 2; ++bj) { const f32x4 v0 = acc[ai][bj][m][0] * s, v1 = acc[ai][bj][m][1] * s;
                        u32x4 w; w.x = cvt_pk_bf16(v0[0], v0[1]); w.y = cvt_pk_bf16(v0[2], v0[3]); w.z = cvt_pk_bf16(v1[0], v1[1]); w.w = cvt_pk_bf16(v1[2], v1[3]);
                        *(u32x4*)(UP + (size_t)row * dup + bj * dff + cbase) = w; } }
            return;
        }
        typedef unsigned u32x2 __attribute__((ext_vector_type(2)));
        PG8_LAS float* wl = wlds + (wr * 4 + wc) * 256;
        int fro = fr, fqo = fq; asm volatile("" : "+v"(fro), "+v"(fqo));
        { const int lane = fqo * 16 + fro, kind = lane >> 3, j0 = (lane & 7) * 4; const int k3 = kind & 3;
          const float* srcp = (k3 < 3 ? cw + (size_t)k3 * dup : cb) + (kind >> 2) * dff + u.pn * HALF + wc * 32 + j0;
          *(PG8_LAS f32x4*)(wl + kind * 32 + j0) = *(const f32x4*)srcp; }
        asm volatile("s_waitcnt lgkmcnt(0)" ::: "memory");
#pragma unroll
        for (int n = 0; n < 2; ++n) { const int c = cbase + 4 * n; const PG8_LAS float* wq = wl + 8 * fqo + 4 * n;
#pragma unroll
            for (int ai = 0; ai < 2; ++ai) { const int kb = u.pm * 4 + ai * 2 + wr; float sp = 0.f;
#pragma unroll
                for (int m = 0; m < 4; ++m) { const int row = row0 + ai * HALF + m * 16; const float s = rs[row];
                    const f32x4 g = acc[ai][0][m][n] * s, v = acc[ai][1][m][n] * s; f32x4 o;
                    const f32x4 gp = acc[ai][0][m > 0 ? m - 1 : 0][n] * sp, vp = acc[ai][1][m > 0 ? m - 1 : 0][n] * sp;
#pragma unroll
                    for (int e = 0; e < 4; ++e) {
                        const float p1g = dppf<0x111>(dppf<0x121>(0.f, gp[e]), g[e]), p2g = dppf<0x112>(dppf<0x122>(0.f, gp[e]), g[e]);
                        const float p1v = dppf<0x111>(dppf<0x121>(0.f, vp[e]), v[e]), p2v = dppf<0x112>(dppf<0x122>(0.f, vp[e]), v[e]);
                        const float gg = wq[96 + e] + wq[e] * p2g + wq[32 + e] * p1g + wq[64 + e] * g[e], vv = wq[224 + e] + wq[128 + e] * p2v + wq[160 + e] * p1v + wq[192 + e] * v[e];
                        o[e] = gg * __builtin_amdgcn_rcpf(1.f + __expf(-gg)) * vv; }
                    const bool head = (m == 0) && (fr < 2);
                    if (!head) { u32x2 w; w.x = cvt_pk_bf16(o[0], o[1]); w.y = cvt_pk_bf16(o[2], o[3]); *(u32x2*)(ACT + (size_t)row * dff + c) = w; }
                    if (head || ((m == 3) && (fr >= 14))) { const int slot = head ? fr : fr - 12; bf16_t* sp = SIDE + ((size_t)kb * 4 + slot) * dup + c;
                        u32x2 wg; wg.x = cvt_pk_bf16(g[0], g[1]); wg.y = cvt_pk_bf16(g[2], g[3]); *(u32x2*)sp = wg;
                        u32x2 wv; wv.x = cvt_pk_bf16(v[0], v[1]); wv.y = cvt_pk_bf16(v[2], v[3]); *(u32x2*)(sp + dff) = wv; }
                    sp = s; asm volatile("" ::: "memory"); } } }
    }
};
struct EpiF32Slab {
    static constexpr bool PERM = false, AFTER_DRAIN = false;
    float* C; int ldc, Mrows;
    __device__ __forceinline__ void operator()(const f32x4 (&acc)[2][2][4][2], const Unit& u, int wr, int wc, int fr, int fq) const {
        const int row0 = u.pm * BM + wr * 64 + fr, col0 = u.pn * BM + wc * 32 + 4 * fq; float* base = C + (size_t)u.ks * Mrows * ldc;
#pragma unroll
        for (int ai = 0; ai < 2; ++ai)
#pragma unroll
            for (int m = 0; m < 4; ++m) { float* rowp = base + (size_t)(row0 + ai * HALF + m * 16) * ldc + col0;
#pragma unroll
                for (int bj = 0; bj < 2; ++bj)
#pragma unroll
                    for (int n = 0; n < 2; ++n) *(f32x4*)(rowp + bj * HALF + n * 16) = acc[ai][bj][m][n]; }
    }
};
template <class Epi, class Sched, bool ALIGN_EPI = false, bool SP2 = false>
__device__ __forceinline__ void gemm_phase(PG8_LAS unsigned char* lds, const Gemm g, const Sched& S, const Epi& E, int wave_id) {
    int tid_ = wave_id * 64 + lane_id(); asm volatile("" : "+v"(tid_));
    const int tid = tid_, wid = __builtin_amdgcn_readfirstlane(tid >> 6), lane = tid & 63, wr = wid >> 2, wc = wid & 3, fr = lane & 15, fq = lane >> 4;
    const int K = g.K, nt = K / BK;
    unsigned voffA[2], voffB[2];
#pragma unroll
    for (int i = 0; i < 2; ++i) { int R, C; stage_rc(tid * 16 + i * 8192, R, C); const int Rb = Epi::PERM ? ((R & ~31) + perm32(R & 31)) : R;
        voffA[i] = (unsigned)(R * g.lda + C) * 2u; voffB[i] = (unsigned)(Rb * g.ldb + C) * 2u; }
    const size_t kstep = (size_t)(BK * 2);
    const size_t hstepA = (size_t)HALF * g.lda * 2, hstepB = (size_t)HALF * g.ldb * 2;
    const size_t tstepA = 2 * hstepA, tstepB = 2 * hstepB;
    const unsigned ldsw = (unsigned)wid * 1024u;
    const int aoff = lds_byte(wr * 64 + fr, fq * 8), boff = lds_byte(wc * 32 + fr, fq * 8);
#define PG8_SA(b, h) (((b) * 2 + (h)) * HTB)
#define PG8_SB(b, h) ((4 + (b) * 2 + (h)) * HTB)
#define PG8_STAGE(bufoff, gbase, voff) do { _Pragma("unroll") for (int _i = 0; _i < 2; ++_i) \
        __builtin_amdgcn_global_load_lds((const unsigned*)((const char*)(gbase) + (voff)[_i]), (PG8_LAS unsigned*)(lds + (bufoff) + ldsw + _i * 8192), 16, 0, 0); } while (0)
#define PG8_LDA(dst, b, h) do { _Pragma("unroll") for (int m = 0; m < 4; ++m) _Pragma("unroll") for (int k = 0; k < 2; ++k) dst[m][k] = *(const PG8_LAS bf16x8*)(lds + PG8_SA(b, h) + aoff + m * 2048 + k * 1024); } while (0)
#define PG8_LDB(dst, b, h) do { _Pragma("unroll") for (int n = 0; n < 2; ++n) _Pragma("unroll") for (int k = 0; k < 2; ++k) dst[n][k] = *(const PG8_LAS bf16x8*)(lds + PG8_SB(b, h) + boff + n * 2048 + k * 1024); } while (0)
#define PG8_MMA(ai, bj, At, Bt) do { __builtin_amdgcn_s_setprio(1); _Pragma("unroll") for (int m = 0; m < 4; ++m) _Pragma("unroll") for (int n = 0; n < 2; ++n) _Pragma("unroll") for (int k = 0; k < 2; ++k) \
        acc[ai][bj][m][n] = __builtin_amdgcn_mfma_f32_16x16x32_bf16(Bt[n][k], At[m][k], acc[ai][bj][m][n], 0, 0, 0); __builtin_amdgcn_s_setprio(0); } while (0)
#define PG8_WAIT_V(n) asm volatile("s_waitcnt vmcnt(" #n ")" ::: "memory")
#define PG8_WAIT_L(n) asm volatile("s_waitcnt lgkmcnt(" #n ")" ::: "memory")
#define PG8_BAR __builtin_amdgcn_s_barrier()
#define PG8_SCHED __builtin_amdgcn_sched_barrier(0)
    Unit cur, nxt; int ui = 0;
    if (!S.next(0, cur)) return;
    f32x4 acc[2][2][4][2];
#pragma unroll
    for (int a = 0; a < 2; ++a)
#pragma unroll
        for (int b = 0; b < 2; ++b)
#pragma unroll
            for (int m = 0; m < 4; ++m)
#pragma unroll
                for (int n = 0; n < 2; ++n) acc[a][b][m][n] = (f32x4){0.f, 0.f, 0.f, 0.f};
    bf16x8 At[4][2], B0[2][2], B1[2][2];
    const size_t ksb = (size_t)g.kslice * 2;
    const char* cA = (const char*)g.A + (size_t)cur.pm * tstepA + cur.ks * ksb; const char* cB = (const char*)g.Bt + (size_t)cur.pn * tstepB + cur.ks * ksb;
    S.a_ready(cur);
    if constexpr (SP2) {
        PG8_STAGE(PG8_SB(0, 0), cB, voffB); PG8_STAGE(PG8_SB(0, 1), cB + hstepB, voffB); PG8_STAGE(PG8_SA(0, 0), cA, voffA); PG8_STAGE(PG8_SA(0, 1), cA + hstepA, voffA);
        if (wr == 1) PG8_BAR;
        PG8_WAIT_V(2); PG8_BAR;
        PG8_STAGE(PG8_SB(1, 0), cB + kstep, voffB); PG8_STAGE(PG8_SA(1, 0), cA + kstep, voffA); PG8_STAGE(PG8_SB(1, 1), cB + hstepB + kstep, voffB);
        PG8_WAIT_V(6); PG8_BAR;
    } else {
        PG8_STAGE(PG8_SB(0, 0), cB, voffB); PG8_STAGE(PG8_SA(0, 0), cA, voffA); PG8_STAGE(PG8_SB(0, 1), cB + hstepB, voffB); PG8_STAGE(PG8_SA(0, 1), cA + hstepA, voffA);
        if (wr == 1) PG8_BAR;
        PG8_WAIT_V(4); PG8_BAR;
        PG8_STAGE(PG8_SB(1, 0), cB + kstep, voffB); PG8_STAGE(PG8_SA(1, 0), cA + kstep, voffA); PG8_STAGE(PG8_SB(1, 1), cB + hstepB + kstep, voffB);
        PG8_WAIT_V(6); PG8_BAR;
    }
    for (;;) {
        const bool has_next = S.next(ui + 1, nxt);
        const char* nA = has_next ? (const char*)g.A + (size_t)nxt.pm * tstepA + nxt.ks * ksb : cA; const char* nB = has_next ? (const char*)g.Bt + (size_t)nxt.pn * tstepB + nxt.ks * ksb : cB;
#if PROBE_SEL > 0
        if (blockIdx.x == 0 && tid == 0) ((volatile PG8_LAS unsigned*)(lds + 131072))[11] = (unsigned)__builtin_amdgcn_s_memrealtime();
#endif
        for (int t = 0; t < nt; t += 2) {
            const bool last = (t == nt - 2);
            const char* a1 = cA + (size_t)(t + 1) * kstep;
            const char* a2 = last ? nA : cA + (size_t)(t + 2) * kstep; const char* b2 = last ? nB : cB + (size_t)(t + 2) * kstep;
            const char* a3 = a2 + kstep; const char* b3 = b2 + kstep;
            if (last && has_next) S.a_ready(nxt);
            if constexpr (SP2) {
            PG8_LDB(B0, 0, 0); PG8_LDB(B1, 0, 1); PG8_SCHED; PG8_LDA(At, 0, 0); PG8_STAGE(PG8_SA(1, 1), a1 + hstepA, voffA);
            PG8_WAIT_V(8); PG8_WAIT_L(0); PG8_BAR; PG8_MMA(0, 0, At, B0); PG8_MMA(0, 1, At, B1); PG8_BAR; PG8_SCHED;
            PG8_LDA(At, 0, 1); PG8_STAGE(PG8_SB(0, 0), b2, voffB); PG8_STAGE(PG8_SB(0, 1), b2 + hstepB, voffB); PG8_STAGE(PG8_SA(0, 0), a2, voffA);
            PG8_WAIT_V(8); PG8_WAIT_L(0); PG8_BAR; PG8_MMA(1, 0, At, B0); PG8_MMA(1, 1, At, B1); PG8_BAR; PG8_SCHED;
            PG8_LDB(B0, 1, 0); PG8_LDB(B1, 1, 1); PG8_SCHED; PG8_LDA(At, 1, 0); PG8_STAGE(PG8_SA(0, 1), a2 + hstepA, voffA);
            PG8_WAIT_V(8); PG8_WAIT_L(0); PG8_BAR; PG8_MMA(0, 0, At, B0); PG8_MMA(0, 1, At, B1); PG8_BAR; PG8_SCHED;
            PG8_LDA(At, 1, 1); PG8_STAGE(PG8_SB(1, 0), b3, voffB); PG8_STAGE(PG8_SB(1, 1), b3 + hstepB, voffB); PG8_STAGE(PG8_SA(1, 0), a3, voffA);
            PG8_WAIT_V(8); PG8_WAIT_L(0); PG8_BAR; PG8_MMA(1, 0, At, B0); PG8_MMA(1, 1, At, B1); PG8_BAR; PG8_SCHED;
            } else {
            PG8_LDB(B0, 0, 0); PG8_SCHED; PG8_LDA(At, 0, 0); PG8_STAGE(PG8_SA(1, 1), a1 + hstepA, voffA);
            PG8_WAIT_L(8); PG8_BAR; PG8_WAIT_L(0); PG8_MMA(0, 0, At, B0); PG8_BAR; PG8_SCHED;
            PG8_LDB(B1, 0, 1); PG8_STAGE(PG8_SB(0, 0), b2, voffB);
            PG8_BAR; PG8_WAIT_L(0); PG8_MMA(0, 1, At, B1); PG8_BAR;
            PG8_LDA(At, 0, 1); PG8_STAGE(PG8_SA(0, 0), a2, voffA);
            PG8_BAR; PG8_WAIT_L(0); PG8_MMA(1, 0, At, B0); PG8_BAR; PG8_SCHED;
            PG8_STAGE(PG8_SB(0, 1), b2 + hstepB, voffB);
            PG8_WAIT_V(6); PG8_BAR; PG8_MMA(1, 1, At, B1); PG8_BAR;
            PG8_LDB(B0, 1, 0); PG8_SCHED; PG8_LDA(At, 1, 0); PG8_STAGE(PG8_SA(0, 1), a2 + hstepA, voffA);
            PG8_WAIT_L(8); PG8_BAR; PG8_WAIT_L(0); PG8_MMA(0, 0, At, B0); PG8_BAR; PG8_SCHED;
            PG8_LDB(B1, 1, 1); PG8_STAGE(PG8_SB(1, 0), b3, voffB);
            PG8_BAR; PG8_WAIT_L(0); PG8_MMA(0, 1, At, B1); PG8_BAR;
            PG8_LDA(At, 1, 1); PG8_STAGE(PG8_SA(1, 0), a3, voffA);
            PG8_BAR; PG8_WAIT_L(0); PG8_MMA(1, 0, At, B0); PG8_BAR; PG8_SCHED;
            PG8_STAGE(PG8_SB(1, 1), b3 + hstepB, voffB);
            PG8_WAIT_V(6); PG8_BAR; PG8_MMA(1, 1, At, B1); PG8_BAR;
            }
        }
#if PROBE_SEL > 0
        if (blockIdx.x == 0 && tid == 0) { const unsigned tn = (unsigned)__builtin_amdgcn_s_memrealtime(); volatile PG8_LAS unsigned* mm = (volatile PG8_LAS unsigned*)(lds + 131072); mm[16 + 17] += tn - mm[11]; mm[11] = tn; }
#endif
        if constexpr (ALIGN_EPI) { if (wr == 0) PG8_BAR; }
        if constexpr (!Epi::AFTER_DRAIN) { E(acc, cur, wr, wc, fr, fq); S.done(cur); }
#if PROBE_SEL > 0
        if (blockIdx.x == 0 && tid == 0) { const unsigned tn = (unsigned)__builtin_amdgcn_s_memrealtime(); volatile PG8_LAS unsigned* mm = (volatile PG8_LAS unsigned*)(lds + 131072); mm[16 + 18] += tn - mm[11]; }
#endif
        if (!has_next) break;
#pragma unroll
        for (int a = 0; a < 2; ++a)
#pragma unroll
            for (int b = 0; b < 2; ++b)
#pragma unroll
                for (int m = 0; m < 4; ++m)
#pragma unroll
                    for (int n = 0; n < 2; ++n) acc[a][b][m][n] = (f32x4){0.f, 0.f, 0.f, 0.f};
        cur = nxt; cA = nA; cB = nB; ++ui;
        if constexpr (ALIGN_EPI) { if (wr == 1) PG8_BAR; }
    }
    PG8_WAIT_V(0);
    if constexpr (!ALIGN_EPI) { if (wr == 0) PG8_BAR; }
    PG8_BAR;
#undef PG8_SA
#undef PG8_SB
#undef PG8_STAGE
#undef PG8_LDA
#undef PG8_LDB
#undef PG8_MMA
#undef PG8_WAIT_V
#undef PG8_WAIT_L
#undef PG8_BAR
#undef PG8_SCHED
}
}

constexpr int NWAVES = 8, NTHR = 512;
constexpr int DM = 2048, SEQ = 2048, NB_P = 8, NB_S = 32, SEQ_S = 32, DEPTH = 4;
constexpr int MP = NB_P * SEQ, MS = NB_S * SEQ_S, M = MP + MS;
constexpr int D_POOL = 1024, POOL_HIST = 15, D_SSD = 2048, HD = 64, NH = 32, HPG = 16, DS = 128, CONV_DIM = 2560, D_MIX = 3072;
constexpr int D_IN = 5664, N_PROJ = 5632, N_INP = 5888, D_FF = 5632, D_UP = 11264;
constexpr int XBC0 = 3072;
constexpr float EPS = 1e-6f;

constexpr size_t O_YP = 0, O_YS = O_YP + (size_t)MP * DM, O_POOLP = O_YS + (size_t)MS * DM, O_POOLS = O_POOLP + (size_t)DEPTH * NB_P * 15 * 1024,
    O_SCP = O_POOLS + (size_t)DEPTH * NB_S * 15 * 1024, O_SCS = O_SCP + (size_t)DEPTH * NB_P * 3 * 2560, O_SSDP = O_SCS + (size_t)DEPTH * NB_S * 3 * 2560,
    O_SSDS = O_SSDP + (size_t)DEPTH * NB_P * 32 * 64 * 128, O_FCP = O_SSDS + (size_t)DEPTH * NB_S * 32 * 64 * 128, O_FCS = O_FCP + (size_t)DEPTH * NB_P * 2 * 11264,
    O_END = O_FCS + (size_t)DEPTH * NB_S * 2 * 11264;

constexpr size_t al256(size_t x) { return (x + 255) & ~(size_t)255; }
constexpr size_t WS_CTL = 0, CTL_BYTES = 1u << 20;
constexpr size_t WS_BTIN = CTL_BYTES;
constexpr int DMP = DM + 64;
constexpr size_t WS_BTOUT = WS_BTIN + (size_t)DEPTH * N_INP * DMP * 2;
constexpr size_t WS_BTUP = WS_BTOUT + (size_t)DEPTH * DM * D_MIX * 2;
constexpr size_t WS_BTDN = WS_BTUP + (size_t)DEPTH * D_UP * DMP * 2;
constexpr size_t WS_WOP = WS_BTDN + (size_t)DEPTH * DM * D_FF * 2;
constexpr size_t WS_WPB = WS_WOP + (size_t)DEPTH * DM * D_POOL * 2;
constexpr size_t WS_X = WS_WPB + (size_t)DEPTH * 4 * 256 * 256 * 2;
constexpr size_t WS_XB = WS_X + (size_t)M * DM * 4;
constexpr size_t WS_R = WS_XB + (size_t)M * DMP * 2;
constexpr size_t WS_DT = WS_R + al256((size_t)M * 4);
constexpr size_t WS_SSQP = WS_DT + (size_t)M * 32 * 4;
constexpr size_t WS_SSQH = WS_SSQP + (size_t)M * 32 * 4;
constexpr size_t WS_ACT = WS_SSQH + (size_t)M * 32 * 4;
constexpr size_t WS_RA = WS_ACT + (size_t)M * D_FF * 2;
constexpr size_t WS_PROJ = WS_RA;
constexpr size_t WS_MIXA = WS_PROJ + (size_t)M * N_PROJ * 2;
constexpr size_t WS_MIX = WS_MIXA + (size_t)M * D_MIX * 2;
constexpr size_t WS_UP = WS_RA;
constexpr int KS_OUT = 8, KS_DN = 4;
constexpr size_t WS_SLAB = WS_MIX + (size_t)M * DM * 4;
constexpr size_t WS_SIDE = WS_SLAB + (size_t)KS_OUT * MS * DM * 4;
constexpr size_t WS_END = WS_SIDE + (size_t)(MP / 64) * 4 * D_UP * 2;
static_assert((size_t)M * D_UP * 2 <= WS_END - WS_RA, "UP fits region A");

constexpr int RING_BYTES = 131072, LDSCTL_OFF = RING_BYTES, LDS_BYTES = 147456;

#define LAS __attribute__((address_space(3)))
typedef unsigned short bf16;
typedef float f32x4 __attribute__((ext_vector_type(4)));
#define RLX_AGENT __ATOMIC_RELAXED, __HIP_MEMORY_SCOPE_AGENT
__device__ __forceinline__ unsigned f2bf(float f) { unsigned u = __builtin_bit_cast(unsigned, f); return (u + 0x7fffu + ((u >> 16) & 1u)) >> 16; }
__device__ __forceinline__ unsigned pk2(float lo, float hi) { unsigned r; asm("v_cvt_pk_bf16_f32 %0, %1, %2" : "=v"(r) : "v"(lo), "v"(hi)); return r; }
__device__ __forceinline__ float bflo(unsigned u) { return __uint_as_float(u << 16); }
__device__ __forceinline__ float bfhi(unsigned u) { return __uint_as_float(u & 0xffff0000u); }
__device__ __forceinline__ float bf2f(bf16 b) { return __uint_as_float(((unsigned)b) << 16); }
struct F8 { float v[8]; };
__device__ __forceinline__ F8 ld_bf8(const bf16* p) { const uint4 u = *(const uint4*)p; F8 r; r.v[0] = bflo(u.x); r.v[1] = bfhi(u.x); r.v[2] = bflo(u.y); r.v[3] = bfhi(u.y); r.v[4] = bflo(u.z); r.v[5] = bfhi(u.z); r.v[6] = bflo(u.w); r.v[7] = bfhi(u.w); return r; }
__device__ __forceinline__ F8 unpack8(const uint4 u) { F8 r; r.v[0] = bflo(u.x); r.v[1] = bfhi(u.x); r.v[2] = bflo(u.y); r.v[3] = bfhi(u.y); r.v[4] = bflo(u.z); r.v[5] = bfhi(u.z); r.v[6] = bflo(u.w); r.v[7] = bfhi(u.w); return r; }
__device__ __forceinline__ F8 ld_f8(const float* p) { const float4 a = *(const float4*)p, b = *(const float4*)(p + 4); F8 r; r.v[0] = a.x; r.v[1] = a.y; r.v[2] = a.z; r.v[3] = a.w; r.v[4] = b.x; r.v[5] = b.y; r.v[6] = b.z; r.v[7] = b.w; return r; }
__device__ __forceinline__ F8 zero8() { F8 r;
#pragma unroll
    for (int i = 0; i < 8; ++i) r.v[i] = 0.f; return r; }
__device__ __forceinline__ void st_bf8(bf16* p, const F8& r) { uint4 u; u.x = pk2(r.v[0], r.v[1]); u.y = pk2(r.v[2], r.v[3]); u.z = pk2(r.v[4], r.v[5]); u.w = pk2(r.v[6], r.v[7]); *(uint4*)p = u; }
__device__ __forceinline__ void st_f8(float* p, const F8& r) { *(float4*)p = make_float4(r.v[0], r.v[1], r.v[2], r.v[3]); *(float4*)(p + 4) = make_float4(r.v[4], r.v[5], r.v[6], r.v[7]); }
__device__ __forceinline__ float silu_f(float x) { return x * __builtin_amdgcn_rcpf(1.f + __expf(-x)); }
__device__ __forceinline__ float wave_sum(float v) {
#pragma unroll
    for (int o = 1; o < 64; o <<= 1) v += __shfl_xor(v, o);
    return v;
}

#define XB_TMO      128
#define XB_XCNT(j)  (256  + 64 * (j))
#define XB_XSUB(j)  (1280 + 64 * (j))
#define XB_XGEN(j)  (2304 + 64 * (j))
#define XB_TOP      3328
#define XB_TOPGEN   3392
#define XCD_BAR_WORDS 3456
#define XB_SPIN_CAP (1u << 18)
__device__ __forceinline__ unsigned xb_ld(unsigned* p)              { return __hip_atomic_load(p, __ATOMIC_RELAXED, __HIP_MEMORY_SCOPE_AGENT); }
__device__ __forceinline__ unsigned xb_add(unsigned* p, unsigned v) { return __hip_atomic_fetch_add(p, v, __ATOMIC_RELAXED, __HIP_MEMORY_SCOPE_AGENT); }
__device__ __forceinline__ unsigned xb_xcc_id() { return (unsigned)__builtin_amdgcn_s_getreg((3 << 11) | 20) & 0xFu; }
#define XB_SPIN(cond, bar) do { unsigned _sp = 0; while (cond) { __builtin_amdgcn_s_sleep(1); \
    if ((++_sp & 255u) == 0u) { if (xb_ld(&(bar)[XB_TMO])) break; if (_sp > XB_SPIN_CAP) { atomicAdd(&(bar)[XB_TMO], 1u); break; } } } } while (0)
struct XcdBarrier { unsigned* bar; unsigned x; volatile LAS unsigned* st; };
__device__ __forceinline__ XcdBarrier xcd_barrier_post(unsigned* bar, volatile LAS unsigned* st, bool lead) {
    XcdBarrier b; b.bar = bar; b.x = xb_xcc_id(); b.st = st;
    if (lead) (void)xb_add(&bar[XB_XCNT(b.x)], 1u);
    return b;
}
__device__ __forceinline__ void xcd_barrier_complete(unsigned* bar, unsigned x, unsigned& nloc, unsigned& nx) {
    const unsigned G = gridDim.x * gridDim.y * gridDim.z;
    unsigned sum, cnt, mine, sp = 0u;
    for (;;) {
        sum = 0u; cnt = 0u; mine = 0u;
#pragma unroll
        for (unsigned j = 0; j < 16; ++j) { const unsigned c = xb_ld(&bar[XB_XCNT(j)]); sum += c; cnt += (c > 0u) ? 1u : 0u; mine = (j == x) ? c : mine; }
        if (sum == G) break;
        __builtin_amdgcn_s_sleep(1);
        if ((++sp & 255u) == 0u) { if (xb_ld(&bar[XB_TMO])) break; if (sp > XB_SPIN_CAP) { atomicAdd(&bar[XB_TMO], 1u); break; } }
    }
    nloc = mine > 0u ? mine : 1u; nx = cnt > 0u ? cnt : 1u;
}
__device__ __forceinline__ void xcd_barrier(const XcdBarrier& b, bool lead) {
    asm volatile("s_waitcnt vmcnt(0)" ::: "memory");
    __syncthreads();
    if (lead) {
        unsigned* bar = b.bar;
        __builtin_amdgcn_s_waitcnt(0);
        unsigned nloc = b.st[0], nx = b.st[1];
        if (nloc == 0u) { xcd_barrier_complete(bar, b.x, nloc, nx); b.st[0] = nloc; b.st[1] = nx; }
        const unsigned old = xb_add(&bar[XB_XSUB(b.x)], 1u);
        const unsigned gen = old / nloc;
        if (old + 1u == (gen + 1u) * nloc) {
            __builtin_amdgcn_fence(__ATOMIC_RELEASE, "agent");
            asm volatile("s_waitcnt vmcnt(0)" ::: "memory");
            const unsigned og = xb_add(&bar[XB_TOP], 1u);
            const unsigned tg = og / nx;
            if (og + 1u == (tg + 1u) * nx) xb_add(&bar[XB_TOPGEN], 1u);
            else XB_SPIN(xb_ld(&bar[XB_TOPGEN]) == tg, bar);
            __builtin_amdgcn_fence(__ATOMIC_ACQUIRE, "agent");
            xb_add(&bar[XB_XGEN(b.x)], 1u);
            asm volatile("s_waitcnt vmcnt(0)" ::: "memory");
        } else {
            XB_SPIN(xb_ld(&bar[XB_XGEN(b.x)]) == gen, bar);
            __builtin_amdgcn_fence(__ATOMIC_ACQUIRE, "agent");
            asm volatile("s_waitcnt vmcnt(0)" ::: "memory");
        }
    }
    __syncthreads();
}

struct Args { const float* in[24]; float* out; unsigned char* ws; int ph_lo, ph_hi; };

struct Ctx {
    LAS unsigned char* lds; int tid, lane, wave, G, gw, NGW, wave0;
    const float* const* in; float* out; unsigned char* ws;
    __device__ __forceinline__ void refresh() {
        int t = wave0 * 64 + lane_id(); asm volatile("" : "+v"(t)); tid = t; lane = t & 63; wave = __builtin_amdgcn_readfirstlane(t >> 6); gw = blockIdx.x * NWAVES + wave; NGW = G * NWAVES; }
};

__device__ __forceinline__ void conv_item(const float* W, int N, const float* gain, bf16* dst, int ldd, LAS float* scr, int kb, int nb, int lane) {
    const int k0 = 64 * kb, n0 = 32 * nb;
    float wv[32];
#pragma unroll
    for (int i = 0; i < 32; ++i) { const int kk = 2 * i + (lane >> 5); wv[i] = W[(size_t)(k0 + kk) * N + n0 + (lane & 31)]; }
#pragma unroll
    for (int i = 0; i < 32; ++i) { const int kk = 2 * i + (lane >> 5); const float gsc = gain ? gain[k0 + kk] : 1.f; scr[kk * 33 + (lane & 31)] = wv[i] * gsc; }
    asm volatile("s_waitcnt lgkmcnt(0)" ::: "memory");
    const int c = lane & 7;
#pragma unroll
    for (int j = 0; j < 4; ++j) { const int n = (lane >> 3) + 8 * j; const LAS float* s = scr + (8 * c) * 33 + n;
        uint4 o; o.x = pk2(s[0 * 33], s[1 * 33]); o.y = pk2(s[2 * 33], s[3 * 33]); o.z = pk2(s[4 * 33], s[5 * 33]); o.w = pk2(s[6 * 33], s[7 * 33]);
        *(uint4*)(dst + (size_t)(n0 + n) * ldd + k0 + 8 * c) = o; }
    asm volatile("s_waitcnt lgkmcnt(0)" ::: "memory");
}
__device__ __forceinline__ void phase_convert(Ctx C) {
    C.refresh();
    LAS float* scr = (LAS float*)(C.lds + C.wave * 16384);
    constexpr int I_IN = (DM / 64) * (D_IN / 32), I_OUT = (D_MIX / 64) * (DM / 32), I_UP = (DM / 64) * (D_UP / 32), I_DN = (D_FF / 64) * (DM / 32), I_L = I_IN + I_OUT + I_UP + I_DN;
    for (int it = C.gw; it < DEPTH * I_L; it += C.NGW) {
        const int l = it / I_L; int r = it % I_L;
        if (r < I_IN) { const int nbk = D_IN / 32; conv_item(C.in[7] + (size_t)l * DM * D_IN, D_IN, C.in[6] + l * DM, (bf16*)(C.ws + WS_BTIN) + (size_t)l * N_INP * DMP, DMP, scr, r / nbk, r % nbk, C.lane); continue; }
        r -= I_IN;
        if (r < I_OUT) { const int nbk = DM / 32, kb = r / nbk, nb = r % nbk; const float* W = C.in[16] + (size_t)l * D_MIX * DM;
            if (kb < 16) conv_item(W, DM, C.in[9] + l * D_POOL, (bf16*)(C.ws + WS_WOP) + (size_t)l * DM * D_POOL, D_POOL, scr, kb, nb, C.lane);
            else conv_item(W, DM, C.in[15] + l * D_SSD - D_POOL, (bf16*)(C.ws + WS_BTOUT) + (size_t)l * DM * D_MIX, D_MIX, scr, kb, nb, C.lane);
            continue; }
        r -= I_OUT;
        if (r < I_UP) { const int nbk = D_UP / 32, nb = r % nbk, n0 = 32 * nb, hv = n0 / D_FF, cc = n0 % D_FF, np = 256 * (cc / 128) + 128 * hv + (cc % 128);
            conv_item(C.in[19] + (size_t)l * DM * D_UP, D_UP, C.in[18] + l * DM, (bf16*)(C.ws + WS_BTUP) + (size_t)l * D_UP * DMP + (long)(np - n0) * DMP, DMP, scr, r / nbk, nb, C.lane); continue; }
        r -= I_UP;
        { const int nbk = DM / 32; conv_item(C.in[22] + (size_t)l * D_FF * DM, DM, nullptr, (bf16*)(C.ws + WS_BTDN) + (size_t)l * DM * D_FF, D_FF, scr, r / nbk, r % nbk, C.lane); }
    }
    { const int gt = C.gw * 64 + C.lane, NGT = C.NGW * 64; constexpr int PER_L = (N_INP - D_IN) * DM / 8;
      for (int i = gt; i < DEPTH * PER_L; i += NGT) { const int l = i / PER_L, r = i % PER_L; *(uint4*)((bf16*)(C.ws + WS_BTIN) + ((size_t)l * N_INP + D_IN + r / (DM / 8)) * DMP + (size_t)(r % (DM / 8)) * 8) = make_uint4(0u, 0u, 0u, 0u); }
      const float* wp = C.in[8]; bf16* wpb = (bf16*)(C.ws + WS_WPB);
      for (int i = gt; i < DEPTH * 4 * 256 * 256 / 8; i += NGT) { const F8 v = ld_f8(wp + (size_t)i * 8); st_bf8(wpb + (size_t)i * 8, v); } }
    for (int row = C.gw; row < M; row += C.NGW) {
        const float* src = row < MP ? C.in[0] + (size_t)row * DM : C.in[1] + (size_t)(row - MP) * DM;
        bf16* XB = (bf16*)(C.ws + WS_XB) + (size_t)row * DMP; float q = 0.f;
#pragma unroll
        for (int j = 0; j < 8; ++j) { const int idx = (C.lane + 64 * j) * 4; const float4 v = *(const float4*)(src + idx); q += (v.x * v.x + v.y * v.y) + (v.z * v.z + v.w * v.w);
            *(uint2*)(XB + idx) = make_uint2(pk2(v.x, v.y), pk2(v.z, v.w)); }
        q = wave_sum(q);
        if (C.lane == 0) ((float*)(C.ws + WS_R))[row] = rsqrtf(q * (1.f / DM) + EPS);
    }
}

__device__ __forceinline__ void phase_dt(Ctx C, int l) {
    C.refresh();
    typedef short bf16x8_t __attribute__((ext_vector_type(8)));
    const bf16* XB = (const bf16*)(C.ws + WS_XB); const bf16* BD = (const bf16*)(C.ws + WS_BTIN) + ((size_t)l * N_INP + N_PROJ) * DMP; const float* R = (const float*)(C.ws + WS_R); float* DT = (float*)(C.ws + WS_DT);
    const int r16 = C.lane & 15, q = C.lane >> 4;
    for (int task = C.gw; task < M / 16; task += C.NGW) {
        const int row0 = task * 16;
        const bf16* ap = XB + (size_t)(row0 + r16) * DMP + 8 * q; const bf16* b0 = BD + (size_t)r16 * DMP + 8 * q; const bf16* b1 = b0 + (size_t)16 * DMP;
        f32x4 acc0 = (f32x4){0.f, 0.f, 0.f, 0.f}, acc1 = acc0;
#pragma unroll 8
        for (int ks = 0; ks < DM / 32; ++ks) { const bf16x8_t a = *(const bf16x8_t*)(ap + 32 * ks);
            acc0 = __builtin_amdgcn_mfma_f32_16x16x32_bf16(a, *(const bf16x8_t*)(b0 + 32 * ks), acc0, 0, 0, 0);
            acc1 = __builtin_amdgcn_mfma_f32_16x16x32_bf16(a, *(const bf16x8_t*)(b1 + 32 * ks), acc1, 0, 0, 0); }
#pragma unroll
        for (int r = 0; r < 4; ++r) { const int row = row0 + 4 * q + r; const float s = R[row]; DT[(size_t)row * 32 + r16] = acc0[r] * s; DT[(size_t)row * 32 + 16 + r16] = acc1[r] * s; }
    }
}

__device__ __forceinline__ void phase_resid(Ctx C, const float* gpost, bool final_out, int nslab) {
    C.refresh();
    const bf16* MIXB = (const bf16*)(C.ws + WS_MIX); const float* SSQ = (const float*)(C.ws + WS_SSQP); const float* SLAB = (const float*)(C.ws + WS_SLAB);
    for (int row = C.gw; row < M; row += C.NGW) {
        F8 mv[4]; float p; uint4 xq[4];
        bf16* XB = (bf16*)(C.ws + WS_XB) + (size_t)row * DMP;
#pragma unroll
        for (int j = 0; j < 4; ++j) xq[j] = *(const uint4*)(XB + (C.lane + 64 * j) * 8);
        if (row < MP) {
            p = C.lane < 32 ? SSQ[(size_t)row * 32 + C.lane] : 0.f;
#pragma unroll
            for (int j = 0; j < 4; ++j) mv[j] = ld_bf8(MIXB + (size_t)row * DM + (C.lane + 64 * j) * 8);
        } else {
            p = 0.f;
#pragma unroll
            for (int j = 0; j < 4; ++j) { F8 a = zero8();
                for (int s = 0; s < nslab; ++s) { const F8 t = ld_f8(SLAB + ((size_t)s * MS + (row - MP)) * DM + (C.lane + 64 * j) * 8);
#pragma unroll
                    for (int k = 0; k < 8; ++k) a.v[k] += t.v[k]; }
                mv[j] = a;
#pragma unroll
                for (int k = 0; k < 8; ++k) p += a.v[k] * a.v[k]; }
        }
        p = wave_sum(p);
        const float rs = rsqrtf(p * (1.f / DM) + EPS);
        float* Y = C.out + O_YP + (size_t)row * DM; float q = 0.f;
#pragma unroll
        for (int j = 0; j < 4; ++j) { const int idx = (C.lane + 64 * j) * 8; const F8 g8 = ld_f8(gpost + idx); F8 v = unpack8(xq[j]);
#pragma unroll
            for (int k = 0; k < 8; ++k) { v.v[k] += mv[j].v[k] * rs * g8.v[k]; q += v.v[k] * v.v[k]; }
            if (final_out) st_f8(Y + idx, v);
            st_bf8(XB + idx, v); }
        q = wave_sum(q);
        if (C.lane == 0) ((float*)(C.ws + WS_R))[row] = rsqrtf(q * (1.f / DM) + EPS);
    }
}

__device__ __forceinline__ void phase_gnorm(Ctx C) {
    C.refresh();
    const float* SSQH = (const float*)(C.ws + WS_SSQH); bf16* MIXA = (bf16*)(C.ws + WS_MIXA);
    for (int rowb = C.gw * 4; rowb < M; rowb += C.NGW * 4) {
        uint4 qv[4][4]; float pr[4];
#pragma unroll
        for (int rr = 0; rr < 4; ++rr) { const int row = rowb + rr; pr[rr] = C.lane < 32 ? SSQH[(size_t)row * 32 + C.lane] : 0.f;
#pragma unroll
            for (int j = 0; j < 4; ++j) qv[rr][j] = *(const uint4*)(MIXA + (size_t)row * D_MIX + D_POOL + (C.lane + 64 * j) * 8); }
#pragma unroll
        for (int rr = 0; rr < 4; ++rr) { const int row = rowb + rr; float p = pr[rr];
#pragma unroll
            for (int o = 1; o < 16; o <<= 1) p += __shfl_xor(p, o);
            const float s0 = __shfl(p, 0), s1 = __shfl(p, 16);
            const float r0 = rsqrtf(s0 * (1.f / 1024.f) + EPS), r1 = rsqrtf(s1 * (1.f / 1024.f) + EPS);
            bf16* y = MIXA + (size_t)row * D_MIX + D_POOL;
#pragma unroll
            for (int j = 0; j < 4; ++j) { const int c = (C.lane + 64 * j) * 8; const float r = c < 1024 ? r0 : r1; F8 v = unpack8(qv[rr][j]);
#pragma unroll
                for (int i = 0; i < 8; ++i) v.v[i] *= r;
                st_bf8(y + c, v); } }
    }
}

__device__ __forceinline__ void phase_act(Ctx C, int l) {
    C.refresh();
    const bf16* UP = (const bf16*)(C.ws + WS_UP); bf16* ACT = (bf16*)(C.ws + WS_ACT);
    const float* cw = C.in[20] + (size_t)l * 3 * D_UP; const float* cb = C.in[21] + (size_t)l * D_UP; const float* hist = C.in[5] + (size_t)l * NB_S * 2 * D_UP;
    constexpr int NCG = D_FF / 8, NSTRIP = M / 32;
    const int gt = C.gw * 64 + C.lane, NGT = C.NGW * 64;
    for (int it = gt + (MP / 32) * NCG; it < NSTRIP * NCG; it += NGT) {
        const int strip = it / NCG, c = (it % NCG) * 8, row0 = strip * 32; const bool prm = row0 < MP;
        const int b = prm ? row0 / SEQ : (row0 - MP) / SEQ_S, t0 = prm ? row0 % SEQ : 0;
        F8 p2g, p1g, p2v, p1v;
        if (t0 == 0) { if (prm) { p2g = zero8(); p1g = zero8(); p2v = zero8(); p1v = zero8(); }
            else { const float* h = hist + (size_t)b * 2 * D_UP; p2g = ld_f8(h + c); p2v = ld_f8(h + D_FF + c); p1g = ld_f8(h + D_UP + c); p1v = ld_f8(h + D_UP + D_FF + c); } }
        else { p2g = ld_bf8(UP + (size_t)(row0 - 2) * D_UP + c); p2v = ld_bf8(UP + (size_t)(row0 - 2) * D_UP + D_FF + c); p1g = ld_bf8(UP + (size_t)(row0 - 1) * D_UP + c); p1v = ld_bf8(UP + (size_t)(row0 - 1) * D_UP + D_FF + c); }
        const F8 w0g = ld_f8(cw + c), w1g = ld_f8(cw + D_UP + c), w2g = ld_f8(cw + 2 * D_UP + c), bg = ld_f8(cb + c);
        const F8 w0v = ld_f8(cw + D_FF + c), w1v = ld_f8(cw + D_UP + D_FF + c), w2v = ld_f8(cw + 2 * D_UP + D_FF + c), bv = ld_f8(cb + D_FF + c);
        for (int r0 = 0; r0 < 32; r0 += 8) {
            uint4 qg[8], qv[8];
#pragma unroll
            for (int r = 0; r < 8; ++r) { qg[r] = *(const uint4*)(UP + (size_t)(row0 + r0 + r) * D_UP + c); qv[r] = *(const uint4*)(UP + (size_t)(row0 + r0 + r) * D_UP + D_FF + c); }
#pragma unroll
            for (int r = 0; r < 8; ++r) { const F8 cg = unpack8(qg[r]), cv = unpack8(qv[r]); F8 o;
#pragma unroll
                for (int i = 0; i < 8; ++i) { const float g = bg.v[i] + w0g.v[i] * p2g.v[i] + w1g.v[i] * p1g.v[i] + w2g.v[i] * cg.v[i]; const float v = bv.v[i] + w0v.v[i] * p2v.v[i] + w1v.v[i] * p1v.v[i] + w2v.v[i] * cv.v[i]; o.v[i] = silu_f(g) * v; }
                st_bf8(ACT + (size_t)(row0 + r0 + r) * D_FF + c, o);
                p2g = p1g; p1g = cg; p2v = p1v; p1v = cv; }
        }
        if (!prm || t0 + 32 == SEQ) {
            float* o = C.out + (prm ? O_FCP + ((size_t)(l * NB_P + b) * 2) * D_UP : O_FCS + ((size_t)(l * NB_S + b) * 2) * D_UP);
            st_f8(o + c, p2g); st_f8(o + D_FF + c, p2v); st_f8(o + D_UP + c, p1g); st_f8(o + D_UP + D_FF + c, p1v);
        }
    }
}

__device__ __forceinline__ void phase_actfix(Ctx C, int l) {
    C.refresh();
    const bf16* SIDE = (const bf16*)(C.ws + WS_SIDE); bf16* ACT = (bf16*)(C.ws + WS_ACT);
    const float* cw = C.in[20] + (size_t)l * 3 * D_UP; const float* cb = C.in[21] + (size_t)l * D_UP;
    constexpr int NCG = D_FF / 8, NBLK = MP / 64;
    const int gt = C.gw * 64 + C.lane, NGT = C.NGW * 64;
    for (int it = gt; it < NBLK * NCG; it += NGT) {
        const int kb = it / NCG, c = (it % NCG) * 8; const bool start = (kb % (SEQ / 64)) == 0;
        const bf16* sp = SIDE + (size_t)(start ? kb : kb - 1) * 4 * D_UP + c; const bf16* sc = SIDE + (size_t)kb * 4 * D_UP + c;
        uint4 q[8];
        q[0] = *(const uint4*)(sp + 2 * D_UP); q[1] = *(const uint4*)(sp + 2 * D_UP + D_FF); q[2] = *(const uint4*)(sp + 3 * D_UP); q[3] = *(const uint4*)(sp + 3 * D_UP + D_FF);
        q[4] = *(const uint4*)(sc); q[5] = *(const uint4*)(sc + D_FF); q[6] = *(const uint4*)(sc + D_UP); q[7] = *(const uint4*)(sc + D_UP + D_FF);
        F8 p2g = unpack8(q[0]), p2v = unpack8(q[1]), p1g = unpack8(q[2]), p1v = unpack8(q[3]); const F8 r0g = unpack8(q[4]), r0v = unpack8(q[5]), r1g = unpack8(q[6]), r1v = unpack8(q[7]);
        if (start) { p2g = zero8(); p2v = zero8(); p1g = zero8(); p1v = zero8(); }
        const F8 w0g = ld_f8(cw + c), w1g = ld_f8(cw + D_UP + c), w2g = ld_f8(cw + 2 * D_UP + c), bg = ld_f8(cb + c);
        const F8 w0v = ld_f8(cw + D_FF + c), w1v = ld_f8(cw + D_UP + D_FF + c), w2v = ld_f8(cw + 2 * D_UP + D_FF + c), bv = ld_f8(cb + D_FF + c);
        F8 o0, o1;
#pragma unroll
        for (int i = 0; i < 8; ++i) { const float g0 = bg.v[i] + w0g.v[i] * p2g.v[i] + w1g.v[i] * p1g.v[i] + w2g.v[i] * r0g.v[i], v0 = bv.v[i] + w0v.v[i] * p2v.v[i] + w1v.v[i] * p1v.v[i] + w2v.v[i] * r0v.v[i];
            const float g1 = bg.v[i] + w0g.v[i] * p1g.v[i] + w1g.v[i] * r0g.v[i] + w2g.v[i] * r1g.v[i], v1 = bv.v[i] + w0v.v[i] * p1v.v[i] + w1v.v[i] * r0v.v[i] + w2v.v[i] * r1v.v[i];
            o0.v[i] = silu_f(g0) * v0; o1.v[i] = silu_f(g1) * v1; }
        st_bf8(ACT + (size_t)(kb * 64) * D_FF + c, o0); st_bf8(ACT + (size_t)(kb * 64 + 1) * D_FF + c, o1);
        if ((kb % (SEQ / 64)) == SEQ / 64 - 1) {
            float* o = C.out + O_FCP + ((size_t)(l * NB_P + kb / (SEQ / 64)) * 2) * D_UP;
            st_f8(o + c, ld_bf8(sc + 2 * D_UP)); st_f8(o + D_FF + c, ld_bf8(sc + 2 * D_UP + D_FF)); st_f8(o + D_UP + c, ld_bf8(sc + 3 * D_UP)); st_f8(o + D_UP + D_FF + c, ld_bf8(sc + 3 * D_UP + D_FF)); }
    }
}

__device__ __forceinline__ void phase_pool(Ctx C, int l) {
    C.refresh();
    const bf16* PROJ = (const bf16*)(C.ws + WS_PROJ); bf16* MIXA = (bf16*)(C.ws + WS_MIXA);
    const float* hist = C.in[2] + (size_t)l * NB_S * POOL_HIST * D_POOL;
    constexpr int NCG = D_POOL / 8, NSTRIP = M / 32;
    const int gt = C.gw * 64 + C.lane, NGT = C.NGW * 64;
    for (int it = gt; it < NSTRIP * NCG; it += NGT) {
        const int strip = it / NCG, cgi = it % NCG, c = cgi * 8, row0 = strip * 32; const bool prm = row0 < MP;
        const int b = prm ? row0 / SEQ : (row0 - MP) / SEQ_S, t0 = prm ? row0 % SEQ : 0, w = 2 << (cgi >> 5);
        const int rb = row0 - t0;
        const float* hb = hist + (size_t)b * POOL_HIST * D_POOL;
        F8 s = zero8();
        for (int i = 1; i < w; ++i) { const int t = t0 - i; F8 v;
            if (t >= 0) v = ld_bf8(PROJ + (size_t)(rb + t) * N_PROJ + c); else if (!prm) v = ld_f8(hb + (size_t)(POOL_HIST + t) * D_POOL + c); else v = zero8();
#pragma unroll
            for (int k = 0; k < 8; ++k) s.v[k] += v.v[k]; }
        for (int r0 = 0; r0 < 32; r0 += 8) {
            uint4 qc[8], ql[8];
#pragma unroll
            for (int r = 0; r < 8; ++r) { const int t = t0 + r0 + r, tl = t - w + 1; qc[r] = *(const uint4*)(PROJ + (size_t)(rb + t) * N_PROJ + c); ql[r] = *(const uint4*)(PROJ + (size_t)(rb + (tl > 0 ? tl : 0)) * N_PROJ + c); }
#pragma unroll
            for (int r = 0; r < 8; ++r) { const int t = t0 + r0 + r, tl = t - w + 1; const F8 cur = unpack8(qc[r]);
                const float inv = 1.f / (float)(prm ? (t + 1 < w ? t + 1 : w) : w); F8 o;
#pragma unroll
                for (int k = 0; k < 8; ++k) { s.v[k] += cur.v[k]; o.v[k] = s.v[k] * inv - cur.v[k]; }
                st_bf8(MIXA + (size_t)(rb + t) * D_MIX + c, o);
                F8 v = unpack8(ql[r]);
                if (tl < 0) { if (!prm) v = ld_f8(hb + (size_t)(POOL_HIST + tl) * D_POOL + c); else v = zero8(); }
#pragma unroll
                for (int k = 0; k < 8; ++k) s.v[k] -= v.v[k]; }
        }
    }
    for (int it = gt; it < (NB_P + NB_S) * 15 * NCG; it += NGT) {
        const int cg = it % NCG, i = (it / NCG) % 15, sb = it / (NCG * 15); const bool prm = sb < NB_P; const int b = prm ? sb : sb - NB_P;
        const int row = prm ? b * SEQ + (SEQ - 15 + i) : MP + b * SEQ_S + (SEQ_S - 15 + i);
        float* o = C.out + (prm ? O_POOLP + ((size_t)(l * NB_P + b) * 15 + i) * D_POOL : O_POOLS + ((size_t)(l * NB_S + b) * 15 + i) * D_POOL);
        st_f8(o + cg * 8, ld_bf8(PROJ + (size_t)row * N_PROJ + cg * 8));
    }
    constexpr int NCG2 = CONV_DIM / 8;
    for (int it = gt; it < (NB_P + NB_S) * 3 * NCG2; it += NGT) {
        const int cg = it % NCG2, i = (it / NCG2) % 3, sb = it / (NCG2 * 3); const bool prm = sb < NB_P; const int b = prm ? sb : sb - NB_P;
        const int row = prm ? b * SEQ + (SEQ - 3 + i) : MP + b * SEQ_S + (SEQ_S - 3 + i);
        float* o = C.out + (prm ? O_SCP + ((size_t)(l * NB_P + b) * 3 + i) * CONV_DIM : O_SCS + ((size_t)(l * NB_S + b) * 3 + i) * CONV_DIM);
        st_f8(o + cg * 8, ld_bf8(PROJ + (size_t)row * N_PROJ + XBC0 + cg * 8));
    }
}

__device__ __forceinline__ void phase_ssd(Ctx C, int l) {
    C.refresh();
    LAS float* xs = (LAS float*)(C.lds); LAS float* Bs = (LAS float*)(C.lds + 16384); LAS float* Cs = (LAS float*)(C.lds + 49152); LAS float* ys = (LAS float*)(C.lds + 81920);
    LAS float* dts = (LAS float*)(C.lds + 98304); LAS float* dAs = dts + 64;
    const bf16* PROJ = (const bf16*)(C.ws + WS_PROJ); const float* DT = (const float*)(C.ws + WS_DT); bf16* MIXA = (bf16*)(C.ws + WS_MIXA); float* SSQH = (float*)(C.ws + WS_SSQH);
    const float* cw = C.in[10] + (size_t)l * 4 * CONV_DIM; const float* cb = C.in[11] + (size_t)l * CONV_DIM;
    const int tid = C.tid, p = tid >> 3, n0 = (tid & 7) * 16;
    for (int u = blockIdx.x; u < NB_P * NH + NB_S * NH; u += C.G) {
        const bool prm = u < NB_P * NH; const int su = prm ? u : u - NB_P * NH, b = su / NH, hh = su % NH, g = hh / HPG;
        const int rb = prm ? b * SEQ : MP + b * SEQ_S, rows = prm ? 64 : 32, nchunk = prm ? SEQ / 64 : 1;
        const float Aneg = -__expf(C.in[13][l * NH + hh]), Dsk = C.in[14][l * NH + hh], dtb = C.in[12][l * NH + hh];
        const float* chist = C.in[3] + ((size_t)(l * NB_S + b) * 3) * CONV_DIM;
        float h[16];
        if (prm) {
#pragma unroll
            for (int i = 0; i < 16; ++i) h[i] = 0.f;
        } else { const float* h0 = C.in[4] + ((((size_t)l * NB_S + b) * NH + hh) * HD + p) * DS + n0;
#pragma unroll
            for (int i = 0; i < 4; ++i) { const float4 v = *(const float4*)(h0 + 4 * i); h[4 * i] = v.x; h[4 * i + 1] = v.y; h[4 * i + 2] = v.z; h[4 * i + 3] = v.w; } }
        for (int ch = 0; ch < nchunk; ++ch) {
            const int tb = ch * 64;
            for (int e = tid; e < rows * 40; e += NTHR) {
                const int cg = e % 40, tt = e / 40, t = tb + tt;
                int cc; LAS float* dstp;
                if (cg < 8) { cc = hh * HD + cg * 8; dstp = xs + tt * 64 + cg * 8; }
                else if (cg < 24) { cc = D_SSD + g * DS + (cg - 8) * 8; dstp = Bs + tt * 128 + (cg - 8) * 8; }
                else { cc = D_SSD + 2 * DS + g * DS + (cg - 24) * 8; dstp = Cs + tt * 128 + (cg - 24) * 8; }
                F8 a = ld_f8(cb + cc);
#pragma unroll
                for (int i = 0; i < 4; ++i) { const int ti = t - 3 + i; F8 v;
                    if (ti >= 0) v = ld_bf8(PROJ + (size_t)(rb + ti) * N_PROJ + XBC0 + cc); else if (!prm) v = ld_f8(chist + (size_t)(3 + ti) * CONV_DIM + cc); else v = zero8();
                    const F8 wv = ld_f8(cw + (size_t)i * CONV_DIM + cc);
#pragma unroll
                    for (int k = 0; k < 8; ++k) a.v[k] += wv.v[k] * v.v[k]; }
#pragma unroll
                for (int k = 0; k < 8; ++k) dstp[k] = silu_f(a.v[k]);
            }
            if (tid < rows) { const float xr = DT[(size_t)(rb + tb + tid) * 32 + hh] + dtb; const float dtv = xr > 20.f ? xr : log1pf(__expf(xr)); dts[tid] = dtv; dAs[tid] = __expf(dtv * Aneg); }
            __syncthreads();
            for (int tt = 0; tt < rows; ++tt) {
                const float xv = xs[tt * 64 + p], xdt = xv * dts[tt], dA = dAs[tt]; float acc = 0.f;
#pragma unroll
                for (int i = 0; i < 4; ++i) { const f32x4 bv = *(const LAS f32x4*)(Bs + tt * 128 + n0 + 4 * i), cv = *(const LAS f32x4*)(Cs + tt * 128 + n0 + 4 * i);
                    h[4 * i] = dA * h[4 * i] + xdt * bv[0]; acc += cv[0] * h[4 * i];
                    h[4 * i + 1] = dA * h[4 * i + 1] + xdt * bv[1]; acc += cv[1] * h[4 * i + 1];
                    h[4 * i + 2] = dA * h[4 * i + 2] + xdt * bv[2]; acc += cv[2] * h[4 * i + 2];
                    h[4 * i + 3] = dA * h[4 * i + 3] + xdt * bv[3]; acc += cv[3] * h[4 * i + 3]; }
                acc += __shfl_xor(acc, 1); acc += __shfl_xor(acc, 2); acc += __shfl_xor(acc, 4);
                if ((tid & 7) == 0) ys[tt * 64 + p] = acc + Dsk * xv;
            }
            __syncthreads();
            for (int e = tid; e < rows * 64; e += NTHR) {
                const int tt = e >> 6, pp = e & 63; const size_t row = (size_t)(rb + tb + tt);
                const float zv = bf2f(PROJ[row * N_PROJ + D_POOL + hh * HD + pp]); const float yz = ys[tt * 64 + pp] * silu_f(zv);
                MIXA[row * D_MIX + D_POOL + hh * HD + pp] = (bf16)f2bf(yz);
                const float q = wave_sum(yz * yz);
                if (pp == 0) SSQH[row * 32 + hh] = q;
            }
            __syncthreads();
        }
        float* ho = C.out + (prm ? O_SSDP + ((((size_t)l * NB_P + b) * NH + hh) * HD + p) * DS + n0 : O_SSDS + ((((size_t)l * NB_S + b) * NH + hh) * HD + p) * DS + n0);
#pragma unroll
        for (int i = 0; i < 4; ++i) *(float4*)(ho + 4 * i) = make_float4(h[4 * i], h[4 * i + 1], h[4 * i + 2], h[4 * i + 3]);
    }
}

constexpr int SL_C = 0, SL_B = 17408, SL_BWT = 34816, SL_XT = 53248, SL_H = 62464, SL_M = 79872, SL_DT = 89088, SL_AC = SL_DT + 512, SL_W = SL_AC + 512, SL_DEC = SL_W + 512, SL_SSQ = SL_DEC + 16, SL_CW = SL_SSQ + 1024;
constexpr int PC = 272, PT = 144;
typedef short bf16x8_t __attribute__((ext_vector_type(8)));
__device__ __forceinline__ bf16x8_t ld_op(const LAS unsigned char* base, int row, int pitch, int kelem) { return *(const LAS bf16x8_t*)(base + row * pitch + kelem * 2); }
__device__ __forceinline__ int swz(int row, int byte) { return byte ^ (((row >> 3) & 7) << 4); }
__device__ __forceinline__ bf16x8_t ld_op_sw(const LAS unsigned char* base, int row, int pitch, int kelem) { return *(const LAS bf16x8_t*)(base + row * pitch + swz(row, kelem * 2)); }

typedef unsigned u32x4_t __attribute__((ext_vector_type(4)));
typedef unsigned u32x2_t __attribute__((ext_vector_type(2)));
__device__ __forceinline__ F8 lds_f8(const LAS float* p) { const f32x4 a = *(const LAS f32x4*)p, b = *(const LAS f32x4*)(p + 4); F8 r; r.v[0] = a[0]; r.v[1] = a[1]; r.v[2] = a[2]; r.v[3] = a[3]; r.v[4] = b[0]; r.v[5] = b[1]; r.v[6] = b[2]; r.v[7] = b[3]; return r; }
__device__ __forceinline__ void ssd_stage(LAS unsigned char* L, int cg, int l0, int rows_valid, const LAS float* cwl, const LAS float* w_s, const uint4 (&rawq)[11]) {
    F8 cwv[4];
#pragma unroll
    for (int i = 0; i < 4; ++i) cwv[i] = lds_f8(cwl + 8 * i);
    const F8 cbv = lds_f8(cwl + 32);
#pragma unroll
    for (int h = 0; h < 2; ++h) {
        float o[4][8];
#pragma unroll
        for (int i = 0; i < 4; ++i)
#pragma unroll
            for (int k = 0; k < 8; ++k) o[i][k] = cbv.v[k];
#pragma unroll
        for (int jj = 0; jj < 7; ++jj) { const F8 rj = unpack8(rawq[4 * h + jj]);
#pragma unroll
            for (int i = 0; i < 4; ++i) { const int tap = jj - i;
                if (tap >= 0 && tap < 4) {
#pragma unroll
                    for (int k = 0; k < 8; ++k) o[i][k] += cwv[tap].v[k] * rj.v[k]; } } }
        const int lb = l0 + 4 * h;
#pragma unroll
        for (int i = 0; i < 4; ++i) { const float okf = lb + i < rows_valid ? 1.f : 0.f;
#pragma unroll
            for (int k = 0; k < 8; ++k) o[i][k] = silu_f(o[i][k]) * okf; }
        if (cg < 8) {
#pragma unroll
            for (int k = 0; k < 8; ++k) *(LAS u32x2_t*)(L + SL_XT + (8 * cg + k) * PT + swz(8 * cg + k, lb * 2)) = (u32x2_t){pk2(o[0][k], o[1][k]), pk2(o[2][k], o[3][k])};
        } else if (cg < 24) { const int n0 = 8 * (cg - 8);
#pragma unroll
            for (int i = 0; i < 4; ++i) *(LAS u32x4_t*)(L + SL_B + (lb + i) * PC + n0 * 2) = (u32x4_t){pk2(o[i][0], o[i][1]), pk2(o[i][2], o[i][3]), pk2(o[i][4], o[i][5]), pk2(o[i][6], o[i][7])};
            const f32x4 wl = *(const LAS f32x4*)(w_s + lb);
#pragma unroll
            for (int k = 0; k < 8; ++k) *(LAS u32x2_t*)(L + SL_BWT + (n0 + k) * PT + swz(n0 + k, lb * 2)) = (u32x2_t){pk2(o[0][k] * wl[0], o[1][k] * wl[1]), pk2(o[2][k] * wl[2], o[3][k] * wl[3])};
        } else { const int n0 = 8 * (cg - 24);
#pragma unroll
            for (int i = 0; i < 4; ++i) *(LAS u32x4_t*)(L + SL_C + (lb + i) * PC + n0 * 2) = (u32x4_t){pk2(o[i][0], o[i][1]), pk2(o[i][2], o[i][3]), pk2(o[i][4], o[i][5]), pk2(o[i][6], o[i][7])};
        }
        __builtin_amdgcn_sched_barrier(0);
    }
}
__device__ __forceinline__ void ssd_dt(LAS unsigned char* L, int par, float xr, bool valid, float Aneg, int lane) {
    const float dtv = valid ? (xr > 20.f ? xr : log1pf(__expf(xr))) : 0.f;
    float a = dtv * Aneg;
#pragma unroll
    for (int o = 1; o < 64; o <<= 1) { const float v = __shfl_up(a, o); if (lane >= o) a += v; }
    const float last = __shfl(a, 63);
    ((LAS float*)(L + SL_DT))[par * 64 + lane] = dtv; ((LAS float*)(L + SL_AC))[par * 64 + lane] = a; ((LAS float*)(L + SL_W))[par * 64 + lane] = dtv * __expf(last - a);
    if (lane == 0) ((LAS float*)(L + SL_DEC))[par] = __expf(last);
}
#define WG_BAR() do { asm volatile("s_waitcnt lgkmcnt(0)" ::: "memory"); __builtin_amdgcn_s_barrier(); asm volatile("" ::: "memory"); } while (0)
__device__ __forceinline__ void stage_role(int tq, int& cg, int& l0) {
    const int ws = tq >> 6, lane = tq & 63;
    if (ws == 0) { cg = lane & 7; l0 = (lane >> 3) * 8; }
    else { const int idx = ((ws - 1) & 1) * 64 + lane; cg = (ws <= 2 ? 8 : 24) + (idx & 15); l0 = (idx >> 4) * 8; }
}
#define OPQ_V(x) asm volatile("" : "+v"(x))
#define OPQ_S(x) asm volatile("" : "+s"(x))
__device__ __forceinline__ void phase_ssd2(Ctx C, int l) {
    C.refresh();
    LAS unsigned char* L = C.lds;
    const bf16* PROJ = (const bf16*)(C.ws + WS_PROJ); const float* DT = (const float*)(C.ws + WS_DT); bf16* MIXA = (bf16*)(C.ws + WS_MIXA); float* SSQH = (float*)(C.ws + WS_SSQH);
    const int w0 = C.wave;
#define tid0 (w0 * 64 + lane_id())
    typedef float f4 __attribute__((ext_vector_type(4)));
#if PROBE_SEL > 0
    volatile LAS unsigned* MISC2 = (volatile LAS unsigned*)(C.lds + LDSCTL_OFF);
    if (blockIdx.x == 0 && w0 == 0 && lane_id() == 0) MISC2[13] = (unsigned)__builtin_amdgcn_s_memrealtime();
#define STAMP2(ty) do { if (blockIdx.x == 0 && w0 == 0 && lane_id() == 0) { const unsigned tn = (unsigned)__builtin_amdgcn_s_memrealtime(); MISC2[16 + (ty)] += tn - MISC2[13]; MISC2[13] = tn; } } while (0)
#else
#define STAMP2(ty) do { } while (0)
#endif
    for (int u = blockIdx.x; u < NB_P * NH + NB_S * NH; u += C.G) {
        STAMP2(19);
        const bool prm = u < NB_P * NH; const int su = prm ? u : u - NB_P * NH, b = su / NH, hh = su % NH, g = hh / HPG;
        const int rb = prm ? b * SEQ : MP + b * SEQ_S, rows = prm ? 64 : 32, nchunk = prm ? SEQ / 64 : 1;
        const float Aneg = -__expf(C.in[13][l * NH + hh]), Dsk = C.in[14][l * NH + hh], dtb = C.in[12][l * NH + hh];
        f4 hacc[4]; float xrn;
        {
            uint4 rawq[11];
            int tq = tid0, w = w0; OPQ_V(tq); OPQ_S(w);
            const int lane = tq & 63, r16 = lane & 15, q = lane >> 4; const bool stg = tq < 320; int cg, l0; stage_role(tq, cg, l0); if (!stg) { cg = 0; l0 = 0; }
            const float* chist = C.in[3] + ((size_t)(l * NB_S + b) * 3) * CONV_DIM;
            const int cc = cg < 8 ? hh * HD + cg * 8 : (cg < 24 ? D_SSD + g * DS + (cg - 8) * 8 : D_SSD + 2 * DS + g * DS + (cg - 24) * 8);
            LAS float* cwl = (LAS float*)(L + SL_CW) + cg * 40;
            if (stg && l0 == 0) { const float* cw = C.in[10] + (size_t)l * 4 * CONV_DIM + cc;
#pragma unroll
                for (int i = 0; i < 4; ++i) { const F8 v = ld_f8(cw + (size_t)i * CONV_DIM); *(LAS f32x4*)(cwl + 8 * i) = (f32x4){v.v[0], v.v[1], v.v[2], v.v[3]}; *(LAS f32x4*)(cwl + 8 * i + 4) = (f32x4){v.v[4], v.v[5], v.v[6], v.v[7]}; }
                const F8 v = ld_f8(C.in[11] + (size_t)l * CONV_DIM + cc); *(LAS f32x4*)(cwl + 32) = (f32x4){v.v[0], v.v[1], v.v[2], v.v[3]}; *(LAS f32x4*)(cwl + 36) = (f32x4){v.v[4], v.v[5], v.v[6], v.v[7]}; }
#pragma unroll
            for (int pj = 0; pj < 4; ++pj) {
                if (prm) hacc[pj] = (f4){0.f, 0.f, 0.f, 0.f};
                else { const float4 v = *(const float4*)(C.in[4] + ((((size_t)l * NB_S + b) * NH + hh) * HD + 16 * pj + r16) * DS + 16 * w + 4 * q); hacc[pj] = (f4){v.x, v.y, v.z, v.w}; }
                *(LAS u32x2_t*)(L + SL_H + (16 * pj + r16) * PC + (16 * w + 4 * q) * 2) = (u32x2_t){pk2(hacc[pj][0], hacc[pj][1]), pk2(hacc[pj][2], hacc[pj][3])};
            }
            const float xr0 = DT[((size_t)rb + (lane < rows ? lane : 0)) * 32 + hh] + dtb;
            {
                const int l0c = l0; const unsigned lo = stg ? (unsigned)(l0c * N_PROJ + cc) * 2u : 0u;
                uint4 pv[11]; F8 hv[3];
#pragma unroll
                for (int j = 0; j < 11; ++j) { const int jr = (j < 3 && l0c == 0) ? 3 : j;
                    const char* ub = (const char*)PROJ + (((size_t)rb) * N_PROJ + XBC0) * 2; pv[j] = *(const uint4*)(ub + ((long)lo + (long)(jr - 3) * (N_PROJ * 2))); }
#pragma unroll
                for (int j = 0; j < 3; ++j) hv[j] = ld_f8((const float*)((const char*)(chist + (size_t)j * CONV_DIM) + (unsigned)cc * 4u));
#pragma unroll
                for (int j = 0; j < 11; ++j) { const int t = l0c - 3 + j; uint4 v = pv[j];
                    if (j < 3) { const uint4 hq = make_uint4(pk2(hv[j].v[0], hv[j].v[1]), pk2(hv[j].v[2], hv[j].v[3]), pk2(hv[j].v[4], hv[j].v[5]), pk2(hv[j].v[6], hv[j].v[7]));
                        const bool useh = t < 0 && !prm, zero = t < 0 && prm;
                        v.x = useh ? hq.x : (zero ? 0u : v.x); v.y = useh ? hq.y : (zero ? 0u : v.y); v.z = useh ? hq.z : (zero ? 0u : v.z); v.w = useh ? hq.w : (zero ? 0u : v.w); }
                    const bool beyond = t >= rows;
                    v.x = beyond ? 0u : v.x; v.y = beyond ? 0u : v.y; v.z = beyond ? 0u : v.z; v.w = beyond ? 0u : v.w;
                    rawq[j] = v; }
            }
            if (w == 0) ssd_dt(L, 0, xr0, lane < rows, Aneg, lane);
            xrn = DT[((size_t)(rb + 64) + lane) * 32 + hh] + dtb;
            WG_BAR();
            if (stg) ssd_stage(L, cg, l0, rows, cwl, (const LAS float*)(L + SL_W), rawq);
            WG_BAR();
        }
        STAMP2(13);
        for (int c = 0; c < nchunk; ++c) {
            const int par = c & 1, tb = c * 64; const bool more = c + 1 < nchunk;
            uint2 zq[2]; uint4 rawq[11];
            {
                int tq = tid0, w = w0; OPQ_V(tq); OPQ_S(w);
                const int lane = tq & 63, r16 = lane & 15, q = lane >> 4;
                const float xrc = xrn;
                xrn = DT[((size_t)(rb + tb + 128) + lane) * 32 + hh] + dtb;
                {
                    int cg, l0c; stage_role(tq, cg, l0c);
                    const int cc = cg < 8 ? hh * HD + cg * 8 : (cg < 24 ? D_SSD + g * DS + (cg - 8) * 8 : D_SSD + 2 * DS + g * DS + (cg - 24) * 8);
                    const unsigned lo = tq < 320 ? (unsigned)(l0c * N_PROJ + cc) * 2u : 0u;
#pragma unroll
                    for (int j = 0; j < 11; ++j) { const char* ub = (const char*)PROJ + ((size_t)(rb + tb + 61 + j) * N_PROJ + XBC0) * 2; rawq[j] = *(const uint4*)(ub + lo); }
                }
                { const int pi = w >> 1, li0 = 2 * (w & 1);
#pragma unroll
                  for (int t = 0; t < 2; ++t) { const int lrow = 16 * (li0 + t) + r16; const char* ub = (const char*)PROJ + ((size_t)(rb + tb + 16 * (li0 + t)) * N_PROJ + D_POOL + hh * HD + 16 * pi) * 2;
                    zq[t] = lrow < rows ? *(const uint2*)(ub + (unsigned)(r16 * N_PROJ + 4 * q) * 2u) : make_uint2(0u, 0u); } }
                if (more && w == 0) ssd_dt(L, par ^ 1, xrc, true, Aneg, lane);
                const LAS float* ac = (const LAS float*)(L + SL_AC) + par * 64; const LAS float* dts = (const LAS float*)(L + SL_DT) + par * 64;
#pragma unroll
                for (int t = 0; t < 2; ++t) { const int T = 2 * w + t, si = T >> 2, li = T & 3; f4 acc = (f4){0.f, 0.f, 0.f, 0.f};
#pragma unroll
                    for (int ks = 0; ks < 4; ++ks) acc = __builtin_amdgcn_mfma_f32_16x16x32_bf16(ld_op(L + SL_B, 16 * si + r16, PC, 32 * ks + 8 * q), ld_op(L + SL_C, 16 * li + r16, PC, 32 * ks + 8 * q), acc, 0, 0, 0);
                    const int lr = 16 * li + r16, s0 = 16 * si + 4 * q; const float al = ac[lr]; const f4 as = *(const LAS f4*)(ac + s0), ds = *(const LAS f4*)(dts + s0); float m[4];
#pragma unroll
                    for (int r = 0; r < 4; ++r) m[r] = (s0 + r <= lr) ? acc[r] * __expf(al - as[r]) * ds[r] : 0.f;
                    *(LAS u32x2_t*)(L + SL_M + lr * PT + s0 * 2) = (u32x2_t){pk2(m[0], m[1]), pk2(m[2], m[3])}; }
            }
            WG_BAR(); STAMP2(14);
            {
                int tq = tid0, w = w0; OPQ_V(tq); OPQ_S(w);
                const int lane = tq & 63, r16 = lane & 15, q = lane >> 4, pi = w >> 1, li0 = 2 * (w & 1);
                const LAS float* ac = (const LAS float*)(L + SL_AC) + par * 64;
#pragma unroll
                for (int t = 0; t < 2; ++t) { const int li = li0 + t; f4 yd = (f4){0.f, 0.f, 0.f, 0.f}, yo = (f4){0.f, 0.f, 0.f, 0.f};
#pragma unroll
                    for (int ks = 0; ks < 2; ++ks) yd = __builtin_amdgcn_mfma_f32_16x16x32_bf16(ld_op_sw(L + SL_XT, 16 * pi + r16, PT, 32 * ks + 8 * q), ld_op(L + SL_M, 16 * li + r16, PT, 32 * ks + 8 * q), yd, 0, 0, 0);
#pragma unroll
                    for (int ks = 0; ks < 4; ++ks) yo = __builtin_amdgcn_mfma_f32_16x16x32_bf16(ld_op(L + SL_H, 16 * pi + r16, PC, 32 * ks + 8 * q), ld_op(L + SL_C, 16 * li + r16, PC, 32 * ks + 8 * q), yo, 0, 0, 0);
                    const int lr = 16 * li + r16, p0 = 16 * pi + 4 * q; const float e = __expf(ac[lr]);
                    const float zf[4] = {bflo(zq[t].x), bfhi(zq[t].x), bflo(zq[t].y), bfhi(zq[t].y)}; float yz[4], ss = 0.f;
#pragma unroll
                    for (int r = 0; r < 4; ++r) { const float xv = bf2f(*(const LAS bf16*)(L + SL_XT + (p0 + r) * PT + swz(p0 + r, lr * 2))); const float y = yd[r] + e * yo[r] + Dsk * xv; yz[r] = y * silu_f(zf[r]); ss += yz[r] * yz[r]; }
                    if (lr < rows) { char* ub = (char*)MIXA + ((size_t)(rb + tb + 16 * li) * D_MIX + D_POOL + hh * HD + 16 * pi) * 2; *(uint2*)(ub + (unsigned)(r16 * D_MIX + 4 * q) * 2u) = make_uint2(pk2(yz[0], yz[1]), pk2(yz[2], yz[3])); }
                    ss += __shfl_xor(ss, 16); ss += __shfl_xor(ss, 32);
                    if (q == 0) ((LAS float*)(L + SL_SSQ))[lr * 4 + pi] = ss; }
            }
            {
                int tq = tid0, w = w0; OPQ_V(tq); OPQ_S(w);
                const int lane = tq & 63, r16 = lane & 15, q = lane >> 4;
                const float dec = ((const LAS float*)(L + SL_DEC))[par];
#pragma unroll
                for (int pj = 0; pj < 4; ++pj) { hacc[pj] = hacc[pj] * dec;
#pragma unroll
                    for (int ks = 0; ks < 2; ++ks) hacc[pj] = __builtin_amdgcn_mfma_f32_16x16x32_bf16(ld_op_sw(L + SL_BWT, 16 * w + r16, PT, 32 * ks + 8 * q), ld_op_sw(L + SL_XT, 16 * pj + r16, PT, 32 * ks + 8 * q), hacc[pj], 0, 0, 0); }
            }
            WG_BAR(); STAMP2(15);
            {
                int tq = tid0, w = w0; OPQ_V(tq); OPQ_S(w);
                const int lane = tq & 63, r16 = lane & 15, q = lane >> 4;
#pragma unroll
                for (int pj = 0; pj < 4; ++pj) *(LAS u32x2_t*)(L + SL_H + (16 * pj + r16) * PC + (16 * w + 4 * q) * 2) = (u32x2_t){pk2(hacc[pj][0], hacc[pj][1]), pk2(hacc[pj][2], hacc[pj][3])};
                if (more && tq < 320) { int cg, l0; stage_role(tq, cg, l0); ssd_stage(L, cg, l0, 64, (const LAS float*)(L + SL_CW) + cg * 40, (const LAS float*)(L + SL_W) + (par ^ 1) * 64, rawq); }
                if (tq >= 448 && (tq - 448) < rows) { const int lr = tq - 448; const f4 s4 = *(const LAS f4*)(L + SL_SSQ + lr * 16); SSQH[(size_t)(rb + tb + lr) * 32 + hh] = (s4[0] + s4[1]) + (s4[2] + s4[3]); }
            }
            WG_BAR();
            STAMP2(16);
        }
        {
            int tq = tid0, w = w0; OPQ_V(tq); OPQ_S(w);
            const int lane = tq & 63, r16 = lane & 15, q = lane >> 4;
            float* ho = C.out + (prm ? O_SSDP + (((size_t)l * NB_P + b) * NH + hh) * HD * DS : O_SSDS + (((size_t)l * NB_S + b) * NH + hh) * HD * DS);
#pragma unroll
            for (int pj = 0; pj < 4; ++pj) *(float4*)(ho + (size_t)(16 * pj + r16) * DS + 16 * w + 4 * q) = make_float4(hacc[pj][0], hacc[pj][1], hacc[pj][2], hacc[pj][3]); }
    }
}

#undef tid0
constexpr int PH_CONV = 0, PH_FOLD = 1, PH_L0 = 2, PH_PER_L = 9, N_PHASES = PH_L0 + DEPTH * PH_PER_L;
constexpr int CW_BAR = 4096;

__global__ void __launch_bounds__(NTHR, 2) fwd_kernel(Args args) {
    extern __shared__ __attribute__((aligned(16))) unsigned char lds_raw[];
    Ctx C; C.lds = (LAS unsigned char*)lds_raw; C.G = gridDim.x; C.in = args.in; C.out = args.out; C.ws = args.ws; C.wave0 = __builtin_amdgcn_readfirstlane(threadIdx.x >> 6); C.refresh();
    volatile LAS unsigned* MISC = (volatile LAS unsigned*)(C.lds + LDSCTL_OFF);
    if (threadIdx.x < 64) MISC[threadIdx.x] = 0u;
#define LEAD() (C.wave0 == 0 && lane_id() == 0)
    __syncthreads();
    const int lo = args.ph_lo, hi = args.ph_hi;
    unsigned* barw = (unsigned*)(args.ws + WS_CTL) + CW_BAR;
    XcdBarrier bar; bar.bar = barw; bar.x = 0; bar.st = MISC + 8;
    if (hi - lo > 1) bar = xcd_barrier_post(barw, MISC + 8, LEAD());
#define IN(k) (lo <= (k) && (k) < hi)
#if PROBE_SEL > 0
    if (blockIdx.x == 0 && LEAD()) { MISC[12] = (unsigned)__builtin_amdgcn_s_memrealtime(); MISC[14] = (unsigned)__builtin_amdgcn_s_memrealtime(); MISC[15] = (unsigned)clock64(); }
#define STAMP(ty) do { if (blockIdx.x == 0 && LEAD()) { const unsigned tn = (unsigned)__builtin_amdgcn_s_memrealtime(); MISC[16 + (ty)] += tn - MISC[12]; MISC[12] = tn; } } while (0)
#else
#define STAMP(ty) do { } while (0)
#endif
#define SEAM(k) do { if ((k) + 1 < hi) xcd_barrier(bar, LEAD()); } while (0)
    LAS unsigned char* ring = C.lds;
    const int vcu = (C.G % 8 == 0) ? ((int)blockIdx.x % 8) * (C.G / 8) + (int)blockIdx.x / 8 : (int)blockIdx.x;

    if (IN(PH_CONV)) { phase_convert(C); SEAM(PH_CONV); STAMP(0); }
    if (IN(PH_FOLD)) {
        for (int w = (int)blockIdx.x; w < DEPTH * 4 * 8; w += C.G) { const int lg = w >> 3, l = lg >> 2, g = lg & 3;
            pg8::Gemm gm{(const bf16*)(C.ws + WS_WOP) + (size_t)l * DM * D_POOL + g * 256, (const bf16*)(C.ws + WS_WPB) + (size_t)lg * 65536, DM, 256, 256, D_POOL, 256, 0};
            pg8::StaticOrder S; S.init(DM, 256, 8, w & 7);
            pg8::EpiBf16S E{(bf16*)(C.ws + WS_BTOUT) + (size_t)l * DM * D_MIX + g * 256, D_MIX, nullptr, nullptr, -1};
            pg8::gemm_phase<pg8::EpiBf16S, pg8::StaticOrder, true, true>(ring, gm, S, E, C.wave0);
        }
        SEAM(PH_FOLD); STAMP(1);
    }
    for (int l = 0; l < DEPTH; ++l) {
        const int pb = PH_L0 + l * PH_PER_L;
        if (IN(pb + 0)) {
            pg8::Gemm gm{(const bf16*)(C.ws + WS_XB), (const bf16*)(C.ws + WS_BTIN) + (size_t)l * N_INP * DMP, M, N_PROJ, DM, DMP, DMP, 0};
            pg8::StaticOrder S; S.init(M, N_PROJ, C.G, (int)blockIdx.x);
            pg8::EpiBf16S E{(bf16*)(C.ws + WS_PROJ), N_PROJ, (const float*)(C.ws + WS_R), nullptr, -1};
            pg8::gemm_phase<pg8::EpiBf16S, pg8::StaticOrder, true, true>(ring, gm, S, E, C.wave0);
            phase_dt(C, l);
            SEAM(pb + 0); STAMP(2);
        }
        if (IN(pb + 1)) { phase_ssd2(C, l); STAMP(11); phase_pool(C, l); STAMP(12); SEAM(pb + 1); STAMP(3); }
        if (IN(pb + 2)) { phase_gnorm(C); SEAM(pb + 2); STAMP(4); }
        if (IN(pb + 3)) {
            {
                pg8::Gemm gm{(const bf16*)(C.ws + WS_MIXA), (const bf16*)(C.ws + WS_BTOUT) + (size_t)l * DM * D_MIX, MP, DM, D_MIX, D_MIX, D_MIX, 0};
                pg8::StaticOrder S; S.init(MP, DM, C.G, (int)blockIdx.x);
                pg8::EpiBf16Ssq E{(bf16*)(C.ws + WS_MIX), DM, (float*)(C.ws + WS_SSQP)};
                pg8::gemm_phase<pg8::EpiBf16Ssq, pg8::StaticOrder, true, true>(ring, gm, S, E, C.wave0); }
            {
                pg8::Gemm gm{(const bf16*)(C.ws + WS_MIXA) + (size_t)MP * D_MIX, (const bf16*)(C.ws + WS_BTOUT) + (size_t)l * DM * D_MIX, MS, DM, D_MIX / KS_OUT, D_MIX, D_MIX, D_MIX / KS_OUT};
                pg8::SplitKOrder S; S.init(MS, DM, KS_OUT, C.G, vcu);
                pg8::EpiF32Slab E{(float*)(C.ws + WS_SLAB), DM, MS};
                pg8::gemm_phase<pg8::EpiF32Slab, pg8::SplitKOrder, true, true>(ring, gm, S, E, C.wave0); }
            SEAM(pb + 3); STAMP(5);
        }
        if (IN(pb + 4)) { phase_resid(C, C.in[17] + l * DM, false, KS_OUT); SEAM(pb + 4); STAMP(6); }
        if (IN(pb + 5)) {
            pg8::Gemm gm{(const bf16*)(C.ws + WS_XB), (const bf16*)(C.ws + WS_BTUP) + (size_t)l * D_UP * DMP, M, D_UP, DM, DMP, DMP, 0};
            pg8::StaticOrder S; S.init(M, D_UP, C.G, (int)blockIdx.x);
            pg8::EpiUpAct E{(bf16*)(C.ws + WS_ACT), (bf16*)(C.ws + WS_UP), (bf16*)(C.ws + WS_SIDE), (const float*)(C.ws + WS_R), C.in[20] + (size_t)l * 3 * D_UP, C.in[21] + (size_t)l * D_UP, D_FF, (LAS float*)(C.lds + LDSCTL_OFF + 1024)};
            pg8::gemm_phase<pg8::EpiUpAct, pg8::StaticOrder, true, true>(ring, gm, S, E, C.wave0);
            SEAM(pb + 5); STAMP(7);
        }
        if (IN(pb + 6)) { phase_act(C, l); phase_actfix(C, l); SEAM(pb + 6); STAMP(8); }
        if (IN(pb + 7)) {
            {
                pg8::Gemm gm{(const bf16*)(C.ws + WS_ACT), (const bf16*)(C.ws + WS_BTDN) + (size_t)l * DM * D_FF, MP, DM, D_FF, D_FF, D_FF, 0};
                pg8::StaticOrder S; S.init(MP, DM, C.G, (int)blockIdx.x);
                pg8::EpiBf16Ssq E{(bf16*)(C.ws + WS_MIX), DM, (float*)(C.ws + WS_SSQP)};
                pg8::gemm_phase<pg8::EpiBf16Ssq, pg8::StaticOrder, true, true>(ring, gm, S, E, C.wave0); }
            {
                pg8::Gemm gm{(const bf16*)(C.ws + WS_ACT) + (size_t)MP * D_FF, (const bf16*)(C.ws + WS_BTDN) + (size_t)l * DM * D_FF, MS, DM, D_FF / KS_DN, D_FF, D_FF, D_FF / KS_DN};
                pg8::SplitKOrder S; S.init(MS, DM, KS_DN, C.G, vcu);
                pg8::EpiF32Slab E{(float*)(C.ws + WS_SLAB), DM, MS};
                pg8::gemm_phase<pg8::EpiF32Slab, pg8::SplitKOrder, true, true>(ring, gm, S, E, C.wave0); }
            SEAM(pb + 7); STAMP(9);
        }
        if (IN(pb + 8)) { phase_resid(C, C.in[23] + l * DM, l == DEPTH - 1, KS_DN); SEAM(pb + 8); STAMP(10); }
    }
#if PROBE_SEL > 0
    if (blockIdx.x == 0 && LEAD()) { asm volatile("s_waitcnt vmcnt(0)" ::: "memory"); unsigned tot = 0; for (int ty = 0; ty < 20; ++ty) if ((PROBE_SEL >> ty) & 1) tot += MISC[16 + ty]; C.out[0] = (float)tot * 0.0001f;
        if (PROBE_SEL & (1 << 30)) { const unsigned dc = (unsigned)clock64() - MISC[15], dt = (unsigned)__builtin_amdgcn_s_memrealtime() - MISC[14]; C.out[0] = 5.f * (float)dc / (float)dt; } }
#endif
#undef IN
#undef SEAM
}

extern "C" void kernel_launch(void* const* d_in, const int* in_sizes, int n_in, void* d_out, int out_size, void* d_ws, size_t ws_size, hipStream_t stream) {
    static int grid = 0;
    if (grid == 0) {
        if (n_in != 24 || (size_t)out_size != O_END || ws_size < WS_END) { fprintf(stderr, "kernel_launch: shape mismatch: n_in %d out %d (want %zu) ws %zu (need %zu)\n", n_in, out_size, (size_t)O_END, ws_size, (size_t)WS_END); grid = -1; return; }
        int dev = 0, cus = 0, per_cu = 0;
        if (hipGetDevice(&dev) != hipSuccess || hipDeviceGetAttribute(&cus, hipDeviceAttributeMultiprocessorCount, dev) != hipSuccess) { grid = -1; return; }
        if (hipFuncSetAttribute((const void*)fwd_kernel, hipFuncAttributeMaxDynamicSharedMemorySize, LDS_BYTES) != hipSuccess) { fprintf(stderr, "kernel_launch: hipFuncSetAttribute failed\n"); grid = -1; return; }
        if (hipOccupancyMaxActiveBlocksPerMultiprocessor(&per_cu, (const void*)fwd_kernel, NTHR, LDS_BYTES) != hipSuccess || per_cu < 1) fprintf(stderr, "kernel_launch: occupancy query reports %d\n", per_cu);
        (void)hipGetLastError();
        grid = cus;
    }
    if (grid < 0) return;
    if (hipMemsetAsync((char*)d_ws + WS_CTL, 0, CTL_BYTES, stream) != hipSuccess) return;
    Args a{};
    for (int i = 0; i < 24; ++i) a.in[i] = (const float*)d_in[i];
    a.out = (float*)d_out; a.ws = (unsigned char*)d_ws;
#if MK_MULTI
    for (int k = 0; k < N_PHASES; ++k) { a.ph_lo = k; a.ph_hi = k + 1; hipLaunchKernelGGL(fwd_kernel, dim3(grid), dim3(NTHR), LDS_BYTES, stream, a); }
#else
    a.ph_lo = 0; a.ph_hi = N_PHASES; hipLaunchKernelGGL(fwd_kernel, dim3(grid), dim3(NTHR), LDS_BYTES, stream, a);
#endif
}
```

```cpp
#include <hip/hip_runtime.h>
#include <cstdio>
#include <cstdint>

#ifndef PROBE_SEL
#define PROBE_SEL 0
#endif
#ifndef MK_MULTI
#define MK_MULTI 0
#endif

__device__ __forceinline__ int lane_id() { int l; asm volatile("v_mbcnt_lo_u32_b32 %0, -1, 0\n\tv_mbcnt_hi_u32_b32 %0, -1, %0" : "=v"(l)); return l; }
namespace pg8 {
#define PG8_LAS __attribute__((address_space(3)))
typedef unsigned short bf16_t;
typedef short bf16x8 __attribute__((ext_vector_type(8)));
typedef float f32x4 __attribute__((ext_vector_type(4)));
typedef unsigned u32x4 __attribute__((ext_vector_type(4)));
constexpr int BM = 256, BK = 64, HALF = 128, HTB = HALF * BK * 2, STAGE_BYTES = 8 * HTB, NXCD = 8, WGM = 8;

__host__ __device__ __forceinline__ int lds_byte(int r, int c) { const int st = (r >> 4) * 2 + (c >> 5), rr = r & 15, cc = c & 31, ob = rr * 64 + cc * 2; return st * 1024 + (ob ^ (((ob >> 9) & 1) << 5)); }
__host__ __device__ __forceinline__ void stage_rc(int b, int& R, int& C) { const int st = b / 1024, sb = b % 1024, swz = sb ^ (((sb >> 9) & 1) << 5); R = (st >> 1) * 16 + swz / 64; C = (st & 1) * 32 + (swz % 64) / 2; }
__host__ __device__ __forceinline__ int perm32(int rho) { const int n = rho >> 4, i = rho & 15; return 8 * (i >> 2) + 4 * n + (i & 3); }

struct Unit { int pm, pn, ks; };
struct Gemm { const bf16_t* A; const bf16_t* Bt; int M, N, K, lda, ldb, kslice; };

struct StaticOrder {
    int nM, nN, nwg, G, c;
    __host__ __device__ void init(int M, int N, int G_, int c_) { nM = M / BM; nN = N / BM; nwg = nM * nN; G = G_; c = c_; }
    __host__ __device__ bool next(int i, Unit& u) const {
        const long L = (long)i * G + c; if (L >= nwg) return false;
        int wgid = (int)L; { const int q = nwg / NXCD, r = nwg % NXCD, xcd = wgid % NXCD, off = wgid / NXCD; wgid = (xcd < r ? xcd * (q + 1) : r * (q + 1) + (xcd - r) * q) + off; }
        const int nig = WGM * nN, gid = wgid / nig, fm = gid * WGM, gsz = (nM - fm) < WGM ? (nM - fm) : WGM;
        u.pm = fm + ((wgid % nig) % gsz); u.pn = (wgid % nig) / gsz; u.ks = 0; return true;
    }
    __device__ __forceinline__ void a_ready(const Unit&) const {}
    __device__ __forceinline__ void done(const Unit&) const {}
};
struct SplitKOrder {
    int nM, nN, KS, nwg, G, c;
    __host__ __device__ void init(int M, int N, int KS_, int G_, int c_) { nM = M / BM; nN = N / BM; KS = KS_; nwg = nM * nN * KS; G = G_; c = c_; }
    __host__ __device__ bool next(int i, Unit& u) const { const long L = (long)i * G + c; if (L >= nwg) return false; const int l = (int)L; u.pn = l % nN; u.ks = (l / nN) % KS; u.pm = l / (nN * KS); return true; }
    __device__ __forceinline__ void a_ready(const Unit&) const {}
    __device__ __forceinline__ void done(const Unit&) const {}
};

__device__ __forceinline__ unsigned cvt_pk_bf16(float lo, float hi) { unsigned r; asm volatile("v_cvt_pk_bf16_f32 %0, %1, %2" : "=v"(r) : "v"(lo), "v"(hi)); return r; }

struct EpiBf16S {
    static constexpr bool PERM = true, AFTER_DRAIN = false;
    bf16_t* O; int ldc; const float* rs; float* dt; int dt_pn;
    __device__ __forceinline__ void operator()(const f32x4 (&acc)[2][2][4][2], const Unit& u, int wr, int wc, int fr, int fq) const {
        const int row0 = u.pm * BM + wr * 64 + fr;
        if (u.pn == dt_pn) {
            if (wc == 0) {
#pragma unroll
                for (int ai = 0; ai < 2; ++ai)
#pragma unroll
                    for (int m = 0; m < 4; ++m) { const int row = row0 + ai * HALF + m * 16; const float s = rs ? rs[row] : 1.f;
#pragma unroll
                        for (int n = 0; n < 2; ++n) *(f32x4*)(dt + (size_t)row * 32 + 8 * fq + 4 * n) = acc[ai][0][m][n] * s; }
            }
            return;
        }
        const int col0 = u.pn * BM + wc * 32 + 8 * fq;
#pragma unroll
        for (int ai = 0; ai < 2; ++ai)
#pragma unroll
            for (int m = 0; m < 4; ++m) { const int row = row0 + ai * HALF + m * 16; const float s = rs ? rs[row] : 1.f; bf16_t* rowp = O + (size_t)row * ldc + col0;
#pragma unroll
                for (int bj = 0; bj < 2; ++bj) { const f32x4 v0 = acc[ai][bj][m][0] * s, v1 = acc[ai][bj][m][1] * s;
                    u32x4 w; w.x = cvt_pk_bf16(v0[0], v0[1]); w.y = cvt_pk_bf16(v0[2], v0[3]); w.z = cvt_pk_bf16(v1[0], v1[1]); w.w = cvt_pk_bf16(v1[2], v1[3]);
                    *(u32x4*)(rowp + bj * HALF) = w; } }
    }
};
struct EpiF32Ssq {
    static constexpr bool PERM = false, AFTER_DRAIN = false;
    float* C; int ldc; float* ssq;
    __device__ __forceinline__ void operator()(const f32x4 (&acc)[2][2][4][2], const Unit& u, int wr, int wc, int fr, int fq) const {
        const int row0 = u.pm * BM + wr * 64 + fr, col0 = u.pn * BM + wc * 32 + 4 * fq;
#pragma unroll
        for (int ai = 0; ai < 2; ++ai)
#pragma unroll
            for (int m = 0; m < 4; ++m) { const int row = row0 + ai * HALF + m * 16; float* rowp = C + (size_t)row * ldc + col0; float q = 0.f;
#pragma unroll
                for (int bj = 0; bj < 2; ++bj)
#pragma unroll
                    for (int n = 0; n < 2; ++n) { const f32x4 v = acc[ai][bj][m][n]; *(f32x4*)(rowp + bj * HALF + n * 16) = v; q += (v[0] * v[0] + v[1] * v[1]) + (v[2] * v[2] + v[3] * v[3]); }
                q += __shfl_xor(q, 16); q += __shfl_xor(q, 32);
                if (fq == 0) ssq[(size_t)row * 32 + u.pn * 4 + wc] = q; }
    }
};

struct EpiBf16Ssq {
    static constexpr bool PERM = true, AFTER_DRAIN = false;
    bf16_t* O; int ldc; float* ssq;
    __device__ __forceinline__ void operator()(const f32x4 (&acc)[2][2][4][2], const Unit& u, int wr, int wc, int fr, int fq) const {
        const int row0 = u.pm * BM + wr * 64 + fr, col0 = u.pn * BM + wc * 32 + 8 * fq;
#pragma unroll
        for (int ai = 0; ai < 2; ++ai)
#pragma unroll
            for (int m = 0; m < 4; ++m) { const int row = row0 + ai * HALF + m * 16; bf16_t* rowp = O + (size_t)row * ldc + col0; float q = 0.f;
#pragma unroll
                for (int bj = 0; bj < 2; ++bj) { const f32x4 v0 = acc[ai][bj][m][0], v1 = acc[ai][bj][m][1];
                    q += ((v0[0] * v0[0] + v0[1] * v0[1]) + (v0[2] * v0[2] + v0[3] * v0[3])) + ((v1[0] * v1[0] + v1[1] * v1[1]) + (v1[2] * v1[2] + v1[3] * v1[3]));
                    u32x4 w; w.x = cvt_pk_bf16(v0[0], v0[1]); w.y = cvt_pk_bf16(v0[2], v0[3]); w.z = cvt_pk_bf16(v1[0], v1[1]); w.w = cvt_pk_bf16(v1[2], v1[3]);
                    *(u32x4*)(rowp + bj * HALF) = w; }
                q += __shfl_xor(q, 16); q += __shfl_xor(q, 32);
                if (fq == 0) ssq[(size_t)row * 32 + u.pn * 4 + wc] = q; }
    }
};
template <int CTRL> __device__ __forceinline__ float dppf(float old, float src) { return __builtin_bit_cast(float, __builtin_amdgcn_update_dpp(__builtin_bit_cast(int, old), __builtin_bit_cast(int, src), CTRL, 0xF, 0xF, false)); }
struct EpiUpAct {
    static constexpr bool PERM = true, AFTER_DRAIN = false;
    bf16_t* ACT; bf16_t* UP; bf16_t* SIDE; const float* rs; const float* cw; const float* cb; int dff;
    PG8_LAS float* wlds;
    __device__ __forceinline__ void operator()(const f32x4 (&acc)[2][2][4][2], const Unit& u, int wr, int wc, int fr, int fq) const {
        const int row0 = u.pm * BM + wr * 64 + fr, cbase = u.pn * HALF + wc * 32 + 8 * fq, dup = 2 * dff;
        if (u.pm >= 64) {
#pragma unroll
            for (int ai = 0; ai < 2; ++ai)
#pragma unroll
                for (int m = 0; m < 4; ++m) { const int row = row0 + ai * HALF + m * 16; const float s = rs[row];
#pragma unroll
                    for (int bj = 0; bj < 2; ++bj) { const f32x4 v0 = acc[ai][bj][m][0] * s, v1 = acc[ai][bj][m][1] * s;
                        u32x4 w; w.x = cvt_pk_bf16(v0[0], v0[1]); w.y = cvt_pk_bf16(v0[2], v0[3]); w.z = cvt_pk_bf16(v1[0], v1[1]); w.w = cvt_pk_bf16(v1[2], v1[3]);
                        *(u32x4*)(UP + (size_t)row * dup + bj * dff + cbase) = w; } }
            return;
        }
        typedef unsigned u32x2 __attribute__((ext_vector_type(2)));
        PG8_LAS float* wl = wlds + (wr * 4 + wc) * 256;
        int fro = fr, fqo = fq; asm volatile("" : "+v"(fro), "+v"(fqo));
        { const int lane = fqo * 16 + fro, kind = lane >> 3, j0 = (lane & 7) * 4; const int k3 = kind & 3;
          const float* srcp = (k3 < 3 ? cw + (size_t)k3 * dup : cb) + (kind >> 2) * dff + u.pn * HALF + wc * 32 + j0;
          *(PG8_LAS f32x4*)(wl + kind * 32 + j0) = *(const f32x4*)srcp; }
        asm volatile("s_waitcnt lgkmcnt(0)" ::: "memory");
#pragma unroll
        for (int n = 0; n < 2; ++n) { const int c = cbase + 4 * n; const PG8_LAS float* wq = wl + 8 * fqo + 4 * n;
#pragma unroll
            for (int ai = 0; ai < 2; ++ai) { const int kb = u.pm * 4 + ai * 2 + wr; float sp = 0.f;
#pragma unroll
                for (int m = 0; m < 4; ++m) { const int row = row0 + ai * HALF + m * 16; const float s = rs[row];
                    const f32x4 g = acc[ai][0][m][n] * s, v = acc[ai][1][m][n] * s; f32x4 o;
                    const f32x4 gp = acc[ai][0][m > 0 ? m - 1 : 0][n] * sp, vp = acc[ai][1][m > 0 ? m - 1 : 0][n] * sp;
#pragma unroll
                    for (int e = 0; e < 4; ++e) {
                        const float p1g = dppf<0x111>(dppf<0x121>(0.f, gp[e]), g[e]), p2g = dppf<0x112>(dppf<0x122>(0.f, gp[e]), g[e]);
                        const float p1v = dppf<0x111>(dppf<0x121>(0.f, vp[e]), v[e]), p2v = dppf<0x112>(dppf<0x122>(0.f, vp[e]), v[e]);
                        const float gg = wq[96 + e] + wq[e] * p2g + wq[32 + e] * p1g + wq[64 + e] * g[e], vv = wq[224 + e] + wq[128 + e] * p2v + wq[160 + e] * p1v + wq[192 + e] * v[e];
                        o[e] = gg * __builtin_amdgcn_rcpf(1.f + __expf(-gg)) * vv; }
                    const bool head = (m == 0) && (fr < 2);
                    if (!head) { u32x2 w; w.x = cvt_pk_bf16(o[0], o[1]); w.y = cvt_pk_bf16(o[2], o[3]); *(u32x2*)(ACT + (size_t)row * dff + c) = w; }
                    if (head || ((m == 3) && (fr >= 14))) { const int slot = head ? fr : fr - 12; bf16_t* sp = SIDE + ((size_t)kb * 4 + slot) * dup + c;
                        u32x2 wg; wg.x = cvt_pk_bf16(g[0], g[1]); wg.y = cvt_pk_bf16(g[2], g[3]); *(u32x2*)sp = wg;
                        u32x2 wv; wv.x = cvt_pk_bf16(v[0], v[1]); wv.y = cvt_pk_bf16(v[2], v[3]); *(u32x2*)(sp + dff) = wv; }
                    sp = s; asm volatile("" ::: "memory"); } } }
    }
};
struct EpiF32Slab {
    static constexpr bool PERM = false, AFTER_DRAIN = false;
    float* C; int ldc, Mrows;
    __device__ __forceinline__ void operator()(const f32x4 (&acc)[2][2][4][2], const Unit& u, int wr, int wc, int fr, int fq) const {
        const int row0 = u.pm * BM + wr * 64 + fr, col0 = u.pn * BM + wc * 32 + 4 * fq; float* base = C + (size_t)u.ks * Mrows * ldc;
#pragma unroll
        for (int ai = 0; ai < 2; ++ai)
#pragma unroll
            for (int m = 0; m < 4; ++m) { float* rowp = base + (size_t)(row0 + ai * HALF + m * 16) * ldc + col0;
#pragma unroll
                for (int bj = 0; bj < 2; ++bj)
#pragma unroll
                    for (int n = 0; n < 2; ++n) *(f32x4*)(rowp + bj * HALF + n * 16) = acc[ai][bj][m][n]; }
    }
};
template <class Epi, class Sched, bool ALIGN_EPI = false, bool SP2 = false>
__device__ __forceinline__ void gemm_phase(PG8_LAS unsigned char* lds, const Gemm g, const Sched& S, const Epi& E, int wave_id) {
    int tid_ = wave_id * 64 + lane_id(); asm volatile("" : "+v"(tid_));
    const int tid = tid_, wid = __builtin_amdgcn_readfirstlane(tid >> 6), lane = tid & 63, wr = wid >> 2, wc = wid & 3, fr = lane & 15, fq = lane >> 4;
    const int K = g.K, nt = K / BK;
    unsigned voffA[2], voffB[2];
#pragma unroll
    for (int i = 0; i < 2; ++i) { int R, C; stage_rc(tid * 16 + i * 8192, R, C); const int Rb = Epi::PERM ? ((R & ~31) + perm32(R & 31)) : R;
        voffA[i] = (unsigned)(R * g.lda + C) * 2u; voffB[i] = (unsigned)(Rb * g.ldb + C) * 2u; }
    const size_t kstep = (size_t)(BK * 2);
    const size_t hstepA = (size_t)HALF * g.lda * 2, hstepB = (size_t)HALF * g.ldb * 2;
    const size_t tstepA = 2 * hstepA, tstepB = 2 * hstepB;
    const unsigned ldsw = (unsigned)wid * 1024u;
    const int aoff = lds_byte(wr * 64 + fr, fq * 8), boff = lds_byte(wc * 32 + fr, fq * 8);
#define PG8_SA(b, h) (((b) * 2 + (h)) * HTB)
#define PG8_SB(b, h) ((4 + (b) * 2 + (h)) * HTB)
#define PG8_STAGE(bufoff, gbase, voff) do { _Pragma("unroll") for (int _i = 0; _i < 2; ++_i) \
        __builtin_amdgcn_global_load_lds((const unsigned*)((const char*)(gbase) + (voff)[_i]), (PG8_LAS unsigned*)(lds + (bufoff) + ldsw + _i * 8192), 16, 0, 0); } while (0)
#define PG8_LDA(dst, b, h) do { _Pragma("unroll") for (int m = 0; m < 4; ++m) _Pragma("unroll") for (int k = 0; k < 2; ++k) dst[m][k] = *(const PG8_LAS bf16x8*)(lds + PG8_SA(b, h) + aoff + m * 2048 + k * 1024); } while (0)
#define PG8_LDB(dst, b, h) do { _Pragma("unroll") for (int n = 0; n < 2; ++n) _Pragma("unroll") for (int k = 0; k < 2; ++k) dst[n][k] = *(const PG8_LAS bf16x8*)(lds + PG8_SB(b, h) + boff + n * 2048 + k * 1024); } while (0)
#define PG8_MMA(ai, bj, At, Bt) do { __builtin_amdgcn_s_setprio(1); _Pragma("unroll") for (int m = 0; m < 4; ++m) _Pragma("unroll") for (int n = 0; n < 2; ++n) _Pragma("unroll") for (int k = 0; k < 2; ++k) \
        acc[ai][bj][m][n] = __builtin_amdgcn_mfma_f32_16x16x32_bf16(Bt[n][k], At[m][k], acc[ai][bj][m][n], 0, 0, 0); __builtin_amdgcn_s_setprio(0); } while (0)
#define PG8_WAIT_V(n) asm volatile("s_waitcnt vmcnt(" #n ")" ::: "memory")
#define PG8_WAIT_L(n) asm volatile("s_waitcnt lgkmcnt(" #n ")" ::: "memory")
#define PG8_BAR __builtin_amdgcn_s_barrier()
#define PG8_SCHED __builtin_amdgcn_sched_barrier(0)
    Unit cur, nxt; int ui = 0;
    if (!S.next(0, cur)) return;
    f32x4 acc[2][2][4][2];
#pragma unroll
    for (int a = 0; a < 2; ++a)
#pragma unroll
        for (int b = 0; b < 2; ++b)
#pragma unroll
            for (int m = 0; m < 4; ++m)
#pragma unroll
                for (int n = 0; n < 2; ++n) acc[a][b][m][n] = (f32x4){0.f, 0.f, 0.f, 0.f};
    bf16x8 At[4][2], B0[2][2], B1[2][2];
    const size_t ksb = (size_t)g.kslice * 2;
    const char* cA = (const char*)g.A + (size_t)cur.pm * tstepA + cur.ks * ksb; const char* cB = (const char*)g.Bt + (size_t)cur.pn * tstepB + cur.ks * ksb;
    S.a_ready(cur);
    if constexpr (SP2) {
        PG8_STAGE(PG8_SB(0, 0), cB, voffB); PG8_STAGE(PG8_SB(0, 1), cB + hstepB, voffB); PG8_STAGE(PG8_SA(0, 0), cA, voffA); PG8_STAGE(PG8_SA(0, 1), cA + hstepA, voffA);
        if (wr == 1) PG8_BAR;
        PG8_WAIT_V(2); PG8_BAR;
        PG8_STAGE(PG8_SB(1, 0), cB + kstep, voffB); PG8_STAGE(PG8_SA(1, 0), cA + kstep, voffA); PG8_STAGE(PG8_SB(1, 1), cB + hstepB + kstep, voffB);
        PG8_WAIT_V(6); PG8_BAR;
    } else {
        PG8_STAGE(PG8_SB(0, 0), cB, voffB); PG8_STAGE(PG8_SA(0, 0), cA, voffA); PG8_STAGE(PG8_SB(0, 1), cB + hstepB, voffB); PG8_STAGE(PG8_SA(0, 1), cA + hstepA, voffA);
        if (wr == 1) PG8_BAR;
        PG8_WAIT_V(4); PG8_BAR;
        PG8_STAGE(PG8_SB(1, 0), cB + kstep, voffB); PG8_STAGE(PG8_SA(1, 0), cA + kstep, voffA); PG8_STAGE(PG8_SB(1, 1), cB + hstepB + kstep, voffB);
        PG8_WAIT_V(6); PG8_BAR;
    }
    for (;;) {
        const bool has_next = S.next(ui + 1, nxt);
        const char* nA = has_next ? (const char*)g.A + (size_t)nxt.pm * tstepA + nxt.ks * ksb : cA; const char* nB = has_next ? (const char*)g.Bt + (size_t)nxt.pn * tstepB + nxt.ks * ksb : cB;
        for (int t = 0; t < nt; t += 2) {
            const bool last = (t == nt - 2);
            const char* a1 = cA + (size_t)(t + 1) * kstep;
            const char* a2 = last ? nA : cA + (size_t)(t + 2) * kstep; const char* b2 = last ? nB : cB + (size_t)(t + 2) * kstep;
            const char* a3 = a2 + kstep; const char* b3 = b2 + kstep;
            if (last && has_next) S.a_ready(nxt);
            if constexpr (SP2) {
            PG8_LDB(B0, 0, 0); PG8_LDB(B1, 0, 1); PG8_SCHED; PG8_LDA(At, 0, 0); PG8_STAGE(PG8_SA(1, 1), a1 + hstepA, voffA);
            PG8_WAIT_V(8); PG8_WAIT_L(0); PG8_BAR; PG8_MMA(0, 0, At, B0); PG8_MMA(0, 1, At, B1); PG8_BAR; PG8_SCHED;
            PG8_LDA(At, 0, 1); PG8_STAGE(PG8_SB(0, 0), b2, voffB); PG8_STAGE(PG8_SB(0, 1), b2 + hstepB, voffB); PG8_STAGE(PG8_SA(0, 0), a2, voffA);
            PG8_WAIT_V(8); PG8_WAIT_L(0); PG8_BAR; PG8_MMA(1, 0, At, B0); PG8_MMA(1, 1, At, B1); PG8_BAR; PG8_SCHED;
            PG8_LDB(B0, 1, 0); PG8_LDB(B1, 1, 1); PG8_SCHED; PG8_LDA(At, 1, 0); PG8_STAGE(PG8_SA(0, 1), a2 + hstepA, voffA);
            PG8_WAIT_V(8); PG8_WAIT_L(0); PG8_BAR; PG8_MMA(0, 0, At, B0); PG8_MMA(0, 1, At, B1); PG8_BAR; PG8_SCHED;
            PG8_LDA(At, 1, 1); PG8_STAGE(PG8_SB(1, 0), b3, voffB); PG8_STAGE(PG8_SB(1, 1), b3 + hstepB, voffB); PG8_STAGE(PG8_SA(1, 0), a3, voffA);
            PG8_WAIT_V(8); PG8_WAIT_L(0); PG8_BAR; PG8_MMA(1, 0, At, B0); PG8_MMA(1, 1, At, B1); PG8_BAR; PG8_SCHED;
            } else {
            PG8_LDB(B0, 0, 0); PG8_SCHED; PG8_LDA(At, 0, 0); PG8_STAGE(PG8_SA(1, 1), a1 + hstepA, voffA);
            PG8_WAIT_L(8); PG8_BAR; PG8_WAIT_L(0); PG8_MMA(0, 0, At, B0); PG8_BAR; PG8_SCHED;
            PG8_LDB(B1, 0, 1); PG8_STAGE(PG8_SB(0, 0), b2, voffB);
            PG8_BAR; PG8_WAIT_L(0); PG8_MMA(0, 1, At, B1); PG8_BAR;
            PG8_LDA(At, 0, 1); PG8_STAGE(PG8_SA(0, 0), a2, voffA);
            PG8_BAR; PG8_WAIT_L(0); PG8_MMA(1, 0, At, B0); PG8_BAR; PG8_SCHED;
            PG8_STAGE(PG8_SB(0, 1), b2 + hstepB, voffB);
            PG8_WAIT_V(6); PG8_BAR; PG8_MMA(1, 1, At, B1); PG8_BAR;
            PG8_LDB(B0, 1, 0); PG8_SCHED; PG8_LDA(At, 1, 0); PG8_STAGE(PG8_SA(0, 1), a2 + hstepA, voffA);
            PG8_WAIT_L(8); PG8_BAR; PG8_WAIT_L(0); PG8_MMA(0, 0, At, B0); PG8_BAR; PG8_SCHED;
            PG8_LDB(B1, 1, 1); PG8_STAGE(PG8_SB(1, 0), b3, voffB);
            PG8_BAR; PG8_WAIT_L(0); PG8_MMA(0, 1, At, B1); PG8_BAR;
            PG8_LDA(At, 1, 1); PG8_STAGE(PG8_SA(1, 0), a3, voffA);
            PG8_BAR; PG8_WAIT_L(0); PG8_MMA(1, 0, At, B0); PG8_BAR; PG8_SCHED;
            PG8_STAGE(PG8_SB(1, 1), b3 + hstepB, voffB);
            PG8_WAIT_V(6); PG8_BAR; PG8_MMA(1, 1, At, B1); PG8_BAR;
            }
        }
        if constexpr (ALIGN_EPI) { if (wr == 0) PG8_BAR; }
        if constexpr (!Epi::AFTER_DRAIN) { E(acc, cur, wr, wc, fr, fq); S.done(cur); }
        if (!has_next) break;
#pragma unroll
        for (int a = 0; a < 2; ++a)
#pragma unroll
            for (int b = 0; b < 2; ++b)
#pragma unroll
                for (int m = 0; m < 4; ++m)
#pragma unroll
                    for (int n = 0; n < 2; ++n) acc[a][b][m][n] = (f32x4){0.f, 0.f, 0.f, 0.f};
        cur = nxt; cA = nA; cB = nB; ++ui;
        if constexpr (ALIGN_EPI) { if (wr == 1) PG8_BAR; }
    }
    PG8_WAIT_V(0);
    if constexpr (!ALIGN_EPI) { if (wr == 0) PG8_BAR; }
    PG8_BAR;
#undef PG8_SA
#undef PG8_SB
#undef PG8_STAGE
#undef PG8_LDA
#undef PG8_LDB
#undef PG8_MMA
#undef PG8_WAIT_V
#undef PG8_WAIT_L
#undef PG8_BAR
#undef PG8_SCHED
}
}

constexpr int NWAVES = 8, NTHR = 512;
constexpr int DM = 2048, SEQ = 2048, NB_P = 8, NB_S = 32, SEQ_S = 32, DEPTH = 4;
constexpr int MP = NB_P * SEQ, MS = NB_S * SEQ_S, M = MP + MS;
constexpr int D_POOL = 1024, POOL_HIST = 15, D_SSD = 2048, HD = 64, NH = 32, HPG = 16, DS = 128, CONV_DIM = 2560, D_MIX = 3072;
constexpr int D_IN = 5664, N_PROJ = 5632, N_INP = 5888, D_FF = 5632, D_UP = 11264;
constexpr int XBC0 = 3072;
constexpr float EPS = 1e-6f;

constexpr size_t O_YP = 0, O_YS = O_YP + (size_t)MP * DM, O_POOLP = O_YS + (size_t)MS * DM, O_POOLS = O_POOLP + (size_t)DEPTH * NB_P * 15 * 1024,
    O_SCP = O_POOLS + (size_t)DEPTH * NB_S * 15 * 1024, O_SCS = O_SCP + (size_t)DEPTH * NB_P * 3 * 2560, O_SSDP = O_SCS + (size_t)DEPTH * NB_S * 3 * 2560,
    O_SSDS = O_SSDP + (size_t)DEPTH * NB_P * 32 * 64 * 128, O_FCP = O_SSDS + (size_t)DEPTH * NB_S * 32 * 64 * 128, O_FCS = O_FCP + (size_t)DEPTH * NB_P * 2 * 11264,
    O_END = O_FCS + (size_t)DEPTH * NB_S * 2 * 11264;

constexpr size_t al256(size_t x) { return (x + 255) & ~(size_t)255; }
constexpr size_t WS_CTL = 0, CTL_BYTES = 1u << 20;
constexpr size_t WS_BTIN = CTL_BYTES;
constexpr int DMP = DM + 64;
constexpr size_t WS_BTOUT = WS_BTIN + (size_t)DEPTH * N_INP * DMP * 2;
constexpr size_t WS_BTUP = WS_BTOUT + (size_t)DEPTH * DM * D_MIX * 2;
constexpr size_t WS_BTDN = WS_BTUP + (size_t)DEPTH * D_UP * DMP * 2;
constexpr size_t WS_WOP = WS_BTDN + (size_t)DEPTH * DM * D_FF * 2;
constexpr size_t WS_WPB = WS_WOP + (size_t)DEPTH * DM * D_POOL * 2;
constexpr size_t WS_X = WS_WPB + (size_t)DEPTH * 4 * 256 * 256 * 2;
constexpr size_t WS_ACTX = WS_X;
constexpr size_t WS_XB = WS_X + (size_t)M * DM * 4;
constexpr size_t WS_R = WS_XB + (size_t)M * DMP * 2;
constexpr size_t WS_DT = WS_R + al256((size_t)M * 4);
constexpr size_t WS_SSQP = WS_DT + (size_t)M * 32 * 4;
constexpr size_t WS_SSQH = WS_SSQP + (size_t)M * 32 * 4;
constexpr size_t WS_ACT = WS_SSQH + (size_t)M * 32 * 4;
constexpr size_t WS_RA = WS_ACT + (size_t)M * D_FF * 2;
constexpr size_t WS_PROJ = WS_RA;
constexpr size_t WS_MIXA = WS_PROJ + (size_t)M * N_PROJ * 2;
constexpr size_t WS_MIX = WS_MIXA + (size_t)M * D_MIX * 2;
constexpr size_t WS_UP = WS_RA;
constexpr int KS_OUT = 8, KS_DN = 4;
constexpr size_t WS_SLAB = WS_MIX + (size_t)M * DM * 4;
constexpr size_t WS_SIDE = WS_SLAB + (size_t)KS_OUT * MS * DM * 4;
constexpr size_t WS_END = WS_SIDE + (size_t)(MP / 64) * 4 * D_UP * 2;
static_assert((size_t)M * D_UP * 2 <= WS_END - WS_RA, "UP fits region A");

constexpr int RING_BYTES = 131072, LDSCTL_OFF = RING_BYTES, LDS_BYTES = 147456;

#define LAS __attribute__((address_space(3)))
typedef unsigned short bf16;
typedef float f32x4 __attribute__((ext_vector_type(4)));
#define RLX_AGENT __ATOMIC_RELAXED, __HIP_MEMORY_SCOPE_AGENT
__device__ __forceinline__ unsigned f2bf(float f) { unsigned u = __builtin_bit_cast(unsigned, f); return (u + 0x7fffu + ((u >> 16) & 1u)) >> 16; }
__device__ __forceinline__ unsigned pk2(float lo, float hi) { unsigned r; asm("v_cvt_pk_bf16_f32 %0, %1, %2" : "=v"(r) : "v"(lo), "v"(hi)); return r; }
__device__ __forceinline__ float bflo(unsigned u) { return __uint_as_float(u << 16); }
__device__ __forceinline__ float bfhi(unsigned u) { return __uint_as_float(u & 0xffff0000u); }
__device__ __forceinline__ float bf2f(bf16 b) { return __uint_as_float(((unsigned)b) << 16); }
struct F8 { float v[8]; };
__device__ __forceinline__ F8 ld_bf8(const bf16* p) { const uint4 u = *(const uint4*)p; F8 r; r.v[0] = bflo(u.x); r.v[1] = bfhi(u.x); r.v[2] = bflo(u.y); r.v[3] = bfhi(u.y); r.v[4] = bflo(u.z); r.v[5] = bfhi(u.z); r.v[6] = bflo(u.w); r.v[7] = bfhi(u.w); return r; }
__device__ __forceinline__ F8 unpack8(const uint4 u) { F8 r; r.v[0] = bflo(u.x); r.v[1] = bfhi(u.x); r.v[2] = bflo(u.y); r.v[3] = bfhi(u.y); r.v[4] = bflo(u.z); r.v[5] = bfhi(u.z); r.v[6] = bflo(u.w); r.v[7] = bfhi(u.w); return r; }
__device__ __forceinline__ F8 ld_f8(const float* p) { const float4 a = *(const float4*)p, b = *(const float4*)(p + 4); F8 r; r.v[0] = a.x; r.v[1] = a.y; r.v[2] = a.z; r.v[3] = a.w; r.v[4] = b.x; r.v[5] = b.y; r.v[6] = b.z; r.v[7] = b.w; return r; }
__device__ __forceinline__ F8 zero8() { F8 r;
#pragma unroll
    for (int i = 0; i < 8; ++i) r.v[i] = 0.f; return r; }
__device__ __forceinline__ void st_bf8(bf16* p, const F8& r) { uint4 u; u.x = pk2(r.v[0], r.v[1]); u.y = pk2(r.v[2], r.v[3]); u.z = pk2(r.v[4], r.v[5]); u.w = pk2(r.v[6], r.v[7]); *(uint4*)p = u; }
__device__ __forceinline__ void st_f8(float* p, const F8& r) { *(float4*)p = make_float4(r.v[0], r.v[1], r.v[2], r.v[3]); *(float4*)(p + 4) = make_float4(r.v[4], r.v[5], r.v[6], r.v[7]); }
__device__ __forceinline__ float silu_f(float x) { return x * __builtin_amdgcn_rcpf(1.f + __expf(-x)); }
__device__ __forceinline__ float wave_sum(float v) {
#pragma unroll
    for (int o = 1; o < 64; o <<= 1) v += __shfl_xor(v, o);
    return v;
}

#define XB_TMO      128
#define XB_XCNT(j)  (256  + 64 * (j))
#define XB_XSUB(j)  (1280 + 64 * (j))
#define XB_XGEN(j)  (2304 + 64 * (j))
#define XB_TOP      3328
#define XB_TOPGEN   3392
#define XCD_BAR_WORDS 3456
#define XB_SPIN_CAP (1u << 18)
__device__ __forceinline__ unsigned xb_ld(unsigned* p)              { return __hip_atomic_load(p, __ATOMIC_RELAXED, __HIP_MEMORY_SCOPE_AGENT); }
__device__ __forceinline__ unsigned xb_add(unsigned* p, unsigned v) { return __hip_atomic_fetch_add(p, v, __ATOMIC_RELAXED, __HIP_MEMORY_SCOPE_AGENT); }
__device__ __forceinline__ unsigned xb_xcc_id() { return (unsigned)__builtin_amdgcn_s_getreg((3 << 11) | 20) & 0xFu; }
#define XB_SPIN(cond, bar) do { unsigned _sp = 0; while (cond) { __builtin_amdgcn_s_sleep(1); \
    if ((++_sp & 255u) == 0u) { if (xb_ld(&(bar)[XB_TMO])) break; if (_sp > XB_SPIN_CAP) { atomicAdd(&(bar)[XB_TMO], 1u); break; } } } } while (0)
struct XcdBarrier { unsigned* bar; unsigned x; volatile LAS unsigned* st; };
__device__ __forceinline__ XcdBarrier xcd_barrier_post(unsigned* bar, volatile LAS unsigned* st, bool lead) {
    XcdBarrier b; b.bar = bar; b.x = xb_xcc_id(); b.st = st;
    if (lead) (void)xb_add(&bar[XB_XCNT(b.x)], 1u);
    return b;
}
__device__ __forceinline__ void xcd_barrier_complete(unsigned* bar, unsigned x, unsigned& nloc, unsigned& nx) {
    const unsigned G = gridDim.x * gridDim.y * gridDim.z;
    unsigned sum, cnt, mine, sp = 0u;
    for (;;) {
        sum = 0u; cnt = 0u; mine = 0u;
#pragma unroll
        for (unsigned j = 0; j < 16; ++j) { const unsigned c = xb_ld(&bar[XB_XCNT(j)]); sum += c; cnt += (c > 0u) ? 1u : 0u; mine = (j == x) ? c : mine; }
        if (sum == G) break;
        __builtin_amdgcn_s_sleep(1);
        if ((++sp & 255u) == 0u) { if (xb_ld(&bar[XB_TMO])) break; if (sp > XB_SPIN_CAP) { atomicAdd(&bar[XB_TMO], 1u); break; } }
    }
    nloc = mine > 0u ? mine : 1u; nx = cnt > 0u ? cnt : 1u;
}
__device__ __forceinline__ void xcd_barrier(const XcdBarrier& b, bool lead) {
    asm volatile("s_waitcnt vmcnt(0)" ::: "memory");
    __syncthreads();
    if (lead) {
        unsigned* bar = b.bar;
        __builtin_amdgcn_s_waitcnt(0);
        unsigned nloc = b.st[0], nx = b.st[1];
        if (nloc == 0u) { xcd_barrier_complete(bar, b.x, nloc, nx); b.st[0] = nloc; b.st[1] = nx; }
        const unsigned old = xb_add(&bar[XB_XSUB(b.x)], 1u);
        const unsigned gen = old / nloc;
        if (old + 1u == (gen + 1u) * nloc) {
            __builtin_amdgcn_fence(__ATOMIC_RELEASE, "agent");
            asm volatile("s_waitcnt vmcnt(0)" ::: "memory");
            const unsigned og = xb_add(&bar[XB_TOP], 1u);
            const unsigned tg = og / nx;
            if (og + 1u == (tg + 1u) * nx) xb_add(&bar[XB_TOPGEN], 1u);
            else XB_SPIN(xb_ld(&bar[XB_TOPGEN]) == tg, bar);
            __builtin_amdgcn_fence(__ATOMIC_ACQUIRE, "agent");
            xb_add(&bar[XB_XGEN(b.x)], 1u);
            asm volatile("s_waitcnt vmcnt(0)" ::: "memory");
        } else {
            XB_SPIN(xb_ld(&bar[XB_XGEN(b.x)]) == gen, bar);
            __builtin_amdgcn_fence(__ATOMIC_ACQUIRE, "agent");
            asm volatile("s_waitcnt vmcnt(0)" ::: "memory");
        }
    }
    __syncthreads();
}

struct Args { const float* in[24]; float* out; unsigned char* ws; int ph_lo, ph_hi; };

struct Ctx {
    LAS unsigned char* lds; int tid, lane, wave, G, gw, NGW, wave0;
    const float* const* in; float* out; unsigned char* ws;
    __device__ __forceinline__ void refresh() {
        int t = wave0 * 64 + lane_id(); asm volatile("" : "+v"(t)); tid = t; lane = t & 63; wave = __builtin_amdgcn_readfirstlane(t >> 6); gw = blockIdx.x * NWAVES + wave; NGW = G * NWAVES; }
};

constexpr int I_IN = (DM / 64) * (D_IN / 32), I_OUT = (D_MIX / 64) * (DM / 32), I_UP = (DM / 64) * (DM * 0 + D_UP / 32), I_DN = (D_FF / 64) * (DM / 32), I_L = I_IN + I_OUT + I_UP + I_DN;
struct ConvJob { const float* W; const float* gain; bf16* dst; int N, ldd, kb, nb; };
__device__ __forceinline__ ConvJob conv_job(const Ctx& C, int l, int r) {
    ConvJob j;
    if (r < I_IN) { const int nbk = D_IN / 32; j.W = C.in[7] + (size_t)l * DM * D_IN; j.gain = C.in[6] + l * DM; j.dst = (bf16*)(C.ws + WS_BTIN) + (size_t)l * N_INP * DMP; j.N = D_IN; j.ldd = DMP; j.kb = r / nbk; j.nb = r % nbk; return j; }
    r -= I_IN;
    if (r < I_OUT) { const int nbk = DM / 32; j.kb = r / nbk; j.nb = r % nbk; j.W = C.in[16] + (size_t)l * D_MIX * DM; j.N = DM;
        if (j.kb < 16) { j.gain = C.in[9] + l * D_POOL; j.dst = (bf16*)(C.ws + WS_WOP) + (size_t)l * DM * D_POOL; j.ldd = D_POOL; }
        else { j.gain = C.in[15] + l * D_SSD - D_POOL; j.dst = (bf16*)(C.ws + WS_BTOUT) + (size_t)l * DM * D_MIX; j.ldd = D_MIX; }
        return j; }
    r -= I_OUT;
    if (r < I_UP) { const int nbk = D_UP / 32, nb = r % nbk, n0 = 32 * nb, hv = n0 / D_FF, cc = n0 % D_FF, np = 256 * (cc / 128) + 128 * hv + (cc % 128);
        j.W = C.in[19] + (size_t)l * DM * D_UP; j.gain = C.in[18] + l * DM; j.dst = (bf16*)(C.ws + WS_BTUP) + (size_t)l * D_UP * DMP + (long)(np - n0) * DMP; j.N = D_UP; j.ldd = DMP; j.kb = r / nbk; j.nb = nb; return j; }
    r -= I_UP;
    { const int nbk = DM / 32; j.W = C.in[22] + (size_t)l * D_FF * DM; j.gain = nullptr; j.dst = (bf16*)(C.ws + WS_BTDN) + (size_t)l * DM * D_FF; j.N = DM; j.ldd = D_FF; j.kb = r / nbk; j.nb = r % nbk; }
    return j;
}
__device__ __forceinline__ void conv_issue(const ConvJob& j, int lane, float (&wv)[32], float& gl) {
    const int k0 = 64 * j.kb, n0 = 32 * j.nb;
    gl = j.gain ? j.gain[k0 + lane] : 1.f;
#pragma unroll
    for (int i = 0; i < 32; ++i) { const int kk = 2 * i + (lane >> 5); wv[i] = j.W[(size_t)(k0 + kk) * j.N + n0 + (lane & 31)]; }
}
__device__ __forceinline__ void conv_finish(const ConvJob& j, int lane, const float (&wv)[32], float gl, LAS float* scr) {
    const int k0 = 64 * j.kb, n0 = 32 * j.nb; const int gli = __builtin_bit_cast(int, gl);
#pragma unroll
    for (int i = 0; i < 32; ++i) { const int kk = 2 * i + (lane >> 5);
        const float g0 = __builtin_bit_cast(float, __builtin_amdgcn_readlane(gli, 2 * i)), g1 = __builtin_bit_cast(float, __builtin_amdgcn_readlane(gli, 2 * i + 1));
        scr[kk * 33 + (lane & 31)] = wv[i] * (lane < 32 ? g0 : g1); }
    asm volatile("s_waitcnt lgkmcnt(0)" ::: "memory");
    const int c = lane & 7;
#pragma unroll
    for (int jj = 0; jj < 4; ++jj) { const int n = (lane >> 3) + 8 * jj; const LAS float* s = scr + (8 * c) * 33 + n;
        uint4 o; o.x = pk2(s[0 * 33], s[1 * 33]); o.y = pk2(s[2 * 33], s[3 * 33]); o.z = pk2(s[4 * 33], s[5 * 33]); o.w = pk2(s[6 * 33], s[7 * 33]);
        *(uint4*)(j.dst + (size_t)(n0 + n) * j.ldd + k0 + 8 * c) = o; }
    asm volatile("s_waitcnt lgkmcnt(0)" ::: "memory");
}
__device__ __forceinline__ void phase_convert(Ctx C) {
    C.refresh();
    LAS float* scr = (LAS float*)(C.lds + C.wave * 16384);
    for (int it = C.gw; it < I_L; it += C.NGW) { const ConvJob j = conv_job(C, 0, it); float wv[32], gl; conv_issue(j, C.lane, wv, gl); conv_finish(j, C.lane, wv, gl, scr); }
    { const int gt = C.gw * 64 + C.lane, NGT = C.NGW * 64;
      const float* wp = C.in[8]; bf16* wpb = (bf16*)(C.ws + WS_WPB);
      for (int i = gt; i < DEPTH * 4 * 256 * 256 / 8; i += NGT) { const F8 v = ld_f8(wp + (size_t)i * 8); st_bf8(wpb + (size_t)i * 8, v); } }
    for (int row = C.gw; row < M; row += C.NGW) {
        const float* src = row < MP ? C.in[0] + (size_t)row * DM : C.in[1] + (size_t)(row - MP) * DM;
        bf16* XB = (bf16*)(C.ws + WS_XB) + (size_t)row * DMP; float q = 0.f;
#pragma unroll
        for (int j = 0; j < 8; ++j) { const int idx = (C.lane + 64 * j) * 4; const float4 v = *(const float4*)(src + idx); q += (v.x * v.x + v.y * v.y) + (v.z * v.z + v.w * v.w);
            *(uint2*)(XB + idx) = make_uint2(pk2(v.x, v.y), pk2(v.z, v.w)); }
        q = wave_sum(q);
        if (C.lane == 0) ((float*)(C.ws + WS_R))[row] = rsqrtf(q * (1.f / DM) + EPS);
    }
}

__device__ __forceinline__ void phase_dt(Ctx C, int l) {
    C.refresh();
    typedef short bf16x8_t __attribute__((ext_vector_type(8)));
    const bf16* XB = (const bf16*)(C.ws + WS_XB); const bf16* BD = (const bf16*)(C.ws + WS_BTIN) + ((size_t)l * N_INP + N_PROJ) * DMP; const float* R = (const float*)(C.ws + WS_R); float* DT = (float*)(C.ws + WS_DT);
    const int r16 = C.lane & 15, q = C.lane >> 4;
    for (int task = C.gw; task < M / 16; task += C.NGW) {
        const int row0 = task * 16;
        const bf16* ap = XB + (size_t)(row0 + r16) * DMP + 8 * q; const bf16* b0 = BD + (size_t)r16 * DMP + 8 * q; const bf16* b1 = b0 + (size_t)16 * DMP;
        f32x4 acc0 = (f32x4){0.f, 0.f, 0.f, 0.f}, acc1 = acc0;
#pragma unroll 8
        for (int ks = 0; ks < DM / 32; ++ks) { const bf16x8_t a = *(const bf16x8_t*)(ap + 32 * ks);
            acc0 = __builtin_amdgcn_mfma_f32_16x16x32_bf16(a, *(const bf16x8_t*)(b0 + 32 * ks), acc0, 0, 0, 0);
            acc1 = __builtin_amdgcn_mfma_f32_16x16x32_bf16(a, *(const bf16x8_t*)(b1 + 32 * ks), acc1, 0, 0, 0); }
#pragma unroll
        for (int r = 0; r < 4; ++r) { const int row = row0 + 4 * q + r; const float s = R[row]; DT[(size_t)row * 32 + r16] = acc0[r] * s; DT[(size_t)row * 32 + 16 + r16] = acc1[r] * s; }
    }
}

__device__ __forceinline__ void phase_resid(Ctx C, const float* gpost, bool final_out, int nslab) {
    C.refresh();
    const bf16* MIXB = (const bf16*)(C.ws + WS_MIX); const float* SSQ = (const float*)(C.ws + WS_SSQP); const float* SLAB = (const float*)(C.ws + WS_SLAB);
    for (int row = C.gw; row < M; row += C.NGW) {
        F8 mv[4]; float p; uint4 xq[4];
        bf16* XB = (bf16*)(C.ws + WS_XB) + (size_t)row * DMP;
#pragma unroll
        for (int j = 0; j < 4; ++j) xq[j] = *(const uint4*)(XB + (C.lane + 64 * j) * 8);
        if (row < MP) {
            p = C.lane < 32 ? SSQ[(size_t)row * 32 + C.lane] : 0.f;
#pragma unroll
            for (int j = 0; j < 4; ++j) mv[j] = ld_bf8(MIXB + (size_t)row * DM + (C.lane + 64 * j) * 8);
        } else {
            p = 0.f;
#pragma unroll
            for (int j = 0; j < 4; ++j) { F8 a = zero8();
                for (int s = 0; s < nslab; ++s) { const F8 t = ld_f8(SLAB + ((size_t)s * MS + (row - MP)) * DM + (C.lane + 64 * j) * 8);
#pragma unroll
                    for (int k = 0; k < 8; ++k) a.v[k] += t.v[k]; }
                mv[j] = a;
#pragma unroll
                for (int k = 0; k < 8; ++k) p += a.v[k] * a.v[k]; }
        }
        p = wave_sum(p);
        const float rs = rsqrtf(p * (1.f / DM) + EPS);
        float* Y = C.out + O_YP + (size_t)row * DM; float q = 0.f;
#pragma unroll
        for (int j = 0; j < 4; ++j) { const int idx = (C.lane + 64 * j) * 8; const F8 g8 = ld_f8(gpost + idx); F8 v = unpack8(xq[j]);
#pragma unroll
            for (int k = 0; k < 8; ++k) { v.v[k] += mv[j].v[k] * rs * g8.v[k]; q += v.v[k] * v.v[k]; }
            if (final_out) st_f8(Y + idx, v);
            st_bf8(XB + idx, v); }
        q = wave_sum(q);
        if (C.lane == 0) ((float*)(C.ws + WS_R))[row] = rsqrtf(q * (1.f / DM) + EPS);
    }
}

__device__ __forceinline__ void phase_gnorm(Ctx C) {
    C.refresh();
    const float* SSQH = (const float*)(C.ws + WS_SSQH); bf16* MIXA = (bf16*)(C.ws + WS_MIXA);
    for (int rowb = C.gw * 4; rowb < M; rowb += C.NGW * 4) {
        uint4 qv[4][4]; float pr[4];
#pragma unroll
        for (int rr = 0; rr < 4; ++rr) { const int row = rowb + rr; pr[rr] = C.lane < 32 ? SSQH[(size_t)row * 32 + C.lane] : 0.f;
#pragma unroll
            for (int j = 0; j < 4; ++j) qv[rr][j] = *(const uint4*)(MIXA + (size_t)row * D_MIX + D_POOL + (C.lane + 64 * j) * 8); }
#pragma unroll
        for (int rr = 0; rr < 4; ++rr) { const int row = rowb + rr; float p = pr[rr];
#pragma unroll
            for (int o = 1; o < 16; o <<= 1) p += __shfl_xor(p, o);
            const float s0 = __shfl(p, 0), s1 = __shfl(p, 16);
            const float r0 = rsqrtf(s0 * (1.f / 1024.f) + EPS), r1 = rsqrtf(s1 * (1.f / 1024.f) + EPS);
            bf16* y = MIXA + (size_t)row * D_MIX + D_POOL;
#pragma unroll
            for (int j = 0; j < 4; ++j) { const int c = (C.lane + 64 * j) * 8; const float r = c < 1024 ? r0 : r1; F8 v = unpack8(qv[rr][j]);
#pragma unroll
                for (int i = 0; i < 8; ++i) v.v[i] *= r;
                st_bf8(y + c, v); } }
    }
}

__device__ __forceinline__ void phase_act(Ctx C, int l) {
    C.refresh();
    const bf16* UP = (const bf16*)(C.ws + WS_UP); bf16* ACT = (bf16*)(C.ws + WS_ACT);
    const float* cw = C.in[20] + (size_t)l * 3 * D_UP; const float* cb = C.in[21] + (size_t)l * D_UP; const float* hist = C.in[5] + (size_t)l * NB_S * 2 * D_UP;
    constexpr int NCG = D_FF / 8, NSTRIP = M / 32;
    const int gt = C.gw * 64 + C.lane, NGT = C.NGW * 64;
    for (int it = gt + (MP / 32) * NCG; it < NSTRIP * NCG; it += NGT) {
        const int strip = it / NCG, c = (it % NCG) * 8, row0 = strip * 32; const bool prm = row0 < MP;
        const int b = prm ? row0 / SEQ : (row0 - MP) / SEQ_S, t0 = prm ? row0 % SEQ : 0;
        F8 p2g, p1g, p2v, p1v;
        if (t0 == 0) { if (prm) { p2g = zero8(); p1g = zero8(); p2v = zero8(); p1v = zero8(); }
            else { const float* h = hist + (size_t)b * 2 * D_UP; p2g = ld_f8(h + c); p2v = ld_f8(h + D_FF + c); p1g = ld_f8(h + D_UP + c); p1v = ld_f8(h + D_UP + D_FF + c); } }
        else { p2g = ld_bf8(UP + (size_t)(row0 - 2) * D_UP + c); p2v = ld_bf8(UP + (size_t)(row0 - 2) * D_UP + D_FF + c); p1g = ld_bf8(UP + (size_t)(row0 - 1) * D_UP + c); p1v = ld_bf8(UP + (size_t)(row0 - 1) * D_UP + D_FF + c); }
        const F8 w0g = ld_f8(cw + c), w1g = ld_f8(cw + D_UP + c), w2g = ld_f8(cw + 2 * D_UP + c), bg = ld_f8(cb + c);
        const F8 w0v = ld_f8(cw + D_FF + c), w1v = ld_f8(cw + D_UP + D_FF + c), w2v = ld_f8(cw + 2 * D_UP + D_FF + c), bv = ld_f8(cb + D_FF + c);
        for (int r0 = 0; r0 < 32; r0 += 8) {
            uint4 qg[8], qv[8];
#pragma unroll
            for (int r = 0; r < 8; ++r) { qg[r] = *(const uint4*)(UP + (size_t)(row0 + r0 + r) * D_UP + c); qv[r] = *(const uint4*)(UP + (size_t)(row0 + r0 + r) * D_UP + D_FF + c); }
#pragma unroll
            for (int r = 0; r < 8; ++r) { const F8 cg = unpack8(qg[r]), cv = unpack8(qv[r]); F8 o;
#pragma unroll
                for (int i = 0; i < 8; ++i) { const float g = bg.v[i] + w0g.v[i] * p2g.v[i] + w1g.v[i] * p1g.v[i] + w2g.v[i] * cg.v[i]; const float v = bv.v[i] + w0v.v[i] * p2v.v[i] + w1v.v[i] * p1v.v[i] + w2v.v[i] * cv.v[i]; o.v[i] = silu_f(g) * v; }
                st_bf8(ACT + (size_t)(row0 + r0 + r) * D_FF + c, o);
                p2g = p1g; p1g = cg; p2v = p1v; p1v = cv; }
        }
        if (!prm || t0 + 32 == SEQ) {
            float* o = C.out + (prm ? O_FCP + ((size_t)(l * NB_P + b) * 2) * D_UP : O_FCS + ((size_t)(l * NB_S + b) * 2) * D_UP);
            st_f8(o + c, p2g); st_f8(o + D_FF + c, p2v); st_f8(o + D_UP + c, p1g); st_f8(o + D_UP + D_FF + c, p1v);
        }
    }
}

__device__ __forceinline__ void phase_actfix(Ctx C, int l) {
    C.refresh();
    const bf16* SIDE = (const bf16*)(C.ws + WS_SIDE); bf16* ACT = (bf16*)(C.ws + WS_ACT);
    const float* cw = C.in[20] + (size_t)l * 3 * D_UP; const float* cb = C.in[21] + (size_t)l * D_UP;
    constexpr int NCG = D_FF / 8, NBLK = MP / 64;
    const int gt = C.gw * 64 + C.lane, NGT = C.NGW * 64;
    for (int it = gt; it < NBLK * NCG; it += NGT) {
        const int kb = it / NCG, c = (it % NCG) * 8; const bool start = (kb % (SEQ / 64)) == 0;
        const bf16* sp = SIDE + (size_t)(start ? kb : kb - 1) * 4 * D_UP + c; const bf16* sc = SIDE + (size_t)kb * 4 * D_UP + c;
        uint4 q[8];
        q[0] = *(const uint4*)(sp + 2 * D_UP); q[1] = *(const uint4*)(sp + 2 * D_UP + D_FF); q[2] = *(const uint4*)(sp + 3 * D_UP); q[3] = *(const uint4*)(sp + 3 * D_UP + D_FF);
        q[4] = *(const uint4*)(sc); q[5] = *(const uint4*)(sc + D_FF); q[6] = *(const uint4*)(sc + D_UP); q[7] = *(const uint4*)(sc + D_UP + D_FF);
        F8 p2g = unpack8(q[0]), p2v = unpack8(q[1]), p1g = unpack8(q[2]), p1v = unpack8(q[3]); const F8 r0g = unpack8(q[4]), r0v = unpack8(q[5]), r1g = unpack8(q[6]), r1v = unpack8(q[7]);
        if (start) { p2g = zero8(); p2v = zero8(); p1g = zero8(); p1v = zero8(); }
        const F8 w0g = ld_f8(cw + c), w1g = ld_f8(cw + D_UP + c), w2g = ld_f8(cw + 2 * D_UP + c), bg = ld_f8(cb + c);
        const F8 w0v = ld_f8(cw + D_FF + c), w1v = ld_f8(cw + D_UP + D_FF + c), w2v = ld_f8(cw + 2 * D_UP + D_FF + c), bv = ld_f8(cb + D_FF + c);
        F8 o0, o1;
#pragma unroll
        for (int i = 0; i < 8; ++i) { const float g0 = bg.v[i] + w0g.v[i] * p2g.v[i] + w1g.v[i] * p1g.v[i] + w2g.v[i] * r0g.v[i], v0 = bv.v[i] + w0v.v[i] * p2v.v[i] + w1v.v[i] * p1v.v[i] + w2v.v[i] * r0v.v[i];
            const float g1 = bg.v[i] + w0g.v[i] * p1g.v[i] + w1g.v[i] * r0g.v[i] + w2g.v[i] * r1g.v[i], v1 = bv.v[i] + w0v.v[i] * p1v.v[i] + w1v.v[i] * r0v.v[i] + w2v.v[i] * r1v.v[i];
            o0.v[i] = silu_f(g0) * v0; o1.v[i] = silu_f(g1) * v1; }
        st_bf8(ACT + (size_t)(kb * 64) * D_FF + c, o0); st_bf8(ACT + (size_t)(kb * 64 + 1) * D_FF + c, o1);
        if ((kb % (SEQ / 64)) == SEQ / 64 - 1) {
            float* o = C.out + O_FCP + ((size_t)(l * NB_P + kb / (SEQ / 64)) * 2) * D_UP;
            st_f8(o + c, ld_bf8(sc + 2 * D_UP)); st_f8(o + D_FF + c, ld_bf8(sc + 2 * D_UP + D_FF)); st_f8(o + D_UP + c, ld_bf8(sc + 3 * D_UP)); st_f8(o + D_UP + D_FF + c, ld_bf8(sc + 3 * D_UP + D_FF)); }
    }
}

__device__ __forceinline__ void phase_pool(Ctx C, int l) {
    C.refresh();
    const bf16* PROJ = (const bf16*)(C.ws + WS_PROJ); bf16* MIXA = (bf16*)(C.ws + WS_MIXA);
    const float* hist = C.in[2] + (size_t)l * NB_S * POOL_HIST * D_POOL;
    constexpr int NCG = D_POOL / 8, NSTRIP = M / 32;
    const int gt = C.gw * 64 + C.lane, NGT = C.NGW * 64;
    for (int it = gt; it < NSTRIP * NCG; it += NGT) {
        const int strip = it / NCG, cgi = it % NCG, c = cgi * 8, row0 = strip * 32; const bool prm = row0 < MP;
        const int b = prm ? row0 / SEQ : (row0 - MP) / SEQ_S, t0 = prm ? row0 % SEQ : 0, w = 2 << (cgi >> 5);
        const int rb = row0 - t0;
        const float* hb = hist + (size_t)b * POOL_HIST * D_POOL;
        F8 s = zero8();
        for (int i = 1; i < w; ++i) { const int t = t0 - i; F8 v;
            if (t >= 0) v = ld_bf8(PROJ + (size_t)(rb + t) * N_PROJ + c); else if (!prm) v = ld_f8(hb + (size_t)(POOL_HIST + t) * D_POOL + c); else v = zero8();
#pragma unroll
            for (int k = 0; k < 8; ++k) s.v[k] += v.v[k]; }
        for (int r0 = 0; r0 < 32; r0 += 8) {
            uint4 qc[8], ql[8];
#pragma unroll
            for (int r = 0; r < 8; ++r) { const int t = t0 + r0 + r, tl = t - w + 1; qc[r] = *(const uint4*)(PROJ + (size_t)(rb + t) * N_PROJ + c); ql[r] = *(const uint4*)(PROJ + (size_t)(rb + (tl > 0 ? tl : 0)) * N_PROJ + c); }
#pragma unroll
            for (int r = 0; r < 8; ++r) { const int t = t0 + r0 + r, tl = t - w + 1; const F8 cur = unpack8(qc[r]);
                const float inv = 1.f / (float)(prm ? (t + 1 < w ? t + 1 : w) : w); F8 o;
#pragma unroll
                for (int k = 0; k < 8; ++k) { s.v[k] += cur.v[k]; o.v[k] = s.v[k] * inv - cur.v[k]; }
                st_bf8(MIXA + (size_t)(rb + t) * D_MIX + c, o);
                F8 v = unpack8(ql[r]);
                if (tl < 0) { if (!prm) v = ld_f8(hb + (size_t)(POOL_HIST + tl) * D_POOL + c); else v = zero8(); }
#pragma unroll
                for (int k = 0; k < 8; ++k) s.v[k] -= v.v[k]; }
        }
    }
    for (int it = gt; it < (NB_P + NB_S) * 15 * NCG; it += NGT) {
        const int cg = it % NCG, i = (it / NCG) % 15, sb = it / (NCG * 15); const bool prm = sb < NB_P; const int b = prm ? sb : sb - NB_P;
        const int row = prm ? b * SEQ + (SEQ - 15 + i) : MP + b * SEQ_S + (SEQ_S - 15 + i);
        float* o = C.out + (prm ? O_POOLP + ((size_t)(l * NB_P + b) * 15 + i) * D_POOL : O_POOLS + ((size_t)(l * NB_S + b) * 15 + i) * D_POOL);
        st_f8(o + cg * 8, ld_bf8(PROJ + (size_t)row * N_PROJ + cg * 8));
    }
    constexpr int NCG2 = CONV_DIM / 8;
    for (int it = gt; it < (NB_P + NB_S) * 3 * NCG2; it += NGT) {
        const int cg = it % NCG2, i = (it / NCG2) % 3, sb = it / (NCG2 * 3); const bool prm = sb < NB_P; const int b = prm ? sb : sb - NB_P;
        const int row = prm ? b * SEQ + (SEQ - 3 + i) : MP + b * SEQ_S + (SEQ_S - 3 + i);
        float* o = C.out + (prm ? O_SCP + ((size_t)(l * NB_P + b) * 3 + i) * CONV_DIM : O_SCS + ((size_t)(l * NB_S + b) * 3 + i) * CONV_DIM);
        st_f8(o + cg * 8, ld_bf8(PROJ + (size_t)row * N_PROJ + XBC0 + cg * 8));
    }
}

__device__ __forceinline__ void phase_ssd(Ctx C, int l) {
    C.refresh();
    LAS float* xs = (LAS float*)(C.lds); LAS float* Bs = (LAS float*)(C.lds + 16384); LAS float* Cs = (LAS float*)(C.lds + 49152); LAS float* ys = (LAS float*)(C.lds + 81920);
    LAS float* dts = (LAS float*)(C.lds + 98304); LAS float* dAs = dts + 64;
    const bf16* PROJ = (const bf16*)(C.ws + WS_PROJ); const float* DT = (const float*)(C.ws + WS_DT); bf16* MIXA = (bf16*)(C.ws + WS_MIXA); float* SSQH = (float*)(C.ws + WS_SSQH);
    const float* cw = C.in[10] + (size_t)l * 4 * CONV_DIM; const float* cb = C.in[11] + (size_t)l * CONV_DIM;
    const int tid = C.tid, p = tid >> 3, n0 = (tid & 7) * 16;
    for (int u = blockIdx.x; u < NB_P * NH + NB_S * NH; u += C.G) {
        const bool prm = u < NB_P * NH; const int su = prm ? u : u - NB_P * NH, b = su / NH, hh = su % NH, g = hh / HPG;
        const int rb = prm ? b * SEQ : MP + b * SEQ_S, rows = prm ? 64 : 32, nchunk = prm ? SEQ / 64 : 1;
        const float Aneg = -__expf(C.in[13][l * NH + hh]), Dsk = C.in[14][l * NH + hh], dtb = C.in[12][l * NH + hh];
        const float* chist = C.in[3] + ((size_t)(l * NB_S + b) * 3) * CONV_DIM;
        float h[16];
        if (prm) {
#pragma unroll
            for (int i = 0; i < 16; ++i) h[i] = 0.f;
        } else { const float* h0 = C.in[4] + ((((size_t)l * NB_S + b) * NH + hh) * HD + p) * DS + n0;
#pragma unroll
            for (int i = 0; i < 4; ++i) { const float4 v = *(const float4*)(h0 + 4 * i); h[4 * i] = v.x; h[4 * i + 1] = v.y; h[4 * i + 2] = v.z; h[4 * i + 3] = v.w; } }
        for (int ch = 0; ch < nchunk; ++ch) {
            const int tb = ch * 64;
            for (int e = tid; e < rows * 40; e += NTHR) {
                const int cg = e % 40, tt = e / 40, t = tb + tt;
                int cc; LAS float* dstp;
                if (cg < 8) { cc = hh * HD + cg * 8; dstp = xs + tt * 64 + cg * 8; }
                else if (cg < 24) { cc = D_SSD + g * DS + (cg - 8) * 8; dstp = Bs + tt * 128 + (cg - 8) * 8; }
                else { cc = D_SSD + 2 * DS + g * DS + (cg - 24) * 8; dstp = Cs + tt * 128 + (cg - 24) * 8; }
                F8 a = ld_f8(cb + cc);
#pragma unroll
                for (int i = 0; i < 4; ++i) { const int ti = t - 3 + i; F8 v;
                    if (ti >= 0) v = ld_bf8(PROJ + (size_t)(rb + ti) * N_PROJ + XBC0 + cc); else if (!prm) v = ld_f8(chist + (size_t)(3 + ti) * CONV_DIM + cc); else v = zero8();
                    const F8 wv = ld_f8(cw + (size_t)i * CONV_DIM + cc);
#pragma unroll
                    for (int k = 0; k < 8; ++k) a.v[k] += wv.v[k] * v.v[k]; }
#pragma unroll
                for (int k = 0; k < 8; ++k) dstp[k] = silu_f(a.v[k]);
            }
            if (tid < rows) { const float xr = DT[(size_t)(rb + tb + tid) * 32 + hh] + dtb; const float dtv = xr > 20.f ? xr : log1pf(__expf(xr)); dts[tid] = dtv; dAs[tid] = __expf(dtv * Aneg); }
            __syncthreads();
            for (int tt = 0; tt < rows; ++tt) {
                const float xv = xs[tt * 64 + p], xdt = xv * dts[tt], dA = dAs[tt]; float acc = 0.f;
#pragma unroll
                for (int i = 0; i < 4; ++i) { const f32x4 bv = *(const LAS f32x4*)(Bs + tt * 128 + n0 + 4 * i), cv = *(const LAS f32x4*)(Cs + tt * 128 + n0 + 4 * i);
                    h[4 * i] = dA * h[4 * i] + xdt * bv[0]; acc += cv[0] * h[4 * i];
                    h[4 * i + 1] = dA * h[4 * i + 1] + xdt * bv[1]; acc += cv[1] * h[4 * i + 1];
                    h[4 * i + 2] = dA * h[4 * i + 2] + xdt * bv[2]; acc += cv[2] * h[4 * i + 2];
                    h[4 * i + 3] = dA * h[4 * i + 3] + xdt * bv[3]; acc += cv[3] * h[4 * i + 3]; }
                acc += __shfl_xor(acc, 1); acc += __shfl_xor(acc, 2); acc += __shfl_xor(acc, 4);
                if ((tid & 7) == 0) ys[tt * 64 + p] = acc + Dsk * xv;
            }
            __syncthreads();
            for (int e = tid; e < rows * 64; e += NTHR) {
                const int tt = e >> 6, pp = e & 63; const size_t row = (size_t)(rb + tb + tt);
                const float zv = bf2f(PROJ[row * N_PROJ + D_POOL + hh * HD + pp]); const float yz = ys[tt * 64 + pp] * silu_f(zv);
                MIXA[row * D_MIX + D_POOL + hh * HD + pp] = (bf16)f2bf(yz);
                const float q = wave_sum(yz * yz);
                if (pp == 0) SSQH[row * 32 + hh] = q;
            }
            __syncthreads();
        }
        float* ho = C.out + (prm ? O_SSDP + ((((size_t)l * NB_P + b) * NH + hh) * HD + p) * DS + n0 : O_SSDS + ((((size_t)l * NB_S + b) * NH + hh) * HD + p) * DS + n0);
#pragma unroll
        for (int i = 0; i < 4; ++i) *(float4*)(ho + 4 * i) = make_float4(h[4 * i], h[4 * i + 1], h[4 * i + 2], h[4 * i + 3]);
    }
}

__device__ __forceinline__ void phase_xact(Ctx C, int l) {
    C.refresh();
    const bf16* PROJ = (const bf16*)(C.ws + WS_PROJ); bf16* ACTX = (bf16*)(C.ws + WS_ACTX);
    const float* cw = C.in[10] + (size_t)l * 4 * CONV_DIM; const float* cb = C.in[11] + (size_t)l * CONV_DIM;
    constexpr int NCG = CONV_DIM / 8, NSTRIP = M / 16;
    const int gt = C.gw * 64 + C.lane, NGT = C.NGW * 64;
    for (int it = gt; it < NSTRIP * NCG; it += NGT) {
        const int strip = it / NCG, c = (it % NCG) * 8, row0 = strip * 16; const bool prm = row0 < MP;
        const int t0 = prm ? row0 % SEQ : (row0 - MP) % SEQ_S, b = prm ? row0 / SEQ : (row0 - MP) / SEQ_S;
        uint4 rq[19];
#pragma unroll
        for (int j = 0; j < 19; ++j) { const int dr = (t0 == 0 && j < 3) ? 0 : j - 3; rq[j] = *(const uint4*)(PROJ + (size_t)(row0 + dr) * N_PROJ + XBC0 + c); }
        if (t0 == 0) {
            const float* h = C.in[3] + ((size_t)(l * NB_S + (prm ? 0 : b)) * 3) * CONV_DIM + c;
#pragma unroll
            for (int j = 0; j < 3; ++j) { uint4 v = make_uint4(0u, 0u, 0u, 0u);
                if (!prm) { const F8 hv = ld_f8(h + (size_t)j * CONV_DIM); v = make_uint4(pk2(hv.v[0], hv.v[1]), pk2(hv.v[2], hv.v[3]), pk2(hv.v[4], hv.v[5]), pk2(hv.v[6], hv.v[7])); }
                rq[j] = v; } }
        F8 wv[4];
#pragma unroll
        for (int i = 0; i < 4; ++i) wv[i] = ld_f8(cw + (size_t)i * CONV_DIM + c);
        const F8 bv = ld_f8(cb + c);
#pragma unroll
        for (int i = 0; i < 16; ++i) { F8 o = bv;
#pragma unroll
            for (int tap = 0; tap < 4; ++tap) { const F8 rj = unpack8(rq[i + tap]);
#pragma unroll
                for (int k = 0; k < 8; ++k) o.v[k] += wv[tap].v[k] * rj.v[k]; }
#pragma unroll
            for (int k = 0; k < 8; ++k) o.v[k] = silu_f(o.v[k]);
            st_bf8(ACTX + (size_t)(row0 + i) * CONV_DIM + c, o); }
    }
}

constexpr int SL_C = 0, SL_B = 17408, SL_BT = 34816, SL_XT = 53248, SL_H = 62464, SL_M = 79872, SL_DT = 89088, SL_AC = SL_DT + 512, SL_W = SL_AC + 512, SL_DEC = SL_W + 512, SL_SSQ = SL_DEC + 16, SL_XWT = SL_SSQ + 1024;
constexpr int PC = 272, PT = 144;
typedef short bf16x8_t __attribute__((ext_vector_type(8)));
__device__ __forceinline__ bf16x8_t ld_op(const LAS unsigned char* base, int row, int pitch, int kelem) { return *(const LAS bf16x8_t*)(base + row * pitch + kelem * 2); }
__device__ __forceinline__ int swz(int row, int byte) { return byte ^ (((row >> 3) & 7) << 4); }
__device__ __forceinline__ bf16x8_t ld_op_sw(const LAS unsigned char* base, int row, int pitch, int kelem) { return *(const LAS bf16x8_t*)(base + row * pitch + swz(row, kelem * 2)); }

typedef unsigned u32x4_t __attribute__((ext_vector_type(4)));
typedef unsigned u32x2_t __attribute__((ext_vector_type(2)));
__device__ __forceinline__ F8 lds_f8(const LAS float* p) { const f32x4 a = *(const LAS f32x4*)p, b = *(const LAS f32x4*)(p + 4); F8 r; r.v[0] = a[0]; r.v[1] = a[1]; r.v[2] = a[2]; r.v[3] = a[3]; r.v[4] = b[0]; r.v[5] = b[1]; r.v[6] = b[2]; r.v[7] = b[3]; return r; }
__device__ __forceinline__ unsigned perm_lo(unsigned hi_row, unsigned lo_row) { return __builtin_amdgcn_perm(hi_row, lo_row, 0x05040100u); }
__device__ __forceinline__ unsigned perm_hi(unsigned hi_row, unsigned lo_row) { return __builtin_amdgcn_perm(hi_row, lo_row, 0x07060302u); }
__device__ __forceinline__ unsigned qword(const uint4& v, int i) { return i == 0 ? v.x : (i == 1 ? v.y : (i == 2 ? v.z : v.w)); }
__device__ __forceinline__ void ssd_stage(LAS unsigned char* L, int cg, int l0, int rows_valid, const LAS float* w_s, const uint4 (&rq)[8]) {
    uint4 r[8];
#pragma unroll
    for (int i = 0; i < 8; ++i) { const bool ok = l0 + i < rows_valid; r[i].x = ok ? rq[i].x : 0u; r[i].y = ok ? rq[i].y : 0u; r[i].z = ok ? rq[i].z : 0u; r[i].w = ok ? rq[i].w : 0u; }
    if (cg < 8) {
        const f32x4 wa = *(const LAS f32x4*)(w_s + l0), wb = *(const LAS f32x4*)(w_s + l0 + 4);
#pragma unroll
        for (int k = 0; k < 8; ++k) { const int p = 8 * cg + k; unsigned t[4];
#pragma unroll
            for (int jj = 0; jj < 4; ++jj) t[jj] = (k & 1) ? perm_hi(qword(r[2 * jj + 1], k >> 1), qword(r[2 * jj], k >> 1)) : perm_lo(qword(r[2 * jj + 1], k >> 1), qword(r[2 * jj], k >> 1));
            *(LAS u32x4_t*)(L + SL_XT + p * PT + swz(p, l0 * 2)) = (u32x4_t){t[0], t[1], t[2], t[3]};
            *(LAS u32x4_t*)(L + SL_XWT + p * PT + swz(p, l0 * 2)) = (u32x4_t){pk2(bflo(t[0]) * wa[0], bfhi(t[0]) * wa[1]), pk2(bflo(t[1]) * wa[2], bfhi(t[1]) * wa[3]), pk2(bflo(t[2]) * wb[0], bfhi(t[2]) * wb[1]), pk2(bflo(t[3]) * wb[2], bfhi(t[3]) * wb[3])}; }
    } else if (cg < 24) { const int n0 = 8 * (cg - 8);
#pragma unroll
        for (int i = 0; i < 8; ++i) *(LAS u32x4_t*)(L + SL_B + (l0 + i) * PC + n0 * 2) = (u32x4_t){r[i].x, r[i].y, r[i].z, r[i].w};
#pragma unroll
        for (int k = 0; k < 8; ++k) { const int n = n0 + k; unsigned t[4];
#pragma unroll
            for (int jj = 0; jj < 4; ++jj) t[jj] = (k & 1) ? perm_hi(qword(r[2 * jj + 1], k >> 1), qword(r[2 * jj], k >> 1)) : perm_lo(qword(r[2 * jj + 1], k >> 1), qword(r[2 * jj], k >> 1));
            *(LAS u32x4_t*)(L + SL_BT + n * PT + swz(n, l0 * 2)) = (u32x4_t){t[0], t[1], t[2], t[3]}; }
    } else { const int n0 = 8 * (cg - 24);
#pragma unroll
        for (int i = 0; i < 8; ++i) *(LAS u32x4_t*)(L + SL_C + (l0 + i) * PC + n0 * 2) = (u32x4_t){r[i].x, r[i].y, r[i].z, r[i].w};
    }
}
__device__ __forceinline__ void ssd_dt(LAS unsigned char* L, int par, float xr, bool valid, float Aneg, int lane) {
    const float dtv = valid ? (xr > 20.f ? xr : log1pf(__expf(xr))) : 0.f;
    float a = dtv * Aneg;
#pragma unroll
    for (int o = 1; o < 64; o <<= 1) { const float v = __shfl_up(a, o); if (lane >= o) a += v; }
    const float last = __shfl(a, 63);
    ((LAS float*)(L + SL_DT))[par * 64 + lane] = dtv; ((LAS float*)(L + SL_AC))[par * 64 + lane] = a; ((LAS float*)(L + SL_W))[par * 64 + lane] = dtv * __expf(last - a);
    if (lane == 0) ((LAS float*)(L + SL_DEC))[par] = __expf(last);
}
#define WG_BAR() do { asm volatile("s_waitcnt lgkmcnt(0)" ::: "memory"); __builtin_amdgcn_s_barrier(); asm volatile("" ::: "memory"); } while (0)
__device__ __forceinline__ void stage_role(int tq, int& cg, int& l0) {
    const int ws = tq >> 6, lane = tq & 63;
    if (ws == 0) { cg = lane & 7; l0 = (lane >> 3) * 8; }
    else { const int idx = ((ws - 1) & 1) * 64 + lane; cg = (ws <= 2 ? 8 : 24) + (idx & 15); l0 = (idx >> 4) * 8; }
}
__device__ __forceinline__ void ssd_load_act(uint4 (&rq)[8], const bf16* ACTX, int tq, int hh, int g, size_t rowf) {
    int cg, l0c; stage_role(tq, cg, l0c);
    const int cc = cg < 8 ? hh * HD + cg * 8 : (cg < 24 ? D_SSD + g * DS + (cg - 8) * 8 : D_SSD + 2 * DS + g * DS + (cg - 24) * 8);
    const unsigned lo = tq < 320 ? (unsigned)(l0c * CONV_DIM + cc) * 2u : 0u;
#pragma unroll
    for (int j = 0; j < 8; ++j) { const char* ub = (const char*)ACTX + ((rowf + j) * CONV_DIM) * 2; rq[j] = *(const uint4*)(ub + lo); }
}
__device__ __forceinline__ void ssd_load_z(uint2 (&zq)[2], const bf16* PROJ, int w, int r16, int q, int hh, size_t row0, int rows) {
    const int pi = w >> 1, li0 = 2 * (w & 1);
#pragma unroll
    for (int t = 0; t < 2; ++t) { const int lrow = 16 * (li0 + t) + r16; const char* ub = (const char*)PROJ + ((row0 + 16 * (li0 + t)) * N_PROJ + D_POOL + hh * HD + 16 * pi) * 2;
        zq[t] = lrow < rows ? *(const uint2*)(ub + (unsigned)(r16 * N_PROJ + 4 * q) * 2u) : make_uint2(0u, 0u); }
}
#define OPQ_V(x) asm volatile("" : "+v"(x))
#define OPQ_S(x) asm volatile("" : "+s"(x))
__device__ __forceinline__ void phase_ssd2(Ctx C, int l) {
    C.refresh();
    LAS unsigned char* L = C.lds;
    const bf16* PROJ = (const bf16*)(C.ws + WS_PROJ); const bf16* ACTX = (const bf16*)(C.ws + WS_ACTX); const float* DT = (const float*)(C.ws + WS_DT); bf16* MIXA = (bf16*)(C.ws + WS_MIXA); float* SSQH = (float*)(C.ws + WS_SSQH);
    const int w0 = C.wave;
    const int conv_l = l + 1 < DEPTH ? l + 1 : -1, cG = C.G, cbx = (int)blockIdx.x;
    float cwv[32], cgl = 1.f; int cslot = 0;
#define tid0 (w0 * 64 + lane_id())
    typedef float f4 __attribute__((ext_vector_type(4)));
#if PROBE_SEL > 0
    volatile LAS unsigned* MISC2 = (volatile LAS unsigned*)(C.lds + LDSCTL_OFF);
    if (blockIdx.x == 0 && w0 == 0 && lane_id() == 0) MISC2[13] = (unsigned)__builtin_amdgcn_s_memrealtime();
#define STAMP2(ty) do { if (blockIdx.x == 0 && w0 == 0 && lane_id() == 0) { const unsigned tn = (unsigned)__builtin_amdgcn_s_memrealtime(); MISC2[16 + (ty)] += tn - MISC2[13]; MISC2[13] = tn; } } while (0)
#else
#define STAMP2(ty) do { } while (0)
#endif
    for (int u = blockIdx.x; u < NB_P * NH + NB_S * NH; u += C.G) {
        STAMP2(19);
        const bool prm = u < NB_P * NH; const int su = prm ? u : u - NB_P * NH, b = su / NH, hh = su % NH, g = hh / HPG;
        const int rb = prm ? b * SEQ : MP + b * SEQ_S, rows = prm ? 64 : 32, nchunk = prm ? SEQ / 64 : 1;
        const float Aneg = -__expf(C.in[13][l * NH + hh]), Dsk = C.in[14][l * NH + hh], dtb = C.in[12][l * NH + hh];
        f4 hacc[4]; float xrn; uint2 zq[2]; uint4 rawq[8];
        {
            int tq = tid0, w = w0; OPQ_V(tq); OPQ_S(w);
            const int lane = tq & 63, r16 = lane & 15, q = lane >> 4; const bool stg = tq < 320; int cg, l0; stage_role(tq, cg, l0);
#pragma unroll
            for (int pj = 0; pj < 4; ++pj) {
                if (prm) hacc[pj] = (f4){0.f, 0.f, 0.f, 0.f};
                else { const float4 v = *(const float4*)(C.in[4] + ((((size_t)l * NB_S + b) * NH + hh) * HD + 16 * pj + r16) * DS + 16 * w + 4 * q); hacc[pj] = (f4){v.x, v.y, v.z, v.w}; }
                *(LAS u32x2_t*)(L + SL_H + (16 * pj + r16) * PC + (16 * w + 4 * q) * 2) = (u32x2_t){pk2(hacc[pj][0], hacc[pj][1]), pk2(hacc[pj][2], hacc[pj][3])};
            }
            const float xr0 = DT[((size_t)rb + (lane < rows ? lane : 0)) * 32 + hh] + dtb;
            ssd_load_act(rawq, ACTX, tq, hh, g, (size_t)rb);
            if (w == 0) ssd_dt(L, 0, xr0, lane < rows, Aneg, lane);
            xrn = DT[((size_t)(rb + 64) + lane) * 32 + hh] + dtb;
            WG_BAR();
            if (stg) ssd_stage(L, cg, l0, rows, (const LAS float*)(L + SL_W), rawq);
            ssd_load_z(zq, PROJ, w, r16, q, hh, (size_t)rb, rows);
            ssd_load_act(rawq, ACTX, tq, hh, g, (size_t)rb + 64);
            WG_BAR();
        }
        STAMP2(13);
        for (int c = 0; c < nchunk; ++c) {
            const int par = c & 1, tb = c * 64; const bool more = c + 1 < nchunk;
            {
                int tq = tid0, w = w0; OPQ_V(tq); OPQ_S(w);
                const int lane = tq & 63, r16 = lane & 15, q = lane >> 4;
                const float xrc = xrn;
                xrn = DT[((size_t)(rb + tb + 128) + lane) * 32 + hh] + dtb;
                if (more && w == 0) ssd_dt(L, par ^ 1, xrc, true, Aneg, lane);
                const LAS float* ac = (const LAS float*)(L + SL_AC) + par * 64; const LAS float* dts = (const LAS float*)(L + SL_DT) + par * 64;
#pragma unroll
                for (int t = 0; t < 2; ++t) { const int T = 2 * w + t, si = T >> 2, li = T & 3; f4 acc = (f4){0.f, 0.f, 0.f, 0.f};
#pragma unroll
                    for (int ks = 0; ks < 4; ++ks) acc = __builtin_amdgcn_mfma_f32_16x16x32_bf16(ld_op(L + SL_B, 16 * si + r16, PC, 32 * ks + 8 * q), ld_op(L + SL_C, 16 * li + r16, PC, 32 * ks + 8 * q), acc, 0, 0, 0);
                    const int lr = 16 * li + r16, s0 = 16 * si + 4 * q; const float al = ac[lr]; const f4 as = *(const LAS f4*)(ac + s0), ds = *(const LAS f4*)(dts + s0); float m[4];
#pragma unroll
                    for (int r = 0; r < 4; ++r) m[r] = (s0 + r <= lr) ? acc[r] * __expf(al - as[r]) * ds[r] : 0.f;
                    *(LAS u32x2_t*)(L + SL_M + lr * PT + s0 * 2) = (u32x2_t){pk2(m[0], m[1]), pk2(m[2], m[3])}; }
            }
            WG_BAR(); STAMP2(14);
            {
                int tq = tid0, w = w0; OPQ_V(tq); OPQ_S(w);
                const int lane = tq & 63, r16 = lane & 15, q = lane >> 4, pi = w >> 1, li0 = 2 * (w & 1);
                const LAS float* ac = (const LAS float*)(L + SL_AC) + par * 64;
#pragma unroll
                for (int t = 0; t < 2; ++t) { const int li = li0 + t; f4 yd = (f4){0.f, 0.f, 0.f, 0.f}, yo = (f4){0.f, 0.f, 0.f, 0.f};
#pragma unroll
                    for (int ks = 0; ks < 2; ++ks) yd = __builtin_amdgcn_mfma_f32_16x16x32_bf16(ld_op_sw(L + SL_XT, 16 * pi + r16, PT, 32 * ks + 8 * q), ld_op(L + SL_M, 16 * li + r16, PT, 32 * ks + 8 * q), yd, 0, 0, 0);
#pragma unroll
                    for (int ks = 0; ks < 4; ++ks) yo = __builtin_amdgcn_mfma_f32_16x16x32_bf16(ld_op(L + SL_H, 16 * pi + r16, PC, 32 * ks + 8 * q), ld_op(L + SL_C, 16 * li + r16, PC, 32 * ks + 8 * q), yo, 0, 0, 0);
                    const int lr = 16 * li + r16, p0 = 16 * pi + 4 * q; const float e = __expf(ac[lr]);
                    const float zf[4] = {bflo(zq[t].x), bfhi(zq[t].x), bflo(zq[t].y), bfhi(zq[t].y)}; float yz[4], ss = 0.f;
#pragma unroll
                    for (int r = 0; r < 4; ++r) { const float xv = bf2f(*(const LAS bf16*)(L + SL_XT + (p0 + r) * PT + swz(p0 + r, lr * 2))); const float y = yd[r] + e * yo[r] + Dsk * xv; yz[r] = y * silu_f(zf[r]); ss += yz[r] * yz[r]; }
                    if (lr < rows) { char* ub = (char*)MIXA + ((size_t)(rb + tb + 16 * li) * D_MIX + D_POOL + hh * HD + 16 * pi) * 2; *(uint2*)(ub + (unsigned)(r16 * D_MIX + 4 * q) * 2u) = make_uint2(pk2(yz[0], yz[1]), pk2(yz[2], yz[3])); }
                    ss += __shfl_xor(ss, 16); ss += __shfl_xor(ss, 32);
                    if (q == 0) ((LAS float*)(L + SL_SSQ))[lr * 4 + pi] = ss; }
            }
            {
                int tq = tid0, w = w0; OPQ_V(tq); OPQ_S(w);
                const int lane = tq & 63, r16 = lane & 15, q = lane >> 4;
                const float dec = ((const LAS float*)(L + SL_DEC))[par];
#pragma unroll
                for (int pj = 0; pj < 4; ++pj) { hacc[pj] = hacc[pj] * dec;
#pragma unroll
                    for (int ks = 0; ks < 2; ++ks) hacc[pj] = __builtin_amdgcn_mfma_f32_16x16x32_bf16(ld_op_sw(L + SL_BT, 16 * w + r16, PT, 32 * ks + 8 * q), ld_op_sw(L + SL_XWT, 16 * pj + r16, PT, 32 * ks + 8 * q), hacc[pj], 0, 0, 0); }
            }
            WG_BAR(); STAMP2(15);
            {
                int tq = tid0, w = w0; OPQ_V(tq); OPQ_S(w);
                const int lane = tq & 63, r16 = lane & 15, q = lane >> 4;
#pragma unroll
                for (int pj = 0; pj < 4; ++pj) *(LAS u32x2_t*)(L + SL_H + (16 * pj + r16) * PC + (16 * w + 4 * q) * 2) = (u32x2_t){pk2(hacc[pj][0], hacc[pj][1]), pk2(hacc[pj][2], hacc[pj][3])};
                if (more && tq < 320) { int cg, l0; stage_role(tq, cg, l0); ssd_stage(L, cg, l0, 64, (const LAS float*)(L + SL_W) + (par ^ 1) * 64, rawq); }
                ssd_load_z(zq, PROJ, w, r16, q, hh, (size_t)(rb + tb + 64), rows);
                ssd_load_act(rawq, ACTX, tq, hh, g, (size_t)(rb + tb + 128));
                if (conv_l >= 0 && w >= 5) { const int mp = (w - 5) + 3 * (cslot - 1), mn = (w - 5) + 3 * cslot; LAS float* cscr = (LAS float*)(L + 101376 + (w - 5) * 8448);
                    if (cslot > 0 && mp * cG + cbx < I_L) conv_finish(conv_job(C, conv_l, mp * cG + cbx), lane, cwv, cgl, cscr);
                    if (mn * cG + cbx < I_L) conv_issue(conv_job(C, conv_l, mn * cG + cbx), lane, cwv, cgl); }
                ++cslot;
                if (tq >= 448 && (tq - 448) < rows) { const int lr = tq - 448; const f4 s4 = *(const LAS f4*)(L + SL_SSQ + lr * 16); SSQH[(size_t)(rb + tb + lr) * 32 + hh] = (s4[0] + s4[1]) + (s4[2] + s4[3]); }
            }
            WG_BAR();
            STAMP2(16);
        }
        {
            int tq = tid0, w = w0; OPQ_V(tq); OPQ_S(w);
            const int lane = tq & 63, r16 = lane & 15, q = lane >> 4;
            float* ho = C.out + (prm ? O_SSDP + (((size_t)l * NB_P + b) * NH + hh) * HD * DS : O_SSDS + (((size_t)l * NB_S + b) * NH + hh) * HD * DS);
#pragma unroll
            for (int pj = 0; pj < 4; ++pj) *(float4*)(ho + (size_t)(16 * pj + r16) * DS + 16 * w + 4 * q) = make_float4(hacc[pj][0], hacc[pj][1], hacc[pj][2], hacc[pj][3]); }
    }
    if (conv_l >= 0) {
        int tq = tid0, w = w0; OPQ_V(tq); OPQ_S(w); const int lane = tq & 63;
        if (w >= 5 && cslot > 0) { const int mp = (w - 5) + 3 * (cslot - 1); if (mp * cG + cbx < I_L) conv_finish(conv_job(C, conv_l, mp * cG + cbx), lane, cwv, cgl, (LAS float*)(L + 101376 + (w - 5) * 8448)); }
        WG_BAR();
        for (int m = 3 * cslot + w; m * cG + cbx < I_L; m += NWAVES) { const ConvJob j = conv_job(C, conv_l, m * cG + cbx); float wv2[32], gl2; conv_issue(j, lane, wv2, gl2); conv_finish(j, lane, wv2, gl2, (LAS float*)(L + w * 16384)); }
    }
}

#undef tid0
constexpr int PH_CONV = 0, PH_FOLD = 1, PH_L0 = 2, PH_PER_L = 10, N_PHASES = PH_L0 + DEPTH * PH_PER_L;
constexpr int CW_BAR = 4096;

__global__ void __launch_bounds__(NTHR, 2) fwd_kernel(Args args) {
    extern __shared__ __attribute__((aligned(16))) unsigned char lds_raw[];
    Ctx C; C.lds = (LAS unsigned char*)lds_raw; C.G = gridDim.x; C.in = args.in; C.out = args.out; C.ws = args.ws; C.wave0 = __builtin_amdgcn_readfirstlane(threadIdx.x >> 6); C.refresh();
    volatile LAS unsigned* MISC = (volatile LAS unsigned*)(C.lds + LDSCTL_OFF);
    if (threadIdx.x < 64) MISC[threadIdx.x] = 0u;
#define LEAD() (C.wave0 == 0 && lane_id() == 0)
    __syncthreads();
    const int lo = args.ph_lo, hi = args.ph_hi;
    unsigned* barw = (unsigned*)(args.ws + WS_CTL) + CW_BAR;
    XcdBarrier bar; bar.bar = barw; bar.x = 0; bar.st = MISC + 8;
    if (hi - lo > 1) bar = xcd_barrier_post(barw, MISC + 8, LEAD());
#define IN(k) (lo <= (k) && (k) < hi)
#if PROBE_SEL > 0
    if (blockIdx.x == 0 && LEAD()) { MISC[12] = (unsigned)__builtin_amdgcn_s_memrealtime(); MISC[14] = (unsigned)__builtin_amdgcn_s_memrealtime(); MISC[15] = (unsigned)clock64(); }
#define STAMP(ty) do { if (blockIdx.x == 0 && LEAD()) { const unsigned tn = (unsigned)__builtin_amdgcn_s_memrealtime(); MISC[16 + (ty)] += tn - MISC[12]; MISC[12] = tn; } } while (0)
#else
#define STAMP(ty) do { } while (0)
#endif
#define SEAM(k) do { if ((k) + 1 < hi) xcd_barrier(bar, LEAD()); } while (0)
    LAS unsigned char* ring = C.lds;
    const int vcu = (C.G % 8 == 0) ? ((int)blockIdx.x % 8) * (C.G / 8) + (int)blockIdx.x / 8 : (int)blockIdx.x;

    if (IN(PH_CONV)) { phase_convert(C); SEAM(PH_CONV); STAMP(0); }
    if (IN(PH_FOLD)) {
        for (int w = (int)blockIdx.x; w < 4 * 8; w += C.G) { const int lg = w >> 3, l = lg >> 2, g = lg & 3;
            pg8::Gemm gm{(const bf16*)(C.ws + WS_WOP) + (size_t)l * DM * D_POOL + g * 256, (const bf16*)(C.ws + WS_WPB) + (size_t)lg * 65536, DM, 256, 256, D_POOL, 256, 0};
            pg8::StaticOrder S; S.init(DM, 256, 8, w & 7);
            pg8::EpiBf16S E{(bf16*)(C.ws + WS_BTOUT) + (size_t)l * DM * D_MIX + g * 256, D_MIX, nullptr, nullptr, -1};
            pg8::gemm_phase<pg8::EpiBf16S, pg8::StaticOrder, true, true>(ring, gm, S, E, C.wave0);
        }
        SEAM(PH_FOLD); STAMP(1);
    }
    for (int l = 0; l < DEPTH; ++l) {
        const int pb = PH_L0 + l * PH_PER_L;
        if (IN(pb + 0)) {
            pg8::Gemm gm{(const bf16*)(C.ws + WS_XB), (const bf16*)(C.ws + WS_BTIN) + (size_t)l * N_INP * DMP, M, N_PROJ, DM, DMP, DMP, 0};
            pg8::StaticOrder S; S.init(M, N_PROJ, C.G, (int)blockIdx.x);
            pg8::EpiBf16S E{(bf16*)(C.ws + WS_PROJ), N_PROJ, (const float*)(C.ws + WS_R), nullptr, -1};
            pg8::gemm_phase<pg8::EpiBf16S, pg8::StaticOrder, true, true>(ring, gm, S, E, C.wave0);
            phase_dt(C, l);
            STAMP(17); SEAM(pb + 0); STAMP(2);
        }
        if (IN(pb + 1)) { phase_xact(C, l); phase_pool(C, l); STAMP(12); SEAM(pb + 1); STAMP(3); }
        if (IN(pb + 2)) { phase_ssd2(C, l); STAMP(11); SEAM(pb + 2); STAMP(19); }
        if (IN(pb + 3)) {
            if (l + 1 < DEPTH) for (int w = (int)blockIdx.x; w < 4 * 8; w += C.G) { const int lg = 4 * (l + 1) + (w >> 3), l1 = l + 1, g = (w >> 3) & 3;
                pg8::Gemm gm{(const bf16*)(C.ws + WS_WOP) + (size_t)l1 * DM * D_POOL + g * 256, (const bf16*)(C.ws + WS_WPB) + (size_t)lg * 65536, DM, 256, 256, D_POOL, 256, 0};
                pg8::StaticOrder S; S.init(DM, 256, 8, w & 7);
                pg8::EpiBf16S E{(bf16*)(C.ws + WS_BTOUT) + (size_t)l1 * DM * D_MIX + g * 256, D_MIX, nullptr, nullptr, -1};
                pg8::gemm_phase<pg8::EpiBf16S, pg8::StaticOrder, true, true>(ring, gm, S, E, C.wave0); }
            phase_gnorm(C); SEAM(pb + 3); STAMP(4); }
        if (IN(pb + 4)) {
            {
                pg8::Gemm gm{(const bf16*)(C.ws + WS_MIXA), (const bf16*)(C.ws + WS_BTOUT) + (size_t)l * DM * D_MIX, MP, DM, D_MIX, D_MIX, D_MIX, 0};
                pg8::StaticOrder S; S.init(MP, DM, C.G, (int)blockIdx.x);
                pg8::EpiBf16Ssq E{(bf16*)(C.ws + WS_MIX), DM, (float*)(C.ws + WS_SSQP)};
                pg8::gemm_phase<pg8::EpiBf16Ssq, pg8::StaticOrder, true, true>(ring, gm, S, E, C.wave0); }
            {
                pg8::Gemm gm{(const bf16*)(C.ws + WS_MIXA) + (size_t)MP * D_MIX, (const bf16*)(C.ws + WS_BTOUT) + (size_t)l * DM * D_MIX, MS, DM, D_MIX / KS_OUT, D_MIX, D_MIX, D_MIX / KS_OUT};
                pg8::SplitKOrder S; S.init(MS, DM, KS_OUT, C.G, vcu);
                pg8::EpiF32Slab E{(float*)(C.ws + WS_SLAB), DM, MS};
                pg8::gemm_phase<pg8::EpiF32Slab, pg8::SplitKOrder, true, true>(ring, gm, S, E, C.wave0); }
            STAMP(17); SEAM(pb + 4); STAMP(5);
        }
        if (IN(pb + 5)) { phase_resid(C, C.in[17] + l * DM, false, KS_OUT); SEAM(pb + 5); STAMP(6); }
        if (IN(pb + 6)) {
            pg8::Gemm gm{(const bf16*)(C.ws + WS_XB), (const bf16*)(C.ws + WS_BTUP) + (size_t)l * D_UP * DMP, M, D_UP, DM, DMP, DMP, 0};
            pg8::StaticOrder S; S.init(M, D_UP, C.G, (int)blockIdx.x);
            pg8::EpiUpAct E{(bf16*)(C.ws + WS_ACT), (bf16*)(C.ws + WS_UP), (bf16*)(C.ws + WS_SIDE), (const float*)(C.ws + WS_R), C.in[20] + (size_t)l * 3 * D_UP, C.in[21] + (size_t)l * D_UP, D_FF, (LAS float*)(C.lds + LDSCTL_OFF + 1024)};
            pg8::gemm_phase<pg8::EpiUpAct, pg8::StaticOrder, true, true>(ring, gm, S, E, C.wave0);
            STAMP(17); SEAM(pb + 6); STAMP(7);
        }
        if (IN(pb + 7)) { phase_act(C, l); phase_actfix(C, l); SEAM(pb + 7); STAMP(8); }
        if (IN(pb + 8)) {
            {
                pg8::Gemm gm{(const bf16*)(C.ws + WS_ACT), (const bf16*)(C.ws + WS_BTDN) + (size_t)l * DM * D_FF, MP, DM, D_FF, D_FF, D_FF, 0};
                pg8::StaticOrder S; S.init(MP, DM, C.G, (int)blockIdx.x);
                pg8::EpiBf16Ssq E{(bf16*)(C.ws + WS_MIX), DM, (float*)(C.ws + WS_SSQP)};
                pg8::gemm_phase<pg8::EpiBf16Ssq, pg8::StaticOrder, true, true>(ring, gm, S, E, C.wave0); }
            {
                pg8::Gemm gm{(const bf16*)(C.ws + WS_ACT) + (size_t)MP * D_FF, (const bf16*)(C.ws + WS_BTDN) + (size_t)l * DM * D_FF, MS, DM, D_FF / KS_DN, D_FF, D_FF, D_FF / KS_DN};
                pg8::SplitKOrder S; S.init(MS, DM, KS_DN, C.G, vcu);
                pg8::EpiF32Slab E{(float*)(C.ws + WS_SLAB), DM, MS};
                pg8::gemm_phase<pg8::EpiF32Slab, pg8::SplitKOrder, true, true>(ring, gm, S, E, C.wave0); }
            STAMP(17); SEAM(pb + 8); STAMP(9);
        }
        if (IN(pb + 9)) { phase_resid(C, C.in[23] + l * DM, l == DEPTH - 1, KS_DN); SEAM(pb + 9); STAMP(10); }
    }
#if PROBE_SEL > 0
    if (blockIdx.x == 0 && LEAD()) { asm volatile("s_waitcnt vmcnt(0)" ::: "memory"); unsigned tot = 0; for (int ty = 0; ty < 20; ++ty) if ((PROBE_SEL >> ty) & 1) tot += MISC[16 + ty]; C.out[0] = (float)tot * 0.0001f;
        if (PROBE_SEL & (1 << 30)) { const unsigned dc = (unsigned)clock64() - MISC[15], dt = (unsigned)__builtin_amdgcn_s_memrealtime() - MISC[14]; C.out[0] = 5.f * (float)dc / (float)dt; } }
#endif
#undef IN
#undef SEAM
}

extern "C" void kernel_launch(void* const* d_in, const int* in_sizes, int n_in, void* d_out, int out_size, void* d_ws, size_t ws_size, hipStream_t stream) {
    static int grid = 0;
    if (grid == 0) {
        if (n_in != 24 || (size_t)out_size != O_END || ws_size < WS_END) { fprintf(stderr, "kernel_launch: shape mismatch: n_in %d out %d (want %zu) ws %zu (need %zu)\n", n_in, out_size, (size_t)O_END, ws_size, (size_t)WS_END); grid = -1; return; }
        int dev = 0, cus = 0, per_cu = 0;
        if (hipGetDevice(&dev) != hipSuccess || hipDeviceGetAttribute(&cus, hipDeviceAttributeMultiprocessorCount, dev) != hipSuccess) { grid = -1; return; }
        if (hipFuncSetAttribute((const void*)fwd_kernel, hipFuncAttributeMaxDynamicSharedMemorySize, LDS_BYTES) != hipSuccess) { fprintf(stderr, "kernel_launch: hipFuncSetAttribute failed\n"); grid = -1; return; }
        if (hipOccupancyMaxActiveBlocksPerMultiprocessor(&per_cu, (const void*)fwd_kernel, NTHR, LDS_BYTES) != hipSuccess || per_cu < 1) fprintf(stderr, "kernel_launch: occupancy query reports %d\n", per_cu);
        (void)hipGetLastError();
        grid = cus;
    }
    if (grid < 0) return;
    if (hipMemsetAsync((char*)d_ws + WS_CTL, 0, CTL_BYTES, stream) != hipSuccess) return;
    Args a{};
    for (int i = 0; i < 24; ++i) a.in[i] = (const float*)d_in[i];
    a.out = (float*)d_out; a.ws = (unsigned char*)d_ws;
#if MK_MULTI
    for (int k = 0; k < N_PHASES; ++k) { a.ph_lo = k; a.ph_hi = k + 1; hipLaunchKernelGGL(fwd_kernel, dim3(grid), dim3(NTHR), LDS_BYTES, stream, a); }
#else
    a.ph_lo = 0; a.ph_hi = N_PHASES; hipLaunchKernelGGL(fwd_kernel, dim3(grid), dim3(NTHR), LDS_BYTES, stream, a);
#endif
}
```

```cpp
#include <hip/hip_runtime.h>
#include <cstdio>
#include <cstdint>

#ifndef PROBE_SEL
#define PROBE_SEL 0
#endif
#ifndef MK_MULTI
#define MK_MULTI 0
#endif

__device__ __forceinline__ int lane_id() { int l; asm volatile("v_mbcnt_lo_u32_b32 %0, -1, 0\n\tv_mbcnt_hi_u32_b32 %0, -1, %0" : "=v"(l)); return l; }
namespace pg8 {
#define PG8_LAS __attribute__((address_space(3)))
typedef unsigned short bf16_t;
typedef short bf16x8 __attribute__((ext_vector_type(8)));
typedef float f32x4 __attribute__((ext_vector_type(4)));
typedef unsigned u32x4 __attribute__((ext_vector_type(4)));
constexpr int BM = 256, BK = 64, HALF = 128, HTB = HALF * BK * 2, STAGE_BYTES = 8 * HTB, NXCD = 8, WGM = 8;

__host__ __device__ __forceinline__ int lds_byte(int r, int c) { const int st = (r >> 4) * 2 + (c >> 5), rr = r & 15, cc = c & 31, ob = rr * 64 + cc * 2; return st * 1024 + (ob ^ (((ob >> 9) & 1) << 5)); }
__host__ __device__ __forceinline__ void stage_rc(int b, int& R, int& C) { const int st = b / 1024, sb = b % 1024, swz = sb ^ (((sb >> 9) & 1) << 5); R = (st >> 1) * 16 + swz / 64; C = (st & 1) * 32 + (swz % 64) / 2; }
__host__ __device__ __forceinline__ int perm32(int rho) { const int n = rho >> 4, i = rho & 15; return 8 * (i >> 2) + 4 * n + (i & 3); }

struct Unit { int pm, pn, ks; };
struct Gemm { const bf16_t* A; const bf16_t* Bt; int M, N, K, lda, ldb, kslice; };

struct StaticOrder {
    int nM, nN, nwg, G, c;
    __host__ __device__ void init(int M, int N, int G_, int c_) { nM = M / BM; nN = N / BM; nwg = nM * nN; G = G_; c = c_; }
    __host__ __device__ bool next(int i, Unit& u) const {
        const long L = (long)i * G + c; if (L >= nwg) return false;
        int wgid = (int)L; { const int q = nwg / NXCD, r = nwg % NXCD, xcd = wgid % NXCD, off = wgid / NXCD; wgid = (xcd < r ? xcd * (q + 1) : r * (q + 1) + (xcd - r) * q) + off; }
        const int nig = WGM * nN, gid = wgid / nig, fm = gid * WGM, gsz = (nM - fm) < WGM ? (nM - fm) : WGM;
        u.pm = fm + ((wgid % nig) % gsz); u.pn = (wgid % nig) / gsz; u.ks = 0; return true;
    }
    __device__ __forceinline__ void a_ready(const Unit&) const {}
    __device__ __forceinline__ void done(const Unit&) const {}
};
struct SplitKOrder {
    int nM, nN, KS, nwg, G, c;
    __host__ __device__ void init(int M, int N, int KS_, int G_, int c_) { nM = M / BM; nN = N / BM; KS = KS_; nwg = nM * nN * KS; G = G_; c = c_; }
    __host__ __device__ bool next(int i, Unit& u) const { const long L = (long)i * G + c; if (L >= nwg) return false; const int l = (int)L; u.pn = l % nN; u.ks = (l / nN) % KS; u.pm = l / (nN * KS); return true; }
    __device__ __forceinline__ void a_ready(const Unit&) const {}
    __device__ __forceinline__ void done(const Unit&) const {}
};

__device__ __forceinline__ unsigned cvt_pk_bf16(float lo, float hi) { unsigned r; asm volatile("v_cvt_pk_bf16_f32 %0, %1, %2" : "=v"(r) : "v"(lo), "v"(hi)); return r; }

struct EpiBf16S {
    static constexpr bool PERM = true, AFTER_DRAIN = false;
    bf16_t* O; int ldc; const float* rs; float* dt; int dt_pn;
    __device__ __forceinline__ void operator()(const f32x4 (&acc)[2][2][4][2], const Unit& u, int wr, int wc, int fr, int fq) const {
        const int row0 = u.pm * BM + wr * 64 + fr;
        if (u.pn == dt_pn) {
            if (wc == 0) {
#pragma unroll
                for (int ai = 0; ai < 2; ++ai)
#pragma unroll
                    for (int m = 0; m < 4; ++m) { const int row = row0 + ai * HALF + m * 16; const float s = rs ? rs[row] : 1.f;
#pragma unroll
                        for (int n = 0; n < 2; ++n) *(f32x4*)(dt + (size_t)row * 32 + 8 * fq + 4 * n) = acc[ai][0][m][n] * s; }
            }
            return;
        }
        const int col0 = u.pn * BM + wc * 32 + 8 * fq;
#pragma unroll
        for (int ai = 0; ai < 2; ++ai)
#pragma unroll
            for (int m = 0; m < 4; ++m) { const int row = row0 + ai * HALF + m * 16; const float s = rs ? rs[row] : 1.f; bf16_t* rowp = O + (size_t)row * ldc + col0;
#pragma unroll
                for (int bj = 0; bj < 2; ++bj) { const f32x4 v0 = acc[ai][bj][m][0] * s, v1 = acc[ai][bj][m][1] * s;
                    u32x4 w; w.x = cvt_pk_bf16(v0[0], v0[1]); w.y = cvt_pk_bf16(v0[2], v0[3]); w.z = cvt_pk_bf16(v1[0], v1[1]); w.w = cvt_pk_bf16(v1[2], v1[3]);
                    *(u32x4*)(rowp + bj * HALF) = w; } }
    }
};
struct EpiF32Ssq {
    static constexpr bool PERM = false, AFTER_DRAIN = false;
    float* C; int ldc; float* ssq;
    __device__ __forceinline__ void operator()(const f32x4 (&acc)[2][2][4][2], const Unit& u, int wr, int wc, int fr, int fq) const {
        const int row0 = u.pm * BM + wr * 64 + fr, col0 = u.pn * BM + wc * 32 + 4 * fq;
#pragma unroll
        for (int ai = 0; ai < 2; ++ai)
#pragma unroll
            for (int m = 0; m < 4; ++m) { const int row = row0 + ai * HALF + m * 16; float* rowp = C + (size_t)row * ldc + col0; float q = 0.f;
#pragma unroll
                for (int bj = 0; bj < 2; ++bj)
#pragma unroll
                    for (int n = 0; n < 2; ++n) { const f32x4 v = acc[ai][bj][m][n]; *(f32x4*)(rowp + bj * HALF + n * 16) = v; q += (v[0] * v[0] + v[1] * v[1]) + (v[2] * v[2] + v[3] * v[3]); }
                q += __shfl_xor(q, 16); q += __shfl_xor(q, 32);
                if (fq == 0) ssq[(size_t)row * 32 + u.pn * 4 + wc] = q; }
    }
};

struct EpiBf16Ssq {
    static constexpr bool PERM = true, AFTER_DRAIN = false;
    bf16_t* O; int ldc; float* ssq;
    __device__ __forceinline__ void operator()(const f32x4 (&acc)[2][2][4][2], const Unit& u, int wr, int wc, int fr, int fq) const {
        const int row0 = u.pm * BM + wr * 64 + fr, col0 = u.pn * BM + wc * 32 + 8 * fq;
#pragma unroll
        for (int ai = 0; ai < 2; ++ai)
#pragma unroll
            for (int m = 0; m < 4; ++m) { const int row = row0 + ai * HALF + m * 16; bf16_t* rowp = O + (size_t)row * ldc + col0; float q = 0.f;
#pragma unroll
                for (int bj = 0; bj < 2; ++bj) { const f32x4 v0 = acc[ai][bj][m][0], v1 = acc[ai][bj][m][1];
                    q += ((v0[0] * v0[0] + v0[1] * v0[1]) + (v0[2] * v0[2] + v0[3] * v0[3])) + ((v1[0] * v1[0] + v1[1] * v1[1]) + (v1[2] * v1[2] + v1[3] * v1[3]));
                    u32x4 w; w.x = cvt_pk_bf16(v0[0], v0[1]); w.y = cvt_pk_bf16(v0[2], v0[3]); w.z = cvt_pk_bf16(v1[0], v1[1]); w.w = cvt_pk_bf16(v1[2], v1[3]);
                    *(u32x4*)(rowp + bj * HALF) = w; }
                q += __shfl_xor(q, 16); q += __shfl_xor(q, 32);
                if (fq == 0) ssq[(size_t)row * 32 + u.pn * 4 + wc] = q; }
    }
};
template <int CTRL> __device__ __forceinline__ float dppf(float old, float src) { return __builtin_bit_cast(float, __builtin_amdgcn_update_dpp(__builtin_bit_cast(int, old), __builtin_bit_cast(int, src), CTRL, 0xF, 0xF, false)); }
struct EpiUpAct {
    static constexpr bool PERM = true, AFTER_DRAIN = false;
    bf16_t* ACT; bf16_t* UP; bf16_t* SIDE; const float* rs; const float* cw; const float* cb; int dff;
    PG8_LAS float* wlds;
    __device__ __forceinline__ void operator()(const f32x4 (&acc)[2][2][4][2], const Unit& u, int wr, int wc, int fr, int fq) const {
        const int row0 = u.pm * BM + wr * 64 + fr, cbase = u.pn * HALF + wc * 32 + 8 * fq, dup = 2 * dff;
        if (u.pm >= 64) {
#pragma unroll
            for (int ai = 0; ai < 2; ++ai)
#pragma unroll
                for (int m = 0; m < 4; ++m) { const int row = row0 + ai * HALF + m * 16; const float s = rs[row];
#pragma unroll
                    for (int bj = 0; bj < 2; ++bj) { const f32x4 v0 = acc[ai][bj][m][0] * s, v1 = acc[ai][bj][m][1] * s;
                        u32x4 w; w.x = cvt_pk_bf16(v0[0], v0[1]); w.y = cvt_pk_bf16(v0[2], v0[3]); w.z = cvt_pk_bf16(v1[0], v1[1]); w.w = cvt_pk_bf16(v1[2], v1[3]);
                        *(u32x4*)(UP + (size_t)row * dup + bj * dff + cbase) = w; } }
            return;
        }
        typedef unsigned u32x2 __attribute__((ext_vector_type(2)));
        PG8_LAS float* wl = wlds + (wr * 4 + wc) * 256;
        int fro = fr, fqo = fq; asm volatile("" : "+v"(fro), "+v"(fqo));
        { const int lane = fqo * 16 + fro, kind = lane >> 3, j0 = (lane & 7) * 4; const int k3 = kind & 3;
          const float* srcp = (k3 < 3 ? cw + (size_t)k3 * dup : cb) + (kind >> 2) * dff + u.pn * HALF + wc * 32 + j0;
          *(PG8_LAS f32x4*)(wl + kind * 32 + j0) = *(const f32x4*)srcp; }
        asm volatile("s_waitcnt lgkmcnt(0)" ::: "memory");
#pragma unroll
        for (int n = 0; n < 2; ++n) { const int c = cbase + 4 * n; const PG8_LAS float* wq = wl + 8 * fqo + 4 * n;
#pragma unroll
            for (int ai = 0; ai < 2; ++ai) { const int kb = u.pm * 4 + ai * 2 + wr; float sp = 0.f;
#pragma unroll
                for (int m = 0; m < 4; ++m) { const int row = row0 + ai * HALF + m * 16; const float s = rs[row];
                    const f32x4 g = acc[ai][0][m][n] * s, v = acc[ai][1][m][n] * s; f32x4 o;
                    const f32x4 gp = acc[ai][0][m > 0 ? m - 1 : 0][n] * sp, vp = acc[ai][1][m > 0 ? m - 1 : 0][n] * sp;
#pragma unroll
                    for (int e = 0; e < 4; ++e) {
                        const float p1g = dppf<0x111>(dppf<0x121>(0.f, gp[e]), g[e]), p2g = dppf<0x112>(dppf<0x122>(0.f, gp[e]), g[e]);
                        const float p1v = dppf<0x111>(dppf<0x121>(0.f, vp[e]), v[e]), p2v = dppf<0x112>(dppf<0x122>(0.f, vp[e]), v[e]);
                        const float gg = wq[96 + e] + wq[e] * p2g + wq[32 + e] * p1g + wq[64 + e] * g[e], vv = wq[224 + e] + wq[128 + e] * p2v + wq[160 + e] * p1v + wq[192 + e] * v[e];
                        o[e] = gg * __builtin_amdgcn_rcpf(1.f + __expf(-gg)) * vv; }
                    const bool head = (m == 0) && (fr < 2);
                    if (!head) { u32x2 w; w.x = cvt_pk_bf16(o[0], o[1]); w.y = cvt_pk_bf16(o[2], o[3]); *(u32x2*)(ACT + (size_t)row * dff + c) = w; }
                    if (head || ((m == 3) && (fr >= 14))) { const int slot = head ? fr : fr - 12; bf16_t* sp = SIDE + ((size_t)kb * 4 + slot) * dup + c;
                        u32x2 wg; wg.x = cvt_pk_bf16(g[0], g[1]); wg.y = cvt_pk_bf16(g[2], g[3]); *(u32x2*)sp = wg;
                        u32x2 wv; wv.x = cvt_pk_bf16(v[0], v[1]); wv.y = cvt_pk_bf16(v[2], v[3]); *(u32x2*)(sp + dff) = wv; }
                    sp = s; asm volatile("" ::: "memory"); } } }
    }
};
struct EpiF32Slab {
    static constexpr bool PERM = false, AFTER_DRAIN = false;
    float* C; int ldc, Mrows;
    __device__ __forceinline__ void operator()(const f32x4 (&acc)[2][2][4][2], const Unit& u, int wr, int wc, int fr, int fq) const {
        const int row0 = u.pm * BM + wr * 64 + fr, col0 = u.pn * BM + wc * 32 + 4 * fq; float* base = C + (size_t)u.ks * Mrows * ldc;
#pragma unroll
        for (int ai = 0; ai < 2; ++ai)
#pragma unroll
            for (int m = 0; m < 4; ++m) { float* rowp = base + (size_t)(row0 + ai * HALF + m * 16) * ldc + col0;
#pragma unroll
                for (int bj = 0; bj < 2; ++bj)
#pragma unroll
                    for (int n = 0; n < 2; ++n) *(f32x4*)(rowp + bj * HALF + n * 16) = acc[ai][bj][m][n]; }
    }
};
template <class Epi, class Sched, bool ALIGN_EPI = false, bool SP2 = false>
__device__ __forceinline__ void gemm_phase(PG8_LAS unsigned char* lds, const Gemm g, const Sched& S, const Epi& E, int wave_id) {
    int tid_ = wave_id * 64 + lane_id(); asm volatile("" : "+v"(tid_));
    const int tid = tid_, wid = __builtin_amdgcn_readfirstlane(tid >> 6), lane = tid & 63, wr = wid >> 2, wc = wid & 3, fr = lane & 15, fq = lane >> 4;
    const int K = g.K, nt = K / BK;
    unsigned voffA[2], voffB[2];
#pragma unroll
    for (int i = 0; i < 2; ++i) { int R, C; stage_rc(tid * 16 + i * 8192, R, C); const int Rb = Epi::PERM ? ((R & ~31) + perm32(R & 31)) : R;
        voffA[i] = (unsigned)(R * g.lda + C) * 2u; voffB[i] = (unsigned)(Rb * g.ldb + C) * 2u; }
    const size_t kstep = (size_t)(BK * 2);
    const size_t hstepA = (size_t)HALF * g.lda * 2, hstepB = (size_t)HALF * g.ldb * 2;
    const size_t tstepA = 2 * hstepA, tstepB = 2 * hstepB;
    const unsigned ldsw = (unsigned)wid * 1024u;
    const int aoff = lds_byte(wr * 64 + fr, fq * 8), boff = lds_byte(wc * 32 + fr, fq * 8);
#define PG8_SA(b, h) (((b) * 2 + (h)) * HTB)
#define PG8_SB(b, h) ((4 + (b) * 2 + (h)) * HTB)
#define PG8_STAGE(bufoff, gbase, voff) do { _Pragma("unroll") for (int _i = 0; _i < 2; ++_i) \
        __builtin_amdgcn_global_load_lds((const unsigned*)((const char*)(gbase) + (voff)[_i]), (PG8_LAS unsigned*)(lds + (bufoff) + ldsw + _i * 8192), 16, 0, 0); } while (0)
#define PG8_LDA(dst, b, h) do { _Pragma("unroll") for (int m = 0; m < 4; ++m) _Pragma("unroll") for (int k = 0; k < 2; ++k) dst[m][k] = *(const PG8_LAS bf16x8*)(lds + PG8_SA(b, h) + aoff + m * 2048 + k * 1024); } while (0)
#define PG8_LDB(dst, b, h) do { _Pragma("unroll") for (int n = 0; n < 2; ++n) _Pragma("unroll") for (int k = 0; k < 2; ++k) dst[n][k] = *(const PG8_LAS bf16x8*)(lds + PG8_SB(b, h) + boff + n * 2048 + k * 1024); } while (0)
#define PG8_MMA(ai, bj, At, Bt) do { __builtin_amdgcn_s_setprio(1); _Pragma("unroll") for (int m = 0; m < 4; ++m) _Pragma("unroll") for (int n = 0; n < 2; ++n) _Pragma("unroll") for (int k = 0; k < 2; ++k) \
        acc[ai][bj][m][n] = __builtin_amdgcn_mfma_f32_16x16x32_bf16(Bt[n][k], At[m][k], acc[ai][bj][m][n], 0, 0, 0); __builtin_amdgcn_s_setprio(0); } while (0)
#define PG8_WAIT_V(n) asm volatile("s_waitcnt vmcnt(" #n ")" ::: "memory")
#define PG8_WAIT_L(n) asm volatile("s_waitcnt lgkmcnt(" #n ")" ::: "memory")
#define PG8_BAR __builtin_amdgcn_s_barrier()
#define PG8_SCHED __builtin_amdgcn_sched_barrier(0)
    Unit cur, nxt; int ui = 0;
    if (!S.next(0, cur)) return;
    f32x4 acc[2][2][4][2];
#pragma unroll
    for (int a = 0; a < 2; ++a)
#pragma unroll
        for (int b = 0; b < 2; ++b)
#pragma unroll
            for (int m = 0; m < 4; ++m)
#pragma unroll
                for (int n = 0; n < 2; ++n) acc[a][b][m][n] = (f32x4){0.f, 0.f, 0.f, 0.f};
    bf16x8 At[4][2], B0[2][2], B1[2][2];
    const size_t ksb = (size_t)g.kslice * 2;
    const char* cA = (const char*)g.A + (size_t)cur.pm * tstepA + cur.ks * ksb; const char* cB = (const char*)g.Bt + (size_t)cur.pn * tstepB + cur.ks * ksb;
    S.a_ready(cur);
    if constexpr (SP2) {
        PG8_STAGE(PG8_SB(0, 0), cB, voffB); PG8_STAGE(PG8_SB(0, 1), cB + hstepB, voffB); PG8_STAGE(PG8_SA(0, 0), cA, voffA); PG8_STAGE(PG8_SA(0, 1), cA + hstepA, voffA);
        if (wr == 1) PG8_BAR;
        PG8_WAIT_V(2); PG8_BAR;
        PG8_STAGE(PG8_SB(1, 0), cB + kstep, voffB); PG8_STAGE(PG8_SA(1, 0), cA + kstep, voffA); PG8_STAGE(PG8_SB(1, 1), cB + hstepB + kstep, voffB);
        PG8_WAIT_V(6); PG8_BAR;
    } else {
        PG8_STAGE(PG8_SB(0, 0), cB, voffB); PG8_STAGE(PG8_SA(0, 0), cA, voffA); PG8_STAGE(PG8_SB(0, 1), cB + hstepB, voffB); PG8_STAGE(PG8_SA(0, 1), cA + hstepA, voffA);
        if (wr == 1) PG8_BAR;
        PG8_WAIT_V(4); PG8_BAR;
        PG8_STAGE(PG8_SB(1, 0), cB + kstep, voffB); PG8_STAGE(PG8_SA(1, 0), cA + kstep, voffA); PG8_STAGE(PG8_SB(1, 1), cB + hstepB + kstep, voffB);
        PG8_WAIT_V(6); PG8_BAR;
    }
    for (;;) {
        const bool has_next = S.next(ui + 1, nxt);
        const char* nA = has_next ? (const char*)g.A + (size_t)nxt.pm * tstepA + nxt.ks * ksb : cA; const char* nB = has_next ? (const char*)g.Bt + (size_t)nxt.pn * tstepB + nxt.ks * ksb : cB;
        for (int t = 0; t < nt; t += 2) {
            const bool last = (t == nt - 2);
            const char* a1 = cA + (size_t)(t + 1) * kstep;
            const char* a2 = last ? nA : cA + (size_t)(t + 2) * kstep; const char* b2 = last ? nB : cB + (size_t)(t + 2) * kstep;
            const char* a3 = a2 + kstep; const char* b3 = b2 + kstep;
            if (last && has_next) S.a_ready(nxt);
            if constexpr (SP2) {
            PG8_LDB(B0, 0, 0); PG8_LDB(B1, 0, 1); PG8_SCHED; PG8_LDA(At, 0, 0); PG8_STAGE(PG8_SA(1, 1), a1 + hstepA, voffA);
            PG8_WAIT_V(8); PG8_WAIT_L(0); PG8_BAR; PG8_MMA(0, 0, At, B0); PG8_MMA(0, 1, At, B1); PG8_BAR; PG8_SCHED;
            PG8_LDA(At, 0, 1); PG8_STAGE(PG8_SB(0, 0), b2, voffB); PG8_STAGE(PG8_SB(0, 1), b2 + hstepB, voffB); PG8_STAGE(PG8_SA(0, 0), a2, voffA);
            PG8_WAIT_V(8); PG8_WAIT_L(0); PG8_BAR; PG8_MMA(1, 0, At, B0); PG8_MMA(1, 1, At, B1); PG8_BAR; PG8_SCHED;
            PG8_LDB(B0, 1, 0); PG8_LDB(B1, 1, 1); PG8_SCHED; PG8_LDA(At, 1, 0); PG8_STAGE(PG8_SA(0, 1), a2 + hstepA, voffA);
            PG8_WAIT_V(8); PG8_WAIT_L(0); PG8_BAR; PG8_MMA(0, 0, At, B0); PG8_MMA(0, 1, At, B1); PG8_BAR; PG8_SCHED;
            PG8_LDA(At, 1, 1); PG8_STAGE(PG8_SB(1, 0), b3, voffB); PG8_STAGE(PG8_SB(1, 1), b3 + hstepB, voffB); PG8_STAGE(PG8_SA(1, 0), a3, voffA);
            PG8_WAIT_V(8); PG8_WAIT_L(0); PG8_BAR; PG8_MMA(1, 0, At, B0); PG8_MMA(1, 1, At, B1); PG8_BAR; PG8_SCHED;
            } else {
            PG8_LDB(B0, 0, 0); PG8_SCHED; PG8_LDA(At, 0, 0); PG8_STAGE(PG8_SA(1, 1), a1 + hstepA, voffA);
            PG8_WAIT_L(8); PG8_BAR; PG8_WAIT_L(0); PG8_MMA(0, 0, At, B0); PG8_BAR; PG8_SCHED;
            PG8_LDB(B1, 0, 1); PG8_STAGE(PG8_SB(0, 0), b2, voffB);
            PG8_BAR; PG8_WAIT_L(0); PG8_MMA(0, 1, At, B1); PG8_BAR;
            PG8_LDA(At, 0, 1); PG8_STAGE(PG8_SA(0, 0), a2, voffA);
            PG8_BAR; PG8_WAIT_L(0); PG8_MMA(1, 0, At, B0); PG8_BAR; PG8_SCHED;
            PG8_STAGE(PG8_SB(0, 1), b2 + hstepB, voffB);
            PG8_WAIT_V(6); PG8_BAR; PG8_MMA(1, 1, At, B1); PG8_BAR;
            PG8_LDB(B0, 1, 0); PG8_SCHED; PG8_LDA(At, 1, 0); PG8_STAGE(PG8_SA(0, 1), a2 + hstepA, voffA);
            PG8_WAIT_L(8); PG8_BAR; PG8_WAIT_L(0); PG8_MMA(0, 0, At, B0); PG8_BAR; PG8_SCHED;
            PG8_LDB(B1, 1, 1); PG8_STAGE(PG8_SB(1, 0), b3, voffB);
            PG8_BAR; PG8_WAIT_L(0); PG8_MMA(0, 1, At, B1); PG8_BAR;
            PG8_LDA(At, 1, 1); PG8_STAGE(PG8_SA(1, 0), a3, voffA);
            PG8_BAR; PG8_WAIT_L(0); PG8_MMA(1, 0, At, B0); PG8_BAR; PG8_SCHED;
            PG8_STAGE(PG8_SB(1, 1), b3 + hstepB, voffB);
            PG8_WAIT_V(6); PG8_BAR; PG8_MMA(1, 1, At, B1); PG8_BAR;
            }
        }
        if constexpr (ALIGN_EPI) { if (wr == 0) PG8_BAR; }
        if constexpr (!Epi::AFTER_DRAIN) { E(acc, cur, wr, wc, fr, fq); S.done(cur); }
        if (!has_next) break;
#pragma unroll
        for (int a = 0; a < 2; ++a)
#pragma unroll
            for (int b = 0; b < 2; ++b)
#pragma unroll
                for (int m = 0; m < 4; ++m)
#pragma unroll
                    for (int n = 0; n < 2; ++n) acc[a][b][m][n] = (f32x4){0.f, 0.f, 0.f, 0.f};
        cur = nxt; cA = nA; cB = nB; ++ui;
        if constexpr (ALIGN_EPI) { if (wr == 1) PG8_BAR; }
    }
    PG8_WAIT_V(0);
    if constexpr (!ALIGN_EPI) { if (wr == 0) PG8_BAR; }
    PG8_BAR;
#undef PG8_SA
#undef PG8_SB
#undef PG8_STAGE
#undef PG8_LDA
#undef PG8_LDB
#undef PG8_MMA
#undef PG8_WAIT_V
#undef PG8_WAIT_L
#undef PG8_BAR
#undef PG8_SCHED
}
}

constexpr int NWAVES = 8, NTHR = 512;
constexpr int DM = 2048, SEQ = 2048, NB_P = 8, NB_S = 32, SEQ_S = 32, DEPTH = 4;
constexpr int MP = NB_P * SEQ, MS = NB_S * SEQ_S, M = MP + MS;
constexpr int D_POOL = 1024, POOL_HIST = 15, D_SSD = 2048, HD = 64, NH = 32, HPG = 16, DS = 128, CONV_DIM = 2560, D_MIX = 3072;
constexpr int D_IN = 5664, N_PROJ = 5632, N_INP = 5888, D_FF = 5632, D_UP = 11264;
constexpr int XBC0 = 3072;
constexpr float EPS = 1e-6f;

constexpr size_t O_YP = 0, O_YS = O_YP + (size_t)MP * DM, O_POOLP = O_YS + (size_t)MS * DM, O_POOLS = O_POOLP + (size_t)DEPTH * NB_P * 15 * 1024,
    O_SCP = O_POOLS + (size_t)DEPTH * NB_S * 15 * 1024, O_SCS = O_SCP + (size_t)DEPTH * NB_P * 3 * 2560, O_SSDP = O_SCS + (size_t)DEPTH * NB_S * 3 * 2560,
    O_SSDS = O_SSDP + (size_t)DEPTH * NB_P * 32 * 64 * 128, O_FCP = O_SSDS + (size_t)DEPTH * NB_S * 32 * 64 * 128, O_FCS = O_FCP + (size_t)DEPTH * NB_P * 2 * 11264,
    O_END = O_FCS + (size_t)DEPTH * NB_S * 2 * 11264;

constexpr size_t al256(size_t x) { return (x + 255) & ~(size_t)255; }
constexpr size_t WS_CTL = 0, CTL_BYTES = 1u << 20;
constexpr size_t WS_BTIN = CTL_BYTES;
constexpr int DMP = DM + 64;
constexpr size_t WS_BTOUT = WS_BTIN + (size_t)DEPTH * N_INP * DMP * 2;
constexpr size_t WS_BTUP = WS_BTOUT + (size_t)DEPTH * DM * D_MIX * 2;
constexpr size_t WS_BTDN = WS_BTUP + (size_t)DEPTH * D_UP * DMP * 2;
constexpr size_t WS_WOP = WS_BTDN + (size_t)DEPTH * DM * D_FF * 2;
constexpr size_t WS_WPB = WS_WOP + (size_t)DEPTH * DM * D_POOL * 2;
constexpr size_t WS_X = WS_WPB + (size_t)DEPTH * 4 * 256 * 256 * 2;
constexpr size_t WS_ACTX = WS_X;
constexpr size_t WS_XB = WS_X + (size_t)M * DM * 4;
constexpr size_t WS_R = WS_XB + (size_t)M * DMP * 2;
constexpr size_t WS_DT = WS_R + al256((size_t)M * 4);
constexpr size_t WS_SSQP = WS_DT + (size_t)M * 32 * 4;
constexpr size_t WS_SSQH = WS_SSQP + (size_t)M * 32 * 4;
constexpr size_t WS_ACT = WS_SSQH + (size_t)M * 32 * 4;
constexpr size_t WS_RA = WS_ACT + (size_t)M * D_FF * 2;
constexpr size_t WS_PROJ = WS_RA;
constexpr size_t WS_MIXA = WS_PROJ + (size_t)M * N_PROJ * 2;
constexpr size_t WS_MIX = WS_MIXA + (size_t)M * D_MIX * 2;
constexpr size_t WS_UP = WS_RA;
constexpr int KS_OUT = 8, KS_DN = 4;
constexpr size_t WS_SLAB = WS_MIX + (size_t)M * DM * 4;
constexpr size_t WS_SIDE = WS_SLAB + (size_t)KS_OUT * MS * DM * 4;
constexpr size_t WS_END = WS_SIDE + (size_t)(MP / 64) * 4 * D_UP * 2;
static_assert((size_t)M * D_UP * 2 <= WS_END - WS_RA, "UP fits region A");

constexpr int RING_BYTES = 131072, LDSCTL_OFF = RING_BYTES, LDS_BYTES = 147456;

#define LAS __attribute__((address_space(3)))
typedef unsigned short bf16;
typedef float f32x4 __attribute__((ext_vector_type(4)));
#define RLX_AGENT __ATOMIC_RELAXED, __HIP_MEMORY_SCOPE_AGENT
__device__ __forceinline__ unsigned f2bf(float f) { unsigned u = __builtin_bit_cast(unsigned, f); return (u + 0x7fffu + ((u >> 16) & 1u)) >> 16; }
__device__ __forceinline__ unsigned pk2(float lo, float hi) { unsigned r; asm("v_cvt_pk_bf16_f32 %0, %1, %2" : "=v"(r) : "v"(lo), "v"(hi)); return r; }
__device__ __forceinline__ float bflo(unsigned u) { return __uint_as_float(u << 16); }
__device__ __forceinline__ float bfhi(unsigned u) { return __uint_as_float(u & 0xffff0000u); }
__device__ __forceinline__ float bf2f(bf16 b) { return __uint_as_float(((unsigned)b) << 16); }
struct F8 { float v[8]; };
__device__ __forceinline__ F8 ld_bf8(const bf16* p) { const uint4 u = *(const uint4*)p; F8 r; r.v[0] = bflo(u.x); r.v[1] = bfhi(u.x); r.v[2] = bflo(u.y); r.v[3] = bfhi(u.y); r.v[4] = bflo(u.z); r.v[5] = bfhi(u.z); r.v[6] = bflo(u.w); r.v[7] = bfhi(u.w); return r; }
__device__ __forceinline__ F8 unpack8(const uint4 u) { F8 r; r.v[0] = bflo(u.x); r.v[1] = bfhi(u.x); r.v[2] = bflo(u.y); r.v[3] = bfhi(u.y); r.v[4] = bflo(u.z); r.v[5] = bfhi(u.z); r.v[6] = bflo(u.w); r.v[7] = bfhi(u.w); return r; }
__device__ __forceinline__ F8 ld_f8(const float* p) { const float4 a = *(const float4*)p, b = *(const float4*)(p + 4); F8 r; r.v[0] = a.x; r.v[1] = a.y; r.v[2] = a.z; r.v[3] = a.w; r.v[4] = b.x; r.v[5] = b.y; r.v[6] = b.z; r.v[7] = b.w; return r; }
__device__ __forceinline__ F8 zero8() { F8 r;
#pragma unroll
    for (int i = 0; i < 8; ++i) r.v[i] = 0.f; return r; }
__device__ __forceinline__ void st_bf8(bf16* p, const F8& r) { uint4 u; u.x = pk2(r.v[0], r.v[1]); u.y = pk2(r.v[2], r.v[3]); u.z = pk2(r.v[4], r.v[5]); u.w = pk2(r.v[6], r.v[7]); *(uint4*)p = u; }
__device__ __forceinline__ void st_f8(float* p, const F8& r) { *(float4*)p = make_float4(r.v[0], r.v[1], r.v[2], r.v[3]); *(float4*)(p + 4) = make_float4(r.v[4], r.v[5], r.v[6], r.v[7]); }
__device__ __forceinline__ float silu_f(float x) { return x * __builtin_amdgcn_rcpf(1.f + __expf(-x)); }
__device__ __forceinline__ float wave_sum(float v) {
#pragma unroll
    for (int o = 1; o < 64; o <<= 1) v += __shfl_xor(v, o);
    return v;
}

#define XB_TMO      128
#define XB_XCNT(j)  (256  + 64 * (j))
#define XB_XSUB(j)  (1280 + 64 * (j))
#define XB_XGEN(j)  (2304 + 64 * (j))
#define XB_TOP      3328
#define XB_TOPGEN   3392
#define XCD_BAR_WORDS 3456
#define XB_SPIN_CAP (1u << 18)
__device__ __forceinline__ unsigned xb_ld(unsigned* p)              { return __hip_atomic_load(p, __ATOMIC_RELAXED, __HIP_MEMORY_SCOPE_AGENT); }
__device__ __forceinline__ unsigned xb_add(unsigned* p, unsigned v) { return __hip_atomic_fetch_add(p, v, __ATOMIC_RELAXED, __HIP_MEMORY_SCOPE_AGENT); }
__device__ __forceinline__ unsigned xb_xcc_id() { return (unsigned)__builtin_amdgcn_s_getreg((3 << 11) | 20) & 0xFu; }
#define XB_SPIN(cond, bar) do { unsigned _sp = 0; while (cond) { __builtin_amdgcn_s_sleep(1); \
    if ((++_sp & 255u) == 0u) { if (xb_ld(&(bar)[XB_TMO])) break; if (_sp > XB_SPIN_CAP) { atomicAdd(&(bar)[XB_TMO], 1u); break; } } } } while (0)
struct XcdBarrier { unsigned* bar; unsigned x; volatile LAS unsigned* st; };
__device__ __forceinline__ XcdBarrier xcd_barrier_post(unsigned* bar, volatile LAS unsigned* st, bool lead) {
    XcdBarrier b; b.bar = bar; b.x = xb_xcc_id(); b.st = st;
    if (lead) (void)xb_add(&bar[XB_XCNT(b.x)], 1u);
    return b;
}
__device__ __forceinline__ void xcd_barrier_complete(unsigned* bar, unsigned x, unsigned& nloc, unsigned& nx) {
    const unsigned G = gridDim.x * gridDim.y * gridDim.z;
    unsigned sum, cnt, mine, sp = 0u;
    for (;;) {
        sum = 0u; cnt = 0u; mine = 0u;
#pragma unroll
        for (unsigned j = 0; j < 16; ++j) { const unsigned c = xb_ld(&bar[XB_XCNT(j)]); sum += c; cnt += (c > 0u) ? 1u : 0u; mine = (j == x) ? c : mine; }
        if (sum == G) break;
        __builtin_amdgcn_s_sleep(1);
        if ((++sp & 255u) == 0u) { if (xb_ld(&bar[XB_TMO])) break; if (sp > XB_SPIN_CAP) { atomicAdd(&bar[XB_TMO], 1u); break; } }
    }
    nloc = mine > 0u ? mine : 1u; nx = cnt > 0u ? cnt : 1u;
}
__device__ __forceinline__ void xcd_barrier(const XcdBarrier& b, bool lead) {
    asm volatile("s_waitcnt vmcnt(0)" ::: "memory");
    __syncthreads();
    if (lead) {
        unsigned* bar = b.bar;
        __builtin_amdgcn_s_waitcnt(0);
        unsigned nloc = b.st[0], nx = b.st[1];
        if (nloc == 0u) { xcd_barrier_complete(bar, b.x, nloc, nx); b.st[0] = nloc; b.st[1] = nx; }
        const unsigned old = xb_add(&bar[XB_XSUB(b.x)], 1u);
        const unsigned gen = old / nloc;
        if (old + 1u == (gen + 1u) * nloc) {
            __builtin_amdgcn_fence(__ATOMIC_RELEASE, "agent");
            asm volatile("s_waitcnt vmcnt(0)" ::: "memory");
            const unsigned og = xb_add(&bar[XB_TOP], 1u);
            const unsigned tg = og / nx;
            if (og + 1u == (tg + 1u) * nx) xb_add(&bar[XB_TOPGEN], 1u);
            else XB_SPIN(xb_ld(&bar[XB_TOPGEN]) == tg, bar);
            __builtin_amdgcn_fence(__ATOMIC_ACQUIRE, "agent");
            xb_add(&bar[XB_XGEN(b.x)], 1u);
            asm volatile("s_waitcnt vmcnt(0)" ::: "memory");
        } else {
            XB_SPIN(xb_ld(&bar[XB_XGEN(b.x)]) == gen, bar);
            __builtin_amdgcn_fence(__ATOMIC_ACQUIRE, "agent");
            asm volatile("s_waitcnt vmcnt(0)" ::: "memory");
        }
    }
    __syncthreads();
}

struct Args { const float* in[24]; float* out; unsigned char* ws; int ph_lo, ph_hi; };

struct Ctx {
    LAS unsigned char* lds; int tid, lane, wave, G, gw, NGW, wave0;
    const float* const* in; float* out; unsigned char* ws;
    __device__ __forceinline__ void refresh() {
        int t = wave0 * 64 + lane_id(); asm volatile("" : "+v"(t)); tid = t; lane = t & 63; wave = __builtin_amdgcn_readfirstlane(t >> 6); gw = blockIdx.x * NWAVES + wave; NGW = G * NWAVES; }
};

constexpr int I_IN = (DM / 64) * (D_IN / 32), I_OUT = (D_MIX / 64) * (DM / 32), I_UP = (DM / 64) * (DM * 0 + D_UP / 32), I_DN = (D_FF / 64) * (DM / 32), I_L = I_IN + I_OUT + I_UP + I_DN;
struct ConvJob { const float* W; const float* gain; bf16* dst; int N, ldd, kb, nb; };
__device__ __forceinline__ ConvJob conv_job(const Ctx& C, int l, int r) {
    ConvJob j;
    if (r < I_IN) { const int nbk = D_IN / 32; j.W = C.in[7] + (size_t)l * DM * D_IN; j.gain = C.in[6] + l * DM; j.dst = (bf16*)(C.ws + WS_BTIN) + (size_t)l * N_INP * DMP; j.N = D_IN; j.ldd = DMP; j.kb = r / nbk; j.nb = r % nbk; return j; }
    r -= I_IN;
    if (r < I_OUT) { const int nbk = DM / 32; j.kb = r / nbk; j.nb = r % nbk; j.W = C.in[16] + (size_t)l * D_MIX * DM; j.N = DM;
        if (j.kb < 16) { j.gain = C.in[9] + l * D_POOL; j.dst = (bf16*)(C.ws + WS_WOP) + (size_t)l * DM * D_POOL; j.ldd = D_POOL; }
        else { j.gain = C.in[15] + l * D_SSD - D_POOL; j.dst = (bf16*)(C.ws + WS_BTOUT) + (size_t)l * DM * D_MIX; j.ldd = D_MIX; }
        return j; }
    r -= I_OUT;
    if (r < I_UP) { const int nbk = D_UP / 32, nb = r % nbk, n0 = 32 * nb, hv = n0 / D_FF, cc = n0 % D_FF, np = 256 * (cc / 128) + 128 * hv + (cc % 128);
        j.W = C.in[19] + (size_t)l * DM * D_UP; j.gain = C.in[18] + l * DM; j.dst = (bf16*)(C.ws + WS_BTUP) + (size_t)l * D_UP * DMP + (long)(np - n0) * DMP; j.N = D_UP; j.ldd = DMP; j.kb = r / nbk; j.nb = nb; return j; }
    r -= I_UP;
    { const int nbk = DM / 32; j.W = C.in[22] + (size_t)l * D_FF * DM; j.gain = nullptr; j.dst = (bf16*)(C.ws + WS_BTDN) + (size_t)l * DM * D_FF; j.N = DM; j.ldd = D_FF; j.kb = r / nbk; j.nb = r % nbk; }
    return j;
}
__device__ __forceinline__ void conv_issue(const ConvJob& j, int lane, float (&wv)[32], float& gl) {
    const int k0 = 64 * j.kb, n0 = 32 * j.nb;
    gl = j.gain ? j.gain[k0 + lane] : 1.f;
#pragma unroll
    for (int i = 0; i < 32; ++i) { const int kk = 2 * i + (lane >> 5); wv[i] = j.W[(size_t)(k0 + kk) * j.N + n0 + (lane & 31)]; }
}
__device__ __forceinline__ void conv_finish(const ConvJob& j, int lane, const float (&wv)[32], float gl, LAS float* scr) {
    const int k0 = 64 * j.kb, n0 = 32 * j.nb; const int gli = __builtin_bit_cast(int, gl);
#pragma unroll
    for (int i = 0; i < 32; ++i) { const int kk = 2 * i + (lane >> 5);
        const float g0 = __builtin_bit_cast(float, __builtin_amdgcn_readlane(gli, 2 * i)), g1 = __builtin_bit_cast(float, __builtin_amdgcn_readlane(gli, 2 * i + 1));
        scr[kk * 33 + (lane & 31)] = wv[i] * (lane < 32 ? g0 : g1); }
    asm volatile("s_waitcnt lgkmcnt(0)" ::: "memory");
    const int c = lane & 7;
#pragma unroll
    for (int jj = 0; jj < 4; ++jj) { const int n = (lane >> 3) + 8 * jj; const LAS float* s = scr + (8 * c) * 33 + n;
        uint4 o; o.x = pk2(s[0 * 33], s[1 * 33]); o.y = pk2(s[2 * 33], s[3 * 33]); o.z = pk2(s[4 * 33], s[5 * 33]); o.w = pk2(s[6 * 33], s[7 * 33]);
        *(uint4*)(j.dst + (size_t)(n0 + n) * j.ldd + k0 + 8 * c) = o; }
    asm volatile("s_waitcnt lgkmcnt(0)" ::: "memory");
}
__device__ __forceinline__ void phase_convert(Ctx C) {
    C.refresh();
    LAS float* scr = (LAS float*)(C.lds + C.wave * 16384);
    for (int it = C.gw; it < I_L; it += C.NGW) { const ConvJob j = conv_job(C, 0, it); float wv[32], gl; conv_issue(j, C.lane, wv, gl); conv_finish(j, C.lane, wv, gl, scr); }
    { const int gt = C.gw * 64 + C.lane, NGT = C.NGW * 64;
      const float* wp = C.in[8]; bf16* wpb = (bf16*)(C.ws + WS_WPB);
      for (int i = gt; i < DEPTH * 4 * 256 * 256 / 8; i += NGT) { const F8 v = ld_f8(wp + (size_t)i * 8); st_bf8(wpb + (size_t)i * 8, v); } }
    for (int row = C.gw; row < M; row += C.NGW) {
        const float* src = row < MP ? C.in[0] + (size_t)row * DM : C.in[1] + (size_t)(row - MP) * DM;
        bf16* XB = (bf16*)(C.ws + WS_XB) + (size_t)row * DMP; float q = 0.f;
#pragma unroll
        for (int j = 0; j < 8; ++j) { const int idx = (C.lane + 64 * j) * 4; const float4 v = *(const float4*)(src + idx); q += (v.x * v.x + v.y * v.y) + (v.z * v.z + v.w * v.w);
            *(uint2*)(XB + idx) = make_uint2(pk2(v.x, v.y), pk2(v.z, v.w)); }
        q = wave_sum(q);
        if (C.lane == 0) ((float*)(C.ws + WS_R))[row] = rsqrtf(q * (1.f / DM) + EPS);
    }
}

__device__ __forceinline__ void phase_dt(Ctx C, int l) {
    C.refresh();
    typedef short bf16x8_t __attribute__((ext_vector_type(8))); typedef unsigned u32x4_t __attribute__((ext_vector_type(4)));
    const bf16* XB = (const bf16*)(C.ws + WS_XB); const bf16* BD = (const bf16*)(C.ws + WS_BTIN) + ((size_t)l * N_INP + N_PROJ) * DMP; const float* R = (const float*)(C.ws + WS_R); float* DT = (float*)(C.ws + WS_DT);
    const int r16 = C.lane & 15, q = C.lane >> 4;
    for (int i = C.tid; i < 32 * (DM / 8); i += NTHR) { const int n = i / (DM / 8), ch = i % (DM / 8);
        const uint4 v = *(const uint4*)(BD + (size_t)n * DMP + ch * 8); *(LAS u32x4_t*)(C.lds + n * 4096 + ((ch ^ (n & 15)) << 4)) = (u32x4_t){v.x, v.y, v.z, v.w}; }
    __syncthreads();
    for (int task = C.gw; task < M / 16; task += C.NGW) {
        const int row0 = task * 16;
        const bf16* ap = XB + (size_t)(row0 + r16) * DMP + 8 * q;
        f32x4 acc0 = (f32x4){0.f, 0.f, 0.f, 0.f}, acc1 = acc0;
#pragma unroll 16
        for (int ks = 0; ks < DM / 32; ++ks) { const bf16x8_t a = *(const bf16x8_t*)(ap + 32 * ks); const int ch = 4 * ks + q;
            acc0 = __builtin_amdgcn_mfma_f32_16x16x32_bf16(a, *(const LAS bf16x8_t*)(C.lds + r16 * 4096 + ((ch ^ r16) << 4)), acc0, 0, 0, 0);
            acc1 = __builtin_amdgcn_mfma_f32_16x16x32_bf16(a, *(const LAS bf16x8_t*)(C.lds + (16 + r16) * 4096 + ((ch ^ r16) << 4)), acc1, 0, 0, 0); }
#pragma unroll
        for (int r = 0; r < 4; ++r) { const int row = row0 + 4 * q + r; const float s = R[row]; DT[(size_t)row * 32 + r16] = acc0[r] * s; DT[(size_t)row * 32 + 16 + r16] = acc1[r] * s; }
    }
    __syncthreads();
}

__device__ __forceinline__ void phase_resid(Ctx C, const float* gpost, bool final_out, int nslab) {
    C.refresh();
    const bf16* MIXB = (const bf16*)(C.ws + WS_MIX); const float* SSQ = (const float*)(C.ws + WS_SSQP); const float* SLAB = (const float*)(C.ws + WS_SLAB);
    for (int row = C.gw; row < M; row += C.NGW) {
        F8 mv[4]; float p; uint4 xq[4];
        bf16* XB = (bf16*)(C.ws + WS_XB) + (size_t)row * DMP;
#pragma unroll
        for (int j = 0; j < 4; ++j) xq[j] = *(const uint4*)(XB + (C.lane + 64 * j) * 8);
        if (row < MP) {
            p = C.lane < 32 ? SSQ[(size_t)row * 32 + C.lane] : 0.f;
#pragma unroll
            for (int j = 0; j < 4; ++j) mv[j] = ld_bf8(MIXB + (size_t)row * DM + (C.lane + 64 * j) * 8);
        } else {
            p = 0.f;
#pragma unroll
            for (int j = 0; j < 4; ++j) { F8 a = zero8();
                for (int s = 0; s < nslab; ++s) { const F8 t = ld_f8(SLAB + ((size_t)s * MS + (row - MP)) * DM + (C.lane + 64 * j) * 8);
#pragma unroll
                    for (int k = 0; k < 8; ++k) a.v[k] += t.v[k]; }
                mv[j] = a;
#pragma unroll
                for (int k = 0; k < 8; ++k) p += a.v[k] * a.v[k]; }
        }
        p = wave_sum(p);
        const float rs = rsqrtf(p * (1.f / DM) + EPS);
        float* Y = C.out + O_YP + (size_t)row * DM; float q = 0.f;
#pragma unroll
        for (int j = 0; j < 4; ++j) { const int idx = (C.lane + 64 * j) * 8; const F8 g8 = ld_f8(gpost + idx); F8 v = unpack8(xq[j]);
#pragma unroll
            for (int k = 0; k < 8; ++k) { v.v[k] += mv[j].v[k] * rs * g8.v[k]; q += v.v[k] * v.v[k]; }
            if (final_out) st_f8(Y + idx, v);
            st_bf8(XB + idx, v); }
        q = wave_sum(q);
        if (C.lane == 0) ((float*)(C.ws + WS_R))[row] = rsqrtf(q * (1.f / DM) + EPS);
    }
}

__device__ __forceinline__ void phase_gnorm(Ctx C) {
    C.refresh();
    const float* SSQH = (const float*)(C.ws + WS_SSQH); bf16* MIXA = (bf16*)(C.ws + WS_MIXA);
    for (int rowb = C.gw * 4; rowb < M; rowb += C.NGW * 4) {
        uint4 qv[4][4]; float pr[4];
#pragma unroll
        for (int rr = 0; rr < 4; ++rr) { const int row = rowb + rr; pr[rr] = C.lane < 32 ? SSQH[(size_t)row * 32 + C.lane] : 0.f;
#pragma unroll
            for (int j = 0; j < 4; ++j) qv[rr][j] = *(const uint4*)(MIXA + (size_t)row * D_MIX + D_POOL + (C.lane + 64 * j) * 8); }
#pragma unroll
        for (int rr = 0; rr < 4; ++rr) { const int row = rowb + rr; float p = pr[rr];
#pragma unroll
            for (int o = 1; o < 16; o <<= 1) p += __shfl_xor(p, o);
            const float s0 = __shfl(p, 0), s1 = __shfl(p, 16);
            const float r0 = rsqrtf(s0 * (1.f / 1024.f) + EPS), r1 = rsqrtf(s1 * (1.f / 1024.f) + EPS);
            bf16* y = MIXA + (size_t)row * D_MIX + D_POOL;
#pragma unroll
            for (int j = 0; j < 4; ++j) { const int c = (C.lane + 64 * j) * 8; const float r = c < 1024 ? r0 : r1; F8 v = unpack8(qv[rr][j]);
#pragma unroll
                for (int i = 0; i < 8; ++i) v.v[i] *= r;
                st_bf8(y + c, v); } }
    }
}

__device__ __forceinline__ void phase_act(Ctx C, int l) {
    C.refresh();
    const bf16* UP = (const bf16*)(C.ws + WS_UP); bf16* ACT = (bf16*)(C.ws + WS_ACT);
    const float* cw = C.in[20] + (size_t)l * 3 * D_UP; const float* cb = C.in[21] + (size_t)l * D_UP; const float* hist = C.in[5] + (size_t)l * NB_S * 2 * D_UP;
    constexpr int NCG = D_FF / 8, NPIECE = MS / 8;
    const int gt = C.gw * 64 + C.lane, NGT = C.NGW * 64;
    for (int it = gt; it < NPIECE * NCG; it += NGT) {
        const int piece = it / NCG, c = (it % NCG) * 8, b = piece >> 2, t0 = (piece & 3) * 8, row0 = MP + b * SEQ_S + t0;
        uint4 qg[10], qv[10];
#pragma unroll
        for (int r = 0; r < 10; ++r) { const int rr = (t0 == 0 && r < 2) ? 2 : r; qg[r] = *(const uint4*)(UP + (size_t)(row0 + rr - 2) * D_UP + c); qv[r] = *(const uint4*)(UP + (size_t)(row0 + rr - 2) * D_UP + D_FF + c); }
        const float* h = hist + (size_t)b * 2 * D_UP;
        const F8 h2g = ld_f8(h + c), h2v = ld_f8(h + D_FF + c), h1g = ld_f8(h + D_UP + c), h1v = ld_f8(h + D_UP + D_FF + c);
        const F8 w0g = ld_f8(cw + c), w1g = ld_f8(cw + D_UP + c), w2g = ld_f8(cw + 2 * D_UP + c), bg = ld_f8(cb + c);
        const F8 w0v = ld_f8(cw + D_FF + c), w1v = ld_f8(cw + D_UP + D_FF + c), w2v = ld_f8(cw + 2 * D_UP + D_FF + c), bv = ld_f8(cb + D_FF + c);
        F8 p2g = unpack8(qg[0]), p2v = unpack8(qv[0]), p1g = unpack8(qg[1]), p1v = unpack8(qv[1]);
        if (t0 == 0) { p2g = h2g; p2v = h2v; p1g = h1g; p1v = h1v; }
#pragma unroll
        for (int r = 0; r < 8; ++r) { const F8 cg = unpack8(qg[r + 2]), cv = unpack8(qv[r + 2]); F8 o;
#pragma unroll
            for (int i = 0; i < 8; ++i) { const float g = bg.v[i] + w0g.v[i] * p2g.v[i] + w1g.v[i] * p1g.v[i] + w2g.v[i] * cg.v[i]; const float v = bv.v[i] + w0v.v[i] * p2v.v[i] + w1v.v[i] * p1v.v[i] + w2v.v[i] * cv.v[i]; o.v[i] = silu_f(g) * v; }
            st_bf8(ACT + (size_t)(row0 + r) * D_FF + c, o);
            p2g = p1g; p1g = cg; p2v = p1v; p1v = cv; }
        if (t0 == SEQ_S - 8) {
            float* o = C.out + O_FCS + ((size_t)(l * NB_S + b) * 2) * D_UP;
            st_f8(o + c, p2g); st_f8(o + D_FF + c, p2v); st_f8(o + D_UP + c, p1g); st_f8(o + D_UP + D_FF + c, p1v);
        }
    }
}

__device__ __forceinline__ void phase_actfix(Ctx C, int l) {
    C.refresh();
    const bf16* SIDE = (const bf16*)(C.ws + WS_SIDE); bf16* ACT = (bf16*)(C.ws + WS_ACT);
    const float* cw = C.in[20] + (size_t)l * 3 * D_UP; const float* cb = C.in[21] + (size_t)l * D_UP;
    constexpr int NCG = D_FF / 8, NBLK = MP / 64;
    const int gt = C.gw * 64 + C.lane, NGT = C.NGW * 64;
    for (int it = gt; it < NBLK * NCG; it += NGT) {
        const int kb = it / NCG, c = (it % NCG) * 8; const bool start = (kb % (SEQ / 64)) == 0;
        const bf16* sp = SIDE + (size_t)(start ? kb : kb - 1) * 4 * D_UP + c; const bf16* sc = SIDE + (size_t)kb * 4 * D_UP + c;
        uint4 q[8];
        q[0] = *(const uint4*)(sp + 2 * D_UP); q[1] = *(const uint4*)(sp + 2 * D_UP + D_FF); q[2] = *(const uint4*)(sp + 3 * D_UP); q[3] = *(const uint4*)(sp + 3 * D_UP + D_FF);
        q[4] = *(const uint4*)(sc); q[5] = *(const uint4*)(sc + D_FF); q[6] = *(const uint4*)(sc + D_UP); q[7] = *(const uint4*)(sc + D_UP + D_FF);
        F8 p2g = unpack8(q[0]), p2v = unpack8(q[1]), p1g = unpack8(q[2]), p1v = unpack8(q[3]); const F8 r0g = unpack8(q[4]), r0v = unpack8(q[5]), r1g = unpack8(q[6]), r1v = unpack8(q[7]);
        if (start) { p2g = zero8(); p2v = zero8(); p1g = zero8(); p1v = zero8(); }
        const F8 w0g = ld_f8(cw + c), w1g = ld_f8(cw + D_UP + c), w2g = ld_f8(cw + 2 * D_UP + c), bg = ld_f8(cb + c);
        const F8 w0v = ld_f8(cw + D_FF + c), w1v = ld_f8(cw + D_UP + D_FF + c), w2v = ld_f8(cw + 2 * D_UP + D_FF + c), bv = ld_f8(cb + D_FF + c);
        F8 o0, o1;
#pragma unroll
        for (int i = 0; i < 8; ++i) { const float g0 = bg.v[i] + w0g.v[i] * p2g.v[i] + w1g.v[i] * p1g.v[i] + w2g.v[i] * r0g.v[i], v0 = bv.v[i] + w0v.v[i] * p2v.v[i] + w1v.v[i] * p1v.v[i] + w2v.v[i] * r0v.v[i];
            const float g1 = bg.v[i] + w0g.v[i] * p1g.v[i] + w1g.v[i] * r0g.v[i] + w2g.v[i] * r1g.v[i], v1 = bv.v[i] + w0v.v[i] * p1v.v[i] + w1v.v[i] * r0v.v[i] + w2v.v[i] * r1v.v[i];
            o0.v[i] = silu_f(g0) * v0; o1.v[i] = silu_f(g1) * v1; }
        st_bf8(ACT + (size_t)(kb * 64) * D_FF + c, o0); st_bf8(ACT + (size_t)(kb * 64 + 1) * D_FF + c, o1);
        if ((kb % (SEQ / 64)) == SEQ / 64 - 1) {
            float* o = C.out + O_FCP + ((size_t)(l * NB_P + kb / (SEQ / 64)) * 2) * D_UP;
            st_f8(o + c, ld_bf8(sc + 2 * D_UP)); st_f8(o + D_FF + c, ld_bf8(sc + 2 * D_UP + D_FF)); st_f8(o + D_UP + c, ld_bf8(sc + 3 * D_UP)); st_f8(o + D_UP + D_FF + c, ld_bf8(sc + 3 * D_UP + D_FF)); }
    }
}

__device__ __forceinline__ void phase_pool(Ctx C, int l) {
    C.refresh();
    const bf16* PROJ = (const bf16*)(C.ws + WS_PROJ); bf16* MIXA = (bf16*)(C.ws + WS_MIXA);
    const float* hist = C.in[2] + (size_t)l * NB_S * POOL_HIST * D_POOL;
    constexpr int NCG = D_POOL / 8, NSTRIP = M / 32;
    const int gt = C.gw * 64 + C.lane, NGT = C.NGW * 64;
    for (int it = gt; it < NSTRIP * NCG; it += NGT) {
        const int strip = it / NCG, cgi = it % NCG, c = cgi * 8, row0 = strip * 32; const bool prm = row0 < MP;
        const int b = prm ? row0 / SEQ : (row0 - MP) / SEQ_S, t0 = prm ? row0 % SEQ : 0, w = 2 << (cgi >> 5);
        const int rb = row0 - t0;
        const float* hb = hist + (size_t)b * POOL_HIST * D_POOL;
        F8 s = zero8();
        for (int i = 1; i < w; ++i) { const int t = t0 - i; F8 v;
            if (t >= 0) v = ld_bf8(PROJ + (size_t)(rb + t) * N_PROJ + c); else if (!prm) v = ld_f8(hb + (size_t)(POOL_HIST + t) * D_POOL + c); else v = zero8();
#pragma unroll
            for (int k = 0; k < 8; ++k) s.v[k] += v.v[k]; }
        for (int r0 = 0; r0 < 32; r0 += 8) {
            uint4 qc[8], ql[8];
#pragma unroll
            for (int r = 0; r < 8; ++r) { const int t = t0 + r0 + r, tl = t - w + 1; qc[r] = *(const uint4*)(PROJ + (size_t)(rb + t) * N_PROJ + c); ql[r] = *(const uint4*)(PROJ + (size_t)(rb + (tl > 0 ? tl : 0)) * N_PROJ + c); }
#pragma unroll
            for (int r = 0; r < 8; ++r) { const int t = t0 + r0 + r, tl = t - w + 1; const F8 cur = unpack8(qc[r]);
                const float inv = 1.f / (float)(prm ? (t + 1 < w ? t + 1 : w) : w); F8 o;
#pragma unroll
                for (int k = 0; k < 8; ++k) { s.v[k] += cur.v[k]; o.v[k] = s.v[k] * inv - cur.v[k]; }
                st_bf8(MIXA + (size_t)(rb + t) * D_MIX + c, o);
                F8 v = unpack8(ql[r]);
                if (tl < 0) { if (!prm) v = ld_f8(hb + (size_t)(POOL_HIST + tl) * D_POOL + c); else v = zero8(); }
#pragma unroll
                for (int k = 0; k < 8; ++k) s.v[k] -= v.v[k]; }
        }
    }
    for (int it = gt; it < (NB_P + NB_S) * 15 * NCG; it += NGT) {
        const int cg = it % NCG, i = (it / NCG) % 15, sb = it / (NCG * 15); const bool prm = sb < NB_P; const int b = prm ? sb : sb - NB_P;
        const int row = prm ? b * SEQ + (SEQ - 15 + i) : MP + b * SEQ_S + (SEQ_S - 15 + i);
        float* o = C.out + (prm ? O_POOLP + ((size_t)(l * NB_P + b) * 15 + i) * D_POOL : O_POOLS + ((size_t)(l * NB_S + b) * 15 + i) * D_POOL);
        st_f8(o + cg * 8, ld_bf8(PROJ + (size_t)row * N_PROJ + cg * 8));
    }
    constexpr int NCG2 = CONV_DIM / 8;
    for (int it = gt; it < (NB_P + NB_S) * 3 * NCG2; it += NGT) {
        const int cg = it % NCG2, i = (it / NCG2) % 3, sb = it / (NCG2 * 3); const bool prm = sb < NB_P; const int b = prm ? sb : sb - NB_P;
        const int row = prm ? b * SEQ + (SEQ - 3 + i) : MP + b * SEQ_S + (SEQ_S - 3 + i);
        float* o = C.out + (prm ? O_SCP + ((size_t)(l * NB_P + b) * 3 + i) * CONV_DIM : O_SCS + ((size_t)(l * NB_S + b) * 3 + i) * CONV_DIM);
        st_f8(o + cg * 8, ld_bf8(PROJ + (size_t)row * N_PROJ + XBC0 + cg * 8));
    }
}

__device__ __forceinline__ void phase_ssd(Ctx C, int l) {
    C.refresh();
    LAS float* xs = (LAS float*)(C.lds); LAS float* Bs = (LAS float*)(C.lds + 16384); LAS float* Cs = (LAS float*)(C.lds + 49152); LAS float* ys = (LAS float*)(C.lds + 81920);
    LAS float* dts = (LAS float*)(C.lds + 98304); LAS float* dAs = dts + 64;
    const bf16* PROJ = (const bf16*)(C.ws + WS_PROJ); const float* DT = (const float*)(C.ws + WS_DT); bf16* MIXA = (bf16*)(C.ws + WS_MIXA); float* SSQH = (float*)(C.ws + WS_SSQH);
    const float* cw = C.in[10] + (size_t)l * 4 * CONV_DIM; const float* cb = C.in[11] + (size_t)l * CONV_DIM;
    const int tid = C.tid, p = tid >> 3, n0 = (tid & 7) * 16;
    for (int u = blockIdx.x; u < NB_P * NH + NB_S * NH; u += C.G) {
        const bool prm = u < NB_P * NH; const int su = prm ? u : u - NB_P * NH, b = su / NH, hh = su % NH, g = hh / HPG;
        const int rb = prm ? b * SEQ : MP + b * SEQ_S, rows = prm ? 64 : 32, nchunk = prm ? SEQ / 64 : 1;
        const float Aneg = -__expf(C.in[13][l * NH + hh]), Dsk = C.in[14][l * NH + hh], dtb = C.in[12][l * NH + hh];
        const float* chist = C.in[3] + ((size_t)(l * NB_S + b) * 3) * CONV_DIM;
        float h[16];
        if (prm) {
#pragma unroll
            for (int i = 0; i < 16; ++i) h[i] = 0.f;
        } else { const float* h0 = C.in[4] + ((((size_t)l * NB_S + b) * NH + hh) * HD + p) * DS + n0;
#pragma unroll
            for (int i = 0; i < 4; ++i) { const float4 v = *(const float4*)(h0 + 4 * i); h[4 * i] = v.x; h[4 * i + 1] = v.y; h[4 * i + 2] = v.z; h[4 * i + 3] = v.w; } }
        for (int ch = 0; ch < nchunk; ++ch) {
            const int tb = ch * 64;
            for (int e = tid; e < rows * 40; e += NTHR) {
                const int cg = e % 40, tt = e / 40, t = tb + tt;
                int cc; LAS float* dstp;
                if (cg < 8) { cc = hh * HD + cg * 8; dstp = xs + tt * 64 + cg * 8; }
                else if (cg < 24) { cc = D_SSD + g * DS + (cg - 8) * 8; dstp = Bs + tt * 128 + (cg - 8) * 8; }
                else { cc = D_SSD + 2 * DS + g * DS + (cg - 24) * 8; dstp = Cs + tt * 128 + (cg - 24) * 8; }
                F8 a = ld_f8(cb + cc);
#pragma unroll
                for (int i = 0; i < 4; ++i) { const int ti = t - 3 + i; F8 v;
                    if (ti >= 0) v = ld_bf8(PROJ + (size_t)(rb + ti) * N_PROJ + XBC0 + cc); else if (!prm) v = ld_f8(chist + (size_t)(3 + ti) * CONV_DIM + cc); else v = zero8();
                    const F8 wv = ld_f8(cw + (size_t)i * CONV_DIM + cc);
#pragma unroll
                    for (int k = 0; k < 8; ++k) a.v[k] += wv.v[k] * v.v[k]; }
#pragma unroll
                for (int k = 0; k < 8; ++k) dstp[k] = silu_f(a.v[k]);
            }
            if (tid < rows) { const float xr = DT[(size_t)(rb + tb + tid) * 32 + hh] + dtb; const float dtv = xr > 20.f ? xr : log1pf(__expf(xr)); dts[tid] = dtv; dAs[tid] = __expf(dtv * Aneg); }
            __syncthreads();
            for (int tt = 0; tt < rows; ++tt) {
                const float xv = xs[tt * 64 + p], xdt = xv * dts[tt], dA = dAs[tt]; float acc = 0.f;
#pragma unroll
                for (int i = 0; i < 4; ++i) { const f32x4 bv = *(const LAS f32x4*)(Bs + tt * 128 + n0 + 4 * i), cv = *(const LAS f32x4*)(Cs + tt * 128 + n0 + 4 * i);
                    h[4 * i] = dA * h[4 * i] + xdt * bv[0]; acc += cv[0] * h[4 * i];
                    h[4 * i + 1] = dA * h[4 * i + 1] + xdt * bv[1]; acc += cv[1] * h[4 * i + 1];
                    h[4 * i + 2] = dA * h[4 * i + 2] + xdt * bv[2]; acc += cv[2] * h[4 * i + 2];
                    h[4 * i + 3] = dA * h[4 * i + 3] + xdt * bv[3]; acc += cv[3] * h[4 * i + 3]; }
                acc += __shfl_xor(acc, 1); acc += __shfl_xor(acc, 2); acc += __shfl_xor(acc, 4);
                if ((tid & 7) == 0) ys[tt * 64 + p] = acc + Dsk * xv;
            }
            __syncthreads();
            for (int e = tid; e < rows * 64; e += NTHR) {
                const int tt = e >> 6, pp = e & 63; const size_t row = (size_t)(rb + tb + tt);
                const float zv = bf2f(PROJ[row * N_PROJ + D_POOL + hh * HD + pp]); const float yz = ys[tt * 64 + pp] * silu_f(zv);
                MIXA[row * D_MIX + D_POOL + hh * HD + pp] = (bf16)f2bf(yz);
                const float q = wave_sum(yz * yz);
                if (pp == 0) SSQH[row * 32 + hh] = q;
            }
            __syncthreads();
        }
        float* ho = C.out + (prm ? O_SSDP + ((((size_t)l * NB_P + b) * NH + hh) * HD + p) * DS + n0 : O_SSDS + ((((size_t)l * NB_S + b) * NH + hh) * HD + p) * DS + n0);
#pragma unroll
        for (int i = 0; i < 4; ++i) *(float4*)(ho + 4 * i) = make_float4(h[4 * i], h[4 * i + 1], h[4 * i + 2], h[4 * i + 3]);
    }
}

__device__ __forceinline__ void phase_xact(Ctx C, int l) {
    C.refresh();
    const bf16* PROJ = (const bf16*)(C.ws + WS_PROJ); bf16* ACTX = (bf16*)(C.ws + WS_ACTX);
    const float* cw = C.in[10] + (size_t)l * 4 * CONV_DIM; const float* cb = C.in[11] + (size_t)l * CONV_DIM;
    constexpr int NCG = CONV_DIM / 8, NSTRIP = M / 16;
    const int gt = C.gw * 64 + C.lane, NGT = C.NGW * 64;
    for (int it = gt; it < NSTRIP * NCG; it += NGT) {
        const int strip = it / NCG, c = (it % NCG) * 8, row0 = strip * 16; const bool prm = row0 < MP;
        const int t0 = prm ? row0 % SEQ : (row0 - MP) % SEQ_S, b = prm ? row0 / SEQ : (row0 - MP) / SEQ_S;
        uint4 rq[19];
#pragma unroll
        for (int j = 0; j < 19; ++j) { const int dr = (t0 == 0 && j < 3) ? 0 : j - 3; rq[j] = *(const uint4*)(PROJ + (size_t)(row0 + dr) * N_PROJ + XBC0 + c); }
        if (t0 == 0) {
            const float* h = C.in[3] + ((size_t)(l * NB_S + (prm ? 0 : b)) * 3) * CONV_DIM + c;
#pragma unroll
            for (int j = 0; j < 3; ++j) { uint4 v = make_uint4(0u, 0u, 0u, 0u);
                if (!prm) { const F8 hv = ld_f8(h + (size_t)j * CONV_DIM); v = make_uint4(pk2(hv.v[0], hv.v[1]), pk2(hv.v[2], hv.v[3]), pk2(hv.v[4], hv.v[5]), pk2(hv.v[6], hv.v[7])); }
                rq[j] = v; } }
        F8 wv[4];
#pragma unroll
        for (int i = 0; i < 4; ++i) wv[i] = ld_f8(cw + (size_t)i * CONV_DIM + c);
        const F8 bv = ld_f8(cb + c);
#pragma unroll
        for (int i = 0; i < 16; ++i) { F8 o = bv;
#pragma unroll
            for (int tap = 0; tap < 4; ++tap) { const F8 rj = unpack8(rq[i + tap]);
#pragma unroll
                for (int k = 0; k < 8; ++k) o.v[k] += wv[tap].v[k] * rj.v[k]; }
#pragma unroll
            for (int k = 0; k < 8; ++k) o.v[k] = silu_f(o.v[k]);
            st_bf8(ACTX + (size_t)(row0 + i) * CONV_DIM + c, o); }
    }
}

constexpr int SL_C = 0, SL_B = 17408, SL_BT = 34816, SL_XT = 53248, SL_H = 62464, SL_M = 79872, SL_DT = 89088, SL_AC = SL_DT + 512, SL_W = SL_AC + 512, SL_DEC = SL_W + 512, SL_SSQ = SL_DEC + 16, SL_XWT = SL_SSQ + 1024;
constexpr int PC = 272, PT = 144;
typedef short bf16x8_t __attribute__((ext_vector_type(8)));
__device__ __forceinline__ bf16x8_t ld_op(const LAS unsigned char* base, int row, int pitch, int kelem) { return *(const LAS bf16x8_t*)(base + row * pitch + kelem * 2); }
__device__ __forceinline__ int swz(int row, int byte) { return byte ^ (((row >> 3) & 7) << 4); }
__device__ __forceinline__ bf16x8_t ld_op_sw(const LAS unsigned char* base, int row, int pitch, int kelem) { return *(const LAS bf16x8_t*)(base + row * pitch + swz(row, kelem * 2)); }

typedef unsigned u32x4_t __attribute__((ext_vector_type(4)));
typedef unsigned u32x2_t __attribute__((ext_vector_type(2)));
__device__ __forceinline__ F8 lds_f8(const LAS float* p) { const f32x4 a = *(const LAS f32x4*)p, b = *(const LAS f32x4*)(p + 4); F8 r; r.v[0] = a[0]; r.v[1] = a[1]; r.v[2] = a[2]; r.v[3] = a[3]; r.v[4] = b[0]; r.v[5] = b[1]; r.v[6] = b[2]; r.v[7] = b[3]; return r; }
__device__ __forceinline__ unsigned perm_lo(unsigned hi_row, unsigned lo_row) { return __builtin_amdgcn_perm(hi_row, lo_row, 0x05040100u); }
__device__ __forceinline__ unsigned perm_hi(unsigned hi_row, unsigned lo_row) { return __builtin_amdgcn_perm(hi_row, lo_row, 0x07060302u); }
__device__ __forceinline__ unsigned qword(const uint4& v, int i) { return i == 0 ? v.x : (i == 1 ? v.y : (i == 2 ? v.z : v.w)); }
__device__ __forceinline__ void ssd_stage(LAS unsigned char* L, int cg, int l0, int rows_valid, const LAS float* w_s, const uint4 (&rq)[8]) {
    uint4 r[8];
#pragma unroll
    for (int i = 0; i < 8; ++i) { const bool ok = l0 + i < rows_valid; r[i].x = ok ? rq[i].x : 0u; r[i].y = ok ? rq[i].y : 0u; r[i].z = ok ? rq[i].z : 0u; r[i].w = ok ? rq[i].w : 0u; }
    if (cg < 8) {
        const f32x4 wa = *(const LAS f32x4*)(w_s + l0), wb = *(const LAS f32x4*)(w_s + l0 + 4);
#pragma unroll
        for (int k = 0; k < 8; ++k) { const int p = 8 * cg + k; unsigned t[4];
#pragma unroll
            for (int jj = 0; jj < 4; ++jj) t[jj] = (k & 1) ? perm_hi(qword(r[2 * jj + 1], k >> 1), qword(r[2 * jj], k >> 1)) : perm_lo(qword(r[2 * jj + 1], k >> 1), qword(r[2 * jj], k >> 1));
            *(LAS u32x4_t*)(L + SL_XT + p * PT + swz(p, l0 * 2)) = (u32x4_t){t[0], t[1], t[2], t[3]};
            *(LAS u32x4_t*)(L + SL_XWT + p * PT + swz(p, l0 * 2)) = (u32x4_t){pk2(bflo(t[0]) * wa[0], bfhi(t[0]) * wa[1]), pk2(bflo(t[1]) * wa[2], bfhi(t[1]) * wa[3]), pk2(bflo(t[2]) * wb[0], bfhi(t[2]) * wb[1]), pk2(bflo(t[3]) * wb[2], bfhi(t[3]) * wb[3])}; }
    } else if (cg < 24) { const int n0 = 8 * (cg - 8);
#pragma unroll
        for (int i = 0; i < 8; ++i) *(LAS u32x4_t*)(L + SL_B + (l0 + i) * PC + n0 * 2) = (u32x4_t){r[i].x, r[i].y, r[i].z, r[i].w};
#pragma unroll
        for (int k = 0; k < 8; ++k) { const int n = n0 + k; unsigned t[4];
#pragma unroll
            for (int jj = 0; jj < 4; ++jj) t[jj] = (k & 1) ? perm_hi(qword(r[2 * jj + 1], k >> 1), qword(r[2 * jj], k >> 1)) : perm_lo(qword(r[2 * jj + 1], k >> 1), qword(r[2 * jj], k >> 1));
            *(LAS u32x4_t*)(L + SL_BT + n * PT + swz(n, l0 * 2)) = (u32x4_t){t[0], t[1], t[2], t[3]}; }
    } else { const int n0 = 8 * (cg - 24);
#pragma unroll
        for (int i = 0; i < 8; ++i) *(LAS u32x4_t*)(L + SL_C + (l0 + i) * PC + n0 * 2) = (u32x4_t){r[i].x, r[i].y, r[i].z, r[i].w};
    }
}
__device__ __forceinline__ void ssd_dt(LAS unsigned char* L, int par, float xr, bool valid, float Aneg, int lane) {
    const float dtv = valid ? (xr > 20.f ? xr : log1pf(__expf(xr))) : 0.f;
    float a = dtv * Aneg;
#pragma unroll
    for (int o = 1; o < 64; o <<= 1) { const float v = __shfl_up(a, o); if (lane >= o) a += v; }
    const float last = __shfl(a, 63);
    ((LAS float*)(L + SL_DT))[par * 64 + lane] = dtv; ((LAS float*)(L + SL_AC))[par * 64 + lane] = a; ((LAS float*)(L + SL_W))[par * 64 + lane] = dtv * __expf(last - a);
    if (lane == 0) ((LAS float*)(L + SL_DEC))[par] = __expf(last);
}
#define WG_BAR() do { asm volatile("s_waitcnt lgkmcnt(0)" ::: "memory"); __builtin_amdgcn_s_barrier(); asm volatile("" ::: "memory"); } while (0)
__device__ __forceinline__ void stage_role(int tq, int& cg, int& l0) {
    const int ws = tq >> 6, lane = tq & 63;
    if (ws == 0) { cg = lane & 7; l0 = (lane >> 3) * 8; }
    else { const int idx = ((ws - 1) & 1) * 64 + lane; cg = (ws <= 2 ? 8 : 24) + (idx & 15); l0 = (idx >> 4) * 8; }
}
__device__ __forceinline__ void ssd_load_act(uint4 (&rq)[8], const bf16* ACTX, int tq, int hh, int g, size_t rowf) {
    int cg, l0c; stage_role(tq, cg, l0c);
    const int cc = cg < 8 ? hh * HD + cg * 8 : (cg < 24 ? D_SSD + g * DS + (cg - 8) * 8 : D_SSD + 2 * DS + g * DS + (cg - 24) * 8);
    const unsigned lo = tq < 320 ? (unsigned)(l0c * CONV_DIM + cc) * 2u : 0u;
#pragma unroll
    for (int j = 0; j < 8; ++j) { const char* ub = (const char*)ACTX + ((rowf + j) * CONV_DIM) * 2; rq[j] = *(const uint4*)(ub + lo); }
}
__device__ __forceinline__ void ssd_load_z(uint2 (&zq)[2], const bf16* PROJ, int w, int r16, int q, int hh, size_t row0, int rows) {
    const int pi = w >> 1, li0 = 2 * (w & 1);
#pragma unroll
    for (int t = 0; t < 2; ++t) { const int lrow = 16 * (li0 + t) + r16; const char* ub = (const char*)PROJ + ((row0 + 16 * (li0 + t)) * N_PROJ + D_POOL + hh * HD + 16 * pi) * 2;
        zq[t] = lrow < rows ? *(const uint2*)(ub + (unsigned)(r16 * N_PROJ + 4 * q) * 2u) : make_uint2(0u, 0u); }
}
#define OPQ_V(x) asm volatile("" : "+v"(x))
#define OPQ_S(x) asm volatile("" : "+s"(x))
__device__ __forceinline__ void phase_ssd2(Ctx C, int l) {
    C.refresh();
    LAS unsigned char* L = C.lds;
    const bf16* PROJ = (const bf16*)(C.ws + WS_PROJ); const bf16* ACTX = (const bf16*)(C.ws + WS_ACTX); const float* DT = (const float*)(C.ws + WS_DT); bf16* MIXA = (bf16*)(C.ws + WS_MIXA); float* SSQH = (float*)(C.ws + WS_SSQH);
    const int w0 = C.wave;
    const int conv_l = l + 1 < DEPTH ? l + 1 : -1, cG = C.G, cbx = (int)blockIdx.x;
    float cwv[32], cgl = 1.f; int cslot = 0;
#define tid0 (w0 * 64 + lane_id())
    typedef float f4 __attribute__((ext_vector_type(4)));
#if PROBE_SEL > 0
    volatile LAS unsigned* MISC2 = (volatile LAS unsigned*)(C.lds + LDSCTL_OFF);
    if (blockIdx.x == 0 && w0 == 0 && lane_id() == 0) MISC2[13] = (unsigned)__builtin_amdgcn_s_memrealtime();
#define STAMP2(ty) do { if (blockIdx.x == 0 && w0 == 0 && lane_id() == 0) { const unsigned tn = (unsigned)__builtin_amdgcn_s_memrealtime(); MISC2[16 + (ty)] += tn - MISC2[13]; MISC2[13] = tn; } } while (0)
#else
#define STAMP2(ty) do { } while (0)
#endif
    for (int u = blockIdx.x; u < NB_P * NH + NB_S * NH; u += C.G) {
        STAMP2(19);
        const bool prm = u < NB_P * NH; const int su = prm ? u : u - NB_P * NH, b = su / NH, hh = su % NH, g = hh / HPG;
        const int rb = prm ? b * SEQ : MP + b * SEQ_S, rows = prm ? 64 : 32, nchunk = prm ? SEQ / 64 : 1;
        const float Aneg = -__expf(C.in[13][l * NH + hh]), Dsk = C.in[14][l * NH + hh], dtb = C.in[12][l * NH + hh];
        f4 hacc[4]; float xrn; uint2 zq[2]; uint4 rawq[8];
        {
            int tq = tid0, w = w0; OPQ_V(tq); OPQ_S(w);
            const int lane = tq & 63, r16 = lane & 15, q = lane >> 4; const bool stg = tq < 320; int cg, l0; stage_role(tq, cg, l0);
#pragma unroll
            for (int pj = 0; pj < 4; ++pj) {
                if (prm) hacc[pj] = (f4){0.f, 0.f, 0.f, 0.f};
                else { const float4 v = *(const float4*)(C.in[4] + ((((size_t)l * NB_S + b) * NH + hh) * HD + 16 * pj + r16) * DS + 16 * w + 4 * q); hacc[pj] = (f4){v.x, v.y, v.z, v.w}; }
                *(LAS u32x2_t*)(L + SL_H + (16 * pj + r16) * PC + (16 * w + 4 * q) * 2) = (u32x2_t){pk2(hacc[pj][0], hacc[pj][1]), pk2(hacc[pj][2], hacc[pj][3])};
            }
            const float xr0 = DT[((size_t)rb + (lane < rows ? lane : 0)) * 32 + hh] + dtb;
            ssd_load_act(rawq, ACTX, tq, hh, g, (size_t)rb);
            if (w == 0) ssd_dt(L, 0, xr0, lane < rows, Aneg, lane);
            xrn = DT[((size_t)(rb + 64) + lane) * 32 + hh] + dtb;
            WG_BAR();
            if (stg) ssd_stage(L, cg, l0, rows, (const LAS float*)(L + SL_W), rawq);
            ssd_load_z(zq, PROJ, w, r16, q, hh, (size_t)rb, rows);
            ssd_load_act(rawq, ACTX, tq, hh, g, (size_t)rb + 64);
            WG_BAR();
        }
        STAMP2(13);
        for (int c = 0; c < nchunk; ++c) {
            const int par = c & 1, tb = c * 64; const bool more = c + 1 < nchunk;
            {
                int tq = tid0, w = w0; OPQ_V(tq); OPQ_S(w);
                const int lane = tq & 63, r16 = lane & 15, q = lane >> 4;
                const float xrc = xrn;
                xrn = DT[((size_t)(rb + tb + 128) + lane) * 32 + hh] + dtb;
                if (more && w == 0) ssd_dt(L, par ^ 1, xrc, true, Aneg, lane);
                const LAS float* ac = (const LAS float*)(L + SL_AC) + par * 64; const LAS float* dts = (const LAS float*)(L + SL_DT) + par * 64;
#pragma unroll
                for (int t = 0; t < 2; ++t) { const int T = 2 * w + t, si = T >> 2, li = T & 3; f4 acc = (f4){0.f, 0.f, 0.f, 0.f};
#pragma unroll
                    for (int ks = 0; ks < 4; ++ks) acc = __builtin_amdgcn_mfma_f32_16x16x32_bf16(ld_op(L + SL_B, 16 * si + r16, PC, 32 * ks + 8 * q), ld_op(L + SL_C, 16 * li + r16, PC, 32 * ks + 8 * q), acc, 0, 0, 0);
                    const int lr = 16 * li + r16, s0 = 16 * si + 4 * q; const float al = ac[lr]; const f4 as = *(const LAS f4*)(ac + s0), ds = *(const LAS f4*)(dts + s0); float m[4];
#pragma unroll
                    for (int r = 0; r < 4; ++r) m[r] = (s0 + r <= lr) ? acc[r] * __expf(al - as[r]) * ds[r] : 0.f;
                    *(LAS u32x2_t*)(L + SL_M + lr * PT + s0 * 2) = (u32x2_t){pk2(m[0], m[1]), pk2(m[2], m[3])}; }
            }
            WG_BAR(); STAMP2(14);
            {
                int tq = tid0, w = w0; OPQ_V(tq); OPQ_S(w);
                const int lane = tq & 63, r16 = lane & 15, q = lane >> 4, pi = w >> 1, li0 = 2 * (w & 1);
                const LAS float* ac = (const LAS float*)(L + SL_AC) + par * 64;
#pragma unroll
                for (int t = 0; t < 2; ++t) { const int li = li0 + t; f4 yd = (f4){0.f, 0.f, 0.f, 0.f}, yo = (f4){0.f, 0.f, 0.f, 0.f};
#pragma unroll
                    for (int ks = 0; ks < 2; ++ks) yd = __builtin_amdgcn_mfma_f32_16x16x32_bf16(ld_op_sw(L + SL_XT, 16 * pi + r16, PT, 32 * ks + 8 * q), ld_op(L + SL_M, 16 * li + r16, PT, 32 * ks + 8 * q), yd, 0, 0, 0);
#pragma unroll
                    for (int ks = 0; ks < 4; ++ks) yo = __builtin_amdgcn_mfma_f32_16x16x32_bf16(ld_op(L + SL_H, 16 * pi + r16, PC, 32 * ks + 8 * q), ld_op(L + SL_C, 16 * li + r16, PC, 32 * ks + 8 * q), yo, 0, 0, 0);
                    const int lr = 16 * li + r16, p0 = 16 * pi + 4 * q; const float e = __expf(ac[lr]);
                    const float zf[4] = {bflo(zq[t].x), bfhi(zq[t].x), bflo(zq[t].y), bfhi(zq[t].y)}; float yz[4], ss = 0.f;
#pragma unroll
                    for (int r = 0; r < 4; ++r) { const float xv = bf2f(*(const LAS bf16*)(L + SL_XT + (p0 + r) * PT + swz(p0 + r, lr * 2))); const float y = yd[r] + e * yo[r] + Dsk * xv; yz[r] = y * silu_f(zf[r]); ss += yz[r] * yz[r]; }
                    if (lr < rows) { char* ub = (char*)MIXA + ((size_t)(rb + tb + 16 * li) * D_MIX + D_POOL + hh * HD + 16 * pi) * 2; *(uint2*)(ub + (unsigned)(r16 * D_MIX + 4 * q) * 2u) = make_uint2(pk2(yz[0], yz[1]), pk2(yz[2], yz[3])); }
                    ss += __shfl_xor(ss, 16); ss += __shfl_xor(ss, 32);
                    if (q == 0) ((LAS float*)(L + SL_SSQ))[lr * 4 + pi] = ss; }
            }
            {
                int tq = tid0, w = w0; OPQ_V(tq); OPQ_S(w);
                const int lane = tq & 63, r16 = lane & 15, q = lane >> 4;
                const float dec = ((const LAS float*)(L + SL_DEC))[par];
#pragma unroll
                for (int pj = 0; pj < 4; ++pj) { hacc[pj] = hacc[pj] * dec;
#pragma unroll
                    for (int ks = 0; ks < 2; ++ks) hacc[pj] = __builtin_amdgcn_mfma_f32_16x16x32_bf16(ld_op_sw(L + SL_BT, 16 * w + r16, PT, 32 * ks + 8 * q), ld_op_sw(L + SL_XWT, 16 * pj + r16, PT, 32 * ks + 8 * q), hacc[pj], 0, 0, 0); }
            }
            WG_BAR(); STAMP2(15);
            {
                int tq = tid0, w = w0; OPQ_V(tq); OPQ_S(w);
                const int lane = tq & 63, r16 = lane & 15, q = lane >> 4;
#pragma unroll
                for (int pj = 0; pj < 4; ++pj) *(LAS u32x2_t*)(L + SL_H + (16 * pj + r16) * PC + (16 * w + 4 * q) * 2) = (u32x2_t){pk2(hacc[pj][0], hacc[pj][1]), pk2(hacc[pj][2], hacc[pj][3])};
                if (more && tq < 320) { int cg, l0; stage_role(tq, cg, l0); ssd_stage(L, cg, l0, 64, (const LAS float*)(L + SL_W) + (par ^ 1) * 64, rawq); }
                ssd_load_z(zq, PROJ, w, r16, q, hh, (size_t)(rb + tb + 64), rows);
                ssd_load_act(rawq, ACTX, tq, hh, g, (size_t)(rb + tb + 128));
                if (conv_l >= 0 && w >= 5) { const int mp = (w - 5) + 3 * (cslot - 1), mn = (w - 5) + 3 * cslot; LAS float* cscr = (LAS float*)(L + 101376 + (w - 5) * 8448);
                    if (cslot > 0 && mp * cG + cbx < I_L) conv_finish(conv_job(C, conv_l, mp * cG + cbx), lane, cwv, cgl, cscr);
                    if (mn * cG + cbx < I_L) conv_issue(conv_job(C, conv_l, mn * cG + cbx), lane, cwv, cgl); }
                ++cslot;
                if (tq >= 448 && (tq - 448) < rows) { const int lr = tq - 448; const f4 s4 = *(const LAS f4*)(L + SL_SSQ + lr * 16); SSQH[(size_t)(rb + tb + lr) * 32 + hh] = (s4[0] + s4[1]) + (s4[2] + s4[3]); }
            }
            WG_BAR();
            STAMP2(16);
        }
        {
            int tq = tid0, w = w0; OPQ_V(tq); OPQ_S(w);
            const int lane = tq & 63, r16 = lane & 15, q = lane >> 4;
            float* ho = C.out + (prm ? O_SSDP + (((size_t)l * NB_P + b) * NH + hh) * HD * DS : O_SSDS + (((size_t)l * NB_S + b) * NH + hh) * HD * DS);
#pragma unroll
            for (int pj = 0; pj < 4; ++pj) *(float4*)(ho + (size_t)(16 * pj + r16) * DS + 16 * w + 4 * q) = make_float4(hacc[pj][0], hacc[pj][1], hacc[pj][2], hacc[pj][3]); }
    }
    if (conv_l >= 0) {
        int tq = tid0, w = w0; OPQ_V(tq); OPQ_S(w); const int lane = tq & 63;
        if (w >= 5 && cslot > 0) { const int mp = (w - 5) + 3 * (cslot - 1); if (mp * cG + cbx < I_L) conv_finish(conv_job(C, conv_l, mp * cG + cbx), lane, cwv, cgl, (LAS float*)(L + 101376 + (w - 5) * 8448)); }
        WG_BAR();
        for (int m = 3 * cslot + w; m * cG + cbx < I_L; m += NWAVES) { const ConvJob j = conv_job(C, conv_l, m * cG + cbx); float wv2[32], gl2; conv_issue(j, lane, wv2, gl2); conv_finish(j, lane, wv2, gl2, (LAS float*)(L + w * 16384)); }
    }
}

#undef tid0
constexpr int PH_CONV = 0, PH_FOLD = 1, PH_L0 = 2, PH_PER_L = 10, N_PHASES = PH_L0 + DEPTH * PH_PER_L;
constexpr int CW_BAR = 4096;

__global__ void __launch_bounds__(NTHR, 2) fwd_kernel(Args args) {
    extern __shared__ __attribute__((aligned(16))) unsigned char lds_raw[];
    Ctx C; C.lds = (LAS unsigned char*)lds_raw; C.G = gridDim.x; C.in = args.in; C.out = args.out; C.ws = args.ws; C.wave0 = __builtin_amdgcn_readfirstlane(threadIdx.x >> 6); C.refresh();
    volatile LAS unsigned* MISC = (volatile LAS unsigned*)(C.lds + LDSCTL_OFF);
    if (threadIdx.x < 64) MISC[threadIdx.x] = 0u;
#define LEAD() (C.wave0 == 0 && lane_id() == 0)
    __syncthreads();
    const int lo = args.ph_lo, hi = args.ph_hi;
    unsigned* barw = (unsigned*)(args.ws + WS_CTL) + CW_BAR;
    XcdBarrier bar; bar.bar = barw; bar.x = 0; bar.st = MISC + 8;
    if (hi - lo > 1) bar = xcd_barrier_post(barw, MISC + 8, LEAD());
#define IN(k) (lo <= (k) && (k) < hi)
#if PROBE_SEL > 0
    if (blockIdx.x == 0 && LEAD()) { MISC[12] = (unsigned)__builtin_amdgcn_s_memrealtime(); MISC[14] = (unsigned)__builtin_amdgcn_s_memrealtime(); MISC[15] = (unsigned)clock64(); }
#define STAMP(ty) do { if (blockIdx.x == 0 && LEAD()) { const unsigned tn = (unsigned)__builtin_amdgcn_s_memrealtime(); MISC[16 + (ty)] += tn - MISC[12]; MISC[12] = tn; } } while (0)
#else
#define STAMP(ty) do { } while (0)
#endif
#define SEAM(k) do { if ((k) + 1 < hi) xcd_barrier(bar, LEAD()); } while (0)
    LAS unsigned char* ring = C.lds;
    const int vcu = (C.G % 8 == 0) ? ((int)blockIdx.x % 8) * (C.G / 8) + (int)blockIdx.x / 8 : (int)blockIdx.x;

    if (IN(PH_CONV)) { phase_convert(C); SEAM(PH_CONV); STAMP(0); }
    if (IN(PH_FOLD)) {
        for (int w = (int)blockIdx.x; w < 4 * 8; w += C.G) { const int lg = w >> 3, l = lg >> 2, g = lg & 3;
            pg8::Gemm gm{(const bf16*)(C.ws + WS_WOP) + (size_t)l * DM * D_POOL + g * 256, (const bf16*)(C.ws + WS_WPB) + (size_t)lg * 65536, DM, 256, 256, D_POOL, 256, 0};
            pg8::StaticOrder S; S.init(DM, 256, 8, w & 7);
            pg8::EpiBf16S E{(bf16*)(C.ws + WS_BTOUT) + (size_t)l * DM * D_MIX + g * 256, D_MIX, nullptr, nullptr, -1};
            pg8::gemm_phase<pg8::EpiBf16S, pg8::StaticOrder, true, true>(ring, gm, S, E, C.wave0);
        }
        SEAM(PH_FOLD); STAMP(1);
    }
    for (int l = 0; l < DEPTH; ++l) {
        const int pb = PH_L0 + l * PH_PER_L;
        if (IN(pb + 0)) {
            pg8::Gemm gm{(const bf16*)(C.ws + WS_XB), (const bf16*)(C.ws + WS_BTIN) + (size_t)l * N_INP * DMP, M, N_PROJ, DM, DMP, DMP, 0};
            pg8::StaticOrder S; S.init(M, N_PROJ, C.G, (int)blockIdx.x);
            pg8::EpiBf16S E{(bf16*)(C.ws + WS_PROJ), N_PROJ, (const float*)(C.ws + WS_R), nullptr, -1};
            pg8::gemm_phase<pg8::EpiBf16S, pg8::StaticOrder, true, true>(ring, gm, S, E, C.wave0);
            phase_dt(C, l);
            STAMP(17); SEAM(pb + 0); STAMP(2);
        }
        if (IN(pb + 1)) { phase_xact(C, l); phase_pool(C, l); STAMP(12); SEAM(pb + 1); STAMP(3); }
        if (IN(pb + 2)) { phase_ssd2(C, l); STAMP(11); SEAM(pb + 2); STAMP(19); }
        if (IN(pb + 3)) {
            if (l + 1 < DEPTH) for (int w = (int)blockIdx.x; w < 4 * 8; w += C.G) { const int lg = 4 * (l + 1) + (w >> 3), l1 = l + 1, g = (w >> 3) & 3;
                pg8::Gemm gm{(const bf16*)(C.ws + WS_WOP) + (size_t)l1 * DM * D_POOL + g * 256, (const bf16*)(C.ws + WS_WPB) + (size_t)lg * 65536, DM, 256, 256, D_POOL, 256, 0};
                pg8::StaticOrder S; S.init(DM, 256, 8, w & 7);
                pg8::EpiBf16S E{(bf16*)(C.ws + WS_BTOUT) + (size_t)l1 * DM * D_MIX + g * 256, D_MIX, nullptr, nullptr, -1};
                pg8::gemm_phase<pg8::EpiBf16S, pg8::StaticOrder, true, true>(ring, gm, S, E, C.wave0); }
            phase_gnorm(C); SEAM(pb + 3); STAMP(4); }
        if (IN(pb + 4)) {
            {
                pg8::Gemm gm{(const bf16*)(C.ws + WS_MIXA), (const bf16*)(C.ws + WS_BTOUT) + (size_t)l * DM * D_MIX, MP, DM, D_MIX, D_MIX, D_MIX, 0};
                pg8::StaticOrder S; S.init(MP, DM, C.G, (int)blockIdx.x);
                pg8::EpiBf16Ssq E{(bf16*)(C.ws + WS_MIX), DM, (float*)(C.ws + WS_SSQP)};
                pg8::gemm_phase<pg8::EpiBf16Ssq, pg8::StaticOrder, true, true>(ring, gm, S, E, C.wave0); }
            {
                pg8::Gemm gm{(const bf16*)(C.ws + WS_MIXA) + (size_t)MP * D_MIX, (const bf16*)(C.ws + WS_BTOUT) + (size_t)l * DM * D_MIX, MS, DM, D_MIX / KS_OUT, D_MIX, D_MIX, D_MIX / KS_OUT};
                pg8::SplitKOrder S; S.init(MS, DM, KS_OUT, C.G, vcu);
                pg8::EpiF32Slab E{(float*)(C.ws + WS_SLAB), DM, MS};
                pg8::gemm_phase<pg8::EpiF32Slab, pg8::SplitKOrder, true, true>(ring, gm, S, E, C.wave0); }
            STAMP(17); SEAM(pb + 4); STAMP(5);
        }
        if (IN(pb + 5)) { phase_resid(C, C.in[17] + l * DM, false, KS_OUT); SEAM(pb + 5); STAMP(6); }
        if (IN(pb + 6)) {
            pg8::Gemm gm{(const bf16*)(C.ws + WS_XB), (const bf16*)(C.ws + WS_BTUP) + (size_t)l * D_UP * DMP, M, D_UP, DM, DMP, DMP, 0};
            pg8::StaticOrder S; S.init(M, D_UP, C.G, (int)blockIdx.x);
            pg8::EpiUpAct E{(bf16*)(C.ws + WS_ACT), (bf16*)(C.ws + WS_UP), (bf16*)(C.ws + WS_SIDE), (const float*)(C.ws + WS_R), C.in[20] + (size_t)l * 3 * D_UP, C.in[21] + (size_t)l * D_UP, D_FF, (LAS float*)(C.lds + LDSCTL_OFF + 1024)};
            pg8::gemm_phase<pg8::EpiUpAct, pg8::StaticOrder, true, true>(ring, gm, S, E, C.wave0);
            STAMP(17); SEAM(pb + 6); STAMP(7);
        }
        if (IN(pb + 7)) { phase_act(C, l); phase_actfix(C, l); SEAM(pb + 7); STAMP(8); }
        if (IN(pb + 8)) {
            {
                pg8::Gemm gm{(const bf16*)(C.ws + WS_ACT), (const bf16*)(C.ws + WS_BTDN) + (size_t)l * DM * D_FF, MP, DM, D_FF, D_FF, D_FF, 0};
                pg8::StaticOrder S; S.init(MP, DM, C.G, (int)blockIdx.x);
                pg8::EpiBf16Ssq E{(bf16*)(C.ws + WS_MIX), DM, (float*)(C.ws + WS_SSQP)};
                pg8::gemm_phase<pg8::EpiBf16Ssq, pg8::StaticOrder, true, true>(ring, gm, S, E, C.wave0); }
            {
                pg8::Gemm gm{(const bf16*)(C.ws + WS_ACT) + (size_t)MP * D_FF, (const bf16*)(C.ws + WS_BTDN) + (size_t)l * DM * D_FF, MS, DM, D_FF / KS_DN, D_FF, D_FF, D_FF / KS_DN};
                pg8::SplitKOrder S; S.init(MS, DM, KS_DN, C.G, vcu);
                pg8::EpiF32Slab E{(float*)(C.ws + WS_SLAB), DM, MS};
                pg8::gemm_phase<pg8::EpiF32Slab, pg8::SplitKOrder, true, true>(ring, gm, S, E, C.wave0); }
            STAMP(17); SEAM(pb + 8); STAMP(9);
        }
        if (IN(pb + 9)) { phase_resid(C, C.in[23] + l * DM, l == DEPTH - 1, KS_DN); SEAM(pb + 9); STAMP(10); }
    }
#if PROBE_SEL > 0
    if (blockIdx.x == 0 && LEAD()) { asm volatile("s_waitcnt vmcnt(0)" ::: "memory"); unsigned tot = 0; for (int ty = 0; ty < 20; ++ty) if ((PROBE_SEL >> ty) & 1) tot += MISC[16 + ty]; C.out[0] = (float)tot * 0.0001f;
        if (PROBE_SEL & (1 << 30)) { const unsigned dc = (unsigned)clock64() - MISC[15], dt = (unsigned)__builtin_amdgcn_s_memrealtime() - MISC[14]; C.out[0] = 5.f * (float)dc / (float)dt; } }
#endif
#undef IN
#undef SEAM
}

extern "C" void kernel_launch(void* const* d_in, const int* in_sizes, int n_in, void* d_out, int out_size, void* d_ws, size_t ws_size, hipStream_t stream) {
    static int grid = 0;
    if (grid == 0) {
        if (n_in != 24 || (size_t)out_size != O_END || ws_size < WS_END) { fprintf(stderr, "kernel_launch: shape mismatch: n_in %d out %d (want %zu) ws %zu (need %zu)\n", n_in, out_size, (size_t)O_END, ws_size, (size_t)WS_END); grid = -1; return; }
        int dev = 0, cus = 0, per_cu = 0;
        if (hipGetDevice(&dev) != hipSuccess || hipDeviceGetAttribute(&cus, hipDeviceAttributeMultiprocessorCount, dev) != hipSuccess) { grid = -1; return; }
        if (hipFuncSetAttribute((const void*)fwd_kernel, hipFuncAttributeMaxDynamicSharedMemorySize, LDS_BYTES) != hipSuccess) { fprintf(stderr, "kernel_launch: hipFuncSetAttribute failed\n"); grid = -1; return; }
        if (hipOccupancyMaxActiveBlocksPerMultiprocessor(&per_cu, (const void*)fwd_kernel, NTHR, LDS_BYTES) != hipSuccess || per_cu < 1) fprintf(stderr, "kernel_launch: occupancy query reports %d\n", per_cu);
        (void)hipGetLastError();
        grid = cus;
    }
    if (grid < 0) return;
    if (hipMemsetAsync((char*)d_ws + WS_CTL, 0, CTL_BYTES, stream) != hipSuccess) return;
    Args a{};
    for (int i = 0; i < 24; ++i) a.in[i] = (const float*)d_in[i];
    a.out = (float*)d_out; a.ws = (unsigned char*)d_ws;
#if MK_MULTI
    for (int k = 0; k < N_PHASES; ++k) { a.ph_lo = k; a.ph_hi = k + 1; hipLaunchKernelGGL(fwd_kernel, dim3(grid), dim3(NTHR), LDS_BYTES, stream, a); }
#else
    a.ph_lo = 0; a.ph_hi = N_PHASES; hipLaunchKernelGGL(fwd_kernel, dim3(grid), dim3(NTHR), LDS_BYTES, stream, a);
#endif
}
```

```cpp
#include <hip/hip_runtime.h>
#include <cstdio>
#include <cstdint>

#ifndef PROBE_SEL
#define PROBE_SEL 0
#endif
#ifndef MK_MULTI
#define MK_MULTI 0
#endif

__device__ __forceinline__ int lane_id() { int l; asm volatile("v_mbcnt_lo_u32_b32 %0, -1, 0\n\tv_mbcnt_hi_u32_b32 %0, -1, %0" : "=v"(l)); return l; }
namespace pg8 {
#define PG8_LAS __attribute__((address_space(3)))
typedef unsigned short bf16_t;
typedef short bf16x8 __attribute__((ext_vector_type(8)));
typedef float f32x4 __attribute__((ext_vector_type(4)));
typedef unsigned u32x4 __attribute__((ext_vector_type(4)));
constexpr int BM = 256, BK = 64, HALF = 128, HTB = HALF * BK * 2, STAGE_BYTES = 8 * HTB, NXCD = 8, WGM = 8;

__host__ __device__ __forceinline__ int lds_byte(int r, int c) { const int st = (r >> 4) * 2 + (c >> 5), rr = r & 15, cc = c & 31, ob = rr * 64 + cc * 2; return st * 1024 + (ob ^ (((ob >> 9) & 1) << 5)); }
__host__ __device__ __forceinline__ void stage_rc(int b, int& R, int& C) { const int st = b / 1024, sb = b % 1024, swz = sb ^ (((sb >> 9) & 1) << 5); R = (st >> 1) * 16 + swz / 64; C = (st & 1) * 32 + (swz % 64) / 2; }
__host__ __device__ __forceinline__ int perm32(int rho) { const int n = rho >> 4, i = rho & 15; return 8 * (i >> 2) + 4 * n + (i & 3); }

struct Unit { int pm, pn, ks, seq; };
struct Gemm { const bf16_t* A; const bf16_t* Bt; int M, N, K, lda, ldb, kslice; };

struct StaticOrder {
    int nM, nN, nwg, G, c;
    __host__ __device__ void init(int M, int N, int G_, int c_) { nM = M / BM; nN = N / BM; nwg = nM * nN; G = G_; c = c_; }
    __host__ __device__ bool next(int i, Unit& u) const {
        const long L = (long)i * G + c; if (L >= nwg) return false;
        int wgid = (int)L; { const int q = nwg / NXCD, r = nwg % NXCD, xcd = wgid % NXCD, off = wgid / NXCD; wgid = (xcd < r ? xcd * (q + 1) : r * (q + 1) + (xcd - r) * q) + off; }
        const int nig = WGM * nN, gid = wgid / nig, fm = gid * WGM, gsz = (nM - fm) < WGM ? (nM - fm) : WGM;
        u.pm = fm + ((wgid % nig) % gsz); u.pn = (wgid % nig) / gsz; u.ks = 0; u.seq = i; return true;
    }
    __device__ __forceinline__ void a_ready(const Unit&) const {}
    __device__ __forceinline__ void done(const Unit&) const {}
};
struct SplitKOrder {
    int nM, nN, KS, nwg, G, c;
    __host__ __device__ void init(int M, int N, int KS_, int G_, int c_) { nM = M / BM; nN = N / BM; KS = KS_; nwg = nM * nN * KS; G = G_; c = c_; }
    __host__ __device__ bool next(int i, Unit& u) const { const long L = (long)i * G + c; if (L >= nwg) return false; const int l = (int)L; u.seq = i; u.pn = l % nN; u.ks = (l / nN) % KS; u.pm = l / (nN * KS); return true; }
    __device__ __forceinline__ void a_ready(const Unit&) const {}
    __device__ __forceinline__ void done(const Unit&) const {}
};

__device__ __forceinline__ unsigned cvt_pk_bf16(float lo, float hi) { unsigned r; asm volatile("v_cvt_pk_bf16_f32 %0, %1, %2" : "=v"(r) : "v"(lo), "v"(hi)); return r; }

struct EpiBf16S {
    static constexpr bool PERM = true, AFTER_DRAIN = false, HAS_KSEG = false;
    bf16_t* O; int ldc; const float* rs; float* dt; int dt_pn;
    __device__ __forceinline__ void operator()(const f32x4 (&acc)[2][2][4][2], const Unit& u, int wr, int wc, int fr, int fq) const {
        const int row0 = u.pm * BM + wr * 64 + fr;
        if (u.pn == dt_pn) {
            if (wc == 0) {
#pragma unroll
                for (int ai = 0; ai < 2; ++ai)
#pragma unroll
                    for (int m = 0; m < 4; ++m) { const int row = row0 + ai * HALF + m * 16; const float s = rs ? rs[row] : 1.f;
#pragma unroll
                        for (int n = 0; n < 2; ++n) *(f32x4*)(dt + (size_t)row * 32 + 8 * fq + 4 * n) = acc[ai][0][m][n] * s; }
            }
            return;
        }
        const int col0 = u.pn * BM + wc * 32 + 8 * fq;
#pragma unroll
        for (int ai = 0; ai < 2; ++ai)
#pragma unroll
            for (int m = 0; m < 4; ++m) { const int row = row0 + ai * HALF + m * 16; const float s = rs ? rs[row] : 1.f; bf16_t* rowp = O + (size_t)row * ldc + col0;
#pragma unroll
                for (int bj = 0; bj < 2; ++bj) { const f32x4 v0 = acc[ai][bj][m][0] * s, v1 = acc[ai][bj][m][1] * s;
                    u32x4 w; w.x = cvt_pk_bf16(v0[0], v0[1]); w.y = cvt_pk_bf16(v0[2], v0[3]); w.z = cvt_pk_bf16(v1[0], v1[1]); w.w = cvt_pk_bf16(v1[2], v1[3]);
                    *(u32x4*)(rowp + bj * HALF) = w; } }
    }
};
struct EpiF32Ssq {
    static constexpr bool PERM = false, AFTER_DRAIN = false, HAS_KSEG = false;
    float* C; int ldc; float* ssq;
    __device__ __forceinline__ void operator()(const f32x4 (&acc)[2][2][4][2], const Unit& u, int wr, int wc, int fr, int fq) const {
        const int row0 = u.pm * BM + wr * 64 + fr, col0 = u.pn * BM + wc * 32 + 4 * fq;
#pragma unroll
        for (int ai = 0; ai < 2; ++ai)
#pragma unroll
            for (int m = 0; m < 4; ++m) { const int row = row0 + ai * HALF + m * 16; float* rowp = C + (size_t)row * ldc + col0; float q = 0.f;
#pragma unroll
                for (int bj = 0; bj < 2; ++bj)
#pragma unroll
                    for (int n = 0; n < 2; ++n) { const f32x4 v = acc[ai][bj][m][n]; *(f32x4*)(rowp + bj * HALF + n * 16) = v; q += (v[0] * v[0] + v[1] * v[1]) + (v[2] * v[2] + v[3] * v[3]); }
                q += __shfl_xor(q, 16); q += __shfl_xor(q, 32);
                if (fq == 0) ssq[(size_t)row * 32 + u.pn * 4 + wc] = q; }
    }
};

struct EpiBf16Ssq {
    static constexpr bool PERM = true, AFTER_DRAIN = false, HAS_KSEG = false;
    bf16_t* O; int ldc; float* ssq;
    __device__ __forceinline__ void operator()(const f32x4 (&acc)[2][2][4][2], const Unit& u, int wr, int wc, int fr, int fq) const {
        const int row0 = u.pm * BM + wr * 64 + fr, col0 = u.pn * BM + wc * 32 + 8 * fq;
#pragma unroll
        for (int ai = 0; ai < 2; ++ai)
#pragma unroll
            for (int m = 0; m < 4; ++m) { const int row = row0 + ai * HALF + m * 16; bf16_t* rowp = O + (size_t)row * ldc + col0; float q = 0.f;
#pragma unroll
                for (int bj = 0; bj < 2; ++bj) { const f32x4 v0 = acc[ai][bj][m][0], v1 = acc[ai][bj][m][1];
                    q += ((v0[0] * v0[0] + v0[1] * v0[1]) + (v0[2] * v0[2] + v0[3] * v0[3])) + ((v1[0] * v1[0] + v1[1] * v1[1]) + (v1[2] * v1[2] + v1[3] * v1[3]));
                    u32x4 w; w.x = cvt_pk_bf16(v0[0], v0[1]); w.y = cvt_pk_bf16(v0[2], v0[3]); w.z = cvt_pk_bf16(v1[0], v1[1]); w.w = cvt_pk_bf16(v1[2], v1[3]);
                    *(u32x4*)(rowp + bj * HALF) = w; }
                q += __shfl_xor(q, 16); q += __shfl_xor(q, 32);
                if (fq == 0) ssq[(size_t)row * 32 + u.pn * 4 + wc] = q; }
    }
};
template <int CTRL> __device__ __forceinline__ float dppf(float old, float src) { return __builtin_bit_cast(float, __builtin_amdgcn_update_dpp(__builtin_bit_cast(int, old), __builtin_bit_cast(int, src), CTRL, 0xF, 0xF, false)); }
struct EpiUpAct {
    static constexpr bool PERM = true, AFTER_DRAIN = false, HAS_KSEG = false;
    bf16_t* ACT; bf16_t* UP; bf16_t* SIDE; const float* rs; const float* cw; const float* cb; int dff;
    PG8_LAS float* wlds;
    __device__ __forceinline__ void operator()(const f32x4 (&acc)[2][2][4][2], const Unit& u, int wr, int wc, int fr, int fq) const {
        const int row0 = u.pm * BM + wr * 64 + fr, cbase = u.pn * HALF + wc * 32 + 8 * fq, dup = 2 * dff;
        if (u.pm >= 64) {
#pragma unroll
            for (int ai = 0; ai < 2; ++ai)
#pragma unroll
                for (int m = 0; m < 4; ++m) { const int row = row0 + ai * HALF + m * 16; const float s = rs[row];
#pragma unroll
                    for (int bj = 0; bj < 2; ++bj) { const f32x4 v0 = acc[ai][bj][m][0] * s, v1 = acc[ai][bj][m][1] * s;
                        u32x4 w; w.x = cvt_pk_bf16(v0[0], v0[1]); w.y = cvt_pk_bf16(v0[2], v0[3]); w.z = cvt_pk_bf16(v1[0], v1[1]); w.w = cvt_pk_bf16(v1[2], v1[3]);
                        *(u32x4*)(UP + (size_t)row * dup + bj * dff + cbase) = w; } }
            return;
        }
        typedef unsigned u32x2 __attribute__((ext_vector_type(2)));
        PG8_LAS float* wl = wlds + (wr * 4 + wc) * 256;
        int fro = fr, fqo = fq; asm volatile("" : "+v"(fro), "+v"(fqo));
        { const int lane = fqo * 16 + fro, kind = lane >> 3, j0 = (lane & 7) * 4; const int k3 = kind & 3;
          const float* srcp = (k3 < 3 ? cw + (size_t)k3 * dup : cb) + (kind >> 2) * dff + u.pn * HALF + wc * 32 + j0;
          *(PG8_LAS f32x4*)(wl + kind * 32 + j0) = *(const f32x4*)srcp; }
        asm volatile("s_waitcnt lgkmcnt(0)" ::: "memory");
#pragma unroll
        for (int n = 0; n < 2; ++n) { const int c = cbase + 4 * n; const PG8_LAS float* wq = wl + 8 * fqo + 4 * n;
#pragma unroll
            for (int ai = 0; ai < 2; ++ai) { const int kb = u.pm * 4 + ai * 2 + wr; float sp = 0.f;
#pragma unroll
                for (int m = 0; m < 4; ++m) { const int row = row0 + ai * HALF + m * 16; const float s = rs[row];
                    const f32x4 g = acc[ai][0][m][n] * s, v = acc[ai][1][m][n] * s; f32x4 o;
                    const f32x4 gp = acc[ai][0][m > 0 ? m - 1 : 0][n] * sp, vp = acc[ai][1][m > 0 ? m - 1 : 0][n] * sp;
#pragma unroll
                    for (int e = 0; e < 4; ++e) {
                        const float p1g = dppf<0x111>(dppf<0x121>(0.f, gp[e]), g[e]), p2g = dppf<0x112>(dppf<0x122>(0.f, gp[e]), g[e]);
                        const float p1v = dppf<0x111>(dppf<0x121>(0.f, vp[e]), v[e]), p2v = dppf<0x112>(dppf<0x122>(0.f, vp[e]), v[e]);
                        const float gg = wq[96 + e] + wq[e] * p2g + wq[32 + e] * p1g + wq[64 + e] * g[e], vv = wq[224 + e] + wq[128 + e] * p2v + wq[160 + e] * p1v + wq[192 + e] * v[e];
                        o[e] = gg * __builtin_amdgcn_rcpf(1.f + __expf(-gg)) * vv; }
                    const bool head = (m == 0) && (fr < 2);
                    if (!head) { u32x2 w; w.x = cvt_pk_bf16(o[0], o[1]); w.y = cvt_pk_bf16(o[2], o[3]); *(u32x2*)(ACT + (size_t)row * dff + c) = w; }
                    if (head || ((m == 3) && (fr >= 14))) { const int slot = head ? fr : fr - 12; bf16_t* sp = SIDE + ((size_t)kb * 4 + slot) * dup + c;
                        u32x2 wg; wg.x = cvt_pk_bf16(g[0], g[1]); wg.y = cvt_pk_bf16(g[2], g[3]); *(u32x2*)sp = wg;
                        u32x2 wv; wv.x = cvt_pk_bf16(v[0], v[1]); wv.y = cvt_pk_bf16(v[2], v[3]); *(u32x2*)(sp + dff) = wv; }
                    sp = s; asm volatile("" ::: "memory"); } } }
    }
};
struct FactorOrder : StaticOrder {
    const float* ssqh; PG8_LAS float* ft; int wave0; float eps;
    __device__ __forceinline__ void a_ready(const Unit& u) const {
        const int t = wave0 * 64 + lane_id();
        if (t < 256) { const float* p = ssqh + (size_t)(u.pm * BM + t) * 32; float s0 = 0.f, s1 = 0.f;
#pragma unroll
            for (int i = 0; i < 4; ++i) { const f32x4 a = *(const f32x4*)(p + 4 * i), b = *(const f32x4*)(p + 16 + 4 * i); s0 += (a[0] + a[1]) + (a[2] + a[3]); s1 += (b[0] + b[1]) + (b[2] + b[3]); }
            const float r0 = rsqrtf(s0 * (1.f / 1024.f) + eps), r1 = rsqrtf(s1 * (1.f / 1024.f) + eps);
            *(PG8_LAS f32x4*)(ft + ((u.seq & 1) * 256 + t) * 4) = (f32x4){1.f / r0, r0 / r1, r1, 0.f}; }
    }
};
struct EpiBf16SsqG {
    static constexpr bool PERM = true, AFTER_DRAIN = false, HAS_KSEG = true;
    bf16_t* O; int ldc; float* ssq; const PG8_LAS float* ft; int t1, t2;
    __device__ __forceinline__ void kseg(f32x4 (&acc)[2][2][4][2], const Unit& u, int t, int wr, int fr) const {
        if (t == t1 || t == t2) { const int sel = (t == t1) ? 0 : 1; const PG8_LAS float* f = ft + ((u.seq & 1) * 256 + wr * 64 + fr) * 4 + sel;
#pragma unroll
            for (int ai = 0; ai < 2; ++ai)
#pragma unroll
                for (int m = 0; m < 4; ++m) { const float s = f[(ai * HALF + m * 16) * 4];
#pragma unroll
                    for (int bj = 0; bj < 2; ++bj)
#pragma unroll
                        for (int n = 0; n < 2; ++n) acc[ai][bj][m][n] = acc[ai][bj][m][n] * s; } }
    }
    __device__ __forceinline__ void operator()(const f32x4 (&acc)[2][2][4][2], const Unit& u, int wr, int wc, int fr, int fq) const {
        const int row0 = u.pm * BM + wr * 64 + fr, col0 = u.pn * BM + wc * 32 + 8 * fq; const PG8_LAS float* f = ft + ((u.seq & 1) * 256 + wr * 64 + fr) * 4 + 2;
#pragma unroll
        for (int ai = 0; ai < 2; ++ai)
#pragma unroll
            for (int m = 0; m < 4; ++m) { const int row = row0 + ai * HALF + m * 16; bf16_t* rowp = O + (size_t)row * ldc + col0; float q = 0.f; const float s = f[(ai * HALF + m * 16) * 4];
#pragma unroll
                for (int bj = 0; bj < 2; ++bj) { const f32x4 v0 = acc[ai][bj][m][0] * s, v1 = acc[ai][bj][m][1] * s;
                    q += ((v0[0] * v0[0] + v0[1] * v0[1]) + (v0[2] * v0[2] + v0[3] * v0[3])) + ((v1[0] * v1[0] + v1[1] * v1[1]) + (v1[2] * v1[2] + v1[3] * v1[3]));
                    u32x4 w; w.x = cvt_pk_bf16(v0[0], v0[1]); w.y = cvt_pk_bf16(v0[2], v0[3]); w.z = cvt_pk_bf16(v1[0], v1[1]); w.w = cvt_pk_bf16(v1[2], v1[3]);
                    *(u32x4*)(rowp + bj * HALF) = w; }
                q += __shfl_xor(q, 16); q += __shfl_xor(q, 32);
                if (fq == 0) ssq[(size_t)row * 32 + u.pn * 4 + wc] = q; }
    }
};
struct EpiF32Slab {
    static constexpr bool PERM = false, AFTER_DRAIN = false, HAS_KSEG = false;
    float* C; int ldc, Mrows;
    __device__ __forceinline__ void operator()(const f32x4 (&acc)[2][2][4][2], const Unit& u, int wr, int wc, int fr, int fq) const {
        const int row0 = u.pm * BM + wr * 64 + fr, col0 = u.pn * BM + wc * 32 + 4 * fq; float* base = C + (size_t)u.ks * Mrows * ldc;
#pragma unroll
        for (int ai = 0; ai < 2; ++ai)
#pragma unroll
            for (int m = 0; m < 4; ++m) { float* rowp = base + (size_t)(row0 + ai * HALF + m * 16) * ldc + col0;
#pragma unroll
                for (int bj = 0; bj < 2; ++bj)
#pragma unroll
                    for (int n = 0; n < 2; ++n) *(f32x4*)(rowp + bj * HALF + n * 16) = acc[ai][bj][m][n]; }
    }
};
template <class Epi, class Sched, bool ALIGN_EPI = false, bool SP2 = false>
__device__ __forceinline__ void gemm_phase(PG8_LAS unsigned char* lds, const Gemm g, const Sched& S, const Epi& E, int wave_id) {
    int tid_ = wave_id * 64 + lane_id(); asm volatile("" : "+v"(tid_));
    const int tid = tid_, wid = __builtin_amdgcn_readfirstlane(tid >> 6), lane = tid & 63, wr = wid >> 2, wc = wid & 3, fr = lane & 15, fq = lane >> 4;
    const int K = g.K, nt = K / BK;
    unsigned voffA[2], voffB[2];
#pragma unroll
    for (int i = 0; i < 2; ++i) { int R, C; stage_rc(tid * 16 + i * 8192, R, C); const int Rb = Epi::PERM ? ((R & ~31) + perm32(R & 31)) : R;
        voffA[i] = (unsigned)(R * g.lda + C) * 2u; voffB[i] = (unsigned)(Rb * g.ldb + C) * 2u; }
    const size_t kstep = (size_t)(BK * 2);
    const size_t hstepA = (size_t)HALF * g.lda * 2, hstepB = (size_t)HALF * g.ldb * 2;
    const size_t tstepA = 2 * hstepA, tstepB = 2 * hstepB;
    const unsigned ldsw = (unsigned)wid * 1024u;
    const int aoff = lds_byte(wr * 64 + fr, fq * 8), boff = lds_byte(wc * 32 + fr, fq * 8);
#define PG8_SA(b, h) (((b) * 2 + (h)) * HTB)
#define PG8_SB(b, h) ((4 + (b) * 2 + (h)) * HTB)
#define PG8_STAGE(bufoff, gbase, voff) do { _Pragma("unroll") for (int _i = 0; _i < 2; ++_i) \
        __builtin_amdgcn_global_load_lds((const unsigned*)((const char*)(gbase) + (voff)[_i]), (PG8_LAS unsigned*)(lds + (bufoff) + ldsw + _i * 8192), 16, 0, 0); } while (0)
#define PG8_LDA(dst, b, h) do { _Pragma("unroll") for (int m = 0; m < 4; ++m) _Pragma("unroll") for (int k = 0; k < 2; ++k) dst[m][k] = *(const PG8_LAS bf16x8*)(lds + PG8_SA(b, h) + aoff + m * 2048 + k * 1024); } while (0)
#define PG8_LDB(dst, b, h) do { _Pragma("unroll") for (int n = 0; n < 2; ++n) _Pragma("unroll") for (int k = 0; k < 2; ++k) dst[n][k] = *(const PG8_LAS bf16x8*)(lds + PG8_SB(b, h) + boff + n * 2048 + k * 1024); } while (0)
#define PG8_MMA(ai, bj, At, Bt) do { __builtin_amdgcn_s_setprio(1); _Pragma("unroll") for (int m = 0; m < 4; ++m) _Pragma("unroll") for (int n = 0; n < 2; ++n) _Pragma("unroll") for (int k = 0; k < 2; ++k) \
        acc[ai][bj][m][n] = __builtin_amdgcn_mfma_f32_16x16x32_bf16(Bt[n][k], At[m][k], acc[ai][bj][m][n], 0, 0, 0); __builtin_amdgcn_s_setprio(0); } while (0)
#define PG8_WAIT_V(n) asm volatile("s_waitcnt vmcnt(" #n ")" ::: "memory")
#define PG8_WAIT_L(n) asm volatile("s_waitcnt lgkmcnt(" #n ")" ::: "memory")
#define PG8_BAR __builtin_amdgcn_s_barrier()
#define PG8_SCHED __builtin_amdgcn_sched_barrier(0)
    Unit cur, nxt; int ui = 0;
    if (!S.next(0, cur)) return;
    f32x4 acc[2][2][4][2];
#pragma unroll
    for (int a = 0; a < 2; ++a)
#pragma unroll
        for (int b = 0; b < 2; ++b)
#pragma unroll
            for (int m = 0; m < 4; ++m)
#pragma unroll
                for (int n = 0; n < 2; ++n) acc[a][b][m][n] = (f32x4){0.f, 0.f, 0.f, 0.f};
    bf16x8 At[4][2], B0[2][2], B1[2][2];
    const size_t ksb = (size_t)g.kslice * 2;
    const char* cA = (const char*)g.A + (size_t)cur.pm * tstepA + cur.ks * ksb; const char* cB = (const char*)g.Bt + (size_t)cur.pn * tstepB + cur.ks * ksb;
    S.a_ready(cur);
    if constexpr (SP2) {
        PG8_STAGE(PG8_SB(0, 0), cB, voffB); PG8_STAGE(PG8_SB(0, 1), cB + hstepB, voffB); PG8_STAGE(PG8_SA(0, 0), cA, voffA); PG8_STAGE(PG8_SA(0, 1), cA + hstepA, voffA);
        if (wr == 1) PG8_BAR;
        PG8_WAIT_V(2); PG8_BAR;
        PG8_STAGE(PG8_SB(1, 0), cB + kstep, voffB); PG8_STAGE(PG8_SA(1, 0), cA + kstep, voffA); PG8_STAGE(PG8_SB(1, 1), cB + hstepB + kstep, voffB);
        PG8_WAIT_V(6); PG8_BAR;
    } else {
        PG8_STAGE(PG8_SB(0, 0), cB, voffB); PG8_STAGE(PG8_SA(0, 0), cA, voffA); PG8_STAGE(PG8_SB(0, 1), cB + hstepB, voffB); PG8_STAGE(PG8_SA(0, 1), cA + hstepA, voffA);
        if (wr == 1) PG8_BAR;
        PG8_WAIT_V(4); PG8_BAR;
        PG8_STAGE(PG8_SB(1, 0), cB + kstep, voffB); PG8_STAGE(PG8_SA(1, 0), cA + kstep, voffA); PG8_STAGE(PG8_SB(1, 1), cB + hstepB + kstep, voffB);
        PG8_WAIT_V(6); PG8_BAR;
    }
    for (;;) {
        const bool has_next = S.next(ui + 1, nxt);
        const char* nA = has_next ? (const char*)g.A + (size_t)nxt.pm * tstepA + nxt.ks * ksb : cA; const char* nB = has_next ? (const char*)g.Bt + (size_t)nxt.pn * tstepB + nxt.ks * ksb : cB;
        for (int t = 0; t < nt; t += 2) {
            const bool last = (t == nt - 2);
            if constexpr (Epi::HAS_KSEG) E.kseg(acc, cur, t, wr, fr);
            const char* a1 = cA + (size_t)(t + 1) * kstep;
            const char* a2 = last ? nA : cA + (size_t)(t + 2) * kstep; const char* b2 = last ? nB : cB + (size_t)(t + 2) * kstep;
            const char* a3 = a2 + kstep; const char* b3 = b2 + kstep;
            if (last && has_next) S.a_ready(nxt);
            if constexpr (SP2) {
            PG8_LDB(B0, 0, 0); PG8_LDB(B1, 0, 1); PG8_SCHED; PG8_LDA(At, 0, 0); PG8_STAGE(PG8_SA(1, 1), a1 + hstepA, voffA);
            PG8_WAIT_V(8); PG8_WAIT_L(0); PG8_BAR; PG8_MMA(0, 0, At, B0); PG8_MMA(0, 1, At, B1); PG8_BAR; PG8_SCHED;
            PG8_LDA(At, 0, 1); PG8_STAGE(PG8_SB(0, 0), b2, voffB); PG8_STAGE(PG8_SB(0, 1), b2 + hstepB, voffB); PG8_STAGE(PG8_SA(0, 0), a2, voffA);
            PG8_WAIT_V(8); PG8_WAIT_L(0); PG8_BAR; PG8_MMA(1, 0, At, B0); PG8_MMA(1, 1, At, B1); PG8_BAR; PG8_SCHED;
            PG8_LDB(B0, 1, 0); PG8_LDB(B1, 1, 1); PG8_SCHED; PG8_LDA(At, 1, 0); PG8_STAGE(PG8_SA(0, 1), a2 + hstepA, voffA);
            PG8_WAIT_V(8); PG8_WAIT_L(0); PG8_BAR; PG8_MMA(0, 0, At, B0); PG8_MMA(0, 1, At, B1); PG8_BAR; PG8_SCHED;
            PG8_LDA(At, 1, 1); PG8_STAGE(PG8_SB(1, 0), b3, voffB); PG8_STAGE(PG8_SB(1, 1), b3 + hstepB, voffB); PG8_STAGE(PG8_SA(1, 0), a3, voffA);
            PG8_WAIT_V(8); PG8_WAIT_L(0); PG8_BAR; PG8_MMA(1, 0, At, B0); PG8_MMA(1, 1, At, B1); PG8_BAR; PG8_SCHED;
            } else {
            PG8_LDB(B0, 0, 0); PG8_SCHED; PG8_LDA(At, 0, 0); PG8_STAGE(PG8_SA(1, 1), a1 + hstepA, voffA);
            PG8_WAIT_L(8); PG8_BAR; PG8_WAIT_L(0); PG8_MMA(0, 0, At, B0); PG8_BAR; PG8_SCHED;
            PG8_LDB(B1, 0, 1); PG8_STAGE(PG8_SB(0, 0), b2, voffB);
            PG8_BAR; PG8_WAIT_L(0); PG8_MMA(0, 1, At, B1); PG8_BAR;
            PG8_LDA(At, 0, 1); PG8_STAGE(PG8_SA(0, 0), a2, voffA);
            PG8_BAR; PG8_WAIT_L(0); PG8_MMA(1, 0, At, B0); PG8_BAR; PG8_SCHED;
            PG8_STAGE(PG8_SB(0, 1), b2 + hstepB, voffB);
            PG8_WAIT_V(6); PG8_BAR; PG8_MMA(1, 1, At, B1); PG8_BAR;
            PG8_LDB(B0, 1, 0); PG8_SCHED; PG8_LDA(At, 1, 0); PG8_STAGE(PG8_SA(0, 1), a2 + hstepA, voffA);
            PG8_WAIT_L(8); PG8_BAR; PG8_WAIT_L(0); PG8_MMA(0, 0, At, B0); PG8_BAR; PG8_SCHED;
            PG8_LDB(B1, 1, 1); PG8_STAGE(PG8_SB(1, 0), b3, voffB);
            PG8_BAR; PG8_WAIT_L(0); PG8_MMA(0, 1, At, B1); PG8_BAR;
            PG8_LDA(At, 1, 1); PG8_STAGE(PG8_SA(1, 0), a3, voffA);
            PG8_BAR; PG8_WAIT_L(0); PG8_MMA(1, 0, At, B0); PG8_BAR; PG8_SCHED;
            PG8_STAGE(PG8_SB(1, 1), b3 + hstepB, voffB);
            PG8_WAIT_V(6); PG8_BAR; PG8_MMA(1, 1, At, B1); PG8_BAR;
            }
        }
        if constexpr (ALIGN_EPI) { if (wr == 0) PG8_BAR; }
        if constexpr (!Epi::AFTER_DRAIN) { E(acc, cur, wr, wc, fr, fq); S.done(cur); }
        if (!has_next) break;
#pragma unroll
        for (int a = 0; a < 2; ++a)
#pragma unroll
            for (int b = 0; b < 2; ++b)
#pragma unroll
                for (int m = 0; m < 4; ++m)
#pragma unroll
                    for (int n = 0; n < 2; ++n) acc[a][b][m][n] = (f32x4){0.f, 0.f, 0.f, 0.f};
        cur = nxt; cA = nA; cB = nB; ++ui;
        if constexpr (ALIGN_EPI) { if (wr == 1) PG8_BAR; }
    }
    PG8_WAIT_V(0);
    if constexpr (!ALIGN_EPI) { if (wr == 0) PG8_BAR; }
    PG8_BAR;
#undef PG8_SA
#undef PG8_SB
#undef PG8_STAGE
#undef PG8_LDA
#undef PG8_LDB
#undef PG8_MMA
#undef PG8_WAIT_V
#undef PG8_WAIT_L
#undef PG8_BAR
#undef PG8_SCHED
}
}

constexpr int NWAVES = 8, NTHR = 512;
constexpr int DM = 2048, SEQ = 2048, NB_P = 8, NB_S = 32, SEQ_S = 32, DEPTH = 4;
constexpr int MP = NB_P * SEQ, MS = NB_S * SEQ_S, M = MP + MS;
constexpr int D_POOL = 1024, POOL_HIST = 15, D_SSD = 2048, HD = 64, NH = 32, HPG = 16, DS = 128, CONV_DIM = 2560, D_MIX = 3072;
constexpr int D_IN = 5664, N_PROJ = 5632, N_INP = 5888, D_FF = 5632, D_UP = 11264;
constexpr int XBC0 = 3072;
constexpr float EPS = 1e-6f;

constexpr size_t O_YP = 0, O_YS = O_YP + (size_t)MP * DM, O_POOLP = O_YS + (size_t)MS * DM, O_POOLS = O_POOLP + (size_t)DEPTH * NB_P * 15 * 1024,
    O_SCP = O_POOLS + (size_t)DEPTH * NB_S * 15 * 1024, O_SCS = O_SCP + (size_t)DEPTH * NB_P * 3 * 2560, O_SSDP = O_SCS + (size_t)DEPTH * NB_S * 3 * 2560,
    O_SSDS = O_SSDP + (size_t)DEPTH * NB_P * 32 * 64 * 128, O_FCP = O_SSDS + (size_t)DEPTH * NB_S * 32 * 64 * 128, O_FCS = O_FCP + (size_t)DEPTH * NB_P * 2 * 11264,
    O_END = O_FCS + (size_t)DEPTH * NB_S * 2 * 11264;

constexpr size_t al256(size_t x) { return (x + 255) & ~(size_t)255; }
constexpr size_t WS_CTL = 0, CTL_BYTES = 1u << 20;
constexpr size_t WS_BTIN = CTL_BYTES;
constexpr int DMP = DM + 64;
constexpr size_t WS_BTOUT = WS_BTIN + (size_t)DEPTH * N_INP * DMP * 2;
constexpr size_t WS_BTUP = WS_BTOUT + (size_t)DEPTH * DM * D_MIX * 2;
constexpr size_t WS_BTDN = WS_BTUP + (size_t)DEPTH * D_UP * DMP * 2;
constexpr size_t WS_WOP = WS_BTDN + (size_t)DEPTH * DM * D_FF * 2;
constexpr size_t WS_WPB = WS_WOP + (size_t)DEPTH * DM * D_POOL * 2;
constexpr size_t WS_X = WS_WPB + (size_t)DEPTH * 4 * 256 * 256 * 2;
constexpr size_t WS_ACTX = WS_X;
constexpr size_t WS_XB = WS_X + (size_t)M * DM * 4;
constexpr size_t WS_R = WS_XB + (size_t)M * DMP * 2;
constexpr size_t WS_DT = WS_R + al256((size_t)M * 4);
constexpr size_t WS_SSQP = WS_DT + (size_t)M * 32 * 4;
constexpr size_t WS_SSQH = WS_SSQP + (size_t)M * 32 * 4;
constexpr size_t WS_ACT = WS_SSQH + (size_t)M * 32 * 4;
constexpr size_t WS_RA = WS_ACT + (size_t)M * D_FF * 2;
constexpr size_t WS_PROJ = WS_RA;
constexpr size_t WS_MIXA = WS_PROJ + (size_t)M * N_PROJ * 2;
constexpr size_t WS_MIX = WS_MIXA + (size_t)M * D_MIX * 2;
constexpr size_t WS_UP = WS_RA;
constexpr int KS_OUT = 6, KS_DN = 4;
constexpr size_t WS_SLAB = WS_MIX + (size_t)M * DM * 4;
constexpr size_t WS_SIDE = WS_SLAB + (size_t)8 * MS * DM * 4;
constexpr size_t WS_END = WS_SIDE + (size_t)(MP / 64) * 4 * D_UP * 2;
static_assert((size_t)M * D_UP * 2 <= WS_END - WS_RA, "UP fits region A");

constexpr int RING_BYTES = 131072, LDSCTL_OFF = RING_BYTES, LDS_BYTES = 147456;

#define LAS __attribute__((address_space(3)))
typedef unsigned short bf16;
typedef float f32x4 __attribute__((ext_vector_type(4)));
#define RLX_AGENT __ATOMIC_RELAXED, __HIP_MEMORY_SCOPE_AGENT
__device__ __forceinline__ unsigned f2bf(float f) { unsigned u = __builtin_bit_cast(unsigned, f); return (u + 0x7fffu + ((u >> 16) & 1u)) >> 16; }
__device__ __forceinline__ unsigned pk2(float lo, float hi) { unsigned r; asm("v_cvt_pk_bf16_f32 %0, %1, %2" : "=v"(r) : "v"(lo), "v"(hi)); return r; }
__device__ __forceinline__ float bflo(unsigned u) { return __uint_as_float(u << 16); }
__device__ __forceinline__ float bfhi(unsigned u) { return __uint_as_float(u & 0xffff0000u); }
__device__ __forceinline__ float bf2f(bf16 b) { return __uint_as_float(((unsigned)b) << 16); }
struct F8 { float v[8]; };
__device__ __forceinline__ F8 ld_bf8(const bf16* p) { const uint4 u = *(const uint4*)p; F8 r; r.v[0] = bflo(u.x); r.v[1] = bfhi(u.x); r.v[2] = bflo(u.y); r.v[3] = bfhi(u.y); r.v[4] = bflo(u.z); r.v[5] = bfhi(u.z); r.v[6] = bflo(u.w); r.v[7] = bfhi(u.w); return r; }
__device__ __forceinline__ F8 unpack8(const uint4 u) { F8 r; r.v[0] = bflo(u.x); r.v[1] = bfhi(u.x); r.v[2] = bflo(u.y); r.v[3] = bfhi(u.y); r.v[4] = bflo(u.z); r.v[5] = bfhi(u.z); r.v[6] = bflo(u.w); r.v[7] = bfhi(u.w); return r; }
__device__ __forceinline__ F8 ld_f8(const float* p) { const float4 a = *(const float4*)p, b = *(const float4*)(p + 4); F8 r; r.v[0] = a.x; r.v[1] = a.y; r.v[2] = a.z; r.v[3] = a.w; r.v[4] = b.x; r.v[5] = b.y; r.v[6] = b.z; r.v[7] = b.w; return r; }
__device__ __forceinline__ F8 zero8() { F8 r;
#pragma unroll
    for (int i = 0; i < 8; ++i) r.v[i] = 0.f; return r; }
__device__ __forceinline__ void st_bf8(bf16* p, const F8& r) { uint4 u; u.x = pk2(r.v[0], r.v[1]); u.y = pk2(r.v[2], r.v[3]); u.z = pk2(r.v[4], r.v[5]); u.w = pk2(r.v[6], r.v[7]); *(uint4*)p = u; }
__device__ __forceinline__ void st_f8(float* p, const F8& r) { *(float4*)p = make_float4(r.v[0], r.v[1], r.v[2], r.v[3]); *(float4*)(p + 4) = make_float4(r.v[4], r.v[5], r.v[6], r.v[7]); }
__device__ __forceinline__ float silu_f(float x) { return x * __builtin_amdgcn_rcpf(1.f + __expf(-x)); }
__device__ __forceinline__ float wave_sum(float v) {
#pragma unroll
    for (int o = 1; o < 64; o <<= 1) v += __shfl_xor(v, o);
    return v;
}

#define XB_TMO      128
#define XB_XCNT(j)  (256  + 64 * (j))
#define XB_XSUB(j)  (1280 + 64 * (j))
#define XB_XGEN(j)  (2304 + 64 * (j))
#define XB_TOP      3328
#define XB_TOPGEN   3392
#define XCD_BAR_WORDS 3456
#define XB_SPIN_CAP (1u << 18)
__device__ __forceinline__ unsigned xb_ld(unsigned* p)              { return __hip_atomic_load(p, __ATOMIC_RELAXED, __HIP_MEMORY_SCOPE_AGENT); }
__device__ __forceinline__ unsigned xb_add(unsigned* p, unsigned v) { return __hip_atomic_fetch_add(p, v, __ATOMIC_RELAXED, __HIP_MEMORY_SCOPE_AGENT); }
__device__ __forceinline__ unsigned xb_xcc_id() { return (unsigned)__builtin_amdgcn_s_getreg((3 << 11) | 20) & 0xFu; }
#define XB_SPIN(cond, bar) do { unsigned _sp = 0; while (cond) { __builtin_amdgcn_s_sleep(1); \
    if ((++_sp & 255u) == 0u) { if (xb_ld(&(bar)[XB_TMO])) break; if (_sp > XB_SPIN_CAP) { atomicAdd(&(bar)[XB_TMO], 1u); break; } } } } while (0)
struct XcdBarrier { unsigned* bar; unsigned x; volatile LAS unsigned* st; };
__device__ __forceinline__ XcdBarrier xcd_barrier_post(unsigned* bar, volatile LAS unsigned* st, bool lead) {
    XcdBarrier b; b.bar = bar; b.x = xb_xcc_id(); b.st = st;
    if (lead) (void)xb_add(&bar[XB_XCNT(b.x)], 1u);
    return b;
}
__device__ __forceinline__ void xcd_barrier_complete(unsigned* bar, unsigned x, unsigned& nloc, unsigned& nx) {
    const unsigned G = gridDim.x * gridDim.y * gridDim.z;
    unsigned sum, cnt, mine, sp = 0u;
    for (;;) {
        sum = 0u; cnt = 0u; mine = 0u;
#pragma unroll
        for (unsigned j = 0; j < 16; ++j) { const unsigned c = xb_ld(&bar[XB_XCNT(j)]); sum += c; cnt += (c > 0u) ? 1u : 0u; mine = (j == x) ? c : mine; }
        if (sum == G) break;
        __builtin_amdgcn_s_sleep(1);
        if ((++sp & 255u) == 0u) { if (xb_ld(&bar[XB_TMO])) break; if (sp > XB_SPIN_CAP) { atomicAdd(&bar[XB_TMO], 1u); break; } }
    }
    nloc = mine > 0u ? mine : 1u; nx = cnt > 0u ? cnt : 1u;
}
__device__ __forceinline__ void xcd_barrier(const XcdBarrier& b, bool lead) {
    asm volatile("s_waitcnt vmcnt(0)" ::: "memory");
    __syncthreads();
    if (lead) {
        unsigned* bar = b.bar;
        __builtin_amdgcn_s_waitcnt(0);
        unsigned nloc = b.st[0], nx = b.st[1];
        if (nloc == 0u) { xcd_barrier_complete(bar, b.x, nloc, nx); b.st[0] = nloc; b.st[1] = nx; }
        const unsigned old = xb_add(&bar[XB_XSUB(b.x)], 1u);
        const unsigned gen = old / nloc;
        if (old + 1u == (gen + 1u) * nloc) {
            __builtin_amdgcn_fence(__ATOMIC_RELEASE, "agent");
            asm volatile("s_waitcnt vmcnt(0)" ::: "memory");
            const unsigned og = xb_add(&bar[XB_TOP], 1u);
            const unsigned tg = og / nx;
            if (og + 1u == (tg + 1u) * nx) xb_add(&bar[XB_TOPGEN], 1u);
            else XB_SPIN(xb_ld(&bar[XB_TOPGEN]) == tg, bar);
            __builtin_amdgcn_fence(__ATOMIC_ACQUIRE, "agent");
            xb_add(&bar[XB_XGEN(b.x)], 1u);
            asm volatile("s_waitcnt vmcnt(0)" ::: "memory");
        } else {
            XB_SPIN(xb_ld(&bar[XB_XGEN(b.x)]) == gen, bar);
            __builtin_amdgcn_fence(__ATOMIC_ACQUIRE, "agent");
            asm volatile("s_waitcnt vmcnt(0)" ::: "memory");
        }
    }
    __syncthreads();
}

struct Args { const float* in[24]; float* out; unsigned char* ws; int ph_lo, ph_hi; };

struct Ctx {
    LAS unsigned char* lds; int tid, lane, wave, G, gw, NGW, wave0;
    const float* const* in; float* out; unsigned char* ws;
    __device__ __forceinline__ void refresh() {
        int t = wave0 * 64 + lane_id(); asm volatile("" : "+v"(t)); tid = t; lane = t & 63; wave = __builtin_amdgcn_readfirstlane(t >> 6); gw = blockIdx.x * NWAVES + wave; NGW = G * NWAVES; }
};

constexpr int I_IN = (DM / 64) * (D_IN / 32), I_OUT = (D_MIX / 64) * (DM / 32), I_UP = (DM / 64) * (DM * 0 + D_UP / 32), I_DN = (D_FF / 64) * (DM / 32), I_L = I_IN + I_OUT + I_UP + I_DN;
struct ConvJob { const float* W; const float* gain; bf16* dst; int N, ldd, kb, nb; };
__device__ __forceinline__ ConvJob conv_job(const Ctx& C, int l, int r) {
    ConvJob j;
    if (r < I_IN) { const int nbk = D_IN / 32; j.W = C.in[7] + (size_t)l * DM * D_IN; j.gain = C.in[6] + l * DM; j.dst = (bf16*)(C.ws + WS_BTIN) + (size_t)l * N_INP * DMP; j.N = D_IN; j.ldd = DMP; j.kb = r / nbk; j.nb = r % nbk; return j; }
    r -= I_IN;
    if (r < I_OUT) { const int nbk = DM / 32; j.kb = r / nbk; j.nb = r % nbk; j.W = C.in[16] + (size_t)l * D_MIX * DM; j.N = DM;
        if (j.kb < 16) { j.gain = C.in[9] + l * D_POOL; j.dst = (bf16*)(C.ws + WS_WOP) + (size_t)l * DM * D_POOL; j.ldd = D_POOL; }
        else { j.gain = C.in[15] + l * D_SSD - D_POOL; j.dst = (bf16*)(C.ws + WS_BTOUT) + (size_t)l * DM * D_MIX; j.ldd = D_MIX; }
        return j; }
    r -= I_OUT;
    if (r < I_UP) { const int nbk = D_UP / 32, nb = r % nbk, n0 = 32 * nb, hv = n0 / D_FF, cc = n0 % D_FF, np = 256 * (cc / 128) + 128 * hv + (cc % 128);
        j.W = C.in[19] + (size_t)l * DM * D_UP; j.gain = C.in[18] + l * DM; j.dst = (bf16*)(C.ws + WS_BTUP) + (size_t)l * D_UP * DMP + (long)(np - n0) * DMP; j.N = D_UP; j.ldd = DMP; j.kb = r / nbk; j.nb = nb; return j; }
    r -= I_UP;
    { const int nbk = DM / 32; j.W = C.in[22] + (size_t)l * D_FF * DM; j.gain = nullptr; j.dst = (bf16*)(C.ws + WS_BTDN) + (size_t)l * DM * D_FF; j.N = DM; j.ldd = D_FF; j.kb = r / nbk; j.nb = r % nbk; }
    return j;
}
__device__ __forceinline__ void conv_issue(const ConvJob& j, int lane, float (&wv)[32], float& gl) {
    const int k0 = 64 * j.kb, n0 = 32 * j.nb;
    gl = j.gain ? j.gain[k0 + lane] : 1.f;
#pragma unroll
    for (int i = 0; i < 32; ++i) { const int kk = 2 * i + (lane >> 5); wv[i] = j.W[(size_t)(k0 + kk) * j.N + n0 + (lane & 31)]; }
}
__device__ __forceinline__ void conv_finish(const ConvJob& j, int lane, const float (&wv)[32], float gl, LAS float* scr) {
    const int k0 = 64 * j.kb, n0 = 32 * j.nb; const int gli = __builtin_bit_cast(int, gl);
#pragma unroll
    for (int i = 0; i < 32; ++i) { const int kk = 2 * i + (lane >> 5);
        const float g0 = __builtin_bit_cast(float, __builtin_amdgcn_readlane(gli, 2 * i)), g1 = __builtin_bit_cast(float, __builtin_amdgcn_readlane(gli, 2 * i + 1));
        scr[kk * 33 + (lane & 31)] = wv[i] * (lane < 32 ? g0 : g1); }
    asm volatile("s_waitcnt lgkmcnt(0)" ::: "memory");
    const int c = lane & 7;
#pragma unroll
    for (int jj = 0; jj < 4; ++jj) { const int n = (lane >> 3) + 8 * jj; const LAS float* s = scr + (8 * c) * 33 + n;
        uint4 o; o.x = pk2(s[0 * 33], s[1 * 33]); o.y = pk2(s[2 * 33], s[3 * 33]); o.z = pk2(s[4 * 33], s[5 * 33]); o.w = pk2(s[6 * 33], s[7 * 33]);
        *(uint4*)(j.dst + (size_t)(n0 + n) * j.ldd + k0 + 8 * c) = o; }
    asm volatile("s_waitcnt lgkmcnt(0)" ::: "memory");
}
__device__ __forceinline__ void phase_convert(Ctx C) {
    C.refresh();
    LAS float* scr = (LAS float*)(C.lds + C.wave * 16384);
    for (int it = C.gw; it < I_L; it += C.NGW) { const ConvJob j = conv_job(C, 0, it); float wv[32], gl; conv_issue(j, C.lane, wv, gl); conv_finish(j, C.lane, wv, gl, scr); }
    { const int gt = C.gw * 64 + C.lane, NGT = C.NGW * 64;
      const float* wp = C.in[8]; bf16* wpb = (bf16*)(C.ws + WS_WPB);
      for (int i = gt; i < DEPTH * 4 * 256 * 256 / 8; i += NGT) { const F8 v = ld_f8(wp + (size_t)i * 8); st_bf8(wpb + (size_t)i * 8, v); } }
    for (int row = C.gw; row < M; row += C.NGW) {
        const float* src = row < MP ? C.in[0] + (size_t)row * DM : C.in[1] + (size_t)(row - MP) * DM;
        bf16* XB = (bf16*)(C.ws + WS_XB) + (size_t)row * DMP; float q = 0.f;
#pragma unroll
        for (int j = 0; j < 8; ++j) { const int idx = (C.lane + 64 * j) * 4; const float4 v = *(const float4*)(src + idx); q += (v.x * v.x + v.y * v.y) + (v.z * v.z + v.w * v.w);
            *(uint2*)(XB + idx) = make_uint2(pk2(v.x, v.y), pk2(v.z, v.w)); }
        q = wave_sum(q);
        if (C.lane == 0) ((float*)(C.ws + WS_R))[row] = rsqrtf(q * (1.f / DM) + EPS);
    }
}

__device__ __forceinline__ void phase_dt(Ctx C, int l) {
    C.refresh();
    typedef short bf16x8_t __attribute__((ext_vector_type(8))); typedef unsigned u32x4_t __attribute__((ext_vector_type(4)));
    const bf16* XB = (const bf16*)(C.ws + WS_XB); const bf16* BD = (const bf16*)(C.ws + WS_BTIN) + ((size_t)l * N_INP + N_PROJ) * DMP; const float* R = (const float*)(C.ws + WS_R); float* DT = (float*)(C.ws + WS_DT);
    const int r16 = C.lane & 15, q = C.lane >> 4;
    for (int i = C.tid; i < 32 * (DM / 8); i += NTHR) { const int n = i / (DM / 8), ch = i % (DM / 8);
        const uint4 v = *(const uint4*)(BD + (size_t)n * DMP + ch * 8); *(LAS u32x4_t*)(C.lds + n * 4096 + ((ch ^ (n & 15)) << 4)) = (u32x4_t){v.x, v.y, v.z, v.w}; }
    __syncthreads();
    for (int task = C.gw; task < M / 16; task += C.NGW) {
        const int row0 = task * 16;
        const bf16* ap = XB + (size_t)(row0 + r16) * DMP + 8 * q;
        f32x4 acc0 = (f32x4){0.f, 0.f, 0.f, 0.f}, acc1 = acc0;
#pragma unroll 16
        for (int ks = 0; ks < DM / 32; ++ks) { const bf16x8_t a = *(const bf16x8_t*)(ap + 32 * ks); const int ch = 4 * ks + q;
            acc0 = __builtin_amdgcn_mfma_f32_16x16x32_bf16(a, *(const LAS bf16x8_t*)(C.lds + r16 * 4096 + ((ch ^ r16) << 4)), acc0, 0, 0, 0);
            acc1 = __builtin_amdgcn_mfma_f32_16x16x32_bf16(a, *(const LAS bf16x8_t*)(C.lds + (16 + r16) * 4096 + ((ch ^ r16) << 4)), acc1, 0, 0, 0); }
#pragma unroll
        for (int r = 0; r < 4; ++r) { const int row = row0 + 4 * q + r; const float s = R[row]; DT[(size_t)row * 32 + r16] = acc0[r] * s; DT[(size_t)row * 32 + 16 + r16] = acc1[r] * s; }
    }
    __syncthreads();
}

__device__ __forceinline__ void phase_resid(Ctx C, const float* gpost, bool final_out, int nslab, bool gfold) {
    C.refresh();
    const bf16* MIXB = (const bf16*)(C.ws + WS_MIX); const float* SSQ = (const float*)(C.ws + WS_SSQP); const float* SLAB = (const float*)(C.ws + WS_SLAB);
    for (int row = C.gw; row < M; row += C.NGW) {
        F8 mv[4]; float p; uint4 xq[4];
        bf16* XB = (bf16*)(C.ws + WS_XB) + (size_t)row * DMP;
#pragma unroll
        for (int j = 0; j < 4; ++j) xq[j] = *(const uint4*)(XB + (C.lane + 64 * j) * 8);
        if (row < MP) {
            p = C.lane < 32 ? SSQ[(size_t)row * 32 + C.lane] : 0.f;
#pragma unroll
            for (int j = 0; j < 4; ++j) mv[j] = ld_bf8(MIXB + (size_t)row * DM + (C.lane + 64 * j) * 8);
        } else {
            p = 0.f; float r0 = 1.f, r1 = 1.f;
            if (gfold) { float hs = C.lane < 32 ? ((const float*)(C.ws + WS_SSQH))[(size_t)row * 32 + C.lane] : 0.f;
#pragma unroll
                for (int o = 1; o < 16; o <<= 1) hs += __shfl_xor(hs, o);
                r0 = rsqrtf(__shfl(hs, 0) * (1.f / 1024.f) + EPS); r1 = rsqrtf(__shfl(hs, 16) * (1.f / 1024.f) + EPS); }
#pragma unroll
            for (int j = 0; j < 4; ++j) { F8 a = zero8();
                for (int s = 0; s < nslab; ++s) { const F8 t = ld_f8(SLAB + ((size_t)s * MS + (row - MP)) * DM + (C.lane + 64 * j) * 8); const float sc = gfold ? (s < 2 ? 1.f : (s < 4 ? r0 : r1)) : 1.f;
#pragma unroll
                    for (int k = 0; k < 8; ++k) a.v[k] += t.v[k] * sc; }
                mv[j] = a;
#pragma unroll
                for (int k = 0; k < 8; ++k) p += a.v[k] * a.v[k]; }
        }
        p = wave_sum(p);
        const float rs = rsqrtf(p * (1.f / DM) + EPS);
        float* Y = C.out + O_YP + (size_t)row * DM; float q = 0.f;
#pragma unroll
        for (int j = 0; j < 4; ++j) { const int idx = (C.lane + 64 * j) * 8; const F8 g8 = ld_f8(gpost + idx); F8 v = unpack8(xq[j]);
#pragma unroll
            for (int k = 0; k < 8; ++k) { v.v[k] += mv[j].v[k] * rs * g8.v[k]; q += v.v[k] * v.v[k]; }
            if (final_out) st_f8(Y + idx, v);
            st_bf8(XB + idx, v); }
        q = wave_sum(q);
        if (C.lane == 0) ((float*)(C.ws + WS_R))[row] = rsqrtf(q * (1.f / DM) + EPS);
    }
}

__device__ __forceinline__ void phase_gnorm(Ctx C) {
    C.refresh();
    const float* SSQH = (const float*)(C.ws + WS_SSQH); bf16* MIXA = (bf16*)(C.ws + WS_MIXA);
    for (int rowb = C.gw * 4; rowb < M; rowb += C.NGW * 4) {
        uint4 qv[4][4]; float pr[4];
#pragma unroll
        for (int rr = 0; rr < 4; ++rr) { const int row = rowb + rr; pr[rr] = C.lane < 32 ? SSQH[(size_t)row * 32 + C.lane] : 0.f;
#pragma unroll
            for (int j = 0; j < 4; ++j) qv[rr][j] = *(const uint4*)(MIXA + (size_t)row * D_MIX + D_POOL + (C.lane + 64 * j) * 8); }
#pragma unroll
        for (int rr = 0; rr < 4; ++rr) { const int row = rowb + rr; float p = pr[rr];
#pragma unroll
            for (int o = 1; o < 16; o <<= 1) p += __shfl_xor(p, o);
            const float s0 = __shfl(p, 0), s1 = __shfl(p, 16);
            const float r0 = rsqrtf(s0 * (1.f / 1024.f) + EPS), r1 = rsqrtf(s1 * (1.f / 1024.f) + EPS);
            bf16* y = MIXA + (size_t)row * D_MIX + D_POOL;
#pragma unroll
            for (int j = 0; j < 4; ++j) { const int c = (C.lane + 64 * j) * 8; const float r = c < 1024 ? r0 : r1; F8 v = unpack8(qv[rr][j]);
#pragma unroll
                for (int i = 0; i < 8; ++i) v.v[i] *= r;
                st_bf8(y + c, v); } }
    }
}

__device__ __forceinline__ void phase_act(Ctx C, int l) {
    C.refresh();
    const bf16* UP = (const bf16*)(C.ws + WS_UP); bf16* ACT = (bf16*)(C.ws + WS_ACT);
    const float* cw = C.in[20] + (size_t)l * 3 * D_UP; const float* cb = C.in[21] + (size_t)l * D_UP; const float* hist = C.in[5] + (size_t)l * NB_S * 2 * D_UP;
    constexpr int NCG = D_FF / 8, NPIECE = MS / 8;
    const int gt = C.gw * 64 + C.lane, NGT = C.NGW * 64;
    for (int it = gt; it < NPIECE * NCG; it += NGT) {
        const int piece = it / NCG, c = (it % NCG) * 8, b = piece >> 2, t0 = (piece & 3) * 8, row0 = MP + b * SEQ_S + t0;
        uint4 qg[10], qv[10];
#pragma unroll
        for (int r = 0; r < 10; ++r) { const int rr = (t0 == 0 && r < 2) ? 2 : r; qg[r] = *(const uint4*)(UP + (size_t)(row0 + rr - 2) * D_UP + c); qv[r] = *(const uint4*)(UP + (size_t)(row0 + rr - 2) * D_UP + D_FF + c); }
        const float* h = hist + (size_t)b * 2 * D_UP;
        const F8 h2g = ld_f8(h + c), h2v = ld_f8(h + D_FF + c), h1g = ld_f8(h + D_UP + c), h1v = ld_f8(h + D_UP + D_FF + c);
        const F8 w0g = ld_f8(cw + c), w1g = ld_f8(cw + D_UP + c), w2g = ld_f8(cw + 2 * D_UP + c), bg = ld_f8(cb + c);
        const F8 w0v = ld_f8(cw + D_FF + c), w1v = ld_f8(cw + D_UP + D_FF + c), w2v = ld_f8(cw + 2 * D_UP + D_FF + c), bv = ld_f8(cb + D_FF + c);
        F8 p2g = unpack8(qg[0]), p2v = unpack8(qv[0]), p1g = unpack8(qg[1]), p1v = unpack8(qv[1]);
        if (t0 == 0) { p2g = h2g; p2v = h2v; p1g = h1g; p1v = h1v; }
#pragma unroll
        for (int r = 0; r < 8; ++r) { const F8 cg = unpack8(qg[r + 2]), cv = unpack8(qv[r + 2]); F8 o;
#pragma unroll
            for (int i = 0; i < 8; ++i) { const float g = bg.v[i] + w0g.v[i] * p2g.v[i] + w1g.v[i] * p1g.v[i] + w2g.v[i] * cg.v[i]; const float v = bv.v[i] + w0v.v[i] * p2v.v[i] + w1v.v[i] * p1v.v[i] + w2v.v[i] * cv.v[i]; o.v[i] = silu_f(g) * v; }
            st_bf8(ACT + (size_t)(row0 + r) * D_FF + c, o);
            p2g = p1g; p1g = cg; p2v = p1v; p1v = cv; }
        if (t0 == SEQ_S - 8) {
            float* o = C.out + O_FCS + ((size_t)(l * NB_S + b) * 2) * D_UP;
            st_f8(o + c, p2g); st_f8(o + D_FF + c, p2v); st_f8(o + D_UP + c, p1g); st_f8(o + D_UP + D_FF + c, p1v);
        }
    }
}

__device__ __forceinline__ void phase_actfix(Ctx C, int l) {
    C.refresh();
    const bf16* SIDE = (const bf16*)(C.ws + WS_SIDE); bf16* ACT = (bf16*)(C.ws + WS_ACT);
    const float* cw = C.in[20] + (size_t)l * 3 * D_UP; const float* cb = C.in[21] + (size_t)l * D_UP;
    constexpr int NCG = D_FF / 8, NBLK = MP / 64;
    const int gt = C.gw * 64 + C.lane, NGT = C.NGW * 64;
    for (int it = gt; it < NBLK * NCG; it += NGT) {
        const int kb = it / NCG, c = (it % NCG) * 8; const bool start = (kb % (SEQ / 64)) == 0;
        const bf16* sp = SIDE + (size_t)(start ? kb : kb - 1) * 4 * D_UP + c; const bf16* sc = SIDE + (size_t)kb * 4 * D_UP + c;
        uint4 q[8];
        q[0] = *(const uint4*)(sp + 2 * D_UP); q[1] = *(const uint4*)(sp + 2 * D_UP + D_FF); q[2] = *(const uint4*)(sp + 3 * D_UP); q[3] = *(const uint4*)(sp + 3 * D_UP + D_FF);
        q[4] = *(const uint4*)(sc); q[5] = *(const uint4*)(sc + D_FF); q[6] = *(const uint4*)(sc + D_UP); q[7] = *(const uint4*)(sc + D_UP + D_FF);
        F8 p2g = unpack8(q[0]), p2v = unpack8(q[1]), p1g = unpack8(q[2]), p1v = unpack8(q[3]); const F8 r0g = unpack8(q[4]), r0v = unpack8(q[5]), r1g = unpack8(q[6]), r1v = unpack8(q[7]);
        if (start) { p2g = zero8(); p2v = zero8(); p1g = zero8(); p1v = zero8(); }
        const F8 w0g = ld_f8(cw + c), w1g = ld_f8(cw + D_UP + c), w2g = ld_f8(cw + 2 * D_UP + c), bg = ld_f8(cb + c);
        const F8 w0v = ld_f8(cw + D_FF + c), w1v = ld_f8(cw + D_UP + D_FF + c), w2v = ld_f8(cw + 2 * D_UP + D_FF + c), bv = ld_f8(cb + D_FF + c);
        F8 o0, o1;
#pragma unroll
        for (int i = 0; i < 8; ++i) { const float g0 = bg.v[i] + w0g.v[i] * p2g.v[i] + w1g.v[i] * p1g.v[i] + w2g.v[i] * r0g.v[i], v0 = bv.v[i] + w0v.v[i] * p2v.v[i] + w1v.v[i] * p1v.v[i] + w2v.v[i] * r0v.v[i];
            const float g1 = bg.v[i] + w0g.v[i] * p1g.v[i] + w1g.v[i] * r0g.v[i] + w2g.v[i] * r1g.v[i], v1 = bv.v[i] + w0v.v[i] * p1v.v[i] + w1v.v[i] * r0v.v[i] + w2v.v[i] * r1v.v[i];
            o0.v[i] = silu_f(g0) * v0; o1.v[i] = silu_f(g1) * v1; }
        st_bf8(ACT + (size_t)(kb * 64) * D_FF + c, o0); st_bf8(ACT + (size_t)(kb * 64 + 1) * D_FF + c, o1);
        if ((kb % (SEQ / 64)) == SEQ / 64 - 1) {
            float* o = C.out + O_FCP + ((size_t)(l * NB_P + kb / (SEQ / 64)) * 2) * D_UP;
            st_f8(o + c, ld_bf8(sc + 2 * D_UP)); st_f8(o + D_FF + c, ld_bf8(sc + 2 * D_UP + D_FF)); st_f8(o + D_UP + c, ld_bf8(sc + 3 * D_UP)); st_f8(o + D_UP + D_FF + c, ld_bf8(sc + 3 * D_UP + D_FF)); }
    }
}

__device__ __forceinline__ void phase_pool(Ctx C, int l) {
    C.refresh();
    const bf16* PROJ = (const bf16*)(C.ws + WS_PROJ); bf16* MIXA = (bf16*)(C.ws + WS_MIXA);
    const float* hist = C.in[2] + (size_t)l * NB_S * POOL_HIST * D_POOL;
    constexpr int NCG = D_POOL / 8, NSTRIP = M / 32;
    const int gt = C.gw * 64 + C.lane, NGT = C.NGW * 64;
    for (int it = gt; it < NSTRIP * NCG; it += NGT) {
        const int strip = it / NCG, cgi = it % NCG, c = cgi * 8, row0 = strip * 32; const bool prm = row0 < MP;
        const int b = prm ? row0 / SEQ : (row0 - MP) / SEQ_S, t0 = prm ? row0 % SEQ : 0, w = 2 << (cgi >> 5);
        const int rb = row0 - t0;
        const float* hb = hist + (size_t)b * POOL_HIST * D_POOL;
        F8 s = zero8();
        for (int i = 1; i < w; ++i) { const int t = t0 - i; F8 v;
            if (t >= 0) v = ld_bf8(PROJ + (size_t)(rb + t) * N_PROJ + c); else if (!prm) v = ld_f8(hb + (size_t)(POOL_HIST + t) * D_POOL + c); else v = zero8();
#pragma unroll
            for (int k = 0; k < 8; ++k) s.v[k] += v.v[k]; }
        for (int r0 = 0; r0 < 32; r0 += 8) {
            uint4 qc[8], ql[8];
#pragma unroll
            for (int r = 0; r < 8; ++r) { const int t = t0 + r0 + r, tl = t - w + 1; qc[r] = *(const uint4*)(PROJ + (size_t)(rb + t) * N_PROJ + c); ql[r] = *(const uint4*)(PROJ + (size_t)(rb + (tl > 0 ? tl : 0)) * N_PROJ + c); }
#pragma unroll
            for (int r = 0; r < 8; ++r) { const int t = t0 + r0 + r, tl = t - w + 1; const F8 cur = unpack8(qc[r]);
                const float inv = 1.f / (float)(prm ? (t + 1 < w ? t + 1 : w) : w); F8 o;
#pragma unroll
                for (int k = 0; k < 8; ++k) { s.v[k] += cur.v[k]; o.v[k] = s.v[k] * inv - cur.v[k]; }
                st_bf8(MIXA + (size_t)(rb + t) * D_MIX + c, o);
                F8 v = unpack8(ql[r]);
                if (tl < 0) { if (!prm) v = ld_f8(hb + (size_t)(POOL_HIST + tl) * D_POOL + c); else v = zero8(); }
#pragma unroll
                for (int k = 0; k < 8; ++k) s.v[k] -= v.v[k]; }
        }
    }
    for (int it = gt; it < (NB_P + NB_S) * 15 * NCG; it += NGT) {
        const int cg = it % NCG, i = (it / NCG) % 15, sb = it / (NCG * 15); const bool prm = sb < NB_P; const int b = prm ? sb : sb - NB_P;
        const int row = prm ? b * SEQ + (SEQ - 15 + i) : MP + b * SEQ_S + (SEQ_S - 15 + i);
        float* o = C.out + (prm ? O_POOLP + ((size_t)(l * NB_P + b) * 15 + i) * D_POOL : O_POOLS + ((size_t)(l * NB_S + b) * 15 + i) * D_POOL);
        st_f8(o + cg * 8, ld_bf8(PROJ + (size_t)row * N_PROJ + cg * 8));
    }
    constexpr int NCG2 = CONV_DIM / 8;
    for (int it = gt; it < (NB_P + NB_S) * 3 * NCG2; it += NGT) {
        const int cg = it % NCG2, i = (it / NCG2) % 3, sb = it / (NCG2 * 3); const bool prm = sb < NB_P; const int b = prm ? sb : sb - NB_P;
        const int row = prm ? b * SEQ + (SEQ - 3 + i) : MP + b * SEQ_S + (SEQ_S - 3 + i);
        float* o = C.out + (prm ? O_SCP + ((size_t)(l * NB_P + b) * 3 + i) * CONV_DIM : O_SCS + ((size_t)(l * NB_S + b) * 3 + i) * CONV_DIM);
        st_f8(o + cg * 8, ld_bf8(PROJ + (size_t)row * N_PROJ + XBC0 + cg * 8));
    }
}

__device__ __forceinline__ void phase_ssd(Ctx C, int l) {
    C.refresh();
    LAS float* xs = (LAS float*)(C.lds); LAS float* Bs = (LAS float*)(C.lds + 16384); LAS float* Cs = (LAS float*)(C.lds + 49152); LAS float* ys = (LAS float*)(C.lds + 81920);
    LAS float* dts = (LAS float*)(C.lds + 98304); LAS float* dAs = dts + 64;
    const bf16* PROJ = (const bf16*)(C.ws + WS_PROJ); const float* DT = (const float*)(C.ws + WS_DT); bf16* MIXA = (bf16*)(C.ws + WS_MIXA); float* SSQH = (float*)(C.ws + WS_SSQH);
    const float* cw = C.in[10] + (size_t)l * 4 * CONV_DIM; const float* cb = C.in[11] + (size_t)l * CONV_DIM;
    const int tid = C.tid, p = tid >> 3, n0 = (tid & 7) * 16;
    for (int u = blockIdx.x; u < NB_P * NH + NB_S * NH; u += C.G) {
        const bool prm = u < NB_P * NH; const int su = prm ? u : u - NB_P * NH, b = su / NH, hh = su % NH, g = hh / HPG;
        const int rb = prm ? b * SEQ : MP + b * SEQ_S, rows = prm ? 64 : 32, nchunk = prm ? SEQ / 64 : 1;
        const float Aneg = -__expf(C.in[13][l * NH + hh]), Dsk = C.in[14][l * NH + hh], dtb = C.in[12][l * NH + hh];
        const float* chist = C.in[3] + ((size_t)(l * NB_S + b) * 3) * CONV_DIM;
        float h[16];
        if (prm) {
#pragma unroll
            for (int i = 0; i < 16; ++i) h[i] = 0.f;
        } else { const float* h0 = C.in[4] + ((((size_t)l * NB_S + b) * NH + hh) * HD + p) * DS + n0;
#pragma unroll
            for (int i = 0; i < 4; ++i) { const float4 v = *(const float4*)(h0 + 4 * i); h[4 * i] = v.x; h[4 * i + 1] = v.y; h[4 * i + 2] = v.z; h[4 * i + 3] = v.w; } }
        for (int ch = 0; ch < nchunk; ++ch) {
            const int tb = ch * 64;
            for (int e = tid; e < rows * 40; e += NTHR) {
                const int cg = e % 40, tt = e / 40, t = tb + tt;
                int cc; LAS float* dstp;
                if (cg < 8) { cc = hh * HD + cg * 8; dstp = xs + tt * 64 + cg * 8; }
                else if (cg < 24) { cc = D_SSD + g * DS + (cg - 8) * 8; dstp = Bs + tt * 128 + (cg - 8) * 8; }
                else { cc = D_SSD + 2 * DS + g * DS + (cg - 24) * 8; dstp = Cs + tt * 128 + (cg - 24) * 8; }
                F8 a = ld_f8(cb + cc);
#pragma unroll
                for (int i = 0; i < 4; ++i) { const int ti = t - 3 + i; F8 v;
                    if (ti >= 0) v = ld_bf8(PROJ + (size_t)(rb + ti) * N_PROJ + XBC0 + cc); else if (!prm) v = ld_f8(chist + (size_t)(3 + ti) * CONV_DIM + cc); else v = zero8();
                    const F8 wv = ld_f8(cw + (size_t)i * CONV_DIM + cc);
#pragma unroll
                    for (int k = 0; k < 8; ++k) a.v[k] += wv.v[k] * v.v[k]; }
#pragma unroll
                for (int k = 0; k < 8; ++k) dstp[k] = silu_f(a.v[k]);
            }
            if (tid < rows) { const float xr = DT[(size_t)(rb + tb + tid) * 32 + hh] + dtb; const float dtv = xr > 20.f ? xr : log1pf(__expf(xr)); dts[tid] = dtv; dAs[tid] = __expf(dtv * Aneg); }
            __syncthreads();
            for (int tt = 0; tt < rows; ++tt) {
                const float xv = xs[tt * 64 + p], xdt = xv * dts[tt], dA = dAs[tt]; float acc = 0.f;
#pragma unroll
                for (int i = 0; i < 4; ++i) { const f32x4 bv = *(const LAS f32x4*)(Bs + tt * 128 + n0 + 4 * i), cv = *(const LAS f32x4*)(Cs + tt * 128 + n0 + 4 * i);
                    h[4 * i] = dA * h[4 * i] + xdt * bv[0]; acc += cv[0] * h[4 * i];
                    h[4 * i + 1] = dA * h[4 * i + 1] + xdt * bv[1]; acc += cv[1] * h[4 * i + 1];
                    h[4 * i + 2] = dA * h[4 * i + 2] + xdt * bv[2]; acc += cv[2] * h[4 * i + 2];
                    h[4 * i + 3] = dA * h[4 * i + 3] + xdt * bv[3]; acc += cv[3] * h[4 * i + 3]; }
                acc += __shfl_xor(acc, 1); acc += __shfl_xor(acc, 2); acc += __shfl_xor(acc, 4);
                if ((tid & 7) == 0) ys[tt * 64 + p] = acc + Dsk * xv;
            }
            __syncthreads();
            for (int e = tid; e < rows * 64; e += NTHR) {
                const int tt = e >> 6, pp = e & 63; const size_t row = (size_t)(rb + tb + tt);
                const float zv = bf2f(PROJ[row * N_PROJ + D_POOL + hh * HD + pp]); const float yz = ys[tt * 64 + pp] * silu_f(zv);
                MIXA[row * D_MIX + D_POOL + hh * HD + pp] = (bf16)f2bf(yz);
                const float q = wave_sum(yz * yz);
                if (pp == 0) SSQH[row * 32 + hh] = q;
            }
            __syncthreads();
        }
        float* ho = C.out + (prm ? O_SSDP + ((((size_t)l * NB_P + b) * NH + hh) * HD + p) * DS + n0 : O_SSDS + ((((size_t)l * NB_S + b) * NH + hh) * HD + p) * DS + n0);
#pragma unroll
        for (int i = 0; i < 4; ++i) *(float4*)(ho + 4 * i) = make_float4(h[4 * i], h[4 * i + 1], h[4 * i + 2], h[4 * i + 3]);
    }
}

__device__ __forceinline__ void phase_xact(Ctx C, int l) {
    C.refresh();
    const bf16* PROJ = (const bf16*)(C.ws + WS_PROJ); bf16* ACTX = (bf16*)(C.ws + WS_ACTX);
    const float* cw = C.in[10] + (size_t)l * 4 * CONV_DIM; const float* cb = C.in[11] + (size_t)l * CONV_DIM;
    constexpr int NCG = CONV_DIM / 8, NSTRIP = M / 16;
    const int gt = C.gw * 64 + C.lane, NGT = C.NGW * 64;
    for (int it = gt; it < NSTRIP * NCG; it += NGT) {
        const int strip = it / NCG, c = (it % NCG) * 8, row0 = strip * 16; const bool prm = row0 < MP;
        const int t0 = prm ? row0 % SEQ : (row0 - MP) % SEQ_S, b = prm ? row0 / SEQ : (row0 - MP) / SEQ_S;
        uint4 rq[19];
#pragma unroll
        for (int j = 0; j < 19; ++j) { const int dr = (t0 == 0 && j < 3) ? 0 : j - 3; rq[j] = *(const uint4*)(PROJ + (size_t)(row0 + dr) * N_PROJ + XBC0 + c); }
        if (t0 == 0) {
            const float* h = C.in[3] + ((size_t)(l * NB_S + (prm ? 0 : b)) * 3) * CONV_DIM + c;
#pragma unroll
            for (int j = 0; j < 3; ++j) { uint4 v = make_uint4(0u, 0u, 0u, 0u);
                if (!prm) { const F8 hv = ld_f8(h + (size_t)j * CONV_DIM); v = make_uint4(pk2(hv.v[0], hv.v[1]), pk2(hv.v[2], hv.v[3]), pk2(hv.v[4], hv.v[5]), pk2(hv.v[6], hv.v[7])); }
                rq[j] = v; } }
        F8 wv[4];
#pragma unroll
        for (int i = 0; i < 4; ++i) wv[i] = ld_f8(cw + (size_t)i * CONV_DIM + c);
        const F8 bv = ld_f8(cb + c);
#pragma unroll
        for (int i = 0; i < 16; ++i) { F8 o = bv;
#pragma unroll
            for (int tap = 0; tap < 4; ++tap) { const F8 rj = unpack8(rq[i + tap]);
#pragma unroll
                for (int k = 0; k < 8; ++k) o.v[k] += wv[tap].v[k] * rj.v[k]; }
#pragma unroll
            for (int k = 0; k < 8; ++k) o.v[k] = silu_f(o.v[k]);
            st_bf8(ACTX + (size_t)(row0 + i) * CONV_DIM + c, o); }
    }
}

constexpr int SL_C = 0, SL_B = 17408, SL_BT = 34816, SL_XT = 53248, SL_H = 62464, SL_M = 79872, SL_DT = 89088, SL_AC = SL_DT + 512, SL_W = SL_AC + 512, SL_DEC = SL_W + 512, SL_SSQ = SL_DEC + 16, SL_XWT = SL_SSQ + 1024;
constexpr int PC = 272, PT = 144;
typedef short bf16x8_t __attribute__((ext_vector_type(8)));
__device__ __forceinline__ bf16x8_t ld_op(const LAS unsigned char* base, int row, int pitch, int kelem) { return *(const LAS bf16x8_t*)(base + row * pitch + kelem * 2); }
__device__ __forceinline__ int swz(int row, int byte) { return byte ^ (((row >> 3) & 7) << 4); }
__device__ __forceinline__ bf16x8_t ld_op_sw(const LAS unsigned char* base, int row, int pitch, int kelem) { return *(const LAS bf16x8_t*)(base + row * pitch + swz(row, kelem * 2)); }

typedef unsigned u32x4_t __attribute__((ext_vector_type(4)));
typedef unsigned u32x2_t __attribute__((ext_vector_type(2)));
__device__ __forceinline__ F8 lds_f8(const LAS float* p) { const f32x4 a = *(const LAS f32x4*)p, b = *(const LAS f32x4*)(p + 4); F8 r; r.v[0] = a[0]; r.v[1] = a[1]; r.v[2] = a[2]; r.v[3] = a[3]; r.v[4] = b[0]; r.v[5] = b[1]; r.v[6] = b[2]; r.v[7] = b[3]; return r; }
__device__ __forceinline__ unsigned perm_lo(unsigned hi_row, unsigned lo_row) { return __builtin_amdgcn_perm(hi_row, lo_row, 0x05040100u); }
__device__ __forceinline__ unsigned perm_hi(unsigned hi_row, unsigned lo_row) { return __builtin_amdgcn_perm(hi_row, lo_row, 0x07060302u); }
__device__ __forceinline__ unsigned qword(const uint4& v, int i) { return i == 0 ? v.x : (i == 1 ? v.y : (i == 2 ? v.z : v.w)); }
__device__ __forceinline__ void ssd_stage(LAS unsigned char* L, int cg, int l0, int rows_valid, const LAS float* w_s, const uint4 (&rq)[8]) {
    uint4 r[8];
#pragma unroll
    for (int i = 0; i < 8; ++i) { const bool ok = l0 + i < rows_valid; r[i].x = ok ? rq[i].x : 0u; r[i].y = ok ? rq[i].y : 0u; r[i].z = ok ? rq[i].z : 0u; r[i].w = ok ? rq[i].w : 0u; }
    if (cg < 8) {
        const f32x4 wa = *(const LAS f32x4*)(w_s + l0), wb = *(const LAS f32x4*)(w_s + l0 + 4);
#pragma unroll
        for (int k = 0; k < 8; ++k) { const int p = 8 * cg + k; unsigned t[4];
#pragma unroll
            for (int jj = 0; jj < 4; ++jj) t[jj] = (k & 1) ? perm_hi(qword(r[2 * jj + 1], k >> 1), qword(r[2 * jj], k >> 1)) : perm_lo(qword(r[2 * jj + 1], k >> 1), qword(r[2 * jj], k >> 1));
            *(LAS u32x4_t*)(L + SL_XT + p * PT + swz(p, l0 * 2)) = (u32x4_t){t[0], t[1], t[2], t[3]};
            *(LAS u32x4_t*)(L + SL_XWT + p * PT + swz(p, l0 * 2)) = (u32x4_t){pk2(bflo(t[0]) * wa[0], bfhi(t[0]) * wa[1]), pk2(bflo(t[1]) * wa[2], bfhi(t[1]) * wa[3]), pk2(bflo(t[2]) * wb[0], bfhi(t[2]) * wb[1]), pk2(bflo(t[3]) * wb[2], bfhi(t[3]) * wb[3])}; }
    } else if (cg < 24) { const int n0 = 8 * (cg - 8);
#pragma unroll
        for (int i = 0; i < 8; ++i) *(LAS u32x4_t*)(L + SL_B + (l0 + i) * PC + n0 * 2) = (u32x4_t){r[i].x, r[i].y, r[i].z, r[i].w};
#pragma unroll
        for (int k = 0; k < 8; ++k) { const int n = n0 + k; unsigned t[4];
#pragma unroll
            for (int jj = 0; jj < 4; ++jj) t[jj] = (k & 1) ? perm_hi(qword(r[2 * jj + 1], k >> 1), qword(r[2 * jj], k >> 1)) : perm_lo(qword(r[2 * jj + 1], k >> 1), qword(r[2 * jj], k >> 1));
            *(LAS u32x4_t*)(L + SL_BT + n * PT + swz(n, l0 * 2)) = (u32x4_t){t[0], t[1], t[2], t[3]}; }
    } else { const int n0 = 8 * (cg - 24);
#pragma unroll
        for (int i = 0; i < 8; ++i) *(LAS u32x4_t*)(L + SL_C + (l0 + i) * PC + n0 * 2) = (u32x4_t){r[i].x, r[i].y, r[i].z, r[i].w};
    }
}
__device__ __forceinline__ void ssd_dt(LAS unsigned char* L, int par, float xr, bool valid, float Aneg, int lane) {
    const float dtv = valid ? (xr > 20.f ? xr : log1pf(__expf(xr))) : 0.f;
    float a = dtv * Aneg;
#pragma unroll
    for (int o = 1; o < 64; o <<= 1) { const float v = __shfl_up(a, o); if (lane >= o) a += v; }
    const float last = __shfl(a, 63);
    ((LAS float*)(L + SL_DT))[par * 64 + lane] = dtv; ((LAS float*)(L + SL_AC))[par * 64 + lane] = a; ((LAS float*)(L + SL_W))[par * 64 + lane] = dtv * __expf(last - a);
    if (lane == 0) ((LAS float*)(L + SL_DEC))[par] = __expf(last);
}
#define WG_BAR() do { asm volatile("s_waitcnt lgkmcnt(0)" ::: "memory"); __builtin_amdgcn_s_barrier(); asm volatile("" ::: "memory"); } while (0)
__device__ __forceinline__ void stage_role(int tq, int& cg, int& l0) {
    const int ws = tq >> 6, lane = tq & 63;
    if (ws == 0) { cg = lane & 7; l0 = (lane >> 3) * 8; }
    else { const int idx = ((ws - 1) & 1) * 64 + lane; cg = (ws <= 2 ? 8 : 24) + (idx & 15); l0 = (idx >> 4) * 8; }
}
__device__ __forceinline__ void ssd_load_act(uint4 (&rq)[8], const bf16* ACTX, int tq, int hh, int g, size_t rowf) {
    int cg, l0c; stage_role(tq, cg, l0c);
    const int cc = cg < 8 ? hh * HD + cg * 8 : (cg < 24 ? D_SSD + g * DS + (cg - 8) * 8 : D_SSD + 2 * DS + g * DS + (cg - 24) * 8);
    const unsigned lo = tq < 320 ? (unsigned)(l0c * CONV_DIM + cc) * 2u : 0u;
#pragma unroll
    for (int j = 0; j < 8; ++j) { const char* ub = (const char*)ACTX + ((rowf + j) * CONV_DIM) * 2; rq[j] = *(const uint4*)(ub + lo); }
}
__device__ __forceinline__ void ssd_load_z(uint2 (&zq)[2], const bf16* PROJ, int w, int r16, int q, int hh, size_t row0, int rows) {
    const int pi = w >> 1, li0 = 2 * (w & 1);
#pragma unroll
    for (int t = 0; t < 2; ++t) { const int lrow = 16 * (li0 + t) + r16; const char* ub = (const char*)PROJ + ((row0 + 16 * (li0 + t)) * N_PROJ + D_POOL + hh * HD + 16 * pi) * 2;
        zq[t] = lrow < rows ? *(const uint2*)(ub + (unsigned)(r16 * N_PROJ + 4 * q) * 2u) : make_uint2(0u, 0u); }
}
#define OPQ_V(x) asm volatile("" : "+v"(x))
#define OPQ_S(x) asm volatile("" : "+s"(x))
__device__ __forceinline__ void phase_ssd2(Ctx C, int l) {
    C.refresh();
    LAS unsigned char* L = C.lds;
    const bf16* PROJ = (const bf16*)(C.ws + WS_PROJ); const bf16* ACTX = (const bf16*)(C.ws + WS_ACTX); const float* DT = (const float*)(C.ws + WS_DT); bf16* MIXA = (bf16*)(C.ws + WS_MIXA); float* SSQH = (float*)(C.ws + WS_SSQH);
    const int w0 = C.wave;
    const int conv_l = l + 1 < DEPTH ? l + 1 : -1, cG = C.G, cbx = (int)blockIdx.x;
    float cwv[32], cgl = 1.f; int cslot = 0;
#define tid0 (w0 * 64 + lane_id())
    typedef float f4 __attribute__((ext_vector_type(4)));
#if PROBE_SEL > 0
    volatile LAS unsigned* MISC2 = (volatile LAS unsigned*)(C.lds + LDSCTL_OFF);
    if (blockIdx.x == 0 && w0 == 0 && lane_id() == 0) MISC2[13] = (unsigned)__builtin_amdgcn_s_memrealtime();
#define STAMP2(ty) do { if (blockIdx.x == 0 && w0 == 0 && lane_id() == 0) { const unsigned tn = (unsigned)__builtin_amdgcn_s_memrealtime(); MISC2[16 + (ty)] += tn - MISC2[13]; MISC2[13] = tn; } } while (0)
#else
#define STAMP2(ty) do { } while (0)
#endif
    for (int u = blockIdx.x; u < NB_P * NH + NB_S * NH; u += C.G) {
        STAMP2(19);
        const bool prm = u < NB_P * NH; const int su = prm ? u : u - NB_P * NH, b = su / NH, hh = su % NH, g = hh / HPG;
        const int rb = prm ? b * SEQ : MP + b * SEQ_S, rows = prm ? 64 : 32, nchunk = prm ? SEQ / 64 : 1;
        const float Aneg = -__expf(C.in[13][l * NH + hh]), Dsk = C.in[14][l * NH + hh], dtb = C.in[12][l * NH + hh];
        f4 hacc[4]; float xrn; uint2 zq[2]; uint4 rawq[8];
        {
            int tq = tid0, w = w0; OPQ_V(tq); OPQ_S(w);
            const int lane = tq & 63, r16 = lane & 15, q = lane >> 4; const bool stg = tq < 320; int cg, l0; stage_role(tq, cg, l0);
            const float xr0 = DT[((size_t)rb + (lane < rows ? lane : 0)) * 32 + hh] + dtb;
            ssd_load_act(rawq, ACTX, tq, hh, g, (size_t)rb);
            xrn = DT[((size_t)(rb + 64) + lane) * 32 + hh] + dtb;
#pragma unroll
            for (int pj = 0; pj < 4; ++pj) {
                if (prm) hacc[pj] = (f4){0.f, 0.f, 0.f, 0.f};
                else { const float4 v = *(const float4*)(C.in[4] + ((((size_t)l * NB_S + b) * NH + hh) * HD + 16 * pj + r16) * DS + 16 * w + 4 * q); hacc[pj] = (f4){v.x, v.y, v.z, v.w}; } }
            if (w == 0) ssd_dt(L, 0, xr0, lane < rows, Aneg, lane);
            WG_BAR();
            if (stg) ssd_stage(L, cg, l0, rows, (const LAS float*)(L + SL_W), rawq);
#pragma unroll
            for (int pj = 0; pj < 4; ++pj) *(LAS u32x2_t*)(L + SL_H + (16 * pj + r16) * PC + (16 * w + 4 * q) * 2) = (u32x2_t){pk2(hacc[pj][0], hacc[pj][1]), pk2(hacc[pj][2], hacc[pj][3])};
            ssd_load_z(zq, PROJ, w, r16, q, hh, (size_t)rb, rows);
            ssd_load_act(rawq, ACTX, tq, hh, g, (size_t)rb + 64);
            WG_BAR();
        }
        STAMP2(13);
        for (int c = 0; c < nchunk; ++c) {
            const int par = c & 1, tb = c * 64; const bool more = c + 1 < nchunk;
            {
                int tq = tid0, w = w0; OPQ_V(tq); OPQ_S(w);
                const int lane = tq & 63, r16 = lane & 15, q = lane >> 4;
                const float xrc = xrn;
                xrn = DT[((size_t)(rb + tb + 128) + lane) * 32 + hh] + dtb;
                if (more && w == 0) ssd_dt(L, par ^ 1, xrc, true, Aneg, lane);
                const LAS float* ac = (const LAS float*)(L + SL_AC) + par * 64; const LAS float* dts = (const LAS float*)(L + SL_DT) + par * 64;
#pragma unroll
                for (int t = 0; t < 2; ++t) { const int T = 2 * w + t, si = T >> 2, li = T & 3; f4 acc = (f4){0.f, 0.f, 0.f, 0.f};
#pragma unroll
                    for (int ks = 0; ks < 4; ++ks) acc = __builtin_amdgcn_mfma_f32_16x16x32_bf16(ld_op(L + SL_B, 16 * si + r16, PC, 32 * ks + 8 * q), ld_op(L + SL_C, 16 * li + r16, PC, 32 * ks + 8 * q), acc, 0, 0, 0);
                    const int lr = 16 * li + r16, s0 = 16 * si + 4 * q; const float al = ac[lr]; const f4 as = *(const LAS f4*)(ac + s0), ds = *(const LAS f4*)(dts + s0); float m[4];
#pragma unroll
                    for (int r = 0; r < 4; ++r) m[r] = (s0 + r <= lr) ? acc[r] * __expf(al - as[r]) * ds[r] : 0.f;
                    *(LAS u32x2_t*)(L + SL_M + lr * PT + s0 * 2) = (u32x2_t){pk2(m[0], m[1]), pk2(m[2], m[3])}; }
            }
            WG_BAR(); STAMP2(14);
            {
                int tq = tid0, w = w0; OPQ_V(tq); OPQ_S(w);
                const int lane = tq & 63, r16 = lane & 15, q = lane >> 4, pi = w >> 1, li0 = 2 * (w & 1);
                const LAS float* ac = (const LAS float*)(L + SL_AC) + par * 64;
#pragma unroll
                for (int t = 0; t < 2; ++t) { const int li = li0 + t; f4 yd = (f4){0.f, 0.f, 0.f, 0.f}, yo = (f4){0.f, 0.f, 0.f, 0.f};
#pragma unroll
                    for (int ks = 0; ks < 2; ++ks) yd = __builtin_amdgcn_mfma_f32_16x16x32_bf16(ld_op_sw(L + SL_XT, 16 * pi + r16, PT, 32 * ks + 8 * q), ld_op(L + SL_M, 16 * li + r16, PT, 32 * ks + 8 * q), yd, 0, 0, 0);
#pragma unroll
                    for (int ks = 0; ks < 4; ++ks) yo = __builtin_amdgcn_mfma_f32_16x16x32_bf16(ld_op(L + SL_H, 16 * pi + r16, PC, 32 * ks + 8 * q), ld_op(L + SL_C, 16 * li + r16, PC, 32 * ks + 8 * q), yo, 0, 0, 0);
                    const int lr = 16 * li + r16, p0 = 16 * pi + 4 * q; const float e = __expf(ac[lr]);
                    const float zf[4] = {bflo(zq[t].x), bfhi(zq[t].x), bflo(zq[t].y), bfhi(zq[t].y)}; float yz[4], ss = 0.f;
#pragma unroll
                    for (int r = 0; r < 4; ++r) { const float xv = bf2f(*(const LAS bf16*)(L + SL_XT + (p0 + r) * PT + swz(p0 + r, lr * 2))); const float y = yd[r] + e * yo[r] + Dsk * xv; yz[r] = y * silu_f(zf[r]); ss += yz[r] * yz[r]; }
                    if (lr < rows) { char* ub = (char*)MIXA + ((size_t)(rb + tb + 16 * li) * D_MIX + D_POOL + hh * HD + 16 * pi) * 2; *(uint2*)(ub + (unsigned)(r16 * D_MIX + 4 * q) * 2u) = make_uint2(pk2(yz[0], yz[1]), pk2(yz[2], yz[3])); }
                    ss += __shfl_xor(ss, 16); ss += __shfl_xor(ss, 32);
                    if (q == 0) ((LAS float*)(L + SL_SSQ))[lr * 4 + pi] = ss; }
            }
            {
                int tq = tid0, w = w0; OPQ_V(tq); OPQ_S(w);
                const int lane = tq & 63, r16 = lane & 15, q = lane >> 4;
                const float dec = ((const LAS float*)(L + SL_DEC))[par];
#pragma unroll
                for (int pj = 0; pj < 4; ++pj) { hacc[pj] = hacc[pj] * dec;
#pragma unroll
                    for (int ks = 0; ks < 2; ++ks) hacc[pj] = __builtin_amdgcn_mfma_f32_16x16x32_bf16(ld_op_sw(L + SL_BT, 16 * w + r16, PT, 32 * ks + 8 * q), ld_op_sw(L + SL_XWT, 16 * pj + r16, PT, 32 * ks + 8 * q), hacc[pj], 0, 0, 0); }
            }
            WG_BAR(); STAMP2(15);
            {
                int tq = tid0, w = w0; OPQ_V(tq); OPQ_S(w);
                const int lane = tq & 63, r16 = lane & 15, q = lane >> 4;
#pragma unroll
                for (int pj = 0; pj < 4; ++pj) *(LAS u32x2_t*)(L + SL_H + (16 * pj + r16) * PC + (16 * w + 4 * q) * 2) = (u32x2_t){pk2(hacc[pj][0], hacc[pj][1]), pk2(hacc[pj][2], hacc[pj][3])};
                if (more && tq < 320) { int cg, l0; stage_role(tq, cg, l0); ssd_stage(L, cg, l0, 64, (const LAS float*)(L + SL_W) + (par ^ 1) * 64, rawq); }
                ssd_load_z(zq, PROJ, w, r16, q, hh, (size_t)(rb + tb + 64), rows);
                ssd_load_act(rawq, ACTX, tq, hh, g, (size_t)(rb + tb + 128));
                if (conv_l >= 0 && w >= 5) { const int mp = (w - 5) + 3 * (cslot - 1), mn = (w - 5) + 3 * cslot; LAS float* cscr = (LAS float*)(L + 101376 + (w - 5) * 8448);
                    if (cslot > 0 && mp * cG + cbx < I_L) conv_finish(conv_job(C, conv_l, mp * cG + cbx), lane, cwv, cgl, cscr);
                    if (mn * cG + cbx < I_L) conv_issue(conv_job(C, conv_l, mn * cG + cbx), lane, cwv, cgl); }
                ++cslot;
                if (tq >= 448 && (tq - 448) < rows) { const int lr = tq - 448; const f4 s4 = *(const LAS f4*)(L + SL_SSQ + lr * 16); SSQH[(size_t)(rb + tb + lr) * 32 + hh] = (s4[0] + s4[1]) + (s4[2] + s4[3]); }
            }
            WG_BAR();
            STAMP2(16);
        }
        {
            int tq = tid0, w = w0; OPQ_V(tq); OPQ_S(w);
            const int lane = tq & 63, r16 = lane & 15, q = lane >> 4;
            float* ho = C.out + (prm ? O_SSDP + (((size_t)l * NB_P + b) * NH + hh) * HD * DS : O_SSDS + (((size_t)l * NB_S + b) * NH + hh) * HD * DS);
#pragma unroll
            for (int pj = 0; pj < 4; ++pj) *(float4*)(ho + (size_t)(16 * pj + r16) * DS + 16 * w + 4 * q) = make_float4(hacc[pj][0], hacc[pj][1], hacc[pj][2], hacc[pj][3]); }
    }
    if (conv_l >= 0) {
        int tq = tid0, w = w0; OPQ_V(tq); OPQ_S(w); const int lane = tq & 63;
        if (w >= 5 && cslot > 0) { const int mp = (w - 5) + 3 * (cslot - 1); if (mp * cG + cbx < I_L) conv_finish(conv_job(C, conv_l, mp * cG + cbx), lane, cwv, cgl, (LAS float*)(L + 101376 + (w - 5) * 8448)); }
        WG_BAR();
        for (int m = 3 * cslot + w; m * cG + cbx < I_L; m += NWAVES) { const ConvJob j = conv_job(C, conv_l, m * cG + cbx); float wv2[32], gl2; conv_issue(j, lane, wv2, gl2); conv_finish(j, lane, wv2, gl2, (LAS float*)(L + w * 16384)); }
    }
}

#undef tid0
constexpr int PH_CONV = 0, PH_FOLD = 1, PH_L0 = 2, PH_PER_L = 10, N_PHASES = PH_L0 + DEPTH * PH_PER_L;
constexpr int CW_BAR = 4096;

__global__ void __launch_bounds__(NTHR, 2) fwd_kernel(Args args) {
    extern __shared__ __attribute__((aligned(16))) unsigned char lds_raw[];
    Ctx C; C.lds = (LAS unsigned char*)lds_raw; C.G = gridDim.x; C.in = args.in; C.out = args.out; C.ws = args.ws; C.wave0 = __builtin_amdgcn_readfirstlane(threadIdx.x >> 6); C.refresh();
    volatile LAS unsigned* MISC = (volatile LAS unsigned*)(C.lds + LDSCTL_OFF);
    if (threadIdx.x < 64) MISC[threadIdx.x] = 0u;
#define LEAD() (C.wave0 == 0 && lane_id() == 0)
    __syncthreads();
    const int lo = args.ph_lo, hi = args.ph_hi;
    unsigned* barw = (unsigned*)(args.ws + WS_CTL) + CW_BAR;
    XcdBarrier bar; bar.bar = barw; bar.x = 0; bar.st = MISC + 8;
    if (hi - lo > 1) bar = xcd_barrier_post(barw, MISC + 8, LEAD());
#define IN(k) (lo <= (k) && (k) < hi)
#if PROBE_SEL > 0
    if (blockIdx.x == 0 && LEAD()) { MISC[12] = (unsigned)__builtin_amdgcn_s_memrealtime(); MISC[14] = (unsigned)__builtin_amdgcn_s_memrealtime(); MISC[15] = (unsigned)clock64(); }
#define STAMP(ty) do { if (blockIdx.x == 0 && LEAD()) { const unsigned tn = (unsigned)__builtin_amdgcn_s_memrealtime(); MISC[16 + (ty)] += tn - MISC[12]; MISC[12] = tn; } } while (0)
#else
#define STAMP(ty) do { } while (0)
#endif
#define SEAM(k) do { if ((k) + 1 < hi) xcd_barrier(bar, LEAD()); } while (0)
    LAS unsigned char* ring = C.lds;
    const int vcu = (C.G % 8 == 0) ? ((int)blockIdx.x % 8) * (C.G / 8) + (int)blockIdx.x / 8 : (int)blockIdx.x;

    if (IN(PH_CONV)) { phase_convert(C); SEAM(PH_CONV); STAMP(0); }
    for (int l = 0; l < DEPTH; ++l) {
        const int pb = PH_L0 + l * PH_PER_L;
        if (IN(pb + 0)) {
            pg8::Gemm gm{(const bf16*)(C.ws + WS_XB), (const bf16*)(C.ws + WS_BTIN) + (size_t)l * N_INP * DMP, M, N_PROJ, DM, DMP, DMP, 0};
            pg8::StaticOrder S; S.init(M, N_PROJ, C.G, (int)blockIdx.x);
            pg8::EpiBf16S E{(bf16*)(C.ws + WS_PROJ), N_PROJ, (const float*)(C.ws + WS_R), nullptr, -1};
            pg8::gemm_phase<pg8::EpiBf16S, pg8::StaticOrder, true, true>(ring, gm, S, E, C.wave0);
            {
                const int first_light = S.nwg % C.G;
                for (int w = ((int)blockIdx.x - first_light + C.G) % C.G; w < 4 * 8; w += C.G) { const int g = w >> 3, lg = 4 * l + g;
                    pg8::Gemm gf{(const bf16*)(C.ws + WS_WOP) + (size_t)l * DM * D_POOL + g * 256, (const bf16*)(C.ws + WS_WPB) + (size_t)lg * 65536, DM, 256, 256, D_POOL, 256, 0};
                    pg8::StaticOrder Sf; Sf.init(DM, 256, 8, w & 7);
                    pg8::EpiBf16S Ef{(bf16*)(C.ws + WS_BTOUT) + (size_t)l * DM * D_MIX + g * 256, D_MIX, nullptr, nullptr, -1};
                    pg8::gemm_phase<pg8::EpiBf16S, pg8::StaticOrder, true, true>(ring, gf, Sf, Ef, C.wave0); } }
            phase_dt(C, l);
            STAMP(17); SEAM(pb + 0); STAMP(2);
        }
        if (IN(pb + 1)) { phase_xact(C, l); phase_pool(C, l); STAMP(12); SEAM(pb + 1); STAMP(3); }
        if (IN(pb + 2)) { phase_ssd2(C, l); STAMP(11); SEAM(pb + 2); STAMP(19); }
        if (IN(pb + 4)) {
            {
                pg8::Gemm gm{(const bf16*)(C.ws + WS_MIXA), (const bf16*)(C.ws + WS_BTOUT) + (size_t)l * DM * D_MIX, MP, DM, D_MIX, D_MIX, D_MIX, 0};
                pg8::FactorOrder S; S.init(MP, DM, C.G, (int)blockIdx.x); S.ssqh = (const float*)(C.ws + WS_SSQH); S.ft = (LAS float*)(C.lds + LDSCTL_OFF + 1024); S.wave0 = C.wave0; S.eps = EPS;
                pg8::EpiBf16SsqG E{(bf16*)(C.ws + WS_MIX), DM, (float*)(C.ws + WS_SSQP), (const LAS float*)(C.lds + LDSCTL_OFF + 1024), D_POOL / 64, (D_POOL + 1024) / 64};
                pg8::gemm_phase<pg8::EpiBf16SsqG, pg8::FactorOrder, true, true>(ring, gm, S, E, C.wave0); }
            {
                pg8::Gemm gm{(const bf16*)(C.ws + WS_MIXA) + (size_t)MP * D_MIX, (const bf16*)(C.ws + WS_BTOUT) + (size_t)l * DM * D_MIX, MS, DM, D_MIX / KS_OUT, D_MIX, D_MIX, D_MIX / KS_OUT};
                pg8::SplitKOrder S; S.init(MS, DM, KS_OUT, C.G, vcu);
                pg8::EpiF32Slab E{(float*)(C.ws + WS_SLAB), DM, MS};
                pg8::gemm_phase<pg8::EpiF32Slab, pg8::SplitKOrder, true, true>(ring, gm, S, E, C.wave0); }
            STAMP(17); SEAM(pb + 4); STAMP(5);
        }
        if (IN(pb + 5)) { phase_resid(C, C.in[17] + l * DM, false, KS_OUT, true); SEAM(pb + 5); STAMP(6); }
        if (IN(pb + 6)) {
            pg8::Gemm gm{(const bf16*)(C.ws + WS_XB), (const bf16*)(C.ws + WS_BTUP) + (size_t)l * D_UP * DMP, M, D_UP, DM, DMP, DMP, 0};
            pg8::StaticOrder S; S.init(M, D_UP, C.G, (int)blockIdx.x);
            pg8::EpiUpAct E{(bf16*)(C.ws + WS_ACT), (bf16*)(C.ws + WS_UP), (bf16*)(C.ws + WS_SIDE), (const float*)(C.ws + WS_R), C.in[20] + (size_t)l * 3 * D_UP, C.in[21] + (size_t)l * D_UP, D_FF, (LAS float*)(C.lds + LDSCTL_OFF + 1024)};
            pg8::gemm_phase<pg8::EpiUpAct, pg8::StaticOrder, true, true>(ring, gm, S, E, C.wave0);
            STAMP(17); SEAM(pb + 6); STAMP(7);
        }
        if (IN(pb + 7)) { phase_act(C, l); phase_actfix(C, l); SEAM(pb + 7); STAMP(8); }
        if (IN(pb + 8)) {
            {
                pg8::Gemm gm{(const bf16*)(C.ws + WS_ACT), (const bf16*)(C.ws + WS_BTDN) + (size_t)l * DM * D_FF, MP, DM, D_FF, D_FF, D_FF, 0};
                pg8::StaticOrder S; S.init(MP, DM, C.G, (int)blockIdx.x);
                pg8::EpiBf16Ssq E{(bf16*)(C.ws + WS_MIX), DM, (float*)(C.ws + WS_SSQP)};
                pg8::gemm_phase<pg8::EpiBf16Ssq, pg8::StaticOrder, true, true>(ring, gm, S, E, C.wave0); }
            {
                pg8::Gemm gm{(const bf16*)(C.ws + WS_ACT) + (size_t)MP * D_FF, (const bf16*)(C.ws + WS_BTDN) + (size_t)l * DM * D_FF, MS, DM, D_FF / KS_DN, D_FF, D_FF, D_FF / KS_DN};
                pg8::SplitKOrder S; S.init(MS, DM, KS_DN, C.G, vcu);
                pg8::EpiF32Slab E{(float*)(C.ws + WS_SLAB), DM, MS};
                pg8::gemm_phase<pg8::EpiF32Slab, pg8::SplitKOrder, true, true>(ring, gm, S, E, C.wave0); }
            STAMP(17); SEAM(pb + 8); STAMP(9);
        }
        if (IN(pb + 9)) { phase_resid(C, C.in[23] + l * DM, l == DEPTH - 1, KS_DN, false); SEAM(pb + 9); STAMP(10); }
    }
#if PROBE_SEL > 0
    if (blockIdx.x == 0 && LEAD()) { asm volatile("s_waitcnt vmcnt(0)" ::: "memory"); unsigned tot = 0; for (int ty = 0; ty < 20; ++ty) if ((PROBE_SEL >> ty) & 1) tot += MISC[16 + ty]; C.out[0] = (float)tot * 0.0001f;
        if (PROBE_SEL & (1 << 30)) { const unsigned dc = (unsigned)clock64() - MISC[15], dt = (unsigned)__builtin_amdgcn_s_memrealtime() - MISC[14]; C.out[0] = 5.f * (float)dc / (float)dt; } }
#endif
#undef IN
#undef SEAM
}

extern "C" void kernel_launch(void* const* d_in, const int* in_sizes, int n_in, void* d_out, int out_size, void* d_ws, size_t ws_size, hipStream_t stream) {
    static int grid = 0;
    if (grid == 0) {
        if (n_in != 24 || (size_t)out_size != O_END || ws_size < WS_END) { fprintf(stderr, "kernel_launch: shape mismatch: n_in %d out %d (want %zu) ws %zu (need %zu)\n", n_in, out_size, (size_t)O_END, ws_size, (size_t)WS_END); grid = -1; return; }
        int dev = 0, cus = 0, per_cu = 0;
        if (hipGetDevice(&dev) != hipSuccess || hipDeviceGetAttribute(&cus, hipDeviceAttributeMultiprocessorCount, dev) != hipSuccess) { grid = -1; return; }
        if (hipFuncSetAttribute((const void*)fwd_kernel, hipFuncAttributeMaxDynamicSharedMemorySize, LDS_BYTES) != hipSuccess) { fprintf(stderr, "kernel_launch: hipFuncSetAttribute failed\n"); grid = -1; return; }
        if (hipOccupancyMaxActiveBlocksPerMultiprocessor(&per_cu, (const void*)fwd_kernel, NTHR, LDS_BYTES) != hipSuccess || per_cu < 1) fprintf(stderr, "kernel_launch: occupancy query reports %d\n", per_cu);
        (void)hipGetLastError();
        grid = cus;
    }
    if (grid < 0) return;
    if (hipMemsetAsync((char*)d_ws + WS_CTL, 0, CTL_BYTES, stream) != hipSuccess) return;
    Args a{};
    for (int i = 0; i < 24; ++i) a.in[i] = (const float*)d_in[i];
    a.out = (float*)d_out; a.ws = (unsigned char*)d_ws;
#if MK_MULTI
    for (int k = 0; k < N_PHASES; ++k) { a.ph_lo = k; a.ph_hi = k + 1; hipLaunchKernelGGL(fwd_kernel, dim3(grid), dim3(NTHR), LDS_BYTES, stream, a); }
#else
    a.ph_lo = 0; a.ph_hi = N_PHASES; hipLaunchKernelGGL(fwd_kernel, dim3(grid), dim3(NTHR), LDS_BYTES, stream, a);
#endif
}
```

```cpp
#include <hip/hip_runtime.h>
#include <cstdio>
#include <cstdint>

#ifndef PROBE_SEL
#define PROBE_SEL 0
#endif
#ifndef MK_MULTI
#define MK_MULTI 0
#endif

__device__ __forceinline__ int lane_id() { int l; asm volatile("v_mbcnt_lo_u32_b32 %0, -1, 0\n\tv_mbcnt_hi_u32_b32 %0, -1, %0" : "=v"(l)); return l; }
namespace pg8 {
#define PG8_LAS __attribute__((address_space(3)))
typedef unsigned short bf16_t;
typedef short bf16x8 __attribute__((ext_vector_type(8)));
typedef float f32x4 __attribute__((ext_vector_type(4)));
typedef unsigned u32x4 __attribute__((ext_vector_type(4)));
constexpr int BM = 256, BK = 64, HALF = 128, HTB = HALF * BK * 2, STAGE_BYTES = 8 * HTB, NXCD = 8, WGM = 4;

__host__ __device__ __forceinline__ int lds_byte(int r, int c) { const int st = (r >> 4) * 2 + (c >> 5), rr = r & 15, cc = c & 31, ob = rr * 64 + cc * 2; return st * 1024 + (ob ^ (((ob >> 9) & 1) << 5)); }
__host__ __device__ __forceinline__ void stage_rc(int b, int& R, int& C) { const int st = b / 1024, sb = b % 1024, swz = sb ^ (((sb >> 9) & 1) << 5); R = (st >> 1) * 16 + swz / 64; C = (st & 1) * 32 + (swz % 64) / 2; }
__host__ __device__ __forceinline__ int perm32(int rho) { const int n = rho >> 4, i = rho & 15; return 8 * (i >> 2) + 4 * n + (i & 3); }

struct Unit { int pm, pn, ks, seq; };
struct Gemm { const bf16_t* A; const bf16_t* Bt; int M, N, K, lda, ldb, kslice; };

struct StaticOrder {
    int nM, nN, nwg, G, c;
    __host__ __device__ void init(int M, int N, int G_, int c_) { nM = M / BM; nN = N / BM; nwg = nM * nN; G = G_; c = c_; }
    __host__ __device__ bool next(int i, Unit& u) const {
        const long L = (long)i * G + c; if (L >= nwg) return false;
        int wgid = (int)L; { const int q = nwg / NXCD, r = nwg % NXCD, xcd = wgid % NXCD, off = wgid / NXCD; wgid = (xcd < r ? xcd * (q + 1) : r * (q + 1) + (xcd - r) * q) + off; }
        const int nig = WGM * nN, gid = wgid / nig, fm = gid * WGM, gsz = (nM - fm) < WGM ? (nM - fm) : WGM;
        u.pm = fm + ((wgid % nig) % gsz); u.pn = (wgid % nig) / gsz; u.ks = 0; u.seq = i; return true;
    }
    __device__ __forceinline__ void a_ready(const Unit&) const {}
    __device__ __forceinline__ void done(const Unit&) const {}
};
struct SplitKOrder {
    int nM, nN, KS, nwg, G, c;
    __host__ __device__ void init(int M, int N, int KS_, int G_, int c_) { nM = M / BM; nN = N / BM; KS = KS_; nwg = nM * nN * KS; G = G_; c = c_; }
    __host__ __device__ bool next(int i, Unit& u) const { const long L = (long)i * G + c; if (L >= nwg) return false; const int l = (int)L; u.seq = i; u.pn = l % nN; u.ks = (l / nN) % KS; u.pm = l / (nN * KS); return true; }
    __device__ __forceinline__ void a_ready(const Unit&) const {}
    __device__ __forceinline__ void done(const Unit&) const {}
};

__device__ __forceinline__ unsigned cvt_pk_bf16(float lo, float hi) { unsigned r; asm volatile("v_cvt_pk_bf16_f32 %0, %1, %2" : "=v"(r) : "v"(lo), "v"(hi)); return r; }

struct EpiBf16S {
    static constexpr bool PERM = true, AFTER_DRAIN = false, HAS_KSEG = false;
    bf16_t* O; int ldc; const float* rs; float* dt; int dt_pn;
    __device__ __forceinline__ void operator()(const f32x4 (&acc)[2][2][4][2], const Unit& u, int wr, int wc, int fr, int fq) const {
        const int row0 = u.pm * BM + wr * 64 + fr;
        if (u.pn == dt_pn) {
            if (wc == 0) {
#pragma unroll
                for (int ai = 0; ai < 2; ++ai)
#pragma unroll
                    for (int m = 0; m < 4; ++m) { const int row = row0 + ai * HALF + m * 16; const float s = rs ? rs[row] : 1.f;
#pragma unroll
                        for (int n = 0; n < 2; ++n) *(f32x4*)(dt + (size_t)row * 32 + 8 * fq + 4 * n) = acc[ai][0][m][n] * s; }
            }
            return;
        }
        const int col0 = u.pn * BM + wc * 32 + 8 * fq;
#pragma unroll
        for (int ai = 0; ai < 2; ++ai)
#pragma unroll
            for (int m = 0; m < 4; ++m) { const int row = row0 + ai * HALF + m * 16; const float s = rs ? rs[row] : 1.f; bf16_t* rowp = O + (size_t)row * ldc + col0;
#pragma unroll
                for (int bj = 0; bj < 2; ++bj) { const f32x4 v0 = acc[ai][bj][m][0] * s, v1 = acc[ai][bj][m][1] * s;
                    u32x4 w; w.x = cvt_pk_bf16(v0[0], v0[1]); w.y = cvt_pk_bf16(v0[2], v0[3]); w.z = cvt_pk_bf16(v1[0], v1[1]); w.w = cvt_pk_bf16(v1[2], v1[3]);
                    *(u32x4*)(rowp + bj * HALF) = w; } }
    }
};
struct EpiF32Ssq {
    static constexpr bool PERM = false, AFTER_DRAIN = false, HAS_KSEG = false;
    float* C; int ldc; float* ssq;
    __device__ __forceinline__ void operator()(const f32x4 (&acc)[2][2][4][2], const Unit& u, int wr, int wc, int fr, int fq) const {
        const int row0 = u.pm * BM + wr * 64 + fr, col0 = u.pn * BM + wc * 32 + 4 * fq;
#pragma unroll
        for (int ai = 0; ai < 2; ++ai)
#pragma unroll
            for (int m = 0; m < 4; ++m) { const int row = row0 + ai * HALF + m * 16; float* rowp = C + (size_t)row * ldc + col0; float q = 0.f;
#pragma unroll
                for (int bj = 0; bj < 2; ++bj)
#pragma unroll
                    for (int n = 0; n < 2; ++n) { const f32x4 v = acc[ai][bj][m][n]; *(f32x4*)(rowp + bj * HALF + n * 16) = v; q += (v[0] * v[0] + v[1] * v[1]) + (v[2] * v[2] + v[3] * v[3]); }
                q += __shfl_xor(q, 16); q += __shfl_xor(q, 32);
                if (fq == 0) ssq[(size_t)row * 32 + u.pn * 4 + wc] = q; }
    }
};

struct EpiBf16Ssq {
    static constexpr bool PERM = true, AFTER_DRAIN = false, HAS_KSEG = false;
    bf16_t* O; int ldc; float* ssq;
    __device__ __forceinline__ void operator()(const f32x4 (&acc)[2][2][4][2], const Unit& u, int wr, int wc, int fr, int fq) const {
        const int row0 = u.pm * BM + wr * 64 + fr, col0 = u.pn * BM + wc * 32 + 8 * fq;
#pragma unroll
        for (int ai = 0; ai < 2; ++ai)
#pragma unroll
            for (int m = 0; m < 4; ++m) { const int row = row0 + ai * HALF + m * 16; bf16_t* rowp = O + (size_t)row * ldc + col0; float q = 0.f;
#pragma unroll
                for (int bj = 0; bj < 2; ++bj) { const f32x4 v0 = acc[ai][bj][m][0], v1 = acc[ai][bj][m][1];
                    q += ((v0[0] * v0[0] + v0[1] * v0[1]) + (v0[2] * v0[2] + v0[3] * v0[3])) + ((v1[0] * v1[0] + v1[1] * v1[1]) + (v1[2] * v1[2] + v1[3] * v1[3]));
                    u32x4 w; w.x = cvt_pk_bf16(v0[0], v0[1]); w.y = cvt_pk_bf16(v0[2], v0[3]); w.z = cvt_pk_bf16(v1[0], v1[1]); w.w = cvt_pk_bf16(v1[2], v1[3]);
                    *(u32x4*)(rowp + bj * HALF) = w; }
                q += __shfl_xor(q, 16); q += __shfl_xor(q, 32);
                if (fq == 0) ssq[(size_t)row * 32 + u.pn * 4 + wc] = q; }
    }
};
template <int CTRL> __device__ __forceinline__ float dppf(float old, float src) { return __builtin_bit_cast(float, __builtin_amdgcn_update_dpp(__builtin_bit_cast(int, old), __builtin_bit_cast(int, src), CTRL, 0xF, 0xF, false)); }
struct EpiUpAct {
    static constexpr bool PERM = true, AFTER_DRAIN = false, HAS_KSEG = false;
    bf16_t* ACT; bf16_t* UP; bf16_t* SIDE; const float* rs; const float* cw; const float* cb; int dff;
    PG8_LAS float* wlds;
    __device__ __forceinline__ void operator()(const f32x4 (&acc)[2][2][4][2], const Unit& u, int wr, int wc, int fr, int fq) const {
        const int row0 = u.pm * BM + wr * 64 + fr, cbase = u.pn * HALF + wc * 32 + 8 * fq, dup = 2 * dff;
        if (u.pm >= 64) {
#pragma unroll
            for (int ai = 0; ai < 2; ++ai)
#pragma unroll
                for (int m = 0; m < 4; ++m) { const int row = row0 + ai * HALF + m * 16; const float s = rs[row];
#pragma unroll
                    for (int bj = 0; bj < 2; ++bj) { const f32x4 v0 = acc[ai][bj][m][0] * s, v1 = acc[ai][bj][m][1] * s;
                        u32x4 w; w.x = cvt_pk_bf16(v0[0], v0[1]); w.y = cvt_pk_bf16(v0[2], v0[3]); w.z = cvt_pk_bf16(v1[0], v1[1]); w.w = cvt_pk_bf16(v1[2], v1[3]);
                        *(u32x4*)(UP + (size_t)row * dup + bj * dff + cbase) = w; } }
            return;
        }
        typedef unsigned u32x2 __attribute__((ext_vector_type(2)));
        PG8_LAS float* wl = wlds + (wr * 4 + wc) * 256;
        int fro = fr, fqo = fq; asm volatile("" : "+v"(fro), "+v"(fqo));
        { const int lane = fqo * 16 + fro, kind = lane >> 3, j0 = (lane & 7) * 4; const int k3 = kind & 3;
          const float* srcp = (k3 < 3 ? cw + (size_t)k3 * dup : cb) + (kind >> 2) * dff + u.pn * HALF + wc * 32 + j0;
          *(PG8_LAS f32x4*)(wl + kind * 32 + j0) = *(const f32x4*)srcp; }
        asm volatile("s_waitcnt lgkmcnt(0)" ::: "memory");
#pragma unroll
        for (int n = 0; n < 2; ++n) { const int c = cbase + 4 * n; const PG8_LAS float* wq = wl + 8 * fqo + 4 * n;
#pragma unroll
            for (int ai = 0; ai < 2; ++ai) { const int kb = u.pm * 4 + ai * 2 + wr; float sp = 0.f;
#pragma unroll
                for (int m = 0; m < 4; ++m) { const int row = row0 + ai * HALF + m * 16; const float s = rs[row];
                    const f32x4 g = acc[ai][0][m][n] * s, v = acc[ai][1][m][n] * s; f32x4 o;
                    const f32x4 gp = acc[ai][0][m > 0 ? m - 1 : 0][n] * sp, vp = acc[ai][1][m > 0 ? m - 1 : 0][n] * sp;
#pragma unroll
                    for (int e = 0; e < 4; ++e) {
                        const float p1g = dppf<0x111>(dppf<0x121>(0.f, gp[e]), g[e]), p2g = dppf<0x112>(dppf<0x122>(0.f, gp[e]), g[e]);
                        const float p1v = dppf<0x111>(dppf<0x121>(0.f, vp[e]), v[e]), p2v = dppf<0x112>(dppf<0x122>(0.f, vp[e]), v[e]);
                        const float gg = wq[96 + e] + wq[e] * p2g + wq[32 + e] * p1g + wq[64 + e] * g[e], vv = wq[224 + e] + wq[128 + e] * p2v + wq[160 + e] * p1v + wq[192 + e] * v[e];
                        o[e] = gg * __builtin_amdgcn_rcpf(1.f + __expf(-gg)) * vv; }
                    const bool head = (m == 0) && (fr < 2);
                    if (!head) { u32x2 w; w.x = cvt_pk_bf16(o[0], o[1]); w.y = cvt_pk_bf16(o[2], o[3]); *(u32x2*)(ACT + (size_t)row * dff + c) = w; }
                    if (head || ((m == 3) && (fr >= 14))) { const int slot = head ? fr : fr - 12; bf16_t* sp = SIDE + ((size_t)kb * 4 + slot) * dup + c;
                        u32x2 wg; wg.x = cvt_pk_bf16(g[0], g[1]); wg.y = cvt_pk_bf16(g[2], g[3]); *(u32x2*)sp = wg;
                        u32x2 wv; wv.x = cvt_pk_bf16(v[0], v[1]); wv.y = cvt_pk_bf16(v[2], v[3]); *(u32x2*)(sp + dff) = wv; }
                    sp = s; asm volatile("" ::: "memory"); } } }
    }
};
struct FactorOrder : StaticOrder {
    const float* ssqh; PG8_LAS float* ft; int wave0; float eps;
    __device__ __forceinline__ void a_ready(const Unit& u) const {
        const int t = wave0 * 64 + lane_id();
        if (t < 256) { const float* p = ssqh + (size_t)(u.pm * BM + t) * 32; float s0 = 0.f, s1 = 0.f;
#pragma unroll
            for (int i = 0; i < 4; ++i) { const f32x4 a = *(const f32x4*)(p + 4 * i), b = *(const f32x4*)(p + 16 + 4 * i); s0 += (a[0] + a[1]) + (a[2] + a[3]); s1 += (b[0] + b[1]) + (b[2] + b[3]); }
            const float r0 = rsqrtf(s0 * (1.f / 1024.f) + eps), r1 = rsqrtf(s1 * (1.f / 1024.f) + eps);
            *(PG8_LAS f32x4*)(ft + ((u.seq & 1) * 256 + t) * 4) = (f32x4){1.f / r0, r0 / r1, r1, 0.f}; }
    }
};
struct EpiBf16SsqG {
    static constexpr bool PERM = true, AFTER_DRAIN = false, HAS_KSEG = true;
    bf16_t* O; int ldc; float* ssq; const PG8_LAS float* ft; int t1, t2;
    __device__ __forceinline__ void kseg(f32x4 (&acc)[2][2][4][2], const Unit& u, int t, int wr, int fr) const {
        if (t == t1 || t == t2) { const int sel = (t == t1) ? 0 : 1; const PG8_LAS float* f = ft + ((u.seq & 1) * 256 + wr * 64 + fr) * 4 + sel;
#pragma unroll
            for (int ai = 0; ai < 2; ++ai)
#pragma unroll
                for (int m = 0; m < 4; ++m) { const float s = f[(ai * HALF + m * 16) * 4];
#pragma unroll
                    for (int bj = 0; bj < 2; ++bj)
#pragma unroll
                        for (int n = 0; n < 2; ++n) acc[ai][bj][m][n] = acc[ai][bj][m][n] * s; } }
    }
    __device__ __forceinline__ void operator()(const f32x4 (&acc)[2][2][4][2], const Unit& u, int wr, int wc, int fr, int fq) const {
        const int row0 = u.pm * BM + wr * 64 + fr, col0 = u.pn * BM + wc * 32 + 8 * fq; const PG8_LAS float* f = ft + ((u.seq & 1) * 256 + wr * 64 + fr) * 4 + 2;
#pragma unroll
        for (int ai = 0; ai < 2; ++ai)
#pragma unroll
            for (int m = 0; m < 4; ++m) { const int row = row0 + ai * HALF + m * 16; bf16_t* rowp = O + (size_t)row * ldc + col0; float q = 0.f; const float s = f[(ai * HALF + m * 16) * 4];
#pragma unroll
                for (int bj = 0; bj < 2; ++bj) { const f32x4 v0 = acc[ai][bj][m][0] * s, v1 = acc[ai][bj][m][1] * s;
                    q += ((v0[0] * v0[0] + v0[1] * v0[1]) + (v0[2] * v0[2] + v0[3] * v0[3])) + ((v1[0] * v1[0] + v1[1] * v1[1]) + (v1[2] * v1[2] + v1[3] * v1[3]));
                    u32x4 w; w.x = cvt_pk_bf16(v0[0], v0[1]); w.y = cvt_pk_bf16(v0[2], v0[3]); w.z = cvt_pk_bf16(v1[0], v1[1]); w.w = cvt_pk_bf16(v1[2], v1[3]);
                    *(u32x4*)(rowp + bj * HALF) = w; }
                q += __shfl_xor(q, 16); q += __shfl_xor(q, 32);
                if (fq == 0) ssq[(size_t)row * 32 + u.pn * 4 + wc] = q; }
    }
};
struct EpiF32Slab {
    static constexpr bool PERM = false, AFTER_DRAIN = false, HAS_KSEG = false;
    float* C; int ldc, Mrows;
    __device__ __forceinline__ void operator()(const f32x4 (&acc)[2][2][4][2], const Unit& u, int wr, int wc, int fr, int fq) const {
        const int row0 = u.pm * BM + wr * 64 + fr, col0 = u.pn * BM + wc * 32 + 4 * fq; float* base = C + (size_t)u.ks * Mrows * ldc;
#pragma unroll
        for (int ai = 0; ai < 2; ++ai)
#pragma unroll
            for (int m = 0; m < 4; ++m) { float* rowp = base + (size_t)(row0 + ai * HALF + m * 16) * ldc + col0;
#pragma unroll
                for (int bj = 0; bj < 2; ++bj)
#pragma unroll
                    for (int n = 0; n < 2; ++n) *(f32x4*)(rowp + bj * HALF + n * 16) = acc[ai][bj][m][n]; }
    }
};
template <class Epi, class Sched, bool ALIGN_EPI = false, bool SP2 = false>
__device__ __forceinline__ void gemm_phase(PG8_LAS unsigned char* lds, const Gemm g, const Sched& S, const Epi& E, int wave_id) {
    int tid_ = wave_id * 64 + lane_id(); asm volatile("" : "+v"(tid_));
    const int tid = tid_, wid = __builtin_amdgcn_readfirstlane(tid >> 6), lane = tid & 63, wr = wid >> 2, wc = wid & 3, fr = lane & 15, fq = lane >> 4;
    const int K = g.K, nt = K / BK;
    unsigned voffA[2], voffB[2];
#pragma unroll
    for (int i = 0; i < 2; ++i) { int R, C; stage_rc(tid * 16 + i * 8192, R, C); const int Rb = Epi::PERM ? ((R & ~31) + perm32(R & 31)) : R;
        voffA[i] = (unsigned)(R * g.lda + C) * 2u; voffB[i] = (unsigned)(Rb * g.ldb + C) * 2u; }
    const size_t kstep = (size_t)(BK * 2);
    const size_t hstepA = (size_t)HALF * g.lda * 2, hstepB = (size_t)HALF * g.ldb * 2;
    const size_t tstepA = 2 * hstepA, tstepB = 2 * hstepB;
    const unsigned ldsw = (unsigned)wid * 1024u;
    const int aoff = lds_byte(wr * 64 + fr, fq * 8), boff = lds_byte(wc * 32 + fr, fq * 8);
#define PG8_SA(b, h) (((b) * 2 + (h)) * HTB)
#define PG8_SB(b, h) ((4 + (b) * 2 + (h)) * HTB)
#define PG8_STAGE(bufoff, gbase, voff) do { _Pragma("unroll") for (int _i = 0; _i < 2; ++_i) \
        __builtin_amdgcn_global_load_lds((const unsigned*)((const char*)(gbase) + (voff)[_i]), (PG8_LAS unsigned*)(lds + (bufoff) + ldsw + _i * 8192), 16, 0, 0); } while (0)
#define PG8_LDA(dst, b, h) do { _Pragma("unroll") for (int m = 0; m < 4; ++m) _Pragma("unroll") for (int k = 0; k < 2; ++k) dst[m][k] = *(const PG8_LAS bf16x8*)(lds + PG8_SA(b, h) + aoff + m * 2048 + k * 1024); } while (0)
#define PG8_LDB(dst, b, h) do { _Pragma("unroll") for (int n = 0; n < 2; ++n) _Pragma("unroll") for (int k = 0; k < 2; ++k) dst[n][k] = *(const PG8_LAS bf16x8*)(lds + PG8_SB(b, h) + boff + n * 2048 + k * 1024); } while (0)
#define PG8_MMA(ai, bj, At, Bt) do { __builtin_amdgcn_s_setprio(1); _Pragma("unroll") for (int m = 0; m < 4; ++m) _Pragma("unroll") for (int n = 0; n < 2; ++n) _Pragma("unroll") for (int k = 0; k < 2; ++k) \
        acc[ai][bj][m][n] = __builtin_amdgcn_mfma_f32_16x16x32_bf16(Bt[n][k], At[m][k], acc[ai][bj][m][n], 0, 0, 0); __builtin_amdgcn_s_setprio(0); } while (0)
#define PG8_WAIT_V(n) asm volatile("s_waitcnt vmcnt(" #n ")" ::: "memory")
#define PG8_WAIT_L(n) asm volatile("s_waitcnt lgkmcnt(" #n ")" ::: "memory")
#define PG8_BAR __builtin_amdgcn_s_barrier()
#define PG8_SCHED __builtin_amdgcn_sched_barrier(0)
    Unit cur, nxt; int ui = 0;
    if (!S.next(0, cur)) return;
    f32x4 acc[2][2][4][2];
#pragma unroll
    for (int a = 0; a < 2; ++a)
#pragma unroll
        for (int b = 0; b < 2; ++b)
#pragma unroll
            for (int m = 0; m < 4; ++m)
#pragma unroll
                for (int n = 0; n < 2; ++n) acc[a][b][m][n] = (f32x4){0.f, 0.f, 0.f, 0.f};
    bf16x8 At[4][2], B0[2][2], B1[2][2];
    const size_t ksb = (size_t)g.kslice * 2;
    const char* cA = (const char*)g.A + (size_t)cur.pm * tstepA + cur.ks * ksb; const char* cB = (const char*)g.Bt + (size_t)cur.pn * tstepB + cur.ks * ksb;
    S.a_ready(cur);
    if constexpr (SP2) {
        PG8_STAGE(PG8_SB(0, 0), cB, voffB); PG8_STAGE(PG8_SB(0, 1), cB + hstepB, voffB); PG8_STAGE(PG8_SA(0, 0), cA, voffA); PG8_STAGE(PG8_SA(0, 1), cA + hstepA, voffA);
        if (wr == 1) PG8_BAR;
        PG8_WAIT_V(2); PG8_BAR;
        PG8_STAGE(PG8_SB(1, 0), cB + kstep, voffB); PG8_STAGE(PG8_SA(1, 0), cA + kstep, voffA); PG8_STAGE(PG8_SB(1, 1), cB + hstepB + kstep, voffB);
        PG8_WAIT_V(6); PG8_BAR;
    } else {
        PG8_STAGE(PG8_SB(0, 0), cB, voffB); PG8_STAGE(PG8_SA(0, 0), cA, voffA); PG8_STAGE(PG8_SB(0, 1), cB + hstepB, voffB); PG8_STAGE(PG8_SA(0, 1), cA + hstepA, voffA);
        if (wr == 1) PG8_BAR;
        PG8_WAIT_V(4); PG8_BAR;
        PG8_STAGE(PG8_SB(1, 0), cB + kstep, voffB); PG8_STAGE(PG8_SA(1, 0), cA + kstep, voffA); PG8_STAGE(PG8_SB(1, 1), cB + hstepB + kstep, voffB);
        PG8_WAIT_V(6); PG8_BAR;
    }
    for (;;) {
        const bool has_next = S.next(ui + 1, nxt);
        const char* nA = has_next ? (const char*)g.A + (size_t)nxt.pm * tstepA + nxt.ks * ksb : cA; const char* nB = has_next ? (const char*)g.Bt + (size_t)nxt.pn * tstepB + nxt.ks * ksb : cB;
        for (int t = 0; t < nt; t += 2) {
            const bool last = (t == nt - 2);
            if constexpr (Epi::HAS_KSEG) E.kseg(acc, cur, t, wr, fr);
            const char* a1 = cA + (size_t)(t + 1) * kstep;
            const char* a2 = last ? nA : cA + (size_t)(t + 2) * kstep; const char* b2 = last ? nB : cB + (size_t)(t + 2) * kstep;
            const char* a3 = a2 + kstep; const char* b3 = b2 + kstep;
            if (last && has_next) S.a_ready(nxt);
            if constexpr (SP2) {
            PG8_LDB(B0, 0, 0); PG8_LDB(B1, 0, 1); PG8_SCHED; PG8_LDA(At, 0, 0); PG8_STAGE(PG8_SA(1, 1), a1 + hstepA, voffA);
            PG8_WAIT_V(8); PG8_WAIT_L(0); PG8_BAR; PG8_MMA(0, 0, At, B0); PG8_MMA(0, 1, At, B1); PG8_BAR; PG8_SCHED;
            PG8_LDA(At, 0, 1); PG8_STAGE(PG8_SB(0, 0), b2, voffB); PG8_STAGE(PG8_SB(0, 1), b2 + hstepB, voffB); PG8_STAGE(PG8_SA(0, 0), a2, voffA);
            PG8_WAIT_V(8); PG8_WAIT_L(0); PG8_BAR; PG8_MMA(1, 0, At, B0); PG8_MMA(1, 1, At, B1); PG8_BAR; PG8_SCHED;
            PG8_LDB(B0, 1, 0); PG8_LDB(B1, 1, 1); PG8_SCHED; PG8_LDA(At, 1, 0); PG8_STAGE(PG8_SA(0, 1), a2 + hstepA, voffA);
            PG8_WAIT_V(8); PG8_WAIT_L(0); PG8_BAR; PG8_MMA(0, 0, At, B0); PG8_MMA(0, 1, At, B1); PG8_BAR; PG8_SCHED;
            PG8_LDA(At, 1, 1); PG8_STAGE(PG8_SB(1, 0), b3, voffB); PG8_STAGE(PG8_SB(1, 1), b3 + hstepB, voffB); PG8_STAGE(PG8_SA(1, 0), a3, voffA);
            PG8_WAIT_V(8); PG8_WAIT_L(0); PG8_BAR; PG8_MMA(1, 0, At, B0); PG8_MMA(1, 1, At, B1); PG8_BAR; PG8_SCHED;
            } else {
            PG8_LDB(B0, 0, 0); PG8_SCHED; PG8_LDA(At, 0, 0); PG8_STAGE(PG8_SA(1, 1), a1 + hstepA, voffA);
            PG8_WAIT_L(8); PG8_BAR; PG8_WAIT_L(0); PG8_MMA(0, 0, At, B0); PG8_BAR; PG8_SCHED;
            PG8_LDB(B1, 0, 1); PG8_STAGE(PG8_SB(0, 0), b2, voffB);
            PG8_BAR; PG8_WAIT_L(0); PG8_MMA(0, 1, At, B1); PG8_BAR;
            PG8_LDA(At, 0, 1); PG8_STAGE(PG8_SA(0, 0), a2, voffA);
            PG8_BAR; PG8_WAIT_L(0); PG8_MMA(1, 0, At, B0); PG8_BAR; PG8_SCHED;
            PG8_STAGE(PG8_SB(0, 1), b2 + hstepB, voffB);
            PG8_WAIT_V(6); PG8_BAR; PG8_MMA(1, 1, At, B1); PG8_BAR;
            PG8_LDB(B0, 1, 0); PG8_SCHED; PG8_LDA(At, 1, 0); PG8_STAGE(PG8_SA(0, 1), a2 + hstepA, voffA);
            PG8_WAIT_L(8); PG8_BAR; PG8_WAIT_L(0); PG8_MMA(0, 0, At, B0); PG8_BAR; PG8_SCHED;
            PG8_LDB(B1, 1, 1); PG8_STAGE(PG8_SB(1, 0), b3, voffB);
            PG8_BAR; PG8_WAIT_L(0); PG8_MMA(0, 1, At, B1); PG8_BAR;
            PG8_LDA(At, 1, 1); PG8_STAGE(PG8_SA(1, 0), a3, voffA);
            PG8_BAR; PG8_WAIT_L(0); PG8_MMA(1, 0, At, B0); PG8_BAR; PG8_SCHED;
            PG8_STAGE(PG8_SB(1, 1), b3 + hstepB, voffB);
            PG8_WAIT_V(6); PG8_BAR; PG8_MMA(1, 1, At, B1); PG8_BAR;
            }
        }
        if constexpr (ALIGN_EPI) { if (wr == 0) PG8_BAR; }
        if constexpr (!Epi::AFTER_DRAIN) { E(acc, cur, wr, wc, fr, fq); S.done(cur); }
        if (!has_next) break;
#pragma unroll
        for (int a = 0; a < 2; ++a)
#pragma unroll
            for (int b = 0; b < 2; ++b)
#pragma unroll
                for (int m = 0; m < 4; ++m)
#pragma unroll
                    for (int n = 0; n < 2; ++n) acc[a][b][m][n] = (f32x4){0.f, 0.f, 0.f, 0.f};
        cur = nxt; cA = nA; cB = nB; ++ui;
        if constexpr (ALIGN_EPI) { if (wr == 1) PG8_BAR; }
    }
    PG8_WAIT_V(0);
    if constexpr (!ALIGN_EPI) { if (wr == 0) PG8_BAR; }
    PG8_BAR;
#undef PG8_SA
#undef PG8_SB
#undef PG8_STAGE
#undef PG8_LDA
#undef PG8_LDB
#undef PG8_MMA
#undef PG8_WAIT_V
#undef PG8_WAIT_L
#undef PG8_BAR
#undef PG8_SCHED
}
}

constexpr int NWAVES = 8, NTHR = 512;
constexpr int DM = 2048, SEQ = 2048, NB_P = 8, NB_S = 32, SEQ_S = 32, DEPTH = 4;
constexpr int MP = NB_P * SEQ, MS = NB_S * SEQ_S, M = MP + MS;
constexpr int D_POOL = 1024, POOL_HIST = 15, D_SSD = 2048, HD = 64, NH = 32, HPG = 16, DS = 128, CONV_DIM = 2560, D_MIX = 3072;
constexpr int D_IN = 5664, N_PROJ = 5632, N_INP = 5888, D_FF = 5632, D_UP = 11264;
constexpr int XBC0 = 3072;
constexpr float EPS = 1e-6f;

constexpr size_t O_YP = 0, O_YS = O_YP + (size_t)MP * DM, O_POOLP = O_YS + (size_t)MS * DM, O_POOLS = O_POOLP + (size_t)DEPTH * NB_P * 15 * 1024,
    O_SCP = O_POOLS + (size_t)DEPTH * NB_S * 15 * 1024, O_SCS = O_SCP + (size_t)DEPTH * NB_P * 3 * 2560, O_SSDP = O_SCS + (size_t)DEPTH * NB_S * 3 * 2560,
    O_SSDS = O_SSDP + (size_t)DEPTH * NB_P * 32 * 64 * 128, O_FCP = O_SSDS + (size_t)DEPTH * NB_S * 32 * 64 * 128, O_FCS = O_FCP + (size_t)DEPTH * NB_P * 2 * 11264,
    O_END = O_FCS + (size_t)DEPTH * NB_S * 2 * 11264;

constexpr size_t al256(size_t x) { return (x + 255) & ~(size_t)255; }
constexpr size_t WS_CTL = 0, CTL_BYTES = 1u << 20;
constexpr size_t WS_BTIN = CTL_BYTES;
constexpr int DMP = DM + 64;
constexpr size_t WS_BTOUT = WS_BTIN + (size_t)DEPTH * N_INP * DMP * 2;
constexpr size_t WS_BTUP = WS_BTOUT + (size_t)DEPTH * DM * D_MIX * 2;
constexpr size_t WS_BTDN = WS_BTUP + (size_t)DEPTH * D_UP * DMP * 2;
constexpr size_t WS_WOP = WS_BTDN + (size_t)DEPTH * DM * D_FF * 2;
constexpr size_t WS_WPB = WS_WOP + (size_t)DEPTH * DM * D_POOL * 2;
constexpr size_t WS_X = WS_WPB + (size_t)DEPTH * 4 * 256 * 256 * 2;
constexpr size_t WS_ACTX = WS_X;
constexpr size_t WS_XB = WS_X + (size_t)M * DM * 4;
constexpr size_t WS_R = WS_XB + (size_t)M * DMP * 2;
constexpr size_t WS_DT = WS_R + al256((size_t)M * 4);
constexpr size_t WS_SSQP = WS_DT + (size_t)M * 32 * 4;
constexpr size_t WS_SSQH = WS_SSQP + (size_t)M * 32 * 4;
constexpr size_t WS_ACT = WS_SSQH + (size_t)M * 32 * 4;
constexpr size_t WS_RA = WS_ACT + (size_t)M * D_FF * 2;
constexpr size_t WS_PROJ = WS_RA;
constexpr size_t WS_MIXA = WS_PROJ + (size_t)M * N_PROJ * 2;
constexpr size_t WS_MIX = WS_MIXA + (size_t)M * D_MIX * 2;
constexpr size_t WS_UP = WS_RA;
constexpr int KS_OUT = 6, KS_DN = 4;
constexpr size_t WS_SLAB = WS_MIX + (size_t)M * DM * 4;
constexpr size_t WS_SIDE = WS_SLAB + (size_t)8 * MS * DM * 4;
constexpr size_t WS_END = WS_SIDE + (size_t)(MP / 64) * 4 * D_UP * 2;
static_assert((size_t)M * D_UP * 2 <= WS_END - WS_RA, "UP fits region A");

constexpr int RING_BYTES = 131072, LDSCTL_OFF = RING_BYTES, LDS_BYTES = 147456;

#define LAS __attribute__((address_space(3)))
typedef unsigned short bf16;
typedef float f32x4 __attribute__((ext_vector_type(4)));
#define RLX_AGENT __ATOMIC_RELAXED, __HIP_MEMORY_SCOPE_AGENT
__device__ __forceinline__ unsigned f2bf(float f) { unsigned u = __builtin_bit_cast(unsigned, f); return (u + 0x7fffu + ((u >> 16) & 1u)) >> 16; }
__device__ __forceinline__ unsigned pk2(float lo, float hi) { unsigned r; asm("v_cvt_pk_bf16_f32 %0, %1, %2" : "=v"(r) : "v"(lo), "v"(hi)); return r; }
__device__ __forceinline__ float bflo(unsigned u) { return __uint_as_float(u << 16); }
__device__ __forceinline__ float bfhi(unsigned u) { return __uint_as_float(u & 0xffff0000u); }
__device__ __forceinline__ float bf2f(bf16 b) { return __uint_as_float(((unsigned)b) << 16); }
struct F8 { float v[8]; };
__device__ __forceinline__ F8 ld_bf8(const bf16* p) { const uint4 u = *(const uint4*)p; F8 r; r.v[0] = bflo(u.x); r.v[1] = bfhi(u.x); r.v[2] = bflo(u.y); r.v[3] = bfhi(u.y); r.v[4] = bflo(u.z); r.v[5] = bfhi(u.z); r.v[6] = bflo(u.w); r.v[7] = bfhi(u.w); return r; }
__device__ __forceinline__ F8 unpack8(const uint4 u) { F8 r; r.v[0] = bflo(u.x); r.v[1] = bfhi(u.x); r.v[2] = bflo(u.y); r.v[3] = bfhi(u.y); r.v[4] = bflo(u.z); r.v[5] = bfhi(u.z); r.v[6] = bflo(u.w); r.v[7] = bfhi(u.w); return r; }
__device__ __forceinline__ F8 ld_f8(const float* p) { const float4 a = *(const float4*)p, b = *(const float4*)(p + 4); F8 r; r.v[0] = a.x; r.v[1] = a.y; r.v[2] = a.z; r.v[3] = a.w; r.v[4] = b.x; r.v[5] = b.y; r.v[6] = b.z; r.v[7] = b.w; return r; }
__device__ __forceinline__ F8 zero8() { F8 r;
#pragma unroll
    for (int i = 0; i < 8; ++i) r.v[i] = 0.f; return r; }
__device__ __forceinline__ void st_bf8(bf16* p, const F8& r) { uint4 u; u.x = pk2(r.v[0], r.v[1]); u.y = pk2(r.v[2], r.v[3]); u.z = pk2(r.v[4], r.v[5]); u.w = pk2(r.v[6], r.v[7]); *(uint4*)p = u; }
__device__ __forceinline__ void st_f8(float* p, const F8& r) { *(float4*)p = make_float4(r.v[0], r.v[1], r.v[2], r.v[3]); *(float4*)(p + 4) = make_float4(r.v[4], r.v[5], r.v[6], r.v[7]); }
__device__ __forceinline__ float silu_f(float x) { return x * __builtin_amdgcn_rcpf(1.f + __expf(-x)); }
__device__ __forceinline__ float wave_sum(float v) {
#pragma unroll
    for (int o = 1; o < 64; o <<= 1) v += __shfl_xor(v, o);
    return v;
}

#define XB_TMO      128
#define XB_XCNT(j)  (256  + 64 * (j))
#define XB_XSUB(j)  (1280 + 64 * (j))
#define XB_XGEN(j)  (2304 + 64 * (j))
#define XB_TOP      3328
#define XB_TOPGEN   3392
#define XCD_BAR_WORDS 3456
#define XB_SPIN_CAP (1u << 18)
__device__ __forceinline__ unsigned xb_ld(unsigned* p)              { return __hip_atomic_load(p, __ATOMIC_RELAXED, __HIP_MEMORY_SCOPE_AGENT); }
__device__ __forceinline__ unsigned xb_add(unsigned* p, unsigned v) { return __hip_atomic_fetch_add(p, v, __ATOMIC_RELAXED, __HIP_MEMORY_SCOPE_AGENT); }
__device__ __forceinline__ unsigned xb_xcc_id() { return (unsigned)__builtin_amdgcn_s_getreg((3 << 11) | 20) & 0xFu; }
#define XB_SPIN(cond, bar) do { unsigned _sp = 0; while (cond) { __builtin_amdgcn_s_sleep(1); \
    if ((++_sp & 255u) == 0u) { if (xb_ld(&(bar)[XB_TMO])) break; if (_sp > XB_SPIN_CAP) { atomicAdd(&(bar)[XB_TMO], 1u); break; } } } } while (0)
struct XcdBarrier { unsigned* bar; unsigned x; volatile LAS unsigned* st; };
__device__ __forceinline__ XcdBarrier xcd_barrier_post(unsigned* bar, volatile LAS unsigned* st, bool lead) {
    XcdBarrier b; b.bar = bar; b.x = xb_xcc_id(); b.st = st;
    if (lead) (void)xb_add(&bar[XB_XCNT(b.x)], 1u);
    return b;
}
__device__ __forceinline__ void xcd_barrier_complete(unsigned* bar, unsigned x, unsigned& nloc, unsigned& nx) {
    const unsigned G = gridDim.x * gridDim.y * gridDim.z;
    unsigned sum, cnt, mine, sp = 0u;
    for (;;) {
        sum = 0u; cnt = 0u; mine = 0u;
#pragma unroll
        for (unsigned j = 0; j < 16; ++j) { const unsigned c = xb_ld(&bar[XB_XCNT(j)]); sum += c; cnt += (c > 0u) ? 1u : 0u; mine = (j == x) ? c : mine; }
        if (sum == G) break;
        __builtin_amdgcn_s_sleep(1);
        if ((++sp & 255u) == 0u) { if (xb_ld(&bar[XB_TMO])) break; if (sp > XB_SPIN_CAP) { atomicAdd(&bar[XB_TMO], 1u); break; } }
    }
    nloc = mine > 0u ? mine : 1u; nx = cnt > 0u ? cnt : 1u;
}
__device__ __forceinline__ void xcd_barrier(const XcdBarrier& b, bool lead) {
    asm volatile("s_waitcnt vmcnt(0)" ::: "memory");
    __syncthreads();
    if (lead) {
        unsigned* bar = b.bar;
        __builtin_amdgcn_s_waitcnt(0);
        unsigned nloc = b.st[0], nx = b.st[1];
        if (nloc == 0u) { xcd_barrier_complete(bar, b.x, nloc, nx); b.st[0] = nloc; b.st[1] = nx; }
        const unsigned old = xb_add(&bar[XB_XSUB(b.x)], 1u);
        const unsigned gen = old / nloc;
        if (old + 1u == (gen + 1u) * nloc) {
            __builtin_amdgcn_fence(__ATOMIC_RELEASE, "agent");
            asm volatile("s_waitcnt vmcnt(0)" ::: "memory");
            const unsigned og = xb_add(&bar[XB_TOP], 1u);
            const unsigned tg = og / nx;
            if (og + 1u == (tg + 1u) * nx) xb_add(&bar[XB_TOPGEN], 1u);
            else XB_SPIN(xb_ld(&bar[XB_TOPGEN]) == tg, bar);
            __builtin_amdgcn_fence(__ATOMIC_ACQUIRE, "agent");
            xb_add(&bar[XB_XGEN(b.x)], 1u);
            asm volatile("s_waitcnt vmcnt(0)" ::: "memory");
        } else {
            XB_SPIN(xb_ld(&bar[XB_XGEN(b.x)]) == gen, bar);
            __builtin_amdgcn_fence(__ATOMIC_ACQUIRE, "agent");
            asm volatile("s_waitcnt vmcnt(0)" ::: "memory");
        }
    }
    __syncthreads();
}

struct Args { const float* in[24]; float* out; unsigned char* ws; int ph_lo, ph_hi; };

struct Ctx {
    LAS unsigned char* lds; int tid, lane, wave, G, gw, NGW, wave0;
    const float* const* in; float* out; unsigned char* ws;
    __device__ __forceinline__ void refresh() {
        int t = wave0 * 64 + lane_id(); asm volatile("" : "+v"(t)); tid = t; lane = t & 63; wave = __builtin_amdgcn_readfirstlane(t >> 6); gw = blockIdx.x * NWAVES + wave; NGW = G * NWAVES; }
};

constexpr int I_IN = (DM / 64) * (D_IN / 32), I_OUT = (D_MIX / 64) * (DM / 32), I_UP = (DM / 64) * (DM * 0 + D_UP / 32), I_DN = (D_FF / 64) * (DM / 32), I_L = I_IN + I_OUT + I_UP + I_DN;
struct ConvJob { const float* W; const float* gain; bf16* dst; int N, ldd, kb, nb; };
__device__ __forceinline__ ConvJob conv_job(const Ctx& C, int l, int r) {
    ConvJob j;
    if (r < I_IN) { const int nbk = D_IN / 32; j.W = C.in[7] + (size_t)l * DM * D_IN; j.gain = C.in[6] + l * DM; j.dst = (bf16*)(C.ws + WS_BTIN) + (size_t)l * N_INP * DMP; j.N = D_IN; j.ldd = DMP; j.kb = r / nbk; j.nb = r % nbk; return j; }
    r -= I_IN;
    if (r < I_OUT) { const int nbk = DM / 32; j.kb = r / nbk; j.nb = r % nbk; j.W = C.in[16] + (size_t)l * D_MIX * DM; j.N = DM;
        if (j.kb < 16) { j.gain = C.in[9] + l * D_POOL; j.dst = (bf16*)(C.ws + WS_WOP) + (size_t)l * DM * D_POOL; j.ldd = D_POOL; }
        else { j.gain = C.in[15] + l * D_SSD - D_POOL; j.dst = (bf16*)(C.ws + WS_BTOUT) + (size_t)l * DM * D_MIX; j.ldd = D_MIX; }
        return j; }
    r -= I_OUT;
    if (r < I_UP) { const int nbk = D_UP / 32, nb = r % nbk, n0 = 32 * nb, hv = n0 / D_FF, cc = n0 % D_FF, np = 256 * (cc / 128) + 128 * hv + (cc % 128);
        j.W = C.in[19] + (size_t)l * DM * D_UP; j.gain = C.in[18] + l * DM; j.dst = (bf16*)(C.ws + WS_BTUP) + (size_t)l * D_UP * DMP + (long)(np - n0) * DMP; j.N = D_UP; j.ldd = DMP; j.kb = r / nbk; j.nb = nb; return j; }
    r -= I_UP;
    { const int nbk = DM / 32; j.W = C.in[22] + (size_t)l * D_FF * DM; j.gain = nullptr; j.dst = (bf16*)(C.ws + WS_BTDN) + (size_t)l * DM * D_FF; j.N = DM; j.ldd = D_FF; j.kb = r / nbk; j.nb = r % nbk; }
    return j;
}
__device__ __forceinline__ void conv_issue(const ConvJob& j, int lane, float (&wv)[32], float& gl) {
    const int k0 = 64 * j.kb, n0 = 32 * j.nb;
    gl = j.gain ? j.gain[k0 + lane] : 1.f;
#pragma unroll
    for (int i = 0; i < 32; ++i) { const int kk = 2 * i + (lane >> 5); wv[i] = j.W[(size_t)(k0 + kk) * j.N + n0 + (lane & 31)]; }
}
__device__ __forceinline__ void conv_finish(const ConvJob& j, int lane, const float (&wv)[32], float gl, LAS float* scr) {
    const int k0 = 64 * j.kb, n0 = 32 * j.nb; const int gli = __builtin_bit_cast(int, gl);
#pragma unroll
    for (int i = 0; i < 32; ++i) { const int kk = 2 * i + (lane >> 5);
        const float g0 = __builtin_bit_cast(float, __builtin_amdgcn_readlane(gli, 2 * i)), g1 = __builtin_bit_cast(float, __builtin_amdgcn_readlane(gli, 2 * i + 1));
        scr[kk * 33 + (lane & 31)] = wv[i] * (lane < 32 ? g0 : g1); }
    asm volatile("s_waitcnt lgkmcnt(0)" ::: "memory");
    const int c = lane & 7;
#pragma unroll
    for (int jj = 0; jj < 4; ++jj) { const int n = (lane >> 3) + 8 * jj; const LAS float* s = scr + (8 * c) * 33 + n;
        uint4 o; o.x = pk2(s[0 * 33], s[1 * 33]); o.y = pk2(s[2 * 33], s[3 * 33]); o.z = pk2(s[4 * 33], s[5 * 33]); o.w = pk2(s[6 * 33], s[7 * 33]);
        *(uint4*)(j.dst + (size_t)(n0 + n) * j.ldd + k0 + 8 * c) = o; }
    asm volatile("s_waitcnt lgkmcnt(0)" ::: "memory");
}
__device__ __forceinline__ void phase_convert(Ctx C) {
    C.refresh();
    LAS float* scr = (LAS float*)(C.lds + C.wave * 16384);
    for (int it = C.gw; it < I_L; it += C.NGW) { const ConvJob j = conv_job(C, 0, it); float wv[32], gl; conv_issue(j, C.lane, wv, gl); conv_finish(j, C.lane, wv, gl, scr); }
    { const int gt = C.gw * 64 + C.lane, NGT = C.NGW * 64;
      const float* wp = C.in[8]; bf16* wpb = (bf16*)(C.ws + WS_WPB);
      for (int i = gt; i < DEPTH * 4 * 256 * 256 / 8; i += NGT) { const F8 v = ld_f8(wp + (size_t)i * 8); st_bf8(wpb + (size_t)i * 8, v); } }
    for (int row = C.gw; row < M; row += C.NGW) {
        const float* src = row < MP ? C.in[0] + (size_t)row * DM : C.in[1] + (size_t)(row - MP) * DM;
        bf16* XB = (bf16*)(C.ws + WS_XB) + (size_t)row * DMP; float q = 0.f;
#pragma unroll
        for (int j = 0; j < 8; ++j) { const int idx = (C.lane + 64 * j) * 4; const float4 v = *(const float4*)(src + idx); q += (v.x * v.x + v.y * v.y) + (v.z * v.z + v.w * v.w);
            *(uint2*)(XB + idx) = make_uint2(pk2(v.x, v.y), pk2(v.z, v.w)); }
        q = wave_sum(q);
        if (C.lane == 0) ((float*)(C.ws + WS_R))[row] = rsqrtf(q * (1.f / DM) + EPS);
    }
}

__device__ __forceinline__ void phase_dt(Ctx C, int l) {
    C.refresh();
    typedef short bf16x8_t __attribute__((ext_vector_type(8))); typedef unsigned u32x4_t __attribute__((ext_vector_type(4)));
    const bf16* XB = (const bf16*)(C.ws + WS_XB); const bf16* BD = (const bf16*)(C.ws + WS_BTIN) + ((size_t)l * N_INP + N_PROJ) * DMP; const float* R = (const float*)(C.ws + WS_R); float* DT = (float*)(C.ws + WS_DT);
    const int r16 = C.lane & 15, q = C.lane >> 4;
    for (int i = C.tid; i < 32 * (DM / 8); i += NTHR) { const int n = i / (DM / 8), ch = i % (DM / 8);
        const uint4 v = *(const uint4*)(BD + (size_t)n * DMP + ch * 8); *(LAS u32x4_t*)(C.lds + n * 4096 + ((ch ^ (n & 15)) << 4)) = (u32x4_t){v.x, v.y, v.z, v.w}; }
    __syncthreads();
    for (int task = C.gw; task < M / 16; task += C.NGW) {
        const int row0 = task * 16;
        const bf16* ap = XB + (size_t)(row0 + r16) * DMP + 8 * q;
        f32x4 acc0 = (f32x4){0.f, 0.f, 0.f, 0.f}, acc1 = acc0;
#pragma unroll 16
        for (int ks = 0; ks < DM / 32; ++ks) { const bf16x8_t a = *(const bf16x8_t*)(ap + 32 * ks); const int ch = 4 * ks + q;
            acc0 = __builtin_amdgcn_mfma_f32_16x16x32_bf16(a, *(const LAS bf16x8_t*)(C.lds + r16 * 4096 + ((ch ^ r16) << 4)), acc0, 0, 0, 0);
            acc1 = __builtin_amdgcn_mfma_f32_16x16x32_bf16(a, *(const LAS bf16x8_t*)(C.lds + (16 + r16) * 4096 + ((ch ^ r16) << 4)), acc1, 0, 0, 0); }
#pragma unroll
        for (int r = 0; r < 4; ++r) { const int row = row0 + 4 * q + r; const float s = R[row]; DT[(size_t)row * 32 + r16] = acc0[r] * s; DT[(size_t)row * 32 + 16 + r16] = acc1[r] * s; }
    }
    __syncthreads();
}

__device__ __forceinline__ void phase_resid(Ctx C, const float* gpost, bool final_out, int nslab, bool gfold) {
    C.refresh();
    const bf16* MIXB = (const bf16*)(C.ws + WS_MIX); const float* SSQ = (const float*)(C.ws + WS_SSQP); const float* SLAB = (const float*)(C.ws + WS_SLAB);
    for (int row = C.gw; row < M; row += C.NGW) {
        F8 mv[4]; float p; uint4 xq[4];
        bf16* XB = (bf16*)(C.ws + WS_XB) + (size_t)row * DMP;
#pragma unroll
        for (int j = 0; j < 4; ++j) xq[j] = *(const uint4*)(XB + (C.lane + 64 * j) * 8);
        if (row < MP) {
            p = C.lane < 32 ? SSQ[(size_t)row * 32 + C.lane] : 0.f;
#pragma unroll
            for (int j = 0; j < 4; ++j) mv[j] = ld_bf8(MIXB + (size_t)row * DM + (C.lane + 64 * j) * 8);
        } else {
            p = 0.f; float r0 = 1.f, r1 = 1.f;
            if (gfold) { float hs = C.lane < 32 ? ((const float*)(C.ws + WS_SSQH))[(size_t)row * 32 + C.lane] : 0.f;
#pragma unroll
                for (int o = 1; o < 16; o <<= 1) hs += __shfl_xor(hs, o);
                r0 = rsqrtf(__shfl(hs, 0) * (1.f / 1024.f) + EPS); r1 = rsqrtf(__shfl(hs, 16) * (1.f / 1024.f) + EPS); }
#pragma unroll
            for (int j = 0; j < 4; ++j) { F8 a = zero8();
                for (int s = 0; s < nslab; ++s) { const F8 t = ld_f8(SLAB + ((size_t)s * MS + (row - MP)) * DM + (C.lane + 64 * j) * 8); const float sc = gfold ? (s < 2 ? 1.f : (s < 4 ? r0 : r1)) : 1.f;
#pragma unroll
                    for (int k = 0; k < 8; ++k) a.v[k] += t.v[k] * sc; }
                mv[j] = a;
#pragma unroll
                for (int k = 0; k < 8; ++k) p += a.v[k] * a.v[k]; }
        }
        p = wave_sum(p);
        const float rs = rsqrtf(p * (1.f / DM) + EPS);
        float* Y = C.out + O_YP + (size_t)row * DM; float q = 0.f;
#pragma unroll
        for (int j = 0; j < 4; ++j) { const int idx = (C.lane + 64 * j) * 8; const F8 g8 = ld_f8(gpost + idx); F8 v = unpack8(xq[j]);
#pragma unroll
            for (int k = 0; k < 8; ++k) { v.v[k] += mv[j].v[k] * rs * g8.v[k]; q += v.v[k] * v.v[k]; }
            if (final_out) st_f8(Y + idx, v);
            st_bf8(XB + idx, v); }
        q = wave_sum(q);
        if (C.lane == 0) ((float*)(C.ws + WS_R))[row] = rsqrtf(q * (1.f / DM) + EPS);
    }
}

__device__ __forceinline__ void phase_gnorm(Ctx C) {
    C.refresh();
    const float* SSQH = (const float*)(C.ws + WS_SSQH); bf16* MIXA = (bf16*)(C.ws + WS_MIXA);
    for (int rowb = C.gw * 4; rowb < M; rowb += C.NGW * 4) {
        uint4 qv[4][4]; float pr[4];
#pragma unroll
        for (int rr = 0; rr < 4; ++rr) { const int row = rowb + rr; pr[rr] = C.lane < 32 ? SSQH[(size_t)row * 32 + C.lane] : 0.f;
#pragma unroll
            for (int j = 0; j < 4; ++j) qv[rr][j] = *(const uint4*)(MIXA + (size_t)row * D_MIX + D_POOL + (C.lane + 64 * j) * 8); }
#pragma unroll
        for (int rr = 0; rr < 4; ++rr) { const int row = rowb + rr; float p = pr[rr];
#pragma unroll
            for (int o = 1; o < 16; o <<= 1) p += __shfl_xor(p, o);
            const float s0 = __shfl(p, 0), s1 = __shfl(p, 16);
            const float r0 = rsqrtf(s0 * (1.f / 1024.f) + EPS), r1 = rsqrtf(s1 * (1.f / 1024.f) + EPS);
            bf16* y = MIXA + (size_t)row * D_MIX + D_POOL;
#pragma unroll
            for (int j = 0; j < 4; ++j) { const int c = (C.lane + 64 * j) * 8; const float r = c < 1024 ? r0 : r1; F8 v = unpack8(qv[rr][j]);
#pragma unroll
                for (int i = 0; i < 8; ++i) v.v[i] *= r;
                st_bf8(y + c, v); } }
    }
}

__device__ __forceinline__ void phase_act(Ctx C, int l) {
    C.refresh();
    const bf16* UP = (const bf16*)(C.ws + WS_UP); bf16* ACT = (bf16*)(C.ws + WS_ACT);
    const float* cw = C.in[20] + (size_t)l * 3 * D_UP; const float* cb = C.in[21] + (size_t)l * D_UP; const float* hist = C.in[5] + (size_t)l * NB_S * 2 * D_UP;
    constexpr int NCG = D_FF / 8, NPIECE = MS / 8;
    const int gt = C.gw * 64 + C.lane, NGT = C.NGW * 64;
    for (int it = gt; it < NPIECE * NCG; it += NGT) {
        const int piece = it / NCG, c = (it % NCG) * 8, b = piece >> 2, t0 = (piece & 3) * 8, row0 = MP + b * SEQ_S + t0;
        uint4 qg[10], qv[10];
#pragma unroll
        for (int r = 0; r < 10; ++r) { const int rr = (t0 == 0 && r < 2) ? 2 : r; qg[r] = *(const uint4*)(UP + (size_t)(row0 + rr - 2) * D_UP + c); qv[r] = *(const uint4*)(UP + (size_t)(row0 + rr - 2) * D_UP + D_FF + c); }
        const float* h = hist + (size_t)b * 2 * D_UP;
        const F8 h2g = ld_f8(h + c), h2v = ld_f8(h + D_FF + c), h1g = ld_f8(h + D_UP + c), h1v = ld_f8(h + D_UP + D_FF + c);
        const F8 w0g = ld_f8(cw + c), w1g = ld_f8(cw + D_UP + c), w2g = ld_f8(cw + 2 * D_UP + c), bg = ld_f8(cb + c);
        const F8 w0v = ld_f8(cw + D_FF + c), w1v = ld_f8(cw + D_UP + D_FF + c), w2v = ld_f8(cw + 2 * D_UP + D_FF + c), bv = ld_f8(cb + D_FF + c);
        F8 p2g = unpack8(qg[0]), p2v = unpack8(qv[0]), p1g = unpack8(qg[1]), p1v = unpack8(qv[1]);
        if (t0 == 0) { p2g = h2g; p2v = h2v; p1g = h1g; p1v = h1v; }
#pragma unroll
        for (int r = 0; r < 8; ++r) { const F8 cg = unpack8(qg[r + 2]), cv = unpack8(qv[r + 2]); F8 o;
#pragma unroll
            for (int i = 0; i < 8; ++i) { const float g = bg.v[i] + w0g.v[i] * p2g.v[i] + w1g.v[i] * p1g.v[i] + w2g.v[i] * cg.v[i]; const float v = bv.v[i] + w0v.v[i] * p2v.v[i] + w1v.v[i] * p1v.v[i] + w2v.v[i] * cv.v[i]; o.v[i] = silu_f(g) * v; }
            st_bf8(ACT + (size_t)(row0 + r) * D_FF + c, o);
            p2g = p1g; p1g = cg; p2v = p1v; p1v = cv; }
        if (t0 == SEQ_S - 8) {
            float* o = C.out + O_FCS + ((size_t)(l * NB_S + b) * 2) * D_UP;
            st_f8(o + c, p2g); st_f8(o + D_FF + c, p2v); st_f8(o + D_UP + c, p1g); st_f8(o + D_UP + D_FF + c, p1v);
        }
    }
}

__device__ __forceinline__ void phase_actfix(Ctx C, int l) {
    C.refresh();
    const bf16* SIDE = (const bf16*)(C.ws + WS_SIDE); bf16* ACT = (bf16*)(C.ws + WS_ACT);
    const float* cw = C.in[20] + (size_t)l * 3 * D_UP; const float* cb = C.in[21] + (size_t)l * D_UP;
    constexpr int NCG = D_FF / 8, NBLK = MP / 64;
    const int gt = C.gw * 64 + C.lane, NGT = C.NGW * 64;
    for (int it = gt; it < NBLK * NCG; it += NGT) {
        const int kb = it / NCG, c = (it % NCG) * 8; const bool start = (kb % (SEQ / 64)) == 0;
        const bf16* sp = SIDE + (size_t)(start ? kb : kb - 1) * 4 * D_UP + c; const bf16* sc = SIDE + (size_t)kb * 4 * D_UP + c;
        uint4 q[8];
        q[0] = *(const uint4*)(sp + 2 * D_UP); q[1] = *(const uint4*)(sp + 2 * D_UP + D_FF); q[2] = *(const uint4*)(sp + 3 * D_UP); q[3] = *(const uint4*)(sp + 3 * D_UP + D_FF);
        q[4] = *(const uint4*)(sc); q[5] = *(const uint4*)(sc + D_FF); q[6] = *(const uint4*)(sc + D_UP); q[7] = *(const uint4*)(sc + D_UP + D_FF);
        F8 p2g = unpack8(q[0]), p2v = unpack8(q[1]), p1g = unpack8(q[2]), p1v = unpack8(q[3]); const F8 r0g = unpack8(q[4]), r0v = unpack8(q[5]), r1g = unpack8(q[6]), r1v = unpack8(q[7]);
        if (start) { p2g = zero8(); p2v = zero8(); p1g = zero8(); p1v = zero8(); }
        const F8 w0g = ld_f8(cw + c), w1g = ld_f8(cw + D_UP + c), w2g = ld_f8(cw + 2 * D_UP + c), bg = ld_f8(cb + c);
        const F8 w0v = ld_f8(cw + D_FF + c), w1v = ld_f8(cw + D_UP + D_FF + c), w2v = ld_f8(cw + 2 * D_UP + D_FF + c), bv = ld_f8(cb + D_FF + c);
        F8 o0, o1;
#pragma unroll
        for (int i = 0; i < 8; ++i) { const float g0 = bg.v[i] + w0g.v[i] * p2g.v[i] + w1g.v[i] * p1g.v[i] + w2g.v[i] * r0g.v[i], v0 = bv.v[i] + w0v.v[i] * p2v.v[i] + w1v.v[i] * p1v.v[i] + w2v.v[i] * r0v.v[i];
            const float g1 = bg.v[i] + w0g.v[i] * p1g.v[i] + w1g.v[i] * r0g.v[i] + w2g.v[i] * r1g.v[i], v1 = bv.v[i] + w0v.v[i] * p1v.v[i] + w1v.v[i] * r0v.v[i] + w2v.v[i] * r1v.v[i];
            o0.v[i] = silu_f(g0) * v0; o1.v[i] = silu_f(g1) * v1; }
        st_bf8(ACT + (size_t)(kb * 64) * D_FF + c, o0); st_bf8(ACT + (size_t)(kb * 64 + 1) * D_FF + c, o1);
        if ((kb % (SEQ / 64)) == SEQ / 64 - 1) {
            float* o = C.out + O_FCP + ((size_t)(l * NB_P + kb / (SEQ / 64)) * 2) * D_UP;
            st_f8(o + c, ld_bf8(sc + 2 * D_UP)); st_f8(o + D_FF + c, ld_bf8(sc + 2 * D_UP + D_FF)); st_f8(o + D_UP + c, ld_bf8(sc + 3 * D_UP)); st_f8(o + D_UP + D_FF + c, ld_bf8(sc + 3 * D_UP + D_FF)); }
    }
}

__device__ __forceinline__ void phase_pool(Ctx C, int l) {
    C.refresh();
    const bf16* PROJ = (const bf16*)(C.ws + WS_PROJ); bf16* MIXA = (bf16*)(C.ws + WS_MIXA);
    const float* hist = C.in[2] + (size_t)l * NB_S * POOL_HIST * D_POOL;
    constexpr int NCG = D_POOL / 8, NSTRIP = M / 32;
    const int gt = C.gw * 64 + C.lane, NGT = C.NGW * 64;
    for (int it = gt; it < NSTRIP * NCG; it += NGT) {
        const int strip = it / NCG, cgi = it % NCG, c = cgi * 8, row0 = strip * 32; const bool prm = row0 < MP;
        const int b = prm ? row0 / SEQ : (row0 - MP) / SEQ_S, t0 = prm ? row0 % SEQ : 0, w = 2 << (cgi >> 5);
        const int rb = row0 - t0;
        const float* hb = hist + (size_t)b * POOL_HIST * D_POOL;
        F8 s = zero8();
        for (int i = 1; i < w; ++i) { const int t = t0 - i; F8 v;
            if (t >= 0) v = ld_bf8(PROJ + (size_t)(rb + t) * N_PROJ + c); else if (!prm) v = ld_f8(hb + (size_t)(POOL_HIST + t) * D_POOL + c); else v = zero8();
#pragma unroll
            for (int k = 0; k < 8; ++k) s.v[k] += v.v[k]; }
        for (int r0 = 0; r0 < 32; r0 += 8) {
            uint4 qc[8], ql[8];
#pragma unroll
            for (int r = 0; r < 8; ++r) { const int t = t0 + r0 + r, tl = t - w + 1; qc[r] = *(const uint4*)(PROJ + (size_t)(rb + t) * N_PROJ + c); ql[r] = *(const uint4*)(PROJ + (size_t)(rb + (tl > 0 ? tl : 0)) * N_PROJ + c); }
#pragma unroll
            for (int r = 0; r < 8; ++r) { const int t = t0 + r0 + r, tl = t - w + 1; const F8 cur = unpack8(qc[r]);
                const float inv = 1.f / (float)(prm ? (t + 1 < w ? t + 1 : w) : w); F8 o;
#pragma unroll
                for (int k = 0; k < 8; ++k) { s.v[k] += cur.v[k]; o.v[k] = s.v[k] * inv - cur.v[k]; }
                st_bf8(MIXA + (size_t)(rb + t) * D_MIX + c, o);
                F8 v = unpack8(ql[r]);
                if (tl < 0) { if (!prm) v = ld_f8(hb + (size_t)(POOL_HIST + tl) * D_POOL + c); else v = zero8(); }
#pragma unroll
                for (int k = 0; k < 8; ++k) s.v[k] -= v.v[k]; }
        }
    }
    for (int it = gt; it < (NB_P + NB_S) * 15 * NCG; it += NGT) {
        const int cg = it % NCG, i = (it / NCG) % 15, sb = it / (NCG * 15); const bool prm = sb < NB_P; const int b = prm ? sb : sb - NB_P;
        const int row = prm ? b * SEQ + (SEQ - 15 + i) : MP + b * SEQ_S + (SEQ_S - 15 + i);
        float* o = C.out + (prm ? O_POOLP + ((size_t)(l * NB_P + b) * 15 + i) * D_POOL : O_POOLS + ((size_t)(l * NB_S + b) * 15 + i) * D_POOL);
        st_f8(o + cg * 8, ld_bf8(PROJ + (size_t)row * N_PROJ + cg * 8));
    }
    constexpr int NCG2 = CONV_DIM / 8;
    for (int it = gt; it < (NB_P + NB_S) * 3 * NCG2; it += NGT) {
        const int cg = it % NCG2, i = (it / NCG2) % 3, sb = it / (NCG2 * 3); const bool prm = sb < NB_P; const int b = prm ? sb : sb - NB_P;
        const int row = prm ? b * SEQ + (SEQ - 3 + i) : MP + b * SEQ_S + (SEQ_S - 3 + i);
        float* o = C.out + (prm ? O_SCP + ((size_t)(l * NB_P + b) * 3 + i) * CONV_DIM : O_SCS + ((size_t)(l * NB_S + b) * 3 + i) * CONV_DIM);
        st_f8(o + cg * 8, ld_bf8(PROJ + (size_t)row * N_PROJ + XBC0 + cg * 8));
    }
}

__device__ __forceinline__ void phase_ssd(Ctx C, int l) {
    C.refresh();
    LAS float* xs = (LAS float*)(C.lds); LAS float* Bs = (LAS float*)(C.lds + 16384); LAS float* Cs = (LAS float*)(C.lds + 49152); LAS float* ys = (LAS float*)(C.lds + 81920);
    LAS float* dts = (LAS float*)(C.lds + 98304); LAS float* dAs = dts + 64;
    const bf16* PROJ = (const bf16*)(C.ws + WS_PROJ); const float* DT = (const float*)(C.ws + WS_DT); bf16* MIXA = (bf16*)(C.ws + WS_MIXA); float* SSQH = (float*)(C.ws + WS_SSQH);
    const float* cw = C.in[10] + (size_t)l * 4 * CONV_DIM; const float* cb = C.in[11] + (size_t)l * CONV_DIM;
    const int tid = C.tid, p = tid >> 3, n0 = (tid & 7) * 16;
    for (int u = blockIdx.x; u < NB_P * NH + NB_S * NH; u += C.G) {
        const bool prm = u < NB_P * NH; const int su = prm ? u : u - NB_P * NH, b = su / NH, hh = su % NH, g = hh / HPG;
        const int rb = prm ? b * SEQ : MP + b * SEQ_S, rows = prm ? 64 : 32, nchunk = prm ? SEQ / 64 : 1;
        const float Aneg = -__expf(C.in[13][l * NH + hh]), Dsk = C.in[14][l * NH + hh], dtb = C.in[12][l * NH + hh];
        const float* chist = C.in[3] + ((size_t)(l * NB_S + b) * 3) * CONV_DIM;
        float h[16];
        if (prm) {
#pragma unroll
            for (int i = 0; i < 16; ++i) h[i] = 0.f;
        } else { const float* h0 = C.in[4] + ((((size_t)l * NB_S + b) * NH + hh) * HD + p) * DS + n0;
#pragma unroll
            for (int i = 0; i < 4; ++i) { const float4 v = *(const float4*)(h0 + 4 * i); h[4 * i] = v.x; h[4 * i + 1] = v.y; h[4 * i + 2] = v.z; h[4 * i + 3] = v.w; } }
        for (int ch = 0; ch < nchunk; ++ch) {
            const int tb = ch * 64;
            for (int e = tid; e < rows * 40; e += NTHR) {
                const int cg = e % 40, tt = e / 40, t = tb + tt;
                int cc; LAS float* dstp;
                if (cg < 8) { cc = hh * HD + cg * 8; dstp = xs + tt * 64 + cg * 8; }
                else if (cg < 24) { cc = D_SSD + g * DS + (cg - 8) * 8; dstp = Bs + tt * 128 + (cg - 8) * 8; }
                else { cc = D_SSD + 2 * DS + g * DS + (cg - 24) * 8; dstp = Cs + tt * 128 + (cg - 24) * 8; }
                F8 a = ld_f8(cb + cc);
#pragma unroll
                for (int i = 0; i < 4; ++i) { const int ti = t - 3 + i; F8 v;
                    if (ti >= 0) v = ld_bf8(PROJ + (size_t)(rb + ti) * N_PROJ + XBC0 + cc); else if (!prm) v = ld_f8(chist + (size_t)(3 + ti) * CONV_DIM + cc); else v = zero8();
                    const F8 wv = ld_f8(cw + (size_t)i * CONV_DIM + cc);
#pragma unroll
                    for (int k = 0; k < 8; ++k) a.v[k] += wv.v[k] * v.v[k]; }
#pragma unroll
                for (int k = 0; k < 8; ++k) dstp[k] = silu_f(a.v[k]);
            }
            if (tid < rows) { const float xr = DT[(size_t)(rb + tb + tid) * 32 + hh] + dtb; const float dtv = xr > 20.f ? xr : log1pf(__expf(xr)); dts[tid] = dtv; dAs[tid] = __expf(dtv * Aneg); }
            __syncthreads();
            for (int tt = 0; tt < rows; ++tt) {
                const float xv = xs[tt * 64 + p], xdt = xv * dts[tt], dA = dAs[tt]; float acc = 0.f;
#pragma unroll
                for (int i = 0; i < 4; ++i) { const f32x4 bv = *(const LAS f32x4*)(Bs + tt * 128 + n0 + 4 * i), cv = *(const LAS f32x4*)(Cs + tt * 128 + n0 + 4 * i);
                    h[4 * i] = dA * h[4 * i] + xdt * bv[0]; acc += cv[0] * h[4 * i];
                    h[4 * i + 1] = dA * h[4 * i + 1] + xdt * bv[1]; acc += cv[1] * h[4 * i + 1];
                    h[4 * i + 2] = dA * h[4 * i + 2] + xdt * bv[2]; acc += cv[2] * h[4 * i + 2];
                    h[4 * i + 3] = dA * h[4 * i + 3] + xdt * bv[3]; acc += cv[3] * h[4 * i + 3]; }
                acc += __shfl_xor(acc, 1); acc += __shfl_xor(acc, 2); acc += __shfl_xor(acc, 4);
                if ((tid & 7) == 0) ys[tt * 64 + p] = acc + Dsk * xv;
            }
            __syncthreads();
            for (int e = tid; e < rows * 64; e += NTHR) {
                const int tt = e >> 6, pp = e & 63; const size_t row = (size_t)(rb + tb + tt);
                const float zv = bf2f(PROJ[row * N_PROJ + D_POOL + hh * HD + pp]); const float yz = ys[tt * 64 + pp] * silu_f(zv);
                MIXA[row * D_MIX + D_POOL + hh * HD + pp] = (bf16)f2bf(yz);
                const float q = wave_sum(yz * yz);
                if (pp == 0) SSQH[row * 32 + hh] = q;
            }
            __syncthreads();
        }
        float* ho = C.out + (prm ? O_SSDP + ((((size_t)l * NB_P + b) * NH + hh) * HD + p) * DS + n0 : O_SSDS + ((((size_t)l * NB_S + b) * NH + hh) * HD + p) * DS + n0);
#pragma unroll
        for (int i = 0; i < 4; ++i) *(float4*)(ho + 4 * i) = make_float4(h[4 * i], h[4 * i + 1], h[4 * i + 2], h[4 * i + 3]);
    }
}

__device__ __forceinline__ void phase_xact(Ctx C, int l) {
    C.refresh();
    const bf16* PROJ = (const bf16*)(C.ws + WS_PROJ); bf16* ACTX = (bf16*)(C.ws + WS_ACTX);
    const float* cw = C.in[10] + (size_t)l * 4 * CONV_DIM; const float* cb = C.in[11] + (size_t)l * CONV_DIM;
    constexpr int NCG = CONV_DIM / 8, NSTRIP = M / 16;
    const int gt = C.gw * 64 + C.lane, NGT = C.NGW * 64;
    for (int it = gt; it < NSTRIP * NCG; it += NGT) {
        const int strip = it / NCG, c = (it % NCG) * 8, row0 = strip * 16; const bool prm = row0 < MP;
        const int t0 = prm ? row0 % SEQ : (row0 - MP) % SEQ_S, b = prm ? row0 / SEQ : (row0 - MP) / SEQ_S;
        uint4 rq[19];
#pragma unroll
        for (int j = 0; j < 19; ++j) { const int dr = (t0 == 0 && j < 3) ? 0 : j - 3; rq[j] = *(const uint4*)(PROJ + (size_t)(row0 + dr) * N_PROJ + XBC0 + c); }
        if (t0 == 0) {
            const float* h = C.in[3] + ((size_t)(l * NB_S + (prm ? 0 : b)) * 3) * CONV_DIM + c;
#pragma unroll
            for (int j = 0; j < 3; ++j) { uint4 v = make_uint4(0u, 0u, 0u, 0u);
                if (!prm) { const F8 hv = ld_f8(h + (size_t)j * CONV_DIM); v = make_uint4(pk2(hv.v[0], hv.v[1]), pk2(hv.v[2], hv.v[3]), pk2(hv.v[4], hv.v[5]), pk2(hv.v[6], hv.v[7])); }
                rq[j] = v; } }
        F8 wv[4];
#pragma unroll
        for (int i = 0; i < 4; ++i) wv[i] = ld_f8(cw + (size_t)i * CONV_DIM + c);
        const F8 bv = ld_f8(cb + c);
#pragma unroll
        for (int i = 0; i < 16; ++i) { F8 o = bv;
#pragma unroll
            for (int tap = 0; tap < 4; ++tap) { const F8 rj = unpack8(rq[i + tap]);
#pragma unroll
                for (int k = 0; k < 8; ++k) o.v[k] += wv[tap].v[k] * rj.v[k]; }
#pragma unroll
            for (int k = 0; k < 8; ++k) o.v[k] = silu_f(o.v[k]);
            st_bf8(ACTX + (size_t)(row0 + i) * CONV_DIM + c, o); }
    }
}

constexpr int SL_C = 0, SL_B = 17408, SL_BT = 34816, SL_XT = 53248, SL_H = 62464, SL_M = 79872, SL_DT = 89088, SL_AC = SL_DT + 512, SL_W = SL_AC + 512, SL_DEC = SL_W + 512, SL_SSQ = SL_DEC + 16, SL_XWT = SL_SSQ + 1024;
constexpr int PC = 272, PT = 144;
typedef short bf16x8_t __attribute__((ext_vector_type(8)));
__device__ __forceinline__ bf16x8_t ld_op(const LAS unsigned char* base, int row, int pitch, int kelem) { return *(const LAS bf16x8_t*)(base + row * pitch + kelem * 2); }
__device__ __forceinline__ int swz(int row, int byte) { return byte ^ (((row >> 3) & 7) << 4); }
__device__ __forceinline__ bf16x8_t ld_op_sw(const LAS unsigned char* base, int row, int pitch, int kelem) { return *(const LAS bf16x8_t*)(base + row * pitch + swz(row, kelem * 2)); }

typedef unsigned u32x4_t __attribute__((ext_vector_type(4)));
typedef unsigned u32x2_t __attribute__((ext_vector_type(2)));
__device__ __forceinline__ F8 lds_f8(const LAS float* p) { const f32x4 a = *(const LAS f32x4*)p, b = *(const LAS f32x4*)(p + 4); F8 r; r.v[0] = a[0]; r.v[1] = a[1]; r.v[2] = a[2]; r.v[3] = a[3]; r.v[4] = b[0]; r.v[5] = b[1]; r.v[6] = b[2]; r.v[7] = b[3]; return r; }
__device__ __forceinline__ unsigned perm_lo(unsigned hi_row, unsigned lo_row) { return __builtin_amdgcn_perm(hi_row, lo_row, 0x05040100u); }
__device__ __forceinline__ unsigned perm_hi(unsigned hi_row, unsigned lo_row) { return __builtin_amdgcn_perm(hi_row, lo_row, 0x07060302u); }
__device__ __forceinline__ unsigned qword(const uint4& v, int i) { return i == 0 ? v.x : (i == 1 ? v.y : (i == 2 ? v.z : v.w)); }
__device__ __forceinline__ void ssd_stage(LAS unsigned char* L, int cg, int l0, int rows_valid, const LAS float* w_s, const uint4 (&rq)[8]) {
    uint4 r[8];
#pragma unroll
    for (int i = 0; i < 8; ++i) { const bool ok = l0 + i < rows_valid; r[i].x = ok ? rq[i].x : 0u; r[i].y = ok ? rq[i].y : 0u; r[i].z = ok ? rq[i].z : 0u; r[i].w = ok ? rq[i].w : 0u; }
    if (cg < 8) {
        const f32x4 wa = *(const LAS f32x4*)(w_s + l0), wb = *(const LAS f32x4*)(w_s + l0 + 4);
#pragma unroll
        for (int k = 0; k < 8; ++k) { const int p = 8 * cg + k; unsigned t[4];
#pragma unroll
            for (int jj = 0; jj < 4; ++jj) t[jj] = (k & 1) ? perm_hi(qword(r[2 * jj + 1], k >> 1), qword(r[2 * jj], k >> 1)) : perm_lo(qword(r[2 * jj + 1], k >> 1), qword(r[2 * jj], k >> 1));
            *(LAS u32x4_t*)(L + SL_XT + p * PT + swz(p, l0 * 2)) = (u32x4_t){t[0], t[1], t[2], t[3]};
            *(LAS u32x4_t*)(L + SL_XWT + p * PT + swz(p, l0 * 2)) = (u32x4_t){pk2(bflo(t[0]) * wa[0], bfhi(t[0]) * wa[1]), pk2(bflo(t[1]) * wa[2], bfhi(t[1]) * wa[3]), pk2(bflo(t[2]) * wb[0], bfhi(t[2]) * wb[1]), pk2(bflo(t[3]) * wb[2], bfhi(t[3]) * wb[3])}; }
    } else if (cg < 24) { const int n0 = 8 * (cg - 8);
#pragma unroll
        for (int i = 0; i < 8; ++i) *(LAS u32x4_t*)(L + SL_B + (l0 + i) * PC + n0 * 2) = (u32x4_t){r[i].x, r[i].y, r[i].z, r[i].w};
#pragma unroll
        for (int k = 0; k < 8; ++k) { const int n = n0 + k; unsigned t[4];
#pragma unroll
            for (int jj = 0; jj < 4; ++jj) t[jj] = (k & 1) ? perm_hi(qword(r[2 * jj + 1], k >> 1), qword(r[2 * jj], k >> 1)) : perm_lo(qword(r[2 * jj + 1], k >> 1), qword(r[2 * jj], k >> 1));
            *(LAS u32x4_t*)(L + SL_BT + n * PT + swz(n, l0 * 2)) = (u32x4_t){t[0], t[1], t[2], t[3]}; }
    } else { const int n0 = 8 * (cg - 24);
#pragma unroll
        for (int i = 0; i < 8; ++i) *(LAS u32x4_t*)(L + SL_C + (l0 + i) * PC + n0 * 2) = (u32x4_t){r[i].x, r[i].y, r[i].z, r[i].w};
    }
}
__device__ __forceinline__ void ssd_dt(LAS unsigned char* L, int par, float xr, bool valid, float Aneg, int lane) {
    const float dtv = valid ? (xr > 20.f ? xr : log1pf(__expf(xr))) : 0.f;
    float a = dtv * Aneg;
#pragma unroll
    for (int o = 1; o < 64; o <<= 1) { const float v = __shfl_up(a, o); if (lane >= o) a += v; }
    const float last = __shfl(a, 63);
    ((LAS float*)(L + SL_DT))[par * 64 + lane] = dtv; ((LAS float*)(L + SL_AC))[par * 64 + lane] = a; ((LAS float*)(L + SL_W))[par * 64 + lane] = dtv * __expf(last - a);
    if (lane == 0) ((LAS float*)(L + SL_DEC))[par] = __expf(last);
}
#define WG_BAR() do { asm volatile("s_waitcnt lgkmcnt(0)" ::: "memory"); __builtin_amdgcn_s_barrier(); asm volatile("" ::: "memory"); } while (0)
__device__ __forceinline__ void stage_role(int tq, int& cg, int& l0) {
    const int ws = tq >> 6, lane = tq & 63;
    if (ws == 0) { cg = lane & 7; l0 = (lane >> 3) * 8; }
    else { const int idx = ((ws - 1) & 1) * 64 + lane; cg = (ws <= 2 ? 8 : 24) + (idx & 15); l0 = (idx >> 4) * 8; }
}
__device__ __forceinline__ void ssd_load_act(uint4 (&rq)[8], const bf16* ACTX, int tq, int hh, int g, size_t rowf) {
    int cg, l0c; stage_role(tq, cg, l0c);
    const int cc = cg < 8 ? hh * HD + cg * 8 : (cg < 24 ? D_SSD + g * DS + (cg - 8) * 8 : D_SSD + 2 * DS + g * DS + (cg - 24) * 8);
    const unsigned lo = tq < 320 ? (unsigned)(l0c * CONV_DIM + cc) * 2u : 0u;
#pragma unroll
    for (int j = 0; j < 8; ++j) { const char* ub = (const char*)ACTX + ((rowf + j) * CONV_DIM) * 2; rq[j] = *(const uint4*)(ub + lo); }
}
__device__ __forceinline__ void ssd_load_z(uint2 (&zq)[2], const bf16* PROJ, int w, int r16, int q, int hh, size_t row0, int rows) {
    const int pi = w >> 1, li0 = 2 * (w & 1);
#pragma unroll
    for (int t = 0; t < 2; ++t) { const int lrow = 16 * (li0 + t) + r16; const char* ub = (const char*)PROJ + ((row0 + 16 * (li0 + t)) * N_PROJ + D_POOL + hh * HD + 16 * pi) * 2;
        zq[t] = lrow < rows ? *(const uint2*)(ub + (unsigned)(r16 * N_PROJ + 4 * q) * 2u) : make_uint2(0u, 0u); }
}
#define OPQ_V(x) asm volatile("" : "+v"(x))
#define OPQ_S(x) asm volatile("" : "+s"(x))
__device__ __forceinline__ void phase_ssd2(Ctx C, int l) {
    C.refresh();
    LAS unsigned char* L = C.lds;
    const bf16* PROJ = (const bf16*)(C.ws + WS_PROJ); const bf16* ACTX = (const bf16*)(C.ws + WS_ACTX); const float* DT = (const float*)(C.ws + WS_DT); bf16* MIXA = (bf16*)(C.ws + WS_MIXA); float* SSQH = (float*)(C.ws + WS_SSQH);
    const int w0 = C.wave;
    const int conv_l = l + 1 < DEPTH ? l + 1 : -1, cG = C.G, cbx = (int)blockIdx.x;
    float cwv[32], cgl = 1.f; int cslot = 0;
#define tid0 (w0 * 64 + lane_id())
    typedef float f4 __attribute__((ext_vector_type(4)));
#if PROBE_SEL > 0
    volatile LAS unsigned* MISC2 = (volatile LAS unsigned*)(C.lds + LDSCTL_OFF);
    if (blockIdx.x == 0 && w0 == 0 && lane_id() == 0) MISC2[13] = (unsigned)__builtin_amdgcn_s_memrealtime();
#define STAMP2(ty) do { if (blockIdx.x == 0 && w0 == 0 && lane_id() == 0) { const unsigned tn = (unsigned)__builtin_amdgcn_s_memrealtime(); MISC2[16 + (ty)] += tn - MISC2[13]; MISC2[13] = tn; } } while (0)
#else
#define STAMP2(ty) do { } while (0)
#endif
    for (int u = blockIdx.x; u < NB_P * NH + NB_S * NH; u += C.G) {
        STAMP2(19);
        const bool prm = u < NB_P * NH; const int su = prm ? u : u - NB_P * NH, b = su / NH, hh = su % NH, g = hh / HPG;
        const int rb = prm ? b * SEQ : MP + b * SEQ_S, rows = prm ? 64 : 32, nchunk = prm ? SEQ / 64 : 1;
        const float Aneg = -__expf(C.in[13][l * NH + hh]), Dsk = C.in[14][l * NH + hh], dtb = C.in[12][l * NH + hh];
        f4 hacc[4]; float xrn; uint2 zq[2]; uint4 rawq[8];
        {
            int tq = tid0, w = w0; OPQ_V(tq); OPQ_S(w);
            const int lane = tq & 63, r16 = lane & 15, q = lane >> 4; const bool stg = tq < 320; int cg, l0; stage_role(tq, cg, l0);
            const float xr0 = DT[((size_t)rb + (lane < rows ? lane : 0)) * 32 + hh] + dtb;
            ssd_load_act(rawq, ACTX, tq, hh, g, (size_t)rb);
            xrn = DT[((size_t)(rb + 64) + lane) * 32 + hh] + dtb;
#pragma unroll
            for (int pj = 0; pj < 4; ++pj) {
                if (prm) hacc[pj] = (f4){0.f, 0.f, 0.f, 0.f};
                else { const float4 v = *(const float4*)(C.in[4] + ((((size_t)l * NB_S + b) * NH + hh) * HD + 16 * pj + r16) * DS + 16 * w + 4 * q); hacc[pj] = (f4){v.x, v.y, v.z, v.w}; } }
            if (w == 0) ssd_dt(L, 0, xr0, lane < rows, Aneg, lane);
            WG_BAR();
            if (stg) ssd_stage(L, cg, l0, rows, (const LAS float*)(L + SL_W), rawq);
#pragma unroll
            for (int pj = 0; pj < 4; ++pj) *(LAS u32x2_t*)(L + SL_H + (16 * pj + r16) * PC + (16 * w + 4 * q) * 2) = (u32x2_t){pk2(hacc[pj][0], hacc[pj][1]), pk2(hacc[pj][2], hacc[pj][3])};
            ssd_load_z(zq, PROJ, w, r16, q, hh, (size_t)rb, rows);
            ssd_load_act(rawq, ACTX, tq, hh, g, (size_t)rb + 64);
            WG_BAR();
        }
        STAMP2(13);
        for (int c = 0; c < nchunk; ++c) {
            const int par = c & 1, tb = c * 64; const bool more = c + 1 < nchunk;
            {
                int tq = tid0, w = w0; OPQ_V(tq); OPQ_S(w);
                const int lane = tq & 63, r16 = lane & 15, q = lane >> 4;
                const float xrc = xrn;
                xrn = DT[((size_t)(rb + tb + 128) + lane) * 32 + hh] + dtb;
                if (more && w == 0) ssd_dt(L, par ^ 1, xrc, true, Aneg, lane);
                const LAS float* ac = (const LAS float*)(L + SL_AC) + par * 64; const LAS float* dts = (const LAS float*)(L + SL_DT) + par * 64;
#pragma unroll
                for (int t = 0; t < 2; ++t) { const int T = 2 * w + t, si = T >> 2, li = T & 3; f4 acc = (f4){0.f, 0.f, 0.f, 0.f};
#pragma unroll
                    for (int ks = 0; ks < 4; ++ks) acc = __builtin_amdgcn_mfma_f32_16x16x32_bf16(ld_op(L + SL_B, 16 * si + r16, PC, 32 * ks + 8 * q), ld_op(L + SL_C, 16 * li + r16, PC, 32 * ks + 8 * q), acc, 0, 0, 0);
                    const int lr = 16 * li + r16, s0 = 16 * si + 4 * q; const float al = ac[lr]; const f4 as = *(const LAS f4*)(ac + s0), ds = *(const LAS f4*)(dts + s0); float m[4];
#pragma unroll
                    for (int r = 0; r < 4; ++r) m[r] = (s0 + r <= lr) ? acc[r] * __expf(al - as[r]) * ds[r] : 0.f;
                    *(LAS u32x2_t*)(L + SL_M + lr * PT + s0 * 2) = (u32x2_t){pk2(m[0], m[1]), pk2(m[2], m[3])}; }
            }
            WG_BAR(); STAMP2(14);
            {
                int tq = tid0, w = w0; OPQ_V(tq); OPQ_S(w);
                const int lane = tq & 63, r16 = lane & 15, q = lane >> 4, pi = w >> 1, li0 = 2 * (w & 1);
                const LAS float* ac = (const LAS float*)(L + SL_AC) + par * 64;
#pragma unroll
                for (int t = 0; t < 2; ++t) { const int li = li0 + t; f4 yd = (f4){0.f, 0.f, 0.f, 0.f}, yo = (f4){0.f, 0.f, 0.f, 0.f};
#pragma unroll
                    for (int ks = 0; ks < 2; ++ks) yd = __builtin_amdgcn_mfma_f32_16x16x32_bf16(ld_op_sw(L + SL_XT, 16 * pi + r16, PT, 32 * ks + 8 * q), ld_op(L + SL_M, 16 * li + r16, PT, 32 * ks + 8 * q), yd, 0, 0, 0);
#pragma unroll
                    for (int ks = 0; ks < 4; ++ks) yo = __builtin_amdgcn_mfma_f32_16x16x32_bf16(ld_op(L + SL_H, 16 * pi + r16, PC, 32 * ks + 8 * q), ld_op(L + SL_C, 16 * li + r16, PC, 32 * ks + 8 * q), yo, 0, 0, 0);
                    const int lr = 16 * li + r16, p0 = 16 * pi + 4 * q; const float e = __expf(ac[lr]);
                    const float zf[4] = {bflo(zq[t].x), bfhi(zq[t].x), bflo(zq[t].y), bfhi(zq[t].y)}; float yz[4], ss = 0.f;
#pragma unroll
                    for (int r = 0; r < 4; ++r) { const float xv = bf2f(*(const LAS bf16*)(L + SL_XT + (p0 + r) * PT + swz(p0 + r, lr * 2))); const float y = yd[r] + e * yo[r] + Dsk * xv; yz[r] = y * silu_f(zf[r]); ss += yz[r] * yz[r]; }
                    if (lr < rows) { char* ub = (char*)MIXA + ((size_t)(rb + tb + 16 * li) * D_MIX + D_POOL + hh * HD + 16 * pi) * 2; *(uint2*)(ub + (unsigned)(r16 * D_MIX + 4 * q) * 2u) = make_uint2(pk2(yz[0], yz[1]), pk2(yz[2], yz[3])); }
                    ss += __shfl_xor(ss, 16); ss += __shfl_xor(ss, 32);
                    if (q == 0) ((LAS float*)(L + SL_SSQ))[lr * 4 + pi] = ss; }
            }
            {
                int tq = tid0, w = w0; OPQ_V(tq); OPQ_S(w);
                const int lane = tq & 63, r16 = lane & 15, q = lane >> 4;
                const float dec = ((const LAS float*)(L + SL_DEC))[par];
#pragma unroll
                for (int pj = 0; pj < 4; ++pj) { hacc[pj] = hacc[pj] * dec;
#pragma unroll
                    for (int ks = 0; ks < 2; ++ks) hacc[pj] = __builtin_amdgcn_mfma_f32_16x16x32_bf16(ld_op_sw(L + SL_BT, 16 * w + r16, PT, 32 * ks + 8 * q), ld_op_sw(L + SL_XWT, 16 * pj + r16, PT, 32 * ks + 8 * q), hacc[pj], 0, 0, 0); }
            }
            WG_BAR(); STAMP2(15);
            {
                int tq = tid0, w = w0; OPQ_V(tq); OPQ_S(w);
                const int lane = tq & 63, r16 = lane & 15, q = lane >> 4;
#pragma unroll
                for (int pj = 0; pj < 4; ++pj) *(LAS u32x2_t*)(L + SL_H + (16 * pj + r16) * PC + (16 * w + 4 * q) * 2) = (u32x2_t){pk2(hacc[pj][0], hacc[pj][1]), pk2(hacc[pj][2], hacc[pj][3])};
                if (more && tq < 320) { int cg, l0; stage_role(tq, cg, l0); ssd_stage(L, cg, l0, 64, (const LAS float*)(L + SL_W) + (par ^ 1) * 64, rawq); }
                ssd_load_z(zq, PROJ, w, r16, q, hh, (size_t)(rb + tb + 64), rows);
                ssd_load_act(rawq, ACTX, tq, hh, g, (size_t)(rb + tb + 128));
                if (conv_l >= 0 && w >= 5) { const int mp = (w - 5) + 3 * (cslot - 1), mn = (w - 5) + 3 * cslot; LAS float* cscr = (LAS float*)(L + 101376 + (w - 5) * 8448);
                    if (cslot > 0 && mp * cG + cbx < I_L) conv_finish(conv_job(C, conv_l, mp * cG + cbx), lane, cwv, cgl, cscr);
                    if (mn * cG + cbx < I_L) conv_issue(conv_job(C, conv_l, mn * cG + cbx), lane, cwv, cgl); }
                ++cslot;
                if (tq >= 448 && (tq - 448) < rows) { const int lr = tq - 448; const f4 s4 = *(const LAS f4*)(L + SL_SSQ + lr * 16); SSQH[(size_t)(rb + tb + lr) * 32 + hh] = (s4[0] + s4[1]) + (s4[2] + s4[3]); }
            }
            WG_BAR();
            STAMP2(16);
        }
        {
            int tq = tid0, w = w0; OPQ_V(tq); OPQ_S(w);
            const int lane = tq & 63, r16 = lane & 15, q = lane >> 4;
            float* ho = C.out + (prm ? O_SSDP + (((size_t)l * NB_P + b) * NH + hh) * HD * DS : O_SSDS + (((size_t)l * NB_S + b) * NH + hh) * HD * DS);
#pragma unroll
            for (int pj = 0; pj < 4; ++pj) *(float4*)(ho + (size_t)(16 * pj + r16) * DS + 16 * w + 4 * q) = make_float4(hacc[pj][0], hacc[pj][1], hacc[pj][2], hacc[pj][3]); }
    }
    if (conv_l >= 0) {
        int tq = tid0, w = w0; OPQ_V(tq); OPQ_S(w); const int lane = tq & 63;
        if (w >= 5 && cslot > 0) { const int mp = (w - 5) + 3 * (cslot - 1); if (mp * cG + cbx < I_L) conv_finish(conv_job(C, conv_l, mp * cG + cbx), lane, cwv, cgl, (LAS float*)(L + 101376 + (w - 5) * 8448)); }
        WG_BAR();
        for (int m = 3 * cslot + w; m * cG + cbx < I_L; m += NWAVES) { const ConvJob j = conv_job(C, conv_l, m * cG + cbx); float wv2[32], gl2; conv_issue(j, lane, wv2, gl2); conv_finish(j, lane, wv2, gl2, (LAS float*)(L + w * 16384)); }
    }
}

#undef tid0
constexpr int PH_CONV = 0, PH_FOLD = 1, PH_L0 = 2, PH_PER_L = 10, N_PHASES = PH_L0 + DEPTH * PH_PER_L;
constexpr int CW_BAR = 4096;

__global__ void __launch_bounds__(NTHR, 2) fwd_kernel(Args args) {
    extern __shared__ __attribute__((aligned(16))) unsigned char lds_raw[];
    Ctx C; C.lds = (LAS unsigned char*)lds_raw; C.G = gridDim.x; C.in = args.in; C.out = args.out; C.ws = args.ws; C.wave0 = __builtin_amdgcn_readfirstlane(threadIdx.x >> 6); C.refresh();
    volatile LAS unsigned* MISC = (volatile LAS unsigned*)(C.lds + LDSCTL_OFF);
    if (threadIdx.x < 64) MISC[threadIdx.x] = 0u;
#define LEAD() (C.wave0 == 0 && lane_id() == 0)
    __syncthreads();
    const int lo = args.ph_lo, hi = args.ph_hi;
    unsigned* barw = (unsigned*)(args.ws + WS_CTL) + CW_BAR;
    XcdBarrier bar; bar.bar = barw; bar.x = 0; bar.st = MISC + 8;
    if (hi - lo > 1) bar = xcd_barrier_post(barw, MISC + 8, LEAD());
#define IN(k) (lo <= (k) && (k) < hi)
#if PROBE_SEL > 0
    if (blockIdx.x == 0 && LEAD()) { MISC[12] = (unsigned)__builtin_amdgcn_s_memrealtime(); MISC[14] = (unsigned)__builtin_amdgcn_s_memrealtime(); MISC[15] = (unsigned)clock64(); }
#define STAMP(ty) do { if (blockIdx.x == 0 && LEAD()) { const unsigned tn = (unsigned)__builtin_amdgcn_s_memrealtime(); MISC[16 + (ty)] += tn - MISC[12]; MISC[12] = tn; } } while (0)
#else
#define STAMP(ty) do { } while (0)
#endif
#define SEAM(k) do { if ((k) + 1 < hi) xcd_barrier(bar, LEAD()); } while (0)
    LAS unsigned char* ring = C.lds;
    const int vcu = (C.G % 8 == 0) ? ((int)blockIdx.x % 8) * (C.G / 8) + (int)blockIdx.x / 8 : (int)blockIdx.x;

    if (IN(PH_CONV)) { phase_convert(C); SEAM(PH_CONV); STAMP(0); }
    for (int l = 0; l < DEPTH; ++l) {
        const int pb = PH_L0 + l * PH_PER_L;
        if (IN(pb + 0)) {
            pg8::Gemm gm{(const bf16*)(C.ws + WS_XB), (const bf16*)(C.ws + WS_BTIN) + (size_t)l * N_INP * DMP, M, N_PROJ, DM, DMP, DMP, 0};
            pg8::StaticOrder S; S.init(M, N_PROJ, C.G, (int)blockIdx.x);
            pg8::EpiBf16S E{(bf16*)(C.ws + WS_PROJ), N_PROJ, (const float*)(C.ws + WS_R), nullptr, -1};
            pg8::gemm_phase<pg8::EpiBf16S, pg8::StaticOrder, true, true>(ring, gm, S, E, C.wave0);
            {
                const int first_light = S.nwg % C.G;
                for (int w = ((int)blockIdx.x - first_light + C.G) % C.G; w < 4 * 8; w += C.G) { const int g = w >> 3, lg = 4 * l + g;
                    pg8::Gemm gf{(const bf16*)(C.ws + WS_WOP) + (size_t)l * DM * D_POOL + g * 256, (const bf16*)(C.ws + WS_WPB) + (size_t)lg * 65536, DM, 256, 256, D_POOL, 256, 0};
                    pg8::StaticOrder Sf; Sf.init(DM, 256, 8, w & 7);
                    pg8::EpiBf16S Ef{(bf16*)(C.ws + WS_BTOUT) + (size_t)l * DM * D_MIX + g * 256, D_MIX, nullptr, nullptr, -1};
                    pg8::gemm_phase<pg8::EpiBf16S, pg8::StaticOrder, true, true>(ring, gf, Sf, Ef, C.wave0); } }
            phase_dt(C, l);
            STAMP(17); SEAM(pb + 0); STAMP(2);
        }
        if (IN(pb + 1)) { phase_xact(C, l); phase_pool(C, l); STAMP(12); SEAM(pb + 1); STAMP(3); }
        if (IN(pb + 2)) { phase_ssd2(C, l); STAMP(11); SEAM(pb + 2); STAMP(19); }
        if (IN(pb + 4)) {
            {
                pg8::Gemm gm{(const bf16*)(C.ws + WS_MIXA), (const bf16*)(C.ws + WS_BTOUT) + (size_t)l * DM * D_MIX, MP, DM, D_MIX, D_MIX, D_MIX, 0};
                pg8::FactorOrder S; S.init(MP, DM, C.G, (int)blockIdx.x); S.ssqh = (const float*)(C.ws + WS_SSQH); S.ft = (LAS float*)(C.lds + LDSCTL_OFF + 1024); S.wave0 = C.wave0; S.eps = EPS;
                pg8::EpiBf16SsqG E{(bf16*)(C.ws + WS_MIX), DM, (float*)(C.ws + WS_SSQP), (const LAS float*)(C.lds + LDSCTL_OFF + 1024), D_POOL / 64, (D_POOL + 1024) / 64};
                pg8::gemm_phase<pg8::EpiBf16SsqG, pg8::FactorOrder, true, true>(ring, gm, S, E, C.wave0); }
            {
                pg8::Gemm gm{(const bf16*)(C.ws + WS_MIXA) + (size_t)MP * D_MIX, (const bf16*)(C.ws + WS_BTOUT) + (size_t)l * DM * D_MIX, MS, DM, D_MIX / KS_OUT, D_MIX, D_MIX, D_MIX / KS_OUT};
                pg8::SplitKOrder S; S.init(MS, DM, KS_OUT, C.G, vcu);
                pg8::EpiF32Slab E{(float*)(C.ws + WS_SLAB), DM, MS};
                pg8::gemm_phase<pg8::EpiF32Slab, pg8::SplitKOrder, true, true>(ring, gm, S, E, C.wave0); }
            STAMP(17); SEAM(pb + 4); STAMP(5);
        }
        if (IN(pb + 5)) { phase_resid(C, C.in[17] + l * DM, false, KS_OUT, true); SEAM(pb + 5); STAMP(6); }
        if (IN(pb + 6)) {
            pg8::Gemm gm{(const bf16*)(C.ws + WS_XB), (const bf16*)(C.ws + WS_BTUP) + (size_t)l * D_UP * DMP, M, D_UP, DM, DMP, DMP, 0};
            pg8::StaticOrder S; S.init(M, D_UP, C.G, (int)blockIdx.x);
            pg8::EpiUpAct E{(bf16*)(C.ws + WS_ACT), (bf16*)(C.ws + WS_UP), (bf16*)(C.ws + WS_SIDE), (const float*)(C.ws + WS_R), C.in[20] + (size_t)l * 3 * D_UP, C.in[21] + (size_t)l * D_UP, D_FF, (LAS float*)(C.lds + LDSCTL_OFF + 1024)};
            pg8::gemm_phase<pg8::EpiUpAct, pg8::StaticOrder, true, true>(ring, gm, S, E, C.wave0);
            STAMP(17); SEAM(pb + 6); STAMP(7);
        }
        if (IN(pb + 7)) { phase_act(C, l); phase_actfix(C, l); SEAM(pb + 7); STAMP(8); }
        if (IN(pb + 8)) {
            {
                pg8::Gemm gm{(const bf16*)(C.ws + WS_ACT), (const bf16*)(C.ws + WS_BTDN) + (size_t)l * DM * D_FF, MP, DM, D_FF, D_FF, D_FF, 0};
                pg8::StaticOrder S; S.init(MP, DM, C.G, (int)blockIdx.x);
                pg8::EpiBf16Ssq E{(bf16*)(C.ws + WS_MIX), DM, (float*)(C.ws + WS_SSQP)};
                pg8::gemm_phase<pg8::EpiBf16Ssq, pg8::StaticOrder, true, true>(ring, gm, S, E, C.wave0); }
            {
                pg8::Gemm gm{(const bf16*)(C.ws + WS_ACT) + (size_t)MP * D_FF, (const bf16*)(C.ws + WS_BTDN) + (size_t)l * DM * D_FF, MS, DM, D_FF / KS_DN, D_FF, D_FF, D_FF / KS_DN};
                pg8::SplitKOrder S; S.init(MS, DM, KS_DN, C.G, vcu);
                pg8::EpiF32Slab E{(float*)(C.ws + WS_SLAB), DM, MS};
                pg8::gemm_phase<pg8::EpiF32Slab, pg8::SplitKOrder, true, true>(ring, gm, S, E, C.wave0); }
            STAMP(17); SEAM(pb + 8); STAMP(9);
        }
        if (IN(pb + 9)) { phase_resid(C, C.in[23] + l * DM, l == DEPTH - 1, KS_DN, false); SEAM(pb + 9); STAMP(10); }
    }
#if PROBE_SEL > 0
    if (blockIdx.x == 0 && LEAD()) { asm volatile("s_waitcnt vmcnt(0)" ::: "memory"); unsigned tot = 0; for (int ty = 0; ty < 20; ++ty) if ((PROBE_SEL >> ty) & 1) tot += MISC[16 + ty]; C.out[0] = (float)tot * 0.0001f;
        if (PROBE_SEL & (1 << 30)) { const unsigned dc = (unsigned)clock64() - MISC[15], dt = (unsigned)__builtin_amdgcn_s_memrealtime() - MISC[14]; C.out[0] = 5.f * (float)dc / (float)dt; } }
#endif
#undef IN
#undef SEAM
}

extern "C" void kernel_launch(void* const* d_in, const int* in_sizes, int n_in, void* d_out, int out_size, void* d_ws, size_t ws_size, hipStream_t stream) {
    static int grid = 0;
    if (grid == 0) {
        if (n_in != 24 || (size_t)out_size != O_END || ws_size < WS_END) { fprintf(stderr, "kernel_launch: shape mismatch: n_in %d out %d (want %zu) ws %zu (need %zu)\n", n_in, out_size, (size_t)O_END, ws_size, (size_t)WS_END); grid = -1; return; }
        int dev = 0, cus = 0, per_cu = 0;
        if (hipGetDevice(&dev) != hipSuccess || hipDeviceGetAttribute(&cus, hipDeviceAttributeMultiprocessorCount, dev) != hipSuccess) { grid = -1; return; }
        if (hipFuncSetAttribute((const void*)fwd_kernel, hipFuncAttributeMaxDynamicSharedMemorySize, LDS_BYTES) != hipSuccess) { fprintf(stderr, "kernel_launch: hipFuncSetAttribute failed\n"); grid = -1; return; }
        if (hipOccupancyMaxActiveBlocksPerMultiprocessor(&per_cu, (const void*)fwd_kernel, NTHR, LDS_BYTES) != hipSuccess || per_cu < 1) fprintf(stderr, "kernel_launch: occupancy query reports %d\n", per_cu);
        (void)hipGetLastError();
        grid = cus;
    }
    if (grid < 0) return;
    if (hipMemsetAsync((char*)d_ws + WS_CTL, 0, CTL_BYTES, stream) != hipSuccess) return;
    Args a{};
    for (int i = 0; i < 24; ++i) a.in[i] = (const float*)d_in[i];
    a.out = (float*)d_out; a.ws = (unsigned char*)d_ws;
#if MK_MULTI
    for (int k = 0; k < N_PHASES; ++k) { a.ph_lo = k; a.ph_hi = k + 1; hipLaunchKernelGGL(fwd_kernel, dim3(grid), dim3(NTHR), LDS_BYTES, stream, a); }
#else
    a.ph_lo = 0; a.ph_hi = N_PHASES; hipLaunchKernelGGL(fwd_kernel, dim3(grid), dim3(NTHR), LDS_BYTES, stream, a);
#endif
}
```

```cpp
#include <hip/hip_runtime.h>
#include <cstdio>
#include <cstdint>

#ifndef PROBE_SEL
#define PROBE_SEL 0
#endif
#ifndef MK_MULTI
#define MK_MULTI 0
#endif

__device__ __forceinline__ int lane_id() { int l; asm volatile("v_mbcnt_lo_u32_b32 %0, -1, 0\n\tv_mbcnt_hi_u32_b32 %0, -1, %0" : "=v"(l)); return l; }
namespace pg8 {
#define PG8_LAS __attribute__((address_space(3)))
typedef unsigned short bf16_t;
typedef short bf16x8 __attribute__((ext_vector_type(8)));
typedef float f32x4 __attribute__((ext_vector_type(4)));
typedef unsigned u32x4 __attribute__((ext_vector_type(4)));
constexpr int BM = 256, BK = 64, HALF = 128, HTB = HALF * BK * 2, STAGE_BYTES = 8 * HTB, NXCD = 8, WGM = 4;

__host__ __device__ __forceinline__ int lds_byte(int r, int c) { const int st = (r >> 4) * 2 + (c >> 5), rr = r & 15, cc = c & 31, ob = rr * 64 + cc * 2; return st * 1024 + (ob ^ (((ob >> 9) & 1) << 5)); }
__host__ __device__ __forceinline__ void stage_rc(int b, int& R, int& C) { const int st = b / 1024, sb = b % 1024, swz = sb ^ (((sb >> 9) & 1) << 5); R = (st >> 1) * 16 + swz / 64; C = (st & 1) * 32 + (swz % 64) / 2; }
__host__ __device__ __forceinline__ int perm32(int rho) { const int n = rho >> 4, i = rho & 15; return 8 * (i >> 2) + 4 * n + (i & 3); }

struct Unit { int pm, pn, ks, seq; };
struct Gemm { const bf16_t* A; const bf16_t* Bt; int M, N, K, lda, ldb, kslice; };

struct StaticOrder {
    int nM, nN, nwg, G, c;
    __host__ __device__ void init(int M, int N, int G_, int c_) { nM = M / BM; nN = N / BM; nwg = nM * nN; G = G_; c = c_; }
    __host__ __device__ bool next(int i, Unit& u) const {
        const long L = (long)i * G + c; if (L >= nwg) return false;
        int wgid = (int)L; { const int q = nwg / NXCD, r = nwg % NXCD, xcd = wgid % NXCD, off = wgid / NXCD; wgid = (xcd < r ? xcd * (q + 1) : r * (q + 1) + (xcd - r) * q) + off; }
        const int nig = WGM * nN, gid = wgid / nig, fm = gid * WGM, gsz = (nM - fm) < WGM ? (nM - fm) : WGM;
        u.pm = fm + ((wgid % nig) % gsz); u.pn = (wgid % nig) / gsz; u.ks = 0; u.seq = i; return true;
    }
    __device__ __forceinline__ void a_ready(const Unit&) const {}
    __device__ __forceinline__ void done(const Unit&) const {}
};
struct SplitKOrder {
    int nM, nN, KS, nwg, G, c;
    __host__ __device__ void init(int M, int N, int KS_, int G_, int c_) { nM = M / BM; nN = N / BM; KS = KS_; nwg = nM * nN * KS; G = G_; c = c_; }
    __host__ __device__ bool next(int i, Unit& u) const { const long L = (long)i * G + c; if (L >= nwg) return false; const int l = (int)L; u.seq = i; u.pn = l % nN; u.ks = (l / nN) % KS; u.pm = l / (nN * KS); return true; }
    __device__ __forceinline__ void a_ready(const Unit&) const {}
    __device__ __forceinline__ void done(const Unit&) const {}
};

__device__ __forceinline__ unsigned cvt_pk_bf16(float lo, float hi) { unsigned r; asm volatile("v_cvt_pk_bf16_f32 %0, %1, %2" : "=v"(r) : "v"(lo), "v"(hi)); return r; }

struct EpiBf16S {
    static constexpr bool PERM = true, AFTER_DRAIN = false, HAS_KSEG = false;
    bf16_t* O; int ldc; const float* rs; float* dt; int dt_pn;
    __device__ __forceinline__ void operator()(const f32x4 (&acc)[2][2][4][2], const Unit& u, int wr, int wc, int fr, int fq) const {
        const int row0 = u.pm * BM + wr * 64 + fr;
        if (u.pn == dt_pn) {
            if (wc == 0) {
#pragma unroll
                for (int ai = 0; ai < 2; ++ai)
#pragma unroll
                    for (int m = 0; m < 4; ++m) { const int row = row0 + ai * HALF + m * 16; const float s = rs ? rs[row] : 1.f;
#pragma unroll
                        for (int n = 0; n < 2; ++n) *(f32x4*)(dt + (size_t)row * 32 + 8 * fq + 4 * n) = acc[ai][0][m][n] * s; }
            }
            return;
        }
        const int col0 = u.pn * BM + wc * 32 + 8 * fq;
#pragma unroll
        for (int ai = 0; ai < 2; ++ai)
#pragma unroll
            for (int m = 0; m < 4; ++m) { const int row = row0 + ai * HALF + m * 16; const float s = rs ? rs[row] : 1.f; bf16_t* rowp = O + (size_t)row * ldc + col0;
#pragma unroll
                for (int bj = 0; bj < 2; ++bj) { const f32x4 v0 = acc[ai][bj][m][0] * s, v1 = acc[ai][bj][m][1] * s;
                    u32x4 w; w.x = cvt_pk_bf16(v0[0], v0[1]); w.y = cvt_pk_bf16(v0[2], v0[3]); w.z = cvt_pk_bf16(v1[0], v1[1]); w.w = cvt_pk_bf16(v1[2], v1[3]);
                    *(u32x4*)(rowp + bj * HALF) = w; } }
    }
};
struct EpiF32Ssq {
    static constexpr bool PERM = false, AFTER_DRAIN = false, HAS_KSEG = false;
    float* C; int ldc; float* ssq;
    __device__ __forceinline__ void operator()(const f32x4 (&acc)[2][2][4][2], const Unit& u, int wr, int wc, int fr, int fq) const {
        const int row0 = u.pm * BM + wr * 64 + fr, col0 = u.pn * BM + wc * 32 + 4 * fq;
#pragma unroll
        for (int ai = 0; ai < 2; ++ai)
#pragma unroll
            for (int m = 0; m < 4; ++m) { const int row = row0 + ai * HALF + m * 16; float* rowp = C + (size_t)row * ldc + col0; float q = 0.f;
#pragma unroll
                for (int bj = 0; bj < 2; ++bj)
#pragma unroll
                    for (int n = 0; n < 2; ++n) { const f32x4 v = acc[ai][bj][m][n]; *(f32x4*)(rowp + bj * HALF + n * 16) = v; q += (v[0] * v[0] + v[1] * v[1]) + (v[2] * v[2] + v[3] * v[3]); }
                q += __shfl_xor(q, 16); q += __shfl_xor(q, 32);
                if (fq == 0) ssq[(size_t)row * 32 + u.pn * 4 + wc] = q; }
    }
};

struct EpiBf16Ssq {
    static constexpr bool PERM = true, AFTER_DRAIN = false, HAS_KSEG = false;
    bf16_t* O; int ldc; float* ssq;
    __device__ __forceinline__ void operator()(const f32x4 (&acc)[2][2][4][2], const Unit& u, int wr, int wc, int fr, int fq) const {
        const int row0 = u.pm * BM + wr * 64 + fr, col0 = u.pn * BM + wc * 32 + 8 * fq;
#pragma unroll
        for (int ai = 0; ai < 2; ++ai)
#pragma unroll
            for (int m = 0; m < 4; ++m) { const int row = row0 + ai * HALF + m * 16; bf16_t* rowp = O + (size_t)row * ldc + col0; float q = 0.f;
#pragma unroll
                for (int bj = 0; bj < 2; ++bj) { const f32x4 v0 = acc[ai][bj][m][0], v1 = acc[ai][bj][m][1];
                    q += ((v0[0] * v0[0] + v0[1] * v0[1]) + (v0[2] * v0[2] + v0[3] * v0[3])) + ((v1[0] * v1[0] + v1[1] * v1[1]) + (v1[2] * v1[2] + v1[3] * v1[3]));
                    u32x4 w; w.x = cvt_pk_bf16(v0[0], v0[1]); w.y = cvt_pk_bf16(v0[2], v0[3]); w.z = cvt_pk_bf16(v1[0], v1[1]); w.w = cvt_pk_bf16(v1[2], v1[3]);
                    *(u32x4*)(rowp + bj * HALF) = w; }
                q += __shfl_xor(q, 16); q += __shfl_xor(q, 32);
                if (fq == 0) ssq[(size_t)row * 32 + u.pn * 4 + wc] = q; }
    }
};
template <int CTRL> __device__ __forceinline__ float dppf(float old, float src) { return __builtin_bit_cast(float, __builtin_amdgcn_update_dpp(__builtin_bit_cast(int, old), __builtin_bit_cast(int, src), CTRL, 0xF, 0xF, false)); }
struct EpiUpAct {
    static constexpr bool PERM = true, AFTER_DRAIN = false, HAS_KSEG = false;
    bf16_t* ACT; bf16_t* UP; bf16_t* SIDE; const float* rs; const float* cw; const float* cb; int dff;
    PG8_LAS float* wlds;
    __device__ __forceinline__ void operator()(const f32x4 (&acc)[2][2][4][2], const Unit& u, int wr, int wc, int fr, int fq) const {
        const int row0 = u.pm * BM + wr * 64 + fr, cbase = u.pn * HALF + wc * 32 + 8 * fq, dup = 2 * dff;
        if (u.pm >= 64) {
#pragma unroll
            for (int ai = 0; ai < 2; ++ai)
#pragma unroll
                for (int m = 0; m < 4; ++m) { const int row = row0 + ai * HALF + m * 16; const float s = rs[row];
#pragma unroll
                    for (int bj = 0; bj < 2; ++bj) { const f32x4 v0 = acc[ai][bj][m][0] * s, v1 = acc[ai][bj][m][1] * s;
                        u32x4 w; w.x = cvt_pk_bf16(v0[0], v0[1]); w.y = cvt_pk_bf16(v0[2], v0[3]); w.z = cvt_pk_bf16(v1[0], v1[1]); w.w = cvt_pk_bf16(v1[2], v1[3]);
                        *(u32x4*)(UP + (size_t)row * dup + bj * dff + cbase) = w; } }
            return;
        }
        typedef unsigned u32x2 __attribute__((ext_vector_type(2)));
        PG8_LAS float* wl = wlds + (wr * 4 + wc) * 256;
        int fro = fr, fqo = fq; asm volatile("" : "+v"(fro), "+v"(fqo));
        { const int lane = fqo * 16 + fro, kind = lane >> 3, j0 = (lane & 7) * 4; const int k3 = kind & 3;
          const float* srcp = (k3 < 3 ? cw + (size_t)k3 * dup : cb) + (kind >> 2) * dff + u.pn * HALF + wc * 32 + j0;
          *(PG8_LAS f32x4*)(wl + kind * 32 + j0) = *(const f32x4*)srcp; }
        asm volatile("s_waitcnt lgkmcnt(0)" ::: "memory");
#pragma unroll
        for (int n = 0; n < 2; ++n) { const int c = cbase + 4 * n; const PG8_LAS float* wq = wl + 8 * fqo + 4 * n;
#pragma unroll
            for (int ai = 0; ai < 2; ++ai) { const int kb = u.pm * 4 + ai * 2 + wr; float sp = 0.f;
#pragma unroll
                for (int m = 0; m < 4; ++m) { const int row = row0 + ai * HALF + m * 16; const float s = rs[row];
                    const f32x4 g = acc[ai][0][m][n] * s, v = acc[ai][1][m][n] * s; f32x4 o;
                    const f32x4 gp = acc[ai][0][m > 0 ? m - 1 : 0][n] * sp, vp = acc[ai][1][m > 0 ? m - 1 : 0][n] * sp;
#pragma unroll
                    for (int e = 0; e < 4; ++e) {
                        const float p1g = dppf<0x111>(dppf<0x121>(0.f, gp[e]), g[e]), p2g = dppf<0x112>(dppf<0x122>(0.f, gp[e]), g[e]);
                        const float p1v = dppf<0x111>(dppf<0x121>(0.f, vp[e]), v[e]), p2v = dppf<0x112>(dppf<0x122>(0.f, vp[e]), v[e]);
                        const float gg = wq[96 + e] + wq[e] * p2g + wq[32 + e] * p1g + wq[64 + e] * g[e], vv = wq[224 + e] + wq[128 + e] * p2v + wq[160 + e] * p1v + wq[192 + e] * v[e];
                        o[e] = gg * __builtin_amdgcn_rcpf(1.f + __expf(-gg)) * vv; }
                    const bool head = (m == 0) && (fr < 2);
                    if (!head) { u32x2 w; w.x = cvt_pk_bf16(o[0], o[1]); w.y = cvt_pk_bf16(o[2], o[3]); *(u32x2*)(ACT + (size_t)row * dff + c) = w; }
                    if (head || ((m == 3) && (fr >= 14))) { const int slot = head ? fr : fr - 12; bf16_t* sp = SIDE + ((size_t)kb * 4 + slot) * dup + c;
                        u32x2 wg; wg.x = cvt_pk_bf16(g[0], g[1]); wg.y = cvt_pk_bf16(g[2], g[3]); *(u32x2*)sp = wg;
                        u32x2 wv; wv.x = cvt_pk_bf16(v[0], v[1]); wv.y = cvt_pk_bf16(v[2], v[3]); *(u32x2*)(sp + dff) = wv; }
                    sp = s; asm volatile("" ::: "memory"); } } }
    }
};
struct FactorOrder : StaticOrder {
    const float* ssqh; PG8_LAS float* ft; int wave0; float eps;
    __device__ __forceinline__ void a_ready(const Unit& u) const {
        const int t = wave0 * 64 + lane_id();
        if (t < 256) { const float* p = ssqh + (size_t)(u.pm * BM + t) * 32; float s0 = 0.f, s1 = 0.f;
#pragma unroll
            for (int i = 0; i < 4; ++i) { const f32x4 a = *(const f32x4*)(p + 4 * i), b = *(const f32x4*)(p + 16 + 4 * i); s0 += (a[0] + a[1]) + (a[2] + a[3]); s1 += (b[0] + b[1]) + (b[2] + b[3]); }
            const float r0 = rsqrtf(s0 * (1.f / 1024.f) + eps), r1 = rsqrtf(s1 * (1.f / 1024.f) + eps);
            *(PG8_LAS f32x4*)(ft + ((u.seq & 1) * 256 + t) * 4) = (f32x4){1.f / r0, r0 / r1, r1, 0.f}; }
    }
};
struct EpiBf16SsqG {
    static constexpr bool PERM = true, AFTER_DRAIN = false, HAS_KSEG = true;
    bf16_t* O; int ldc; float* ssq; const PG8_LAS float* ft; int t1, t2;
    __device__ __forceinline__ void kseg(f32x4 (&acc)[2][2][4][2], const Unit& u, int t, int wr, int fr) const {
        if (t == t1 || t == t2) { const int sel = (t == t1) ? 0 : 1; const PG8_LAS float* f = ft + ((u.seq & 1) * 256 + wr * 64 + fr) * 4 + sel;
#pragma unroll
            for (int ai = 0; ai < 2; ++ai)
#pragma unroll
                for (int m = 0; m < 4; ++m) { const float s = f[(ai * HALF + m * 16) * 4];
#pragma unroll
                    for (int bj = 0; bj < 2; ++bj)
#pragma unroll
                        for (int n = 0; n < 2; ++n) acc[ai][bj][m][n] = acc[ai][bj][m][n] * s; } }
    }
    __device__ __forceinline__ void operator()(const f32x4 (&acc)[2][2][4][2], const Unit& u, int wr, int wc, int fr, int fq) const {
        const int row0 = u.pm * BM + wr * 64 + fr, col0 = u.pn * BM + wc * 32 + 8 * fq; const PG8_LAS float* f = ft + ((u.seq & 1) * 256 + wr * 64 + fr) * 4 + 2;
#pragma unroll
        for (int ai = 0; ai < 2; ++ai)
#pragma unroll
            for (int m = 0; m < 4; ++m) { const int row = row0 + ai * HALF + m * 16; bf16_t* rowp = O + (size_t)row * ldc + col0; float q = 0.f; const float s = f[(ai * HALF + m * 16) * 4];
#pragma unroll
                for (int bj = 0; bj < 2; ++bj) { const f32x4 v0 = acc[ai][bj][m][0] * s, v1 = acc[ai][bj][m][1] * s;
                    q += ((v0[0] * v0[0] + v0[1] * v0[1]) + (v0[2] * v0[2] + v0[3] * v0[3])) + ((v1[0] * v1[0] + v1[1] * v1[1]) + (v1[2] * v1[2] + v1[3] * v1[3]));
                    u32x4 w; w.x = cvt_pk_bf16(v0[0], v0[1]); w.y = cvt_pk_bf16(v0[2], v0[3]); w.z = cvt_pk_bf16(v1[0], v1[1]); w.w = cvt_pk_bf16(v1[2], v1[3]);
                    *(u32x4*)(rowp + bj * HALF) = w; }
                q += __shfl_xor(q, 16); q += __shfl_xor(q, 32);
                if (fq == 0) ssq[(size_t)row * 32 + u.pn * 4 + wc] = q; }
    }
};
struct EpiF32Slab {
    static constexpr bool PERM = false, AFTER_DRAIN = false, HAS_KSEG = false;
    float* C; int ldc, Mrows;
    __device__ __forceinline__ void operator()(const f32x4 (&acc)[2][2][4][2], const Unit& u, int wr, int wc, int fr, int fq) const {
        const int row0 = u.pm * BM + wr * 64 + fr, col0 = u.pn * BM + wc * 32 + 4 * fq; float* base = C + (size_t)u.ks * Mrows * ldc;
#pragma unroll
        for (int ai = 0; ai < 2; ++ai)
#pragma unroll
            for (int m = 0; m < 4; ++m) { float* rowp = base + (size_t)(row0 + ai * HALF + m * 16) * ldc + col0;
#pragma unroll
                for (int bj = 0; bj < 2; ++bj)
#pragma unroll
                    for (int n = 0; n < 2; ++n) *(f32x4*)(rowp + bj * HALF + n * 16) = acc[ai][bj][m][n]; }
    }
};
template <class Epi, class Sched, bool ALIGN_EPI = false, bool SP2 = false>
__device__ __forceinline__ void gemm_phase(PG8_LAS unsigned char* lds, const Gemm g, const Sched& S, const Epi& E, int wave_id) {
    int tid_ = wave_id * 64 + lane_id(); asm volatile("" : "+v"(tid_));
    const int tid = tid_, wid = __builtin_amdgcn_readfirstlane(tid >> 6), lane = tid & 63, wr = wid >> 2, wc = wid & 3, fr = lane & 15, fq = lane >> 4;
    const int K = g.K, nt = K / BK;
    unsigned voffA[2], voffB[2];
#pragma unroll
    for (int i = 0; i < 2; ++i) { int R, C; stage_rc(tid * 16 + i * 8192, R, C); const int Rb = Epi::PERM ? ((R & ~31) + perm32(R & 31)) : R;
        voffA[i] = (unsigned)(R * g.lda + C) * 2u; voffB[i] = (unsigned)(Rb * g.ldb + C) * 2u; }
    const size_t kstep = (size_t)(BK * 2);
    const size_t hstepA = (size_t)HALF * g.lda * 2, hstepB = (size_t)HALF * g.ldb * 2;
    const size_t tstepA = 2 * hstepA, tstepB = 2 * hstepB;
    const unsigned ldsw = (unsigned)wid * 1024u;
    const int aoff = lds_byte(wr * 64 + fr, fq * 8), boff = lds_byte(wc * 32 + fr, fq * 8);
#define PG8_SA(b, h) (((b) * 2 + (h)) * HTB)
#define PG8_SB(b, h) ((4 + (b) * 2 + (h)) * HTB)
#define PG8_STAGE(bufoff, gbase, voff) do { _Pragma("unroll") for (int _i = 0; _i < 2; ++_i) \
        __builtin_amdgcn_global_load_lds((const unsigned*)((const char*)(gbase) + (voff)[_i]), (PG8_LAS unsigned*)(lds + (bufoff) + ldsw + _i * 8192), 16, 0, 0); } while (0)
#define PG8_LDA(dst, b, h) do { _Pragma("unroll") for (int m = 0; m < 4; ++m) _Pragma("unroll") for (int k = 0; k < 2; ++k) dst[m][k] = *(const PG8_LAS bf16x8*)(lds + PG8_SA(b, h) + aoff + m * 2048 + k * 1024); } while (0)
#define PG8_LDB(dst, b, h) do { _Pragma("unroll") for (int n = 0; n < 2; ++n) _Pragma("unroll") for (int k = 0; k < 2; ++k) dst[n][k] = *(const PG8_LAS bf16x8*)(lds + PG8_SB(b, h) + boff + n * 2048 + k * 1024); } while (0)
#define PG8_MMA(ai, bj, At, Bt) do { __builtin_amdgcn_s_setprio(1); _Pragma("unroll") for (int m = 0; m < 4; ++m) _Pragma("unroll") for (int n = 0; n < 2; ++n) _Pragma("unroll") for (int k = 0; k < 2; ++k) \
        acc[ai][bj][m][n] = __builtin_amdgcn_mfma_f32_16x16x32_bf16(Bt[n][k], At[m][k], acc[ai][bj][m][n], 0, 0, 0); __builtin_amdgcn_s_setprio(0); } while (0)
#define PG8_WAIT_V(n) asm volatile("s_waitcnt vmcnt(" #n ")" ::: "memory")
#define PG8_WAIT_L(n) asm volatile("s_waitcnt lgkmcnt(" #n ")" ::: "memory")
#define PG8_BAR __builtin_amdgcn_s_barrier()
#define PG8_SCHED __builtin_amdgcn_sched_barrier(0)
    Unit cur, nxt; int ui = 0;
    if (!S.next(0, cur)) return;
    f32x4 acc[2][2][4][2];
#pragma unroll
    for (int a = 0; a < 2; ++a)
#pragma unroll
        for (int b = 0; b < 2; ++b)
#pragma unroll
            for (int m = 0; m < 4; ++m)
#pragma unroll
                for (int n = 0; n < 2; ++n) acc[a][b][m][n] = (f32x4){0.f, 0.f, 0.f, 0.f};
    bf16x8 At[4][2], B0[2][2], B1[2][2];
    const size_t ksb = (size_t)g.kslice * 2;
    const char* cA = (const char*)g.A + (size_t)cur.pm * tstepA + cur.ks * ksb; const char* cB = (const char*)g.Bt + (size_t)cur.pn * tstepB + cur.ks * ksb;
    S.a_ready(cur);
    if constexpr (SP2) {
        PG8_STAGE(PG8_SB(0, 0), cB, voffB); PG8_STAGE(PG8_SB(0, 1), cB + hstepB, voffB); PG8_STAGE(PG8_SA(0, 0), cA, voffA); PG8_STAGE(PG8_SA(0, 1), cA + hstepA, voffA);
        if (wr == 1) PG8_BAR;
        PG8_WAIT_V(2); PG8_BAR;
        PG8_STAGE(PG8_SB(1, 0), cB + kstep, voffB); PG8_STAGE(PG8_SA(1, 0), cA + kstep, voffA); PG8_STAGE(PG8_SB(1, 1), cB + hstepB + kstep, voffB);
        PG8_WAIT_V(6); PG8_BAR;
    } else {
        PG8_STAGE(PG8_SB(0, 0), cB, voffB); PG8_STAGE(PG8_SA(0, 0), cA, voffA); PG8_STAGE(PG8_SB(0, 1), cB + hstepB, voffB); PG8_STAGE(PG8_SA(0, 1), cA + hstepA, voffA);
        if (wr == 1) PG8_BAR;
        PG8_WAIT_V(4); PG8_BAR;
        PG8_STAGE(PG8_SB(1, 0), cB + kstep, voffB); PG8_STAGE(PG8_SA(1, 0), cA + kstep, voffA); PG8_STAGE(PG8_SB(1, 1), cB + hstepB + kstep, voffB);
        PG8_WAIT_V(6); PG8_BAR;
    }
    for (;;) {
        const bool has_next = S.next(ui + 1, nxt);
        const char* nA = has_next ? (const char*)g.A + (size_t)nxt.pm * tstepA + nxt.ks * ksb : cA; const char* nB = has_next ? (const char*)g.Bt + (size_t)nxt.pn * tstepB + nxt.ks * ksb : cB;
        for (int t = 0; t < nt; t += 2) {
            const bool last = (t == nt - 2);
            if constexpr (Epi::HAS_KSEG) E.kseg(acc, cur, t, wr, fr);
            const char* a1 = cA + (size_t)(t + 1) * kstep;
            const char* a2 = last ? nA : cA + (size_t)(t + 2) * kstep; const char* b2 = last ? nB : cB + (size_t)(t + 2) * kstep;
            const char* a3 = a2 + kstep; const char* b3 = b2 + kstep;
            if (last && has_next) S.a_ready(nxt);
            if constexpr (SP2) {
            PG8_LDB(B0, 0, 0); PG8_LDB(B1, 0, 1); PG8_SCHED; PG8_LDA(At, 0, 0); PG8_STAGE(PG8_SA(1, 1), a1 + hstepA, voffA);
            PG8_WAIT_V(8); PG8_WAIT_L(0); PG8_BAR; PG8_MMA(0, 0, At, B0); PG8_MMA(0, 1, At, B1); PG8_BAR; PG8_SCHED;
            PG8_LDA(At, 0, 1); PG8_STAGE(PG8_SB(0, 0), b2, voffB); PG8_STAGE(PG8_SB(0, 1), b2 + hstepB, voffB); PG8_STAGE(PG8_SA(0, 0), a2, voffA);
            PG8_WAIT_V(8); PG8_WAIT_L(0); PG8_BAR; PG8_MMA(1, 0, At, B0); PG8_MMA(1, 1, At, B1); PG8_BAR; PG8_SCHED;
            PG8_LDB(B0, 1, 0); PG8_LDB(B1, 1, 1); PG8_SCHED; PG8_LDA(At, 1, 0); PG8_STAGE(PG8_SA(0, 1), a2 + hstepA, voffA);
            PG8_WAIT_V(8); PG8_WAIT_L(0); PG8_BAR; PG8_MMA(0, 0, At, B0); PG8_MMA(0, 1, At, B1); PG8_BAR; PG8_SCHED;
            PG8_LDA(At, 1, 1); PG8_STAGE(PG8_SB(1, 0), b3, voffB); PG8_STAGE(PG8_SB(1, 1), b3 + hstepB, voffB); PG8_STAGE(PG8_SA(1, 0), a3, voffA);
            PG8_WAIT_V(8); PG8_WAIT_L(0); PG8_BAR; PG8_MMA(1, 0, At, B0); PG8_MMA(1, 1, At, B1); PG8_BAR; PG8_SCHED;
            } else {
            PG8_LDB(B0, 0, 0); PG8_SCHED; PG8_LDA(At, 0, 0); PG8_STAGE(PG8_SA(1, 1), a1 + hstepA, voffA);
            PG8_WAIT_L(8); PG8_BAR; PG8_WAIT_L(0); PG8_MMA(0, 0, At, B0); PG8_BAR; PG8_SCHED;
            PG8_LDB(B1, 0, 1); PG8_STAGE(PG8_SB(0, 0), b2, voffB);
            PG8_BAR; PG8_WAIT_L(0); PG8_MMA(0, 1, At, B1); PG8_BAR;
            PG8_LDA(At, 0, 1); PG8_STAGE(PG8_SA(0, 0), a2, voffA);
            PG8_BAR; PG8_WAIT_L(0); PG8_MMA(1, 0, At, B0); PG8_BAR; PG8_SCHED;
            PG8_STAGE(PG8_SB(0, 1), b2 + hstepB, voffB);
            PG8_WAIT_V(6); PG8_BAR; PG8_MMA(1, 1, At, B1); PG8_BAR;
            PG8_LDB(B0, 1, 0); PG8_SCHED; PG8_LDA(At, 1, 0); PG8_STAGE(PG8_SA(0, 1), a2 + hstepA, voffA);
            PG8_WAIT_L(8); PG8_BAR; PG8_WAIT_L(0); PG8_MMA(0, 0, At, B0); PG8_BAR; PG8_SCHED;
            PG8_LDB(B1, 1, 1); PG8_STAGE(PG8_SB(1, 0), b3, voffB);
            PG8_BAR; PG8_WAIT_L(0); PG8_MMA(0, 1, At, B1); PG8_BAR;
            PG8_LDA(At, 1, 1); PG8_STAGE(PG8_SA(1, 0), a3, voffA);
            PG8_BAR; PG8_WAIT_L(0); PG8_MMA(1, 0, At, B0); PG8_BAR; PG8_SCHED;
            PG8_STAGE(PG8_SB(1, 1), b3 + hstepB, voffB);
            PG8_WAIT_V(6); PG8_BAR; PG8_MMA(1, 1, At, B1); PG8_BAR;
            }
        }
        if constexpr (ALIGN_EPI) { if (wr == 0) PG8_BAR; }
        if constexpr (!Epi::AFTER_DRAIN) { E(acc, cur, wr, wc, fr, fq); S.done(cur); }
        if (!has_next) break;
#pragma unroll
        for (int a = 0; a < 2; ++a)
#pragma unroll
            for (int b = 0; b < 2; ++b)
#pragma unroll
                for (int m = 0; m < 4; ++m)
#pragma unroll
                    for (int n = 0; n < 2; ++n) acc[a][b][m][n] = (f32x4){0.f, 0.f, 0.f, 0.f};
        cur = nxt; cA = nA; cB = nB; ++ui;
        if constexpr (ALIGN_EPI) { if (wr == 1) PG8_BAR; }
    }
    PG8_WAIT_V(0);
    if constexpr (!ALIGN_EPI) { if (wr == 0) PG8_BAR; }
    PG8_BAR;
#undef PG8_SA
#undef PG8_SB
#undef PG8_STAGE
#undef PG8_LDA
#undef PG8_LDB
#undef PG8_MMA
#undef PG8_WAIT_V
#undef PG8_WAIT_L
#undef PG8_BAR
#undef PG8_SCHED
}
}

constexpr int NWAVES = 8, NTHR = 512;
constexpr int DM = 2048, SEQ = 2048, NB_P = 8, NB_S = 32, SEQ_S = 32, DEPTH = 4;
constexpr int MP = NB_P * SEQ, MS = NB_S * SEQ_S, M = MP + MS;
constexpr int D_POOL = 1024, POOL_HIST = 15, D_SSD = 2048, HD = 64, NH = 32, HPG = 16, DS = 128, CONV_DIM = 2560, D_MIX = 3072;
constexpr int D_IN = 5664, N_PROJ = 5632, N_INP = 5888, D_FF = 5632, D_UP = 11264;
constexpr int XBC0 = 3072;
constexpr float EPS = 1e-6f;

constexpr size_t O_YP = 0, O_YS = O_YP + (size_t)MP * DM, O_POOLP = O_YS + (size_t)MS * DM, O_POOLS = O_POOLP + (size_t)DEPTH * NB_P * 15 * 1024,
    O_SCP = O_POOLS + (size_t)DEPTH * NB_S * 15 * 1024, O_SCS = O_SCP + (size_t)DEPTH * NB_P * 3 * 2560, O_SSDP = O_SCS + (size_t)DEPTH * NB_S * 3 * 2560,
    O_SSDS = O_SSDP + (size_t)DEPTH * NB_P * 32 * 64 * 128, O_FCP = O_SSDS + (size_t)DEPTH * NB_S * 32 * 64 * 128, O_FCS = O_FCP + (size_t)DEPTH * NB_P * 2 * 11264,
    O_END = O_FCS + (size_t)DEPTH * NB_S * 2 * 11264;

constexpr size_t al256(size_t x) { return (x + 255) & ~(size_t)255; }
constexpr size_t WS_CTL = 0, CTL_BYTES = 1u << 20;
constexpr size_t WS_BTIN = CTL_BYTES;
constexpr int DMP = DM + 64;
constexpr size_t WS_BTOUT = WS_BTIN + (size_t)DEPTH * N_INP * DMP * 2;
constexpr size_t WS_BTUP = WS_BTOUT + (size_t)DEPTH * DM * D_MIX * 2;
constexpr size_t WS_BTDN = WS_BTUP + (size_t)DEPTH * D_UP * DMP * 2;
constexpr size_t WS_WOP = WS_BTDN + (size_t)DEPTH * DM * D_FF * 2;
constexpr size_t WS_WPB = WS_WOP + (size_t)DEPTH * DM * D_POOL * 2;
constexpr size_t WS_X = WS_WPB + (size_t)DEPTH * 4 * 256 * 256 * 2;
constexpr size_t WS_ACTX = WS_X;
constexpr size_t WS_XB = WS_X + (size_t)M * DM * 4;
constexpr size_t WS_R = WS_XB + (size_t)M * DMP * 2;
constexpr size_t WS_DT = WS_R + al256((size_t)M * 4);
constexpr size_t WS_SSQP = WS_DT + (size_t)M * 32 * 4;
constexpr size_t WS_SSQH = WS_SSQP + (size_t)M * 32 * 4;
constexpr size_t WS_ACT = WS_SSQH + (size_t)M * 32 * 4;
constexpr size_t WS_RA = WS_ACT + (size_t)M * D_FF * 2;
constexpr size_t WS_PROJ = WS_RA;
constexpr size_t WS_MIXA = WS_PROJ + (size_t)M * N_PROJ * 2;
constexpr size_t WS_MIX = WS_MIXA + (size_t)M * D_MIX * 2;
constexpr size_t WS_UP = WS_RA;
constexpr int KS_OUT = 6, KS_DN = 4;
constexpr size_t WS_SLAB = WS_MIX + (size_t)M * DM * 4;
constexpr size_t WS_SIDE = WS_SLAB + (size_t)8 * MS * DM * 4;
constexpr size_t WS_END = WS_SIDE + (size_t)(MP / 64) * 4 * D_UP * 2;
static_assert((size_t)M * D_UP * 2 <= WS_END - WS_RA, "UP fits region A");

constexpr int RING_BYTES = 131072, LDSCTL_OFF = RING_BYTES, LDS_BYTES = 147456;

#define LAS __attribute__((address_space(3)))
typedef unsigned short bf16;
typedef float f32x4 __attribute__((ext_vector_type(4)));
#define RLX_AGENT __ATOMIC_RELAXED, __HIP_MEMORY_SCOPE_AGENT
__device__ __forceinline__ unsigned f2bf(float f) { unsigned u = __builtin_bit_cast(unsigned, f); return (u + 0x7fffu + ((u >> 16) & 1u)) >> 16; }
__device__ __forceinline__ unsigned pk2(float lo, float hi) { unsigned r; asm("v_cvt_pk_bf16_f32 %0, %1, %2" : "=v"(r) : "v"(lo), "v"(hi)); return r; }
__device__ __forceinline__ float bflo(unsigned u) { return __uint_as_float(u << 16); }
__device__ __forceinline__ float bfhi(unsigned u) { return __uint_as_float(u & 0xffff0000u); }
__device__ __forceinline__ float bf2f(bf16 b) { return __uint_as_float(((unsigned)b) << 16); }
struct F8 { float v[8]; };
__device__ __forceinline__ F8 ld_bf8(const bf16* p) { const uint4 u = *(const uint4*)p; F8 r; r.v[0] = bflo(u.x); r.v[1] = bfhi(u.x); r.v[2] = bflo(u.y); r.v[3] = bfhi(u.y); r.v[4] = bflo(u.z); r.v[5] = bfhi(u.z); r.v[6] = bflo(u.w); r.v[7] = bfhi(u.w); return r; }
__device__ __forceinline__ F8 unpack8(const uint4 u) { F8 r; r.v[0] = bflo(u.x); r.v[1] = bfhi(u.x); r.v[2] = bflo(u.y); r.v[3] = bfhi(u.y); r.v[4] = bflo(u.z); r.v[5] = bfhi(u.z); r.v[6] = bflo(u.w); r.v[7] = bfhi(u.w); return r; }
__device__ __forceinline__ F8 ld_f8(const float* p) { const float4 a = *(const float4*)p, b = *(const float4*)(p + 4); F8 r; r.v[0] = a.x; r.v[1] = a.y; r.v[2] = a.z; r.v[3] = a.w; r.v[4] = b.x; r.v[5] = b.y; r.v[6] = b.z; r.v[7] = b.w; return r; }
__device__ __forceinline__ F8 zero8() { F8 r;
#pragma unroll
    for (int i = 0; i < 8; ++i) r.v[i] = 0.f; return r; }
__device__ __forceinline__ void st_bf8(bf16* p, const F8& r) { uint4 u; u.x = pk2(r.v[0], r.v[1]); u.y = pk2(r.v[2], r.v[3]); u.z = pk2(r.v[4], r.v[5]); u.w = pk2(r.v[6], r.v[7]); *(uint4*)p = u; }
__device__ __forceinline__ void st_f8(float* p, const F8& r) { *(float4*)p = make_float4(r.v[0], r.v[1], r.v[2], r.v[3]); *(float4*)(p + 4) = make_float4(r.v[4], r.v[5], r.v[6], r.v[7]); }
__device__ __forceinline__ float silu_f(float x) { return x * __builtin_amdgcn_rcpf(1.f + __expf(-x)); }
__device__ __forceinline__ float wave_sum(float v) {
#pragma unroll
    for (int o = 1; o < 64; o <<= 1) v += __shfl_xor(v, o);
    return v;
}

#define XB_TMO      128
#define XB_XCNT(j)  (256  + 64 * (j))
#define XB_XSUB(j)  (1280 + 64 * (j))
#define XB_XGEN(j)  (2304 + 64 * (j))
#define XB_TOP      3328
#define XB_TOPGEN   3392
#define XCD_BAR_WORDS 3456
#define XB_SPIN_CAP (1u << 18)
__device__ __forceinline__ unsigned xb_ld(unsigned* p)              { return __hip_atomic_load(p, __ATOMIC_RELAXED, __HIP_MEMORY_SCOPE_AGENT); }
__device__ __forceinline__ unsigned xb_add(unsigned* p, unsigned v) { return __hip_atomic_fetch_add(p, v, __ATOMIC_RELAXED, __HIP_MEMORY_SCOPE_AGENT); }
__device__ __forceinline__ unsigned xb_xcc_id() { return (unsigned)__builtin_amdgcn_s_getreg((3 << 11) | 20) & 0xFu; }
#define XB_SPIN(cond, bar) do { unsigned _sp = 0; while (cond) { __builtin_amdgcn_s_sleep(1); \
    if ((++_sp & 255u) == 0u) { if (xb_ld(&(bar)[XB_TMO])) break; if (_sp > XB_SPIN_CAP) { atomicAdd(&(bar)[XB_TMO], 1u); break; } } } } while (0)
struct XcdBarrier { unsigned* bar; unsigned x; volatile LAS unsigned* st; };
__device__ __forceinline__ XcdBarrier xcd_barrier_post(unsigned* bar, volatile LAS unsigned* st, bool lead) {
    XcdBarrier b; b.bar = bar; b.x = xb_xcc_id(); b.st = st;
    if (lead) (void)xb_add(&bar[XB_XCNT(b.x)], 1u);
    return b;
}
__device__ __forceinline__ void xcd_barrier_complete(unsigned* bar, unsigned x, unsigned& nloc, unsigned& nx) {
    const unsigned G = gridDim.x * gridDim.y * gridDim.z;
    unsigned sum, cnt, mine, sp = 0u;
    for (;;) {
        sum = 0u; cnt = 0u; mine = 0u;
#pragma unroll
        for (unsigned j = 0; j < 16; ++j) { const unsigned c = xb_ld(&bar[XB_XCNT(j)]); sum += c; cnt += (c > 0u) ? 1u : 0u; mine = (j == x) ? c : mine; }
        if (sum == G) break;
        __builtin_amdgcn_s_sleep(1);
        if ((++sp & 255u) == 0u) { if (xb_ld(&bar[XB_TMO])) break; if (sp > XB_SPIN_CAP) { atomicAdd(&bar[XB_TMO], 1u); break; } }
    }
    nloc = mine > 0u ? mine : 1u; nx = cnt > 0u ? cnt : 1u;
}
__device__ __forceinline__ void xcd_barrier(const XcdBarrier& b, bool lead) {
    asm volatile("s_waitcnt vmcnt(0)" ::: "memory");
    __syncthreads();
    if (lead) {
        unsigned* bar = b.bar;
        __builtin_amdgcn_s_waitcnt(0);
        unsigned nloc = b.st[0], nx = b.st[1];
        if (nloc == 0u) { xcd_barrier_complete(bar, b.x, nloc, nx); b.st[0] = nloc; b.st[1] = nx; }
        const unsigned old = xb_add(&bar[XB_XSUB(b.x)], 1u);
        const unsigned gen = old / nloc;
        if (old + 1u == (gen + 1u) * nloc) {
            __builtin_amdgcn_fence(__ATOMIC_RELEASE, "agent");
            asm volatile("s_waitcnt vmcnt(0)" ::: "memory");
            const unsigned og = xb_add(&bar[XB_TOP], 1u);
            const unsigned tg = og / nx;
            if (og + 1u == (tg + 1u) * nx) xb_add(&bar[XB_TOPGEN], 1u);
            else XB_SPIN(xb_ld(&bar[XB_TOPGEN]) == tg, bar);
            __builtin_amdgcn_fence(__ATOMIC_ACQUIRE, "agent");
            xb_add(&bar[XB_XGEN(b.x)], 1u);
            asm volatile("s_waitcnt vmcnt(0)" ::: "memory");
        } else {
            XB_SPIN(xb_ld(&bar[XB_XGEN(b.x)]) == gen, bar);
            __builtin_amdgcn_fence(__ATOMIC_ACQUIRE, "agent");
            asm volatile("s_waitcnt vmcnt(0)" ::: "memory");
        }
    }
    __syncthreads();
}

struct Args { const float* in[24]; float* out; unsigned char* ws; int ph_lo, ph_hi; };

struct Ctx {
    LAS unsigned char* lds; int tid, lane, wave, G, gw, NGW, wave0;
    const float* const* in; float* out; unsigned char* ws;
    __device__ __forceinline__ void refresh() {
        int t = wave0 * 64 + lane_id(); asm volatile("" : "+v"(t)); tid = t; lane = t & 63; wave = __builtin_amdgcn_readfirstlane(t >> 6); gw = blockIdx.x * NWAVES + wave; NGW = G * NWAVES; }
};

constexpr int I_IN = (DM / 64) * (D_IN / 32), I_OUT = (D_MIX / 64) * (DM / 32), I_UP = (DM / 64) * (DM * 0 + D_UP / 32), I_DN = (D_FF / 64) * (DM / 32), I_L = I_IN + I_OUT + I_UP + I_DN;
struct ConvJob { const float* W; const float* gain; bf16* dst; int N, ldd, kb, nb; };
__device__ __forceinline__ ConvJob conv_job(const Ctx& C, int l, int r) {
    ConvJob j;
    if (r < I_IN) { const int nbk = D_IN / 32; j.W = C.in[7] + (size_t)l * DM * D_IN; j.gain = C.in[6] + l * DM; j.dst = (bf16*)(C.ws + WS_BTIN) + (size_t)l * N_INP * DMP; j.N = D_IN; j.ldd = DMP; j.kb = r / nbk; j.nb = r % nbk; return j; }
    r -= I_IN;
    if (r < I_OUT) { const int nbk = DM / 32; j.kb = r / nbk; j.nb = r % nbk; j.W = C.in[16] + (size_t)l * D_MIX * DM; j.N = DM;
        if (j.kb < 16) { j.gain = C.in[9] + l * D_POOL; j.dst = (bf16*)(C.ws + WS_WOP) + (size_t)l * DM * D_POOL; j.ldd = D_POOL; }
        else { j.gain = C.in[15] + l * D_SSD - D_POOL; j.dst = (bf16*)(C.ws + WS_BTOUT) + (size_t)l * DM * D_MIX; j.ldd = D_MIX; }
        return j; }
    r -= I_OUT;
    if (r < I_UP) { const int nbk = D_UP / 32, nb = r % nbk, n0 = 32 * nb, hv = n0 / D_FF, cc = n0 % D_FF, np = 256 * (cc / 128) + 128 * hv + (cc % 128);
        j.W = C.in[19] + (size_t)l * DM * D_UP; j.gain = C.in[18] + l * DM; j.dst = (bf16*)(C.ws + WS_BTUP) + (size_t)l * D_UP * DMP + (long)(np - n0) * DMP; j.N = D_UP; j.ldd = DMP; j.kb = r / nbk; j.nb = nb; return j; }
    r -= I_UP;
    { const int nbk = DM / 32; j.W = C.in[22] + (size_t)l * D_FF * DM; j.gain = nullptr; j.dst = (bf16*)(C.ws + WS_BTDN) + (size_t)l * DM * D_FF; j.N = DM; j.ldd = D_FF; j.kb = r / nbk; j.nb = r % nbk; }
    return j;
}
constexpr int I_FFN = I_UP + I_DN, I_MIX = I_IN + I_OUT;
__device__ __forceinline__ int conv_ssd_count(int l) { return l + 1 < DEPTH ? I_L : I_FFN; }
__device__ __forceinline__ ConvJob conv_job_ssd(const Ctx& C, int l, int r) { return r < I_FFN ? conv_job(C, l, r + I_MIX) : conv_job(C, l + 1, r - I_FFN); }
__device__ __forceinline__ void conv_issue(const ConvJob& j, int lane, float (&wv)[32], float& gl) {
    const int k0 = 64 * j.kb, n0 = 32 * j.nb;
    gl = j.gain ? j.gain[k0 + lane] : 1.f;
#pragma unroll
    for (int i = 0; i < 32; ++i) { const int kk = 2 * i + (lane >> 5); wv[i] = j.W[(size_t)(k0 + kk) * j.N + n0 + (lane & 31)]; }
}
__device__ __forceinline__ void conv_finish(const ConvJob& j, int lane, const float (&wv)[32], float gl, LAS float* scr) {
    const int k0 = 64 * j.kb, n0 = 32 * j.nb; const int gli = __builtin_bit_cast(int, gl);
#pragma unroll
    for (int i = 0; i < 32; ++i) { const int kk = 2 * i + (lane >> 5);
        const float g0 = __builtin_bit_cast(float, __builtin_amdgcn_readlane(gli, 2 * i)), g1 = __builtin_bit_cast(float, __builtin_amdgcn_readlane(gli, 2 * i + 1));
        scr[kk * 33 + (lane & 31)] = wv[i] * (lane < 32 ? g0 : g1); }
    asm volatile("s_waitcnt lgkmcnt(0)" ::: "memory");
    const int c = lane & 7;
#pragma unroll
    for (int jj = 0; jj < 4; ++jj) { const int n = (lane >> 3) + 8 * jj; const LAS float* s = scr + (8 * c) * 33 + n;
        uint4 o; o.x = pk2(s[0 * 33], s[1 * 33]); o.y = pk2(s[2 * 33], s[3 * 33]); o.z = pk2(s[4 * 33], s[5 * 33]); o.w = pk2(s[6 * 33], s[7 * 33]);
        *(uint4*)(j.dst + (size_t)(n0 + n) * j.ldd + k0 + 8 * c) = o; }
    asm volatile("s_waitcnt lgkmcnt(0)" ::: "memory");
}
__device__ __forceinline__ void phase_convert(Ctx C) {
    C.refresh();
    LAS float* scr = (LAS float*)(C.lds + C.wave * 16384);
    for (int it = C.gw; it < I_IN + I_OUT; it += C.NGW) { const ConvJob j = conv_job(C, 0, it); float wv[32], gl; conv_issue(j, C.lane, wv, gl); conv_finish(j, C.lane, wv, gl, scr); }
    { const int gt = C.gw * 64 + C.lane, NGT = C.NGW * 64;
      const float* wp = C.in[8]; bf16* wpb = (bf16*)(C.ws + WS_WPB);
      for (int i = gt; i < DEPTH * 4 * 256 * 256 / 8; i += NGT) { const F8 v = ld_f8(wp + (size_t)i * 8); st_bf8(wpb + (size_t)i * 8, v); } }
    for (int row = C.gw; row < M; row += C.NGW) {
        const float* src = row < MP ? C.in[0] + (size_t)row * DM : C.in[1] + (size_t)(row - MP) * DM;
        bf16* XB = (bf16*)(C.ws + WS_XB) + (size_t)row * DMP; float q = 0.f;
#pragma unroll
        for (int j = 0; j < 8; ++j) { const int idx = (C.lane + 64 * j) * 4; const float4 v = *(const float4*)(src + idx); q += (v.x * v.x + v.y * v.y) + (v.z * v.z + v.w * v.w);
            *(uint2*)(XB + idx) = make_uint2(pk2(v.x, v.y), pk2(v.z, v.w)); }
        q = wave_sum(q);
        if (C.lane == 0) ((float*)(C.ws + WS_R))[row] = rsqrtf(q * (1.f / DM) + EPS);
    }
}

__device__ __forceinline__ void phase_dt(Ctx C, int l) {
    C.refresh();
    typedef short bf16x8_t __attribute__((ext_vector_type(8))); typedef unsigned u32x4_t __attribute__((ext_vector_type(4)));
    const bf16* XB = (const bf16*)(C.ws + WS_XB); const bf16* BD = (const bf16*)(C.ws + WS_BTIN) + ((size_t)l * N_INP + N_PROJ) * DMP; const float* R = (const float*)(C.ws + WS_R); float* DT = (float*)(C.ws + WS_DT);
    const int r16 = C.lane & 15, q = C.lane >> 4;
    for (int i = C.tid; i < 32 * (DM / 8); i += NTHR) { const int n = i / (DM / 8), ch = i % (DM / 8);
        const uint4 v = *(const uint4*)(BD + (size_t)n * DMP + ch * 8); *(LAS u32x4_t*)(C.lds + n * 4096 + ((ch ^ (n & 15)) << 4)) = (u32x4_t){v.x, v.y, v.z, v.w}; }
    __syncthreads();
    for (int task = C.gw; task < M / 16; task += C.NGW) {
        const int row0 = task * 16;
        const bf16* ap = XB + (size_t)(row0 + r16) * DMP + 8 * q;
        f32x4 acc0 = (f32x4){0.f, 0.f, 0.f, 0.f}, acc1 = acc0;
#pragma unroll 16
        for (int ks = 0; ks < DM / 32; ++ks) { const bf16x8_t a = *(const bf16x8_t*)(ap + 32 * ks); const int ch = 4 * ks + q;
            acc0 = __builtin_amdgcn_mfma_f32_16x16x32_bf16(a, *(const LAS bf16x8_t*)(C.lds + r16 * 4096 + ((ch ^ r16) << 4)), acc0, 0, 0, 0);
            acc1 = __builtin_amdgcn_mfma_f32_16x16x32_bf16(a, *(const LAS bf16x8_t*)(C.lds + (16 + r16) * 4096 + ((ch ^ r16) << 4)), acc1, 0, 0, 0); }
#pragma unroll
        for (int r = 0; r < 4; ++r) { const int row = row0 + 4 * q + r; const float s = R[row]; DT[(size_t)row * 32 + r16] = acc0[r] * s; DT[(size_t)row * 32 + 16 + r16] = acc1[r] * s; }
    }
    __syncthreads();
}

__device__ __forceinline__ void phase_resid(Ctx C, const float* gpost, bool final_out, int nslab, bool gfold) {
    C.refresh();
    const bf16* MIXB = (const bf16*)(C.ws + WS_MIX); const float* SSQ = (const float*)(C.ws + WS_SSQP); const float* SLAB = (const float*)(C.ws + WS_SLAB);
    for (int row = C.gw; row < M; row += C.NGW) {
        F8 mv[4]; float p; uint4 xq[4];
        bf16* XB = (bf16*)(C.ws + WS_XB) + (size_t)row * DMP;
#pragma unroll
        for (int j = 0; j < 4; ++j) xq[j] = *(const uint4*)(XB + (C.lane + 64 * j) * 8);
        if (row < MP) {
            p = C.lane < 32 ? SSQ[(size_t)row * 32 + C.lane] : 0.f;
#pragma unroll
            for (int j = 0; j < 4; ++j) mv[j] = ld_bf8(MIXB + (size_t)row * DM + (C.lane + 64 * j) * 8);
        } else {
            p = 0.f; float r0 = 1.f, r1 = 1.f;
            if (gfold) { float hs = C.lane < 32 ? ((const float*)(C.ws + WS_SSQH))[(size_t)row * 32 + C.lane] : 0.f;
#pragma unroll
                for (int o = 1; o < 16; o <<= 1) hs += __shfl_xor(hs, o);
                r0 = rsqrtf(__shfl(hs, 0) * (1.f / 1024.f) + EPS); r1 = rsqrtf(__shfl(hs, 16) * (1.f / 1024.f) + EPS); }
#pragma unroll
            for (int j = 0; j < 4; ++j) { F8 a = zero8();
                for (int s = 0; s < nslab; ++s) { const F8 t = ld_f8(SLAB + ((size_t)s * MS + (row - MP)) * DM + (C.lane + 64 * j) * 8); const float sc = gfold ? (s < 2 ? 1.f : (s < 4 ? r0 : r1)) : 1.f;
#pragma unroll
                    for (int k = 0; k < 8; ++k) a.v[k] += t.v[k] * sc; }
                mv[j] = a;
#pragma unroll
                for (int k = 0; k < 8; ++k) p += a.v[k] * a.v[k]; }
        }
        p = wave_sum(p);
        const float rs = rsqrtf(p * (1.f / DM) + EPS);
        float* Y = C.out + O_YP + (size_t)row * DM; float q = 0.f;
#pragma unroll
        for (int j = 0; j < 4; ++j) { const int idx = (C.lane + 64 * j) * 8; const F8 g8 = ld_f8(gpost + idx); F8 v = unpack8(xq[j]);
#pragma unroll
            for (int k = 0; k < 8; ++k) { v.v[k] += mv[j].v[k] * rs * g8.v[k]; q += v.v[k] * v.v[k]; }
            if (final_out) st_f8(Y + idx, v);
            st_bf8(XB + idx, v); }
        q = wave_sum(q);
        if (C.lane == 0) ((float*)(C.ws + WS_R))[row] = rsqrtf(q * (1.f / DM) + EPS);
    }
}

__device__ __forceinline__ void phase_gnorm(Ctx C) {
    C.refresh();
    const float* SSQH = (const float*)(C.ws + WS_SSQH); bf16* MIXA = (bf16*)(C.ws + WS_MIXA);
    for (int rowb = C.gw * 4; rowb < M; rowb += C.NGW * 4) {
        uint4 qv[4][4]; float pr[4];
#pragma unroll
        for (int rr = 0; rr < 4; ++rr) { const int row = rowb + rr; pr[rr] = C.lane < 32 ? SSQH[(size_t)row * 32 + C.lane] : 0.f;
#pragma unroll
            for (int j = 0; j < 4; ++j) qv[rr][j] = *(const uint4*)(MIXA + (size_t)row * D_MIX + D_POOL + (C.lane + 64 * j) * 8); }
#pragma unroll
        for (int rr = 0; rr < 4; ++rr) { const int row = rowb + rr; float p = pr[rr];
#pragma unroll
            for (int o = 1; o < 16; o <<= 1) p += __shfl_xor(p, o);
            const float s0 = __shfl(p, 0), s1 = __shfl(p, 16);
            const float r0 = rsqrtf(s0 * (1.f / 1024.f) + EPS), r1 = rsqrtf(s1 * (1.f / 1024.f) + EPS);
            bf16* y = MIXA + (size_t)row * D_MIX + D_POOL;
#pragma unroll
            for (int j = 0; j < 4; ++j) { const int c = (C.lane + 64 * j) * 8; const float r = c < 1024 ? r0 : r1; F8 v = unpack8(qv[rr][j]);
#pragma unroll
                for (int i = 0; i < 8; ++i) v.v[i] *= r;
                st_bf8(y + c, v); } }
    }
}

__device__ __forceinline__ void phase_act(Ctx C, int l) {
    C.refresh();
    const bf16* UP = (const bf16*)(C.ws + WS_UP); bf16* ACT = (bf16*)(C.ws + WS_ACT);
    const float* cw = C.in[20] + (size_t)l * 3 * D_UP; const float* cb = C.in[21] + (size_t)l * D_UP; const float* hist = C.in[5] + (size_t)l * NB_S * 2 * D_UP;
    constexpr int NCG = D_FF / 8, NPIECE = MS / 8;
    const int gt = C.gw * 64 + C.lane, NGT = C.NGW * 64;
    for (int it = gt; it < NPIECE * NCG; it += NGT) {
        const int piece = it / NCG, c = (it % NCG) * 8, b = piece >> 2, t0 = (piece & 3) * 8, row0 = MP + b * SEQ_S + t0;
        uint4 qg[10], qv[10];
#pragma unroll
        for (int r = 0; r < 10; ++r) { const int rr = (t0 == 0 && r < 2) ? 2 : r; qg[r] = *(const uint4*)(UP + (size_t)(row0 + rr - 2) * D_UP + c); qv[r] = *(const uint4*)(UP + (size_t)(row0 + rr - 2) * D_UP + D_FF + c); }
        const float* h = hist + (size_t)b * 2 * D_UP;
        const F8 h2g = ld_f8(h + c), h2v = ld_f8(h + D_FF + c), h1g = ld_f8(h + D_UP + c), h1v = ld_f8(h + D_UP + D_FF + c);
        const F8 w0g = ld_f8(cw + c), w1g = ld_f8(cw + D_UP + c), w2g = ld_f8(cw + 2 * D_UP + c), bg = ld_f8(cb + c);
        const F8 w0v = ld_f8(cw + D_FF + c), w1v = ld_f8(cw + D_UP + D_FF + c), w2v = ld_f8(cw + 2 * D_UP + D_FF + c), bv = ld_f8(cb + D_FF + c);
        F8 p2g = unpack8(qg[0]), p2v = unpack8(qv[0]), p1g = unpack8(qg[1]), p1v = unpack8(qv[1]);
        if (t0 == 0) { p2g = h2g; p2v = h2v; p1g = h1g; p1v = h1v; }
#pragma unroll
        for (int r = 0; r < 8; ++r) { const F8 cg = unpack8(qg[r + 2]), cv = unpack8(qv[r + 2]); F8 o;
#pragma unroll
            for (int i = 0; i < 8; ++i) { const float g = bg.v[i] + w0g.v[i] * p2g.v[i] + w1g.v[i] * p1g.v[i] + w2g.v[i] * cg.v[i]; const float v = bv.v[i] + w0v.v[i] * p2v.v[i] + w1v.v[i] * p1v.v[i] + w2v.v[i] * cv.v[i]; o.v[i] = silu_f(g) * v; }
            st_bf8(ACT + (size_t)(row0 + r) * D_FF + c, o);
            p2g = p1g; p1g = cg; p2v = p1v; p1v = cv; }
        if (t0 == SEQ_S - 8) {
            float* o = C.out + O_FCS + ((size_t)(l * NB_S + b) * 2) * D_UP;
            st_f8(o + c, p2g); st_f8(o + D_FF + c, p2v); st_f8(o + D_UP + c, p1g); st_f8(o + D_UP + D_FF + c, p1v);
        }
    }
}

__device__ __forceinline__ void phase_actfix(Ctx C, int l) {
    C.refresh();
    const bf16* SIDE = (const bf16*)(C.ws + WS_SIDE); bf16* ACT = (bf16*)(C.ws + WS_ACT);
    const float* cw = C.in[20] + (size_t)l * 3 * D_UP; const float* cb = C.in[21] + (size_t)l * D_UP;
    constexpr int NCG = D_FF / 8, NBLK = MP / 64;
    const int gt = C.gw * 64 + C.lane, NGT = C.NGW * 64;
    for (int it = gt; it < NBLK * NCG; it += NGT) {
        const int kb = it / NCG, c = (it % NCG) * 8; const bool start = (kb % (SEQ / 64)) == 0;
        const bf16* sp = SIDE + (size_t)(start ? kb : kb - 1) * 4 * D_UP + c; const bf16* sc = SIDE + (size_t)kb * 4 * D_UP + c;
        uint4 q[8];
        q[0] = *(const uint4*)(sp + 2 * D_UP); q[1] = *(const uint4*)(sp + 2 * D_UP + D_FF); q[2] = *(const uint4*)(sp + 3 * D_UP); q[3] = *(const uint4*)(sp + 3 * D_UP + D_FF);
        q[4] = *(const uint4*)(sc); q[5] = *(const uint4*)(sc + D_FF); q[6] = *(const uint4*)(sc + D_UP); q[7] = *(const uint4*)(sc + D_UP + D_FF);
        F8 p2g = unpack8(q[0]), p2v = unpack8(q[1]), p1g = unpack8(q[2]), p1v = unpack8(q[3]); const F8 r0g = unpack8(q[4]), r0v = unpack8(q[5]), r1g = unpack8(q[6]), r1v = unpack8(q[7]);
        if (start) { p2g = zero8(); p2v = zero8(); p1g = zero8(); p1v = zero8(); }
        const F8 w0g = ld_f8(cw + c), w1g = ld_f8(cw + D_UP + c), w2g = ld_f8(cw + 2 * D_UP + c), bg = ld_f8(cb + c);
        const F8 w0v = ld_f8(cw + D_FF + c), w1v = ld_f8(cw + D_UP + D_FF + c), w2v = ld_f8(cw + 2 * D_UP + D_FF + c), bv = ld_f8(cb + D_FF + c);
        F8 o0, o1;
#pragma unroll
        for (int i = 0; i < 8; ++i) { const float g0 = bg.v[i] + w0g.v[i] * p2g.v[i] + w1g.v[i] * p1g.v[i] + w2g.v[i] * r0g.v[i], v0 = bv.v[i] + w0v.v[i] * p2v.v[i] + w1v.v[i] * p1v.v[i] + w2v.v[i] * r0v.v[i];
            const float g1 = bg.v[i] + w0g.v[i] * p1g.v[i] + w1g.v[i] * r0g.v[i] + w2g.v[i] * r1g.v[i], v1 = bv.v[i] + w0v.v[i] * p1v.v[i] + w1v.v[i] * r0v.v[i] + w2v.v[i] * r1v.v[i];
            o0.v[i] = silu_f(g0) * v0; o1.v[i] = silu_f(g1) * v1; }
        st_bf8(ACT + (size_t)(kb * 64) * D_FF + c, o0); st_bf8(ACT + (size_t)(kb * 64 + 1) * D_FF + c, o1);
        if ((kb % (SEQ / 64)) == SEQ / 64 - 1) {
            float* o = C.out + O_FCP + ((size_t)(l * NB_P + kb / (SEQ / 64)) * 2) * D_UP;
            st_f8(o + c, ld_bf8(sc + 2 * D_UP)); st_f8(o + D_FF + c, ld_bf8(sc + 2 * D_UP + D_FF)); st_f8(o + D_UP + c, ld_bf8(sc + 3 * D_UP)); st_f8(o + D_UP + D_FF + c, ld_bf8(sc + 3 * D_UP + D_FF)); }
    }
}

__device__ __forceinline__ void phase_pool(Ctx C, int l) {
    C.refresh();
    const bf16* PROJ = (const bf16*)(C.ws + WS_PROJ); bf16* MIXA = (bf16*)(C.ws + WS_MIXA);
    const float* hist = C.in[2] + (size_t)l * NB_S * POOL_HIST * D_POOL;
    constexpr int NCG = D_POOL / 8, NSTRIP = M / 32;
    const int gt = C.gw * 64 + C.lane, NGT = C.NGW * 64;
    for (int it = gt; it < NSTRIP * NCG; it += NGT) {
        const int strip = it / NCG, cgi = it % NCG, c = cgi * 8, row0 = strip * 32; const bool prm = row0 < MP;
        const int b = prm ? row0 / SEQ : (row0 - MP) / SEQ_S, t0 = prm ? row0 % SEQ : 0, w = 2 << (cgi >> 5);
        const int rb = row0 - t0;
        const float* hb = hist + (size_t)b * POOL_HIST * D_POOL;
        F8 s = zero8();
        for (int i = 1; i < w; ++i) { const int t = t0 - i; F8 v;
            if (t >= 0) v = ld_bf8(PROJ + (size_t)(rb + t) * N_PROJ + c); else if (!prm) v = ld_f8(hb + (size_t)(POOL_HIST + t) * D_POOL + c); else v = zero8();
#pragma unroll
            for (int k = 0; k < 8; ++k) s.v[k] += v.v[k]; }
        for (int r0 = 0; r0 < 32; r0 += 8) {
            uint4 qc[8], ql[8];
#pragma unroll
            for (int r = 0; r < 8; ++r) { const int t = t0 + r0 + r, tl = t - w + 1; qc[r] = *(const uint4*)(PROJ + (size_t)(rb + t) * N_PROJ + c); ql[r] = *(const uint4*)(PROJ + (size_t)(rb + (tl > 0 ? tl : 0)) * N_PROJ + c); }
#pragma unroll
            for (int r = 0; r < 8; ++r) { const int t = t0 + r0 + r, tl = t - w + 1; const F8 cur = unpack8(qc[r]);
                const float inv = 1.f / (float)(prm ? (t + 1 < w ? t + 1 : w) : w); F8 o;
#pragma unroll
                for (int k = 0; k < 8; ++k) { s.v[k] += cur.v[k]; o.v[k] = s.v[k] * inv - cur.v[k]; }
                st_bf8(MIXA + (size_t)(rb + t) * D_MIX + c, o);
                F8 v = unpack8(ql[r]);
                if (tl < 0) { if (!prm) v = ld_f8(hb + (size_t)(POOL_HIST + tl) * D_POOL + c); else v = zero8(); }
#pragma unroll
                for (int k = 0; k < 8; ++k) s.v[k] -= v.v[k]; }
        }
    }
    for (int it = gt; it < (NB_P + NB_S) * 15 * NCG; it += NGT) {
        const int cg = it % NCG, i = (it / NCG) % 15, sb = it / (NCG * 15); const bool prm = sb < NB_P; const int b = prm ? sb : sb - NB_P;
        const int row = prm ? b * SEQ + (SEQ - 15 + i) : MP + b * SEQ_S + (SEQ_S - 15 + i);
        float* o = C.out + (prm ? O_POOLP + ((size_t)(l * NB_P + b) * 15 + i) * D_POOL : O_POOLS + ((size_t)(l * NB_S + b) * 15 + i) * D_POOL);
        st_f8(o + cg * 8, ld_bf8(PROJ + (size_t)row * N_PROJ + cg * 8));
    }
    constexpr int NCG2 = CONV_DIM / 8;
    for (int it = gt; it < (NB_P + NB_S) * 3 * NCG2; it += NGT) {
        const int cg = it % NCG2, i = (it / NCG2) % 3, sb = it / (NCG2 * 3); const bool prm = sb < NB_P; const int b = prm ? sb : sb - NB_P;
        const int row = prm ? b * SEQ + (SEQ - 3 + i) : MP + b * SEQ_S + (SEQ_S - 3 + i);
        float* o = C.out + (prm ? O_SCP + ((size_t)(l * NB_P + b) * 3 + i) * CONV_DIM : O_SCS + ((size_t)(l * NB_S + b) * 3 + i) * CONV_DIM);
        st_f8(o + cg * 8, ld_bf8(PROJ + (size_t)row * N_PROJ + XBC0 + cg * 8));
    }
}

__device__ __forceinline__ void phase_ssd(Ctx C, int l) {
    C.refresh();
    LAS float* xs = (LAS float*)(C.lds); LAS float* Bs = (LAS float*)(C.lds + 16384); LAS float* Cs = (LAS float*)(C.lds + 49152); LAS float* ys = (LAS float*)(C.lds + 81920);
    LAS float* dts = (LAS float*)(C.lds + 98304); LAS float* dAs = dts + 64;
    const bf16* PROJ = (const bf16*)(C.ws + WS_PROJ); const float* DT = (const float*)(C.ws + WS_DT); bf16* MIXA = (bf16*)(C.ws + WS_MIXA); float* SSQH = (float*)(C.ws + WS_SSQH);
    const float* cw = C.in[10] + (size_t)l * 4 * CONV_DIM; const float* cb = C.in[11] + (size_t)l * CONV_DIM;
    const int tid = C.tid, p = tid >> 3, n0 = (tid & 7) * 16;
    for (int u = blockIdx.x; u < NB_P * NH + NB_S * NH; u += C.G) {
        const bool prm = u < NB_P * NH; const int su = prm ? u : u - NB_P * NH, b = su / NH, hh = su % NH, g = hh / HPG;
        const int rb = prm ? b * SEQ : MP + b * SEQ_S, rows = prm ? 64 : 32, nchunk = prm ? SEQ / 64 : 1;
        const float Aneg = -__expf(C.in[13][l * NH + hh]), Dsk = C.in[14][l * NH + hh], dtb = C.in[12][l * NH + hh];
        const float* chist = C.in[3] + ((size_t)(l * NB_S + b) * 3) * CONV_DIM;
        float h[16];
        if (prm) {
#pragma unroll
            for (int i = 0; i < 16; ++i) h[i] = 0.f;
        } else { const float* h0 = C.in[4] + ((((size_t)l * NB_S + b) * NH + hh) * HD + p) * DS + n0;
#pragma unroll
            for (int i = 0; i < 4; ++i) { const float4 v = *(const float4*)(h0 + 4 * i); h[4 * i] = v.x; h[4 * i + 1] = v.y; h[4 * i + 2] = v.z; h[4 * i + 3] = v.w; } }
        for (int ch = 0; ch < nchunk; ++ch) {
            const int tb = ch * 64;
            for (int e = tid; e < rows * 40; e += NTHR) {
                const int cg = e % 40, tt = e / 40, t = tb + tt;
                int cc; LAS float* dstp;
                if (cg < 8) { cc = hh * HD + cg * 8; dstp = xs + tt * 64 + cg * 8; }
                else if (cg < 24) { cc = D_SSD + g * DS + (cg - 8) * 8; dstp = Bs + tt * 128 + (cg - 8) * 8; }
                else { cc = D_SSD + 2 * DS + g * DS + (cg - 24) * 8; dstp = Cs + tt * 128 + (cg - 24) * 8; }
                F8 a = ld_f8(cb + cc);
#pragma unroll
                for (int i = 0; i < 4; ++i) { const int ti = t - 3 + i; F8 v;
                    if (ti >= 0) v = ld_bf8(PROJ + (size_t)(rb + ti) * N_PROJ + XBC0 + cc); else if (!prm) v = ld_f8(chist + (size_t)(3 + ti) * CONV_DIM + cc); else v = zero8();
                    const F8 wv = ld_f8(cw + (size_t)i * CONV_DIM + cc);
#pragma unroll
                    for (int k = 0; k < 8; ++k) a.v[k] += wv.v[k] * v.v[k]; }
#pragma unroll
                for (int k = 0; k < 8; ++k) dstp[k] = silu_f(a.v[k]);
            }
            if (tid < rows) { const float xr = DT[(size_t)(rb + tb + tid) * 32 + hh] + dtb; const float dtv = xr > 20.f ? xr : log1pf(__expf(xr)); dts[tid] = dtv; dAs[tid] = __expf(dtv * Aneg); }
            __syncthreads();
            for (int tt = 0; tt < rows; ++tt) {
                const float xv = xs[tt * 64 + p], xdt = xv * dts[tt], dA = dAs[tt]; float acc = 0.f;
#pragma unroll
                for (int i = 0; i < 4; ++i) { const f32x4 bv = *(const LAS f32x4*)(Bs + tt * 128 + n0 + 4 * i), cv = *(const LAS f32x4*)(Cs + tt * 128 + n0 + 4 * i);
                    h[4 * i] = dA * h[4 * i] + xdt * bv[0]; acc += cv[0] * h[4 * i];
                    h[4 * i + 1] = dA * h[4 * i + 1] + xdt * bv[1]; acc += cv[1] * h[4 * i + 1];
                    h[4 * i + 2] = dA * h[4 * i + 2] + xdt * bv[2]; acc += cv[2] * h[4 * i + 2];
                    h[4 * i + 3] = dA * h[4 * i + 3] + xdt * bv[3]; acc += cv[3] * h[4 * i + 3]; }
                acc += __shfl_xor(acc, 1); acc += __shfl_xor(acc, 2); acc += __shfl_xor(acc, 4);
                if ((tid & 7) == 0) ys[tt * 64 + p] = acc + Dsk * xv;
            }
            __syncthreads();
            for (int e = tid; e < rows * 64; e += NTHR) {
                const int tt = e >> 6, pp = e & 63; const size_t row = (size_t)(rb + tb + tt);
                const float zv = bf2f(PROJ[row * N_PROJ + D_POOL + hh * HD + pp]); const float yz = ys[tt * 64 + pp] * silu_f(zv);
                MIXA[row * D_MIX + D_POOL + hh * HD + pp] = (bf16)f2bf(yz);
                const float q = wave_sum(yz * yz);
                if (pp == 0) SSQH[row * 32 + hh] = q;
            }
            __syncthreads();
        }
        float* ho = C.out + (prm ? O_SSDP + ((((size_t)l * NB_P + b) * NH + hh) * HD + p) * DS + n0 : O_SSDS + ((((size_t)l * NB_S + b) * NH + hh) * HD + p) * DS + n0);
#pragma unroll
        for (int i = 0; i < 4; ++i) *(float4*)(ho + 4 * i) = make_float4(h[4 * i], h[4 * i + 1], h[4 * i + 2], h[4 * i + 3]);
    }
}

__device__ __forceinline__ void phase_xact(Ctx C, int l) {
    C.refresh();
    const bf16* PROJ = (const bf16*)(C.ws + WS_PROJ); bf16* ACTX = (bf16*)(C.ws + WS_ACTX);
    const float* cw = C.in[10] + (size_t)l * 4 * CONV_DIM; const float* cb = C.in[11] + (size_t)l * CONV_DIM;
    constexpr int NCG = CONV_DIM / 8, NSTRIP = M / 16;
    const int gt = C.gw * 64 + C.lane, NGT = C.NGW * 64;
    for (int it = gt; it < NSTRIP * NCG; it += NGT) {
        const int strip = it / NCG, c = (it % NCG) * 8, row0 = strip * 16; const bool prm = row0 < MP;
        const int t0 = prm ? row0 % SEQ : (row0 - MP) % SEQ_S, b = prm ? row0 / SEQ : (row0 - MP) / SEQ_S;
        uint4 rq[19];
#pragma unroll
        for (int j = 0; j < 19; ++j) { const int dr = (t0 == 0 && j < 3) ? 0 : j - 3; rq[j] = *(const uint4*)(PROJ + (size_t)(row0 + dr) * N_PROJ + XBC0 + c); }
        if (t0 == 0) {
            const float* h = C.in[3] + ((size_t)(l * NB_S + (prm ? 0 : b)) * 3) * CONV_DIM + c;
#pragma unroll
            for (int j = 0; j < 3; ++j) { uint4 v = make_uint4(0u, 0u, 0u, 0u);
                if (!prm) { const F8 hv = ld_f8(h + (size_t)j * CONV_DIM); v = make_uint4(pk2(hv.v[0], hv.v[1]), pk2(hv.v[2], hv.v[3]), pk2(hv.v[4], hv.v[5]), pk2(hv.v[6], hv.v[7])); }
                rq[j] = v; } }
        F8 wv[4];
#pragma unroll
        for (int i = 0; i < 4; ++i) wv[i] = ld_f8(cw + (size_t)i * CONV_DIM + c);
        const F8 bv = ld_f8(cb + c);
#pragma unroll
        for (int i = 0; i < 16; ++i) { F8 o = bv;
#pragma unroll
            for (int tap = 0; tap < 4; ++tap) { const F8 rj = unpack8(rq[i + tap]);
#pragma unroll
                for (int k = 0; k < 8; ++k) o.v[k] += wv[tap].v[k] * rj.v[k]; }
#pragma unroll
            for (int k = 0; k < 8; ++k) o.v[k] = silu_f(o.v[k]);
            st_bf8(ACTX + (size_t)(row0 + i) * CONV_DIM + c, o); }
    }
}

constexpr int SL_C = 0, SL_B = 17408, SL_BT = 34816, SL_XT = 53248, SL_H = 62464, SL_M = 79872, SL_DT = 89088, SL_AC = SL_DT + 512, SL_W = SL_AC + 512, SL_DEC = SL_W + 512, SL_SSQ = SL_DEC + 16, SL_XWT = SL_SSQ + 1024;
constexpr int PC = 272, PT = 144;
typedef short bf16x8_t __attribute__((ext_vector_type(8)));
__device__ __forceinline__ bf16x8_t ld_op(const LAS unsigned char* base, int row, int pitch, int kelem) { return *(const LAS bf16x8_t*)(base + row * pitch + kelem * 2); }
__device__ __forceinline__ int swz(int row, int byte) { return byte ^ (((row >> 3) & 7) << 4); }
__device__ __forceinline__ bf16x8_t ld_op_sw(const LAS unsigned char* base, int row, int pitch, int kelem) { return *(const LAS bf16x8_t*)(base + row * pitch + swz(row, kelem * 2)); }

typedef unsigned u32x4_t __attribute__((ext_vector_type(4)));
typedef unsigned u32x2_t __attribute__((ext_vector_type(2)));
__device__ __forceinline__ F8 lds_f8(const LAS float* p) { const f32x4 a = *(const LAS f32x4*)p, b = *(const LAS f32x4*)(p + 4); F8 r; r.v[0] = a[0]; r.v[1] = a[1]; r.v[2] = a[2]; r.v[3] = a[3]; r.v[4] = b[0]; r.v[5] = b[1]; r.v[6] = b[2]; r.v[7] = b[3]; return r; }
__device__ __forceinline__ unsigned perm_lo(unsigned hi_row, unsigned lo_row) { return __builtin_amdgcn_perm(hi_row, lo_row, 0x05040100u); }
__device__ __forceinline__ unsigned perm_hi(unsigned hi_row, unsigned lo_row) { return __builtin_amdgcn_perm(hi_row, lo_row, 0x07060302u); }
__device__ __forceinline__ unsigned qword(const uint4& v, int i) { return i == 0 ? v.x : (i == 1 ? v.y : (i == 2 ? v.z : v.w)); }
__device__ __forceinline__ void ssd_stage(LAS unsigned char* L, int cg, int l0, int rows_valid, const LAS float* w_s, const uint4 (&rq)[8]) {
    uint4 r[8];
#pragma unroll
    for (int i = 0; i < 8; ++i) { const bool ok = l0 + i < rows_valid; r[i].x = ok ? rq[i].x : 0u; r[i].y = ok ? rq[i].y : 0u; r[i].z = ok ? rq[i].z : 0u; r[i].w = ok ? rq[i].w : 0u; }
    if (cg < 8) {
        const f32x4 wa = *(const LAS f32x4*)(w_s + l0), wb = *(const LAS f32x4*)(w_s + l0 + 4);
#pragma unroll
        for (int k = 0; k < 8; ++k) { const int p = 8 * cg + k; unsigned t[4];
#pragma unroll
            for (int jj = 0; jj < 4; ++jj) t[jj] = (k & 1) ? perm_hi(qword(r[2 * jj + 1], k >> 1), qword(r[2 * jj], k >> 1)) : perm_lo(qword(r[2 * jj + 1], k >> 1), qword(r[2 * jj], k >> 1));
            *(LAS u32x4_t*)(L + SL_XT + p * PT + swz(p, l0 * 2)) = (u32x4_t){t[0], t[1], t[2], t[3]};
            *(LAS u32x4_t*)(L + SL_XWT + p * PT + swz(p, l0 * 2)) = (u32x4_t){pk2(bflo(t[0]) * wa[0], bfhi(t[0]) * wa[1]), pk2(bflo(t[1]) * wa[2], bfhi(t[1]) * wa[3]), pk2(bflo(t[2]) * wb[0], bfhi(t[2]) * wb[1]), pk2(bflo(t[3]) * wb[2], bfhi(t[3]) * wb[3])}; }
    } else if (cg < 24) { const int n0 = 8 * (cg - 8);
#pragma unroll
        for (int i = 0; i < 8; ++i) *(LAS u32x4_t*)(L + SL_B + (l0 + i) * PC + n0 * 2) = (u32x4_t){r[i].x, r[i].y, r[i].z, r[i].w};
#pragma unroll
        for (int k = 0; k < 8; ++k) { const int n = n0 + k; unsigned t[4];
#pragma unroll
            for (int jj = 0; jj < 4; ++jj) t[jj] = (k & 1) ? perm_hi(qword(r[2 * jj + 1], k >> 1), qword(r[2 * jj], k >> 1)) : perm_lo(qword(r[2 * jj + 1], k >> 1), qword(r[2 * jj], k >> 1));
            *(LAS u32x4_t*)(L + SL_BT + n * PT + swz(n, l0 * 2)) = (u32x4_t){t[0], t[1], t[2], t[3]}; }
    } else { const int n0 = 8 * (cg - 24);
#pragma unroll
        for (int i = 0; i < 8; ++i) *(LAS u32x4_t*)(L + SL_C + (l0 + i) * PC + n0 * 2) = (u32x4_t){r[i].x, r[i].y, r[i].z, r[i].w};
    }
}
__device__ __forceinline__ void ssd_dt(LAS unsigned char* L, int par, float xr, bool valid, float Aneg, int lane) {
    const float dtv = valid ? (xr > 20.f ? xr : log1pf(__expf(xr))) : 0.f;
    float a = dtv * Aneg;
#pragma unroll
    for (int o = 1; o < 64; o <<= 1) { const float v = __shfl_up(a, o); if (lane >= o) a += v; }
    const float last = __shfl(a, 63);
    ((LAS float*)(L + SL_DT))[par * 64 + lane] = dtv; ((LAS float*)(L + SL_AC))[par * 64 + lane] = a; ((LAS float*)(L + SL_W))[par * 64 + lane] = dtv * __expf(last - a);
    if (lane == 0) ((LAS float*)(L + SL_DEC))[par] = __expf(last);
}
#define WG_BAR() do { asm volatile("s_waitcnt lgkmcnt(0)" ::: "memory"); __builtin_amdgcn_s_barrier(); asm volatile("" ::: "memory"); } while (0)
__device__ __forceinline__ void stage_role(int tq, int& cg, int& l0) {
    const int ws = tq >> 6, lane = tq & 63;
    if (ws == 0) { cg = lane & 7; l0 = (lane >> 3) * 8; }
    else { const int idx = ((ws - 1) & 1) * 64 + lane; cg = (ws <= 2 ? 8 : 24) + (idx & 15); l0 = (idx >> 4) * 8; }
}
__device__ __forceinline__ void ssd_load_act(uint4 (&rq)[8], const bf16* ACTX, int tq, int hh, int g, size_t rowf) {
    int cg, l0c; stage_role(tq, cg, l0c);
    const int cc = cg < 8 ? hh * HD + cg * 8 : (cg < 24 ? D_SSD + g * DS + (cg - 8) * 8 : D_SSD + 2 * DS + g * DS + (cg - 24) * 8);
    const unsigned lo = tq < 320 ? (unsigned)(l0c * CONV_DIM + cc) * 2u : 0u;
#pragma unroll
    for (int j = 0; j < 8; ++j) { const char* ub = (const char*)ACTX + ((rowf + j) * CONV_DIM) * 2; rq[j] = *(const uint4*)(ub + lo); }
}
__device__ __forceinline__ void ssd_load_z(uint2 (&zq)[2], const bf16* PROJ, int w, int r16, int q, int hh, size_t row0, int rows) {
    const int pi = w >> 1, li0 = 2 * (w & 1);
#pragma unroll
    for (int t = 0; t < 2; ++t) { const int lrow = 16 * (li0 + t) + r16; const char* ub = (const char*)PROJ + ((row0 + 16 * (li0 + t)) * N_PROJ + D_POOL + hh * HD + 16 * pi) * 2;
        zq[t] = lrow < rows ? *(const uint2*)(ub + (unsigned)(r16 * N_PROJ + 4 * q) * 2u) : make_uint2(0u, 0u); }
}
#define OPQ_V(x) asm volatile("" : "+v"(x))
#define OPQ_S(x) asm volatile("" : "+s"(x))
__device__ __forceinline__ void phase_ssd2(Ctx C, int l) {
    C.refresh();
    LAS unsigned char* L = C.lds;
    const bf16* PROJ = (const bf16*)(C.ws + WS_PROJ); const bf16* ACTX = (const bf16*)(C.ws + WS_ACTX); const float* DT = (const float*)(C.ws + WS_DT); bf16* MIXA = (bf16*)(C.ws + WS_MIXA); float* SSQH = (float*)(C.ws + WS_SSQH);
    const int w0 = C.wave;
    const int conv_l = l, cG = C.G, cbx = (int)blockIdx.x, cN = conv_ssd_count(l);
    float cwv[32], cgl = 1.f; int cslot = 0;
#define tid0 (w0 * 64 + lane_id())
    typedef float f4 __attribute__((ext_vector_type(4)));
#if PROBE_SEL > 0
    volatile LAS unsigned* MISC2 = (volatile LAS unsigned*)(C.lds + LDSCTL_OFF);
    if (blockIdx.x == 0 && w0 == 0 && lane_id() == 0) MISC2[13] = (unsigned)__builtin_amdgcn_s_memrealtime();
#define STAMP2(ty) do { if (blockIdx.x == 0 && w0 == 0 && lane_id() == 0) { const unsigned tn = (unsigned)__builtin_amdgcn_s_memrealtime(); MISC2[16 + (ty)] += tn - MISC2[13]; MISC2[13] = tn; } } while (0)
#else
#define STAMP2(ty) do { } while (0)
#endif
    for (int u = blockIdx.x; u < NB_P * NH + NB_S * NH; u += C.G) {
        STAMP2(19);
        const bool prm = u < NB_P * NH; const int su = prm ? u : u - NB_P * NH, b = su / NH, hh = su % NH, g = hh / HPG;
        const int rb = prm ? b * SEQ : MP + b * SEQ_S, rows = prm ? 64 : 32, nchunk = prm ? SEQ / 64 : 1;
        const float Aneg = -__expf(C.in[13][l * NH + hh]), Dsk = C.in[14][l * NH + hh], dtb = C.in[12][l * NH + hh];
        f4 hacc[4]; float xrn; uint2 zq[2]; uint4 rawq[8];
        {
            int tq = tid0, w = w0; OPQ_V(tq); OPQ_S(w);
            const int lane = tq & 63, r16 = lane & 15, q = lane >> 4; const bool stg = tq < 320; int cg, l0; stage_role(tq, cg, l0);
            const float xr0 = DT[((size_t)rb + (lane < rows ? lane : 0)) * 32 + hh] + dtb;
            ssd_load_act(rawq, ACTX, tq, hh, g, (size_t)rb);
            xrn = DT[((size_t)(rb + 64) + lane) * 32 + hh] + dtb;
#pragma unroll
            for (int pj = 0; pj < 4; ++pj) {
                if (prm) hacc[pj] = (f4){0.f, 0.f, 0.f, 0.f};
                else { const float4 v = *(const float4*)(C.in[4] + ((((size_t)l * NB_S + b) * NH + hh) * HD + 16 * pj + r16) * DS + 16 * w + 4 * q); hacc[pj] = (f4){v.x, v.y, v.z, v.w}; } }
            if (w == 0) ssd_dt(L, 0, xr0, lane < rows, Aneg, lane);
            WG_BAR();
            if (stg) ssd_stage(L, cg, l0, rows, (const LAS float*)(L + SL_W), rawq);
#pragma unroll
            for (int pj = 0; pj < 4; ++pj) *(LAS u32x2_t*)(L + SL_H + (16 * pj + r16) * PC + (16 * w + 4 * q) * 2) = (u32x2_t){pk2(hacc[pj][0], hacc[pj][1]), pk2(hacc[pj][2], hacc[pj][3])};
            ssd_load_z(zq, PROJ, w, r16, q, hh, (size_t)rb, rows);
            ssd_load_act(rawq, ACTX, tq, hh, g, (size_t)rb + 64);
            WG_BAR();
        }
        STAMP2(13);
        for (int c = 0; c < nchunk; ++c) {
            const int par = c & 1, tb = c * 64; const bool more = c + 1 < nchunk;
            {
                int tq = tid0, w = w0; OPQ_V(tq); OPQ_S(w);
                const int lane = tq & 63, r16 = lane & 15, q = lane >> 4;
                const float xrc = xrn;
                xrn = DT[((size_t)(rb + tb + 128) + lane) * 32 + hh] + dtb;
                if (more && w == 0) ssd_dt(L, par ^ 1, xrc, true, Aneg, lane);
                const LAS float* ac = (const LAS float*)(L + SL_AC) + par * 64; const LAS float* dts = (const LAS float*)(L + SL_DT) + par * 64;
#pragma unroll
                for (int t = 0; t < 2; ++t) { const int T = 2 * w + t, si = T >> 2, li = T & 3; f4 acc = (f4){0.f, 0.f, 0.f, 0.f};
#pragma unroll
                    for (int ks = 0; ks < 4; ++ks) acc = __builtin_amdgcn_mfma_f32_16x16x32_bf16(ld_op(L + SL_B, 16 * si + r16, PC, 32 * ks + 8 * q), ld_op(L + SL_C, 16 * li + r16, PC, 32 * ks + 8 * q), acc, 0, 0, 0);
                    const int lr = 16 * li + r16, s0 = 16 * si + 4 * q; const float al = ac[lr]; const f4 as = *(const LAS f4*)(ac + s0), ds = *(const LAS f4*)(dts + s0); float m[4];
#pragma unroll
                    for (int r = 0; r < 4; ++r) m[r] = (s0 + r <= lr) ? acc[r] * __expf(al - as[r]) * ds[r] : 0.f;
                    *(LAS u32x2_t*)(L + SL_M + lr * PT + s0 * 2) = (u32x2_t){pk2(m[0], m[1]), pk2(m[2], m[3])}; }
            }
            WG_BAR(); STAMP2(14);
            {
                int tq = tid0, w = w0; OPQ_V(tq); OPQ_S(w);
                const int lane = tq & 63, r16 = lane & 15, q = lane >> 4, pi = w >> 1, li0 = 2 * (w & 1);
                const LAS float* ac = (const LAS float*)(L + SL_AC) + par * 64;
#pragma unroll
                for (int t = 0; t < 2; ++t) { const int li = li0 + t; f4 yd = (f4){0.f, 0.f, 0.f, 0.f}, yo = (f4){0.f, 0.f, 0.f, 0.f};
#pragma unroll
                    for (int ks = 0; ks < 2; ++ks) yd = __builtin_amdgcn_mfma_f32_16x16x32_bf16(ld_op_sw(L + SL_XT, 16 * pi + r16, PT, 32 * ks + 8 * q), ld_op(L + SL_M, 16 * li + r16, PT, 32 * ks + 8 * q), yd, 0, 0, 0);
#pragma unroll
                    for (int ks = 0; ks < 4; ++ks) yo = __builtin_amdgcn_mfma_f32_16x16x32_bf16(ld_op(L + SL_H, 16 * pi + r16, PC, 32 * ks + 8 * q), ld_op(L + SL_C, 16 * li + r16, PC, 32 * ks + 8 * q), yo, 0, 0, 0);
                    const int lr = 16 * li + r16, p0 = 16 * pi + 4 * q; const float e = __expf(ac[lr]);
                    const float zf[4] = {bflo(zq[t].x), bfhi(zq[t].x), bflo(zq[t].y), bfhi(zq[t].y)}; float yz[4], ss = 0.f;
#pragma unroll
                    for (int r = 0; r < 4; ++r) { const float xv = bf2f(*(const LAS bf16*)(L + SL_XT + (p0 + r) * PT + swz(p0 + r, lr * 2))); const float y = yd[r] + e * yo[r] + Dsk * xv; yz[r] = y * silu_f(zf[r]); ss += yz[r] * yz[r]; }
                    if (lr < rows) { char* ub = (char*)MIXA + ((size_t)(rb + tb + 16 * li) * D_MIX + D_POOL + hh * HD + 16 * pi) * 2; *(uint2*)(ub + (unsigned)(r16 * D_MIX + 4 * q) * 2u) = make_uint2(pk2(yz[0], yz[1]), pk2(yz[2], yz[3])); }
                    ss += __shfl_xor(ss, 16); ss += __shfl_xor(ss, 32);
                    if (q == 0) ((LAS float*)(L + SL_SSQ))[lr * 4 + pi] = ss; }
            }
            {
                int tq = tid0, w = w0; OPQ_V(tq); OPQ_S(w);
                const int lane = tq & 63, r16 = lane & 15, q = lane >> 4;
                const float dec = ((const LAS float*)(L + SL_DEC))[par];
#pragma unroll
                for (int pj = 0; pj < 4; ++pj) { hacc[pj] = hacc[pj] * dec;
#pragma unroll
                    for (int ks = 0; ks < 2; ++ks) hacc[pj] = __builtin_amdgcn_mfma_f32_16x16x32_bf16(ld_op_sw(L + SL_BT, 16 * w + r16, PT, 32 * ks + 8 * q), ld_op_sw(L + SL_XWT, 16 * pj + r16, PT, 32 * ks + 8 * q), hacc[pj], 0, 0, 0); }
            }
            WG_BAR(); STAMP2(15);
            {
                int tq = tid0, w = w0; OPQ_V(tq); OPQ_S(w);
                const int lane = tq & 63, r16 = lane & 15, q = lane >> 4;
#pragma unroll
                for (int pj = 0; pj < 4; ++pj) *(LAS u32x2_t*)(L + SL_H + (16 * pj + r16) * PC + (16 * w + 4 * q) * 2) = (u32x2_t){pk2(hacc[pj][0], hacc[pj][1]), pk2(hacc[pj][2], hacc[pj][3])};
                if (more && tq < 320) { int cg, l0; stage_role(tq, cg, l0); ssd_stage(L, cg, l0, 64, (const LAS float*)(L + SL_W) + (par ^ 1) * 64, rawq); }
                ssd_load_z(zq, PROJ, w, r16, q, hh, (size_t)(rb + tb + 64), rows);
                ssd_load_act(rawq, ACTX, tq, hh, g, (size_t)(rb + tb + 128));
                if (conv_l >= 0 && w >= 5) { const int mp = (w - 5) + 3 * (cslot - 1), mn = (w - 5) + 3 * cslot; LAS float* cscr = (LAS float*)(L + 101376 + (w - 5) * 8448);
                    if (cslot > 0 && mp * cG + cbx < cN) conv_finish(conv_job_ssd(C, conv_l, mp * cG + cbx), lane, cwv, cgl, cscr);
                    if (mn * cG + cbx < cN) conv_issue(conv_job_ssd(C, conv_l, mn * cG + cbx), lane, cwv, cgl); }
                ++cslot;
                if (tq >= 448 && (tq - 448) < rows) { const int lr = tq - 448; const f4 s4 = *(const LAS f4*)(L + SL_SSQ + lr * 16); SSQH[(size_t)(rb + tb + lr) * 32 + hh] = (s4[0] + s4[1]) + (s4[2] + s4[3]); }
            }
            WG_BAR();
            STAMP2(16);
        }
        {
            int tq = tid0, w = w0; OPQ_V(tq); OPQ_S(w);
            const int lane = tq & 63, r16 = lane & 15, q = lane >> 4;
            float* ho = C.out + (prm ? O_SSDP + (((size_t)l * NB_P + b) * NH + hh) * HD * DS : O_SSDS + (((size_t)l * NB_S + b) * NH + hh) * HD * DS);
#pragma unroll
            for (int pj = 0; pj < 4; ++pj) *(float4*)(ho + (size_t)(16 * pj + r16) * DS + 16 * w + 4 * q) = make_float4(hacc[pj][0], hacc[pj][1], hacc[pj][2], hacc[pj][3]); }
    }
    if (conv_l >= 0) {
        int tq = tid0, w = w0; OPQ_V(tq); OPQ_S(w); const int lane = tq & 63;
        if (w >= 5 && cslot > 0) { const int mp = (w - 5) + 3 * (cslot - 1); if (mp * cG + cbx < cN) conv_finish(conv_job_ssd(C, conv_l, mp * cG + cbx), lane, cwv, cgl, (LAS float*)(L + 101376 + (w - 5) * 8448)); }
        WG_BAR();
        for (int m = 3 * cslot + w; m * cG + cbx < cN; m += NWAVES) { const ConvJob j = conv_job_ssd(C, conv_l, m * cG + cbx); float wv2[32], gl2; conv_issue(j, lane, wv2, gl2); conv_finish(j, lane, wv2, gl2, (LAS float*)(L + w * 16384)); }
    }
}

#undef tid0
constexpr int PH_CONV = 0, PH_FOLD = 1, PH_L0 = 2, PH_PER_L = 10, N_PHASES = PH_L0 + DEPTH * PH_PER_L;
constexpr int CW_BAR = 4096;

__global__ void __launch_bounds__(NTHR, 2) fwd_kernel(Args args) {
    extern __shared__ __attribute__((aligned(16))) unsigned char lds_raw[];
    Ctx C; C.lds = (LAS unsigned char*)lds_raw; C.G = gridDim.x; C.in = args.in; C.out = args.out; C.ws = args.ws; C.wave0 = __builtin_amdgcn_readfirstlane(threadIdx.x >> 6); C.refresh();
    volatile LAS unsigned* MISC = (volatile LAS unsigned*)(C.lds + LDSCTL_OFF);
    if (threadIdx.x < 64) MISC[threadIdx.x] = 0u;
#define LEAD() (C.wave0 == 0 && lane_id() == 0)
    __syncthreads();
    const int lo = args.ph_lo, hi = args.ph_hi;
    unsigned* barw = (unsigned*)(args.ws + WS_CTL) + CW_BAR;
    XcdBarrier bar; bar.bar = barw; bar.x = 0; bar.st = MISC + 8;
    if (hi - lo > 1) bar = xcd_barrier_post(barw, MISC + 8, LEAD());
#define IN(k) (lo <= (k) && (k) < hi)
#if PROBE_SEL > 0
    if (blockIdx.x == 0 && LEAD()) { MISC[12] = (unsigned)__builtin_amdgcn_s_memrealtime(); MISC[14] = (unsigned)__builtin_amdgcn_s_memrealtime(); MISC[15] = (unsigned)clock64(); }
#define STAMP(ty) do { if (blockIdx.x == 0 && LEAD()) { const unsigned tn = (unsigned)__builtin_amdgcn_s_memrealtime(); MISC[16 + (ty)] += tn - MISC[12]; MISC[12] = tn; } } while (0)
#else
#define STAMP(ty) do { } while (0)
#endif
#define SEAM(k) do { if ((k) + 1 < hi) xcd_barrier(bar, LEAD()); } while (0)
    LAS unsigned char* ring = C.lds;
    const int vcu = (C.G % 8 == 0) ? ((int)blockIdx.x % 8) * (C.G / 8) + (int)blockIdx.x / 8 : (int)blockIdx.x;

    if (IN(PH_CONV)) { phase_convert(C); SEAM(PH_CONV); STAMP(0); }
    for (int l = 0; l < DEPTH; ++l) {
        const int pb = PH_L0 + l * PH_PER_L;
        if (IN(pb + 0)) {
            pg8::Gemm gm{(const bf16*)(C.ws + WS_XB), (const bf16*)(C.ws + WS_BTIN) + (size_t)l * N_INP * DMP, M, N_PROJ, DM, DMP, DMP, 0};
            pg8::StaticOrder S; S.init(M, N_PROJ, C.G, (int)blockIdx.x);
            pg8::EpiBf16S E{(bf16*)(C.ws + WS_PROJ), N_PROJ, (const float*)(C.ws + WS_R), nullptr, -1};
            pg8::gemm_phase<pg8::EpiBf16S, pg8::StaticOrder, true, true>(ring, gm, S, E, C.wave0);
            {
                const int first_light = S.nwg % C.G;
                for (int w = ((int)blockIdx.x - first_light + C.G) % C.G; w < 4 * 8; w += C.G) { const int g = w >> 3, lg = 4 * l + g;
                    pg8::Gemm gf{(const bf16*)(C.ws + WS_WOP) + (size_t)l * DM * D_POOL + g * 256, (const bf16*)(C.ws + WS_WPB) + (size_t)lg * 65536, DM, 256, 256, D_POOL, 256, 0};
                    pg8::StaticOrder Sf; Sf.init(DM, 256, 8, w & 7);
                    pg8::EpiBf16S Ef{(bf16*)(C.ws + WS_BTOUT) + (size_t)l * DM * D_MIX + g * 256, D_MIX, nullptr, nullptr, -1};
                    pg8::gemm_phase<pg8::EpiBf16S, pg8::StaticOrder, true, true>(ring, gf, Sf, Ef, C.wave0); } }
            phase_dt(C, l);
            STAMP(17); SEAM(pb + 0); STAMP(2);
        }
        if (IN(pb + 1)) { phase_xact(C, l); phase_pool(C, l); STAMP(12); SEAM(pb + 1); STAMP(3); }
        if (IN(pb + 2)) { phase_ssd2(C, l); STAMP(11); SEAM(pb + 2); STAMP(19); }
        if (IN(pb + 4)) {
            {
                pg8::Gemm gm{(const bf16*)(C.ws + WS_MIXA), (const bf16*)(C.ws + WS_BTOUT) + (size_t)l * DM * D_MIX, MP, DM, D_MIX, D_MIX, D_MIX, 0};
                pg8::FactorOrder S; S.init(MP, DM, C.G, (int)blockIdx.x); S.ssqh = (const float*)(C.ws + WS_SSQH); S.ft = (LAS float*)(C.lds + LDSCTL_OFF + 1024); S.wave0 = C.wave0; S.eps = EPS;
                pg8::EpiBf16SsqG E{(bf16*)(C.ws + WS_MIX), DM, (float*)(C.ws + WS_SSQP), (const LAS float*)(C.lds + LDSCTL_OFF + 1024), D_POOL / 64, (D_POOL + 1024) / 64};
                pg8::gemm_phase<pg8::EpiBf16SsqG, pg8::FactorOrder, true, true>(ring, gm, S, E, C.wave0); }
            {
                pg8::Gemm gm{(const bf16*)(C.ws + WS_MIXA) + (size_t)MP * D_MIX, (const bf16*)(C.ws + WS_BTOUT) + (size_t)l * DM * D_MIX, MS, DM, D_MIX / KS_OUT, D_MIX, D_MIX, D_MIX / KS_OUT};
                pg8::SplitKOrder S; S.init(MS, DM, KS_OUT, C.G, vcu);
                pg8::EpiF32Slab E{(float*)(C.ws + WS_SLAB), DM, MS};
                pg8::gemm_phase<pg8::EpiF32Slab, pg8::SplitKOrder, true, true>(ring, gm, S, E, C.wave0); }
            STAMP(17); SEAM(pb + 4); STAMP(5);
        }
        if (IN(pb + 5)) { phase_resid(C, C.in[17] + l * DM, false, KS_OUT, true); SEAM(pb + 5); STAMP(6); }
        if (IN(pb + 6)) {
            pg8::Gemm gm{(const bf16*)(C.ws + WS_XB), (const bf16*)(C.ws + WS_BTUP) + (size_t)l * D_UP * DMP, M, D_UP, DM, DMP, DMP, 0};
            pg8::StaticOrder S; S.init(M, D_UP, C.G, (int)blockIdx.x);
            pg8::EpiUpAct E{(bf16*)(C.ws + WS_ACT), (bf16*)(C.ws + WS_UP), (bf16*)(C.ws + WS_SIDE), (const float*)(C.ws + WS_R), C.in[20] + (size_t)l * 3 * D_UP, C.in[21] + (size_t)l * D_UP, D_FF, (LAS float*)(C.lds + LDSCTL_OFF + 1024)};
            pg8::gemm_phase<pg8::EpiUpAct, pg8::StaticOrder, true, true>(ring, gm, S, E, C.wave0);
            STAMP(17); SEAM(pb + 6); STAMP(7);
        }
        if (IN(pb + 7)) { phase_act(C, l); phase_actfix(C, l); SEAM(pb + 7); STAMP(8); }
        if (IN(pb + 8)) {
            {
                pg8::Gemm gm{(const bf16*)(C.ws + WS_ACT), (const bf16*)(C.ws + WS_BTDN) + (size_t)l * DM * D_FF, MP, DM, D_FF, D_FF, D_FF, 0};
                pg8::StaticOrder S; S.init(MP, DM, C.G, (int)blockIdx.x);
                pg8::EpiBf16Ssq E{(bf16*)(C.ws + WS_MIX), DM, (float*)(C.ws + WS_SSQP)};
                pg8::gemm_phase<pg8::EpiBf16Ssq, pg8::StaticOrder, true, true>(ring, gm, S, E, C.wave0); }
            {
                pg8::Gemm gm{(const bf16*)(C.ws + WS_ACT) + (size_t)MP * D_FF, (const bf16*)(C.ws + WS_BTDN) + (size_t)l * DM * D_FF, MS, DM, D_FF / KS_DN, D_FF, D_FF, D_FF / KS_DN};
                pg8::SplitKOrder S; S.init(MS, DM, KS_DN, C.G, vcu);
                pg8::EpiF32Slab E{(float*)(C.ws + WS_SLAB), DM, MS};
                pg8::gemm_phase<pg8::EpiF32Slab, pg8::SplitKOrder, true, true>(ring, gm, S, E, C.wave0); }
            STAMP(17); SEAM(pb + 8); STAMP(9);
        }
        if (IN(pb + 9)) { phase_resid(C, C.in[23] + l * DM, l == DEPTH - 1, KS_DN, false); SEAM(pb + 9); STAMP(10); }
    }
#if PROBE_SEL > 0
    if (blockIdx.x == 0 && LEAD()) { asm volatile("s_waitcnt vmcnt(0)" ::: "memory"); unsigned tot = 0; for (int ty = 0; ty < 20; ++ty) if ((PROBE_SEL >> ty) & 1) tot += MISC[16 + ty]; C.out[0] = (float)tot * 0.0001f;
        if (PROBE_SEL & (1 << 30)) { const unsigned dc = (unsigned)clock64() - MISC[15], dt = (unsigned)__builtin_amdgcn_s_memrealtime() - MISC[14]; C.out[0] = 5.f * (float)dc / (float)dt; } }
#endif
#undef IN
#undef SEAM
}

extern "C" void kernel_launch(void* const* d_in, const int* in_sizes, int n_in, void* d_out, int out_size, void* d_ws, size_t ws_size, hipStream_t stream) {
    static int grid = 0;
    if (grid == 0) {
        if (n_in != 24 || (size_t)out_size != O_END || ws_size < WS_END) { fprintf(stderr, "kernel_launch: shape mismatch: n_in %d out %d (want %zu) ws %zu (need %zu)\n", n_in, out_size, (size_t)O_END, ws_size, (size_t)WS_END); grid = -1; return; }
        int dev = 0, cus = 0, per_cu = 0;
        if (hipGetDevice(&dev) != hipSuccess || hipDeviceGetAttribute(&cus, hipDeviceAttributeMultiprocessorCount, dev) != hipSuccess) { grid = -1; return; }
        if (hipFuncSetAttribute((const void*)fwd_kernel, hipFuncAttributeMaxDynamicSharedMemorySize, LDS_BYTES) != hipSuccess) { fprintf(stderr, "kernel_launch: hipFuncSetAttribute failed\n"); grid = -1; return; }
        if (hipOccupancyMaxActiveBlocksPerMultiprocessor(&per_cu, (const void*)fwd_kernel, NTHR, LDS_BYTES) != hipSuccess || per_cu < 1) fprintf(stderr, "kernel_launch: occupancy query reports %d\n", per_cu);
        (void)hipGetLastError();
        grid = cus;
    }
    if (grid < 0) return;
    if (hipMemsetAsync((char*)d_ws + WS_CTL, 0, CTL_BYTES, stream) != hipSuccess) return;
    Args a{};
    for (int i = 0; i < 24; ++i) a.in[i] = (const float*)d_in[i];
    a.out = (float*)d_out; a.ws = (unsigned char*)d_ws;
#if MK_MULTI
    for (int k = 0; k < N_PHASES; ++k) { a.ph_lo = k; a.ph_hi = k + 1; hipLaunchKernelGGL(fwd_kernel, dim3(grid), dim3(NTHR), LDS_BYTES, stream, a); }
#else
    a.ph_lo = 0; a.ph_hi = N_PHASES; hipLaunchKernelGGL(fwd_kernel, dim3(grid), dim3(NTHR), LDS_BYTES, stream, a);
#endif
}
```
